# Optimizing an MI355X kernel written in HIP

```python
import math
import jax, jax.numpy as jnp
from jax import lax
import numpy as np

D_MODEL = 1024
BATCH = 2
SEQ = 8192
DEPTH = 1

CONV_DIM = 512
CONV_WIDTH = 31
CONV_GROUPS = 8
N_HEADS = 8
HEAD_DIM = 64
ATTN_DIM = N_HEADS * HEAD_DIM
Q_BLOCK = 128
N_EXPERTS = 64
TOP_K = 8
N_GROUPS = 8
TOPK_GROUPS = 4
EXPERT_DIM = 256
SHARED_DIM = 256
ROUTED_SCALE = 2.5
TOKEN_CHUNK_MAX = 1024
EPS = 1e-6

OFF_CONV = 0
OFF_Q = OFF_CONV + 2 * CONV_DIM
OFF_K = OFF_Q + ATTN_DIM
OFF_V = OFF_K + ATTN_DIM
OFF_F = OFF_V + ATTN_DIM
OFF_GC = OFF_F + N_HEADS
OFF_GA = OFF_GC + D_MODEL
IN_COLS = OFF_GA + D_MODEL

kernel_name = "hybrid_conformer_fox_moe_block"


def rms_norm(x, g):
    xf = x.astype(jnp.float32)
    y = xf * lax.rsqrt(jnp.mean(xf * xf, axis=-1, keepdims=True) + EPS)
    return (y * g).astype(x.dtype)


def group_norm(u, g, b):
    B, S, C = u.shape
    uf = u.astype(jnp.float32).reshape(B, S, CONV_GROUPS, C // CONV_GROUPS)
    mu = jnp.mean(uf, axis=-1, keepdims=True)
    var = jnp.mean(jnp.square(uf - mu), axis=-1, keepdims=True)
    y = ((uf - mu) * lax.rsqrt(var + EPS)).reshape(B, S, C)
    return (y * g + b).astype(u.dtype)


def conformer_conv(a, gate, w_dw, b_dw, gn_g, gn_b, w_conv_out):
    u = a * jax.nn.sigmoid(gate)
    u = lax.conv_general_dilated(
        u, w_dw[:, None, :].astype(u.dtype), window_strides=(1,),
        padding=[(CONV_WIDTH - 1, 0)],
        dimension_numbers=('NWC', 'WIO', 'NWC'),
        feature_group_count=CONV_DIM) + b_dw
    u = jax.nn.silu(group_norm(u, gn_g, gn_b))
    return u @ w_conv_out


def forgetting_attention(q, k, v, log_f):
    S = q.shape[2]
    cum = jnp.cumsum(log_f, axis=-1)
    scale = HEAD_DIM ** -0.5
    neg = jnp.finfo(jnp.float32).min
    outs = []
    for i in range(S // Q_BLOCK):
        q0, q1 = i * Q_BLOCK, (i + 1) * Q_BLOCK
        s = jnp.einsum('bhqd,bhkd->bhqk', q[:, :, q0:q1], k[:, :, :q1],
                       preferred_element_type=jnp.float32) * scale
        s = s + cum[:, :, q0:q1, None] - cum[:, :, None, :q1]
        causal = (q0 + jnp.arange(Q_BLOCK))[:, None] >= jnp.arange(q1)[None, :]
        p = jax.nn.softmax(jnp.where(causal, s, neg), axis=-1)
        outs.append(jnp.einsum('bhqk,bhkd->bhqd', p.astype(v.dtype), v[:, :, :q1]))
    return jnp.concatenate(outs, axis=2)


def mixer_sublayer(h, w_in, w_dw, b_dw, gn_g, gn_b, w_conv_out, q_norm_g, k_norm_g,
                   b_forget, w_attn_out, w_out):
    B, S, _ = h.shape
    p = h @ w_in
    y_conv = conformer_conv(p[..., OFF_CONV:OFF_CONV + CONV_DIM],
                            p[..., OFF_CONV + CONV_DIM:OFF_Q],
                            w_dw, b_dw, gn_g, gn_b, w_conv_out)
    q = rms_norm(p[..., OFF_Q:OFF_K].reshape(B, S, N_HEADS, HEAD_DIM), q_norm_g)
    k = rms_norm(p[..., OFF_K:OFF_V].reshape(B, S, N_HEADS, HEAD_DIM), k_norm_g)
    v = p[..., OFF_V:OFF_F].reshape(B, S, N_HEADS, HEAD_DIM)
    log_f = jax.nn.log_sigmoid((p[..., OFF_F:OFF_GC] + b_forget).astype(jnp.float32))
    o = forgetting_attention(q.transpose(0, 2, 1, 3), k.transpose(0, 2, 1, 3),
                             v.transpose(0, 2, 1, 3), log_f.transpose(0, 2, 1))
    y_attn = o.transpose(0, 2, 1, 3).reshape(B, S, ATTN_DIM) @ w_attn_out
    merged = (jax.nn.sigmoid(p[..., OFF_GC:OFF_GA]) * y_conv
              + jax.nn.sigmoid(p[..., OFF_GA:IN_COLS]) * y_attn)
    return merged @ w_out


def moe_sublayer(h, w_router, router_bias, w_experts_gate_up, w_experts_down,
                 w_shared_gate_up, w_shared_down):
    B, S, D = h.shape
    T = B * S
    t = h.reshape(T, D)
    scores = jax.nn.sigmoid((t @ w_router).astype(jnp.float32))
    biased = scores + router_bias.astype(jnp.float32)
    grp = biased.reshape(T, N_GROUPS, N_EXPERTS // N_GROUPS)
    grp_score = lax.top_k(grp, 2)[0].sum(-1)
    _, gidx = lax.top_k(grp_score, TOPK_GROUPS)
    gmask = jax.nn.one_hot(gidx, N_GROUPS, dtype=jnp.float32).sum(1) > 0
    emask = jnp.repeat(gmask, N_EXPERTS // N_GROUPS, axis=-1)
    _, eidx = lax.top_k(jnp.where(emask, biased, -jnp.inf), TOP_K)
    w = jnp.take_along_axis(scores, eidx, axis=-1)
    w = w / jnp.sum(w, axis=-1, keepdims=True) * ROUTED_SCALE
    combine = jnp.sum(jax.nn.one_hot(eidx, N_EXPERTS, dtype=jnp.float32) * w[..., None],
                      axis=1).astype(h.dtype)
    chunk = math.gcd(T, TOKEN_CHUNK_MAX)

    def expert_chunk(args):
        tc, cc = args
        gu = jnp.einsum('cd,edf->cef', tc, w_experts_gate_up)
        act = jax.nn.silu(gu[..., :EXPERT_DIM]) * gu[..., EXPERT_DIM:] * cc[..., None]
        return jnp.einsum('cef,efd->cd', act, w_experts_down)

    routed = lax.map(expert_chunk, (t.reshape(T // chunk, chunk, D),
                                    combine.reshape(T // chunk, chunk, N_EXPERTS))).reshape(T, D)
    sgu = t @ w_shared_gate_up
    shared = (jax.nn.silu(sgu[:, :SHARED_DIM]) * sgu[:, SHARED_DIM:]) @ w_shared_down
    return (routed + shared).reshape(B, S, D)


def setup_inputs(seed: int = 0) -> dict:
    key = jax.random.key(seed)
    ks = jax.random.split(key, 24)
    L, D = DEPTH, D_MODEL
    f32 = jnp.float32

    def nrm(k, shape, scale):
        return jax.random.normal(k, shape, f32) * scale

    return {
        "x": nrm(ks[0], (BATCH, SEQ, D), 1.0),
        "c": nrm(ks[1], (BATCH, D), 1.0),
        "w_ada": nrm(ks[2], (L, D, 6 * D), 0.1 * D ** -0.5),
        "b_ada": nrm(ks[3], (L, 6 * D), 0.02),
        "norm1_g": 1.0 + nrm(ks[4], (L, D), 0.02),
        "w_in": nrm(ks[5], (L, D, IN_COLS), D ** -0.5),
        "w_dw": nrm(ks[6], (L, CONV_WIDTH, CONV_DIM), CONV_WIDTH ** -0.5),
        "b_dw": nrm(ks[7], (L, CONV_DIM), 0.02),
        "conv_gn_g": 1.0 + nrm(ks[8], (L, CONV_DIM), 0.02),
        "conv_gn_b": nrm(ks[9], (L, CONV_DIM), 0.02),
        "w_conv_out": nrm(ks[10], (L, CONV_DIM, D), CONV_DIM ** -0.5),
        "q_norm_g": 1.0 + nrm(ks[11], (L, HEAD_DIM), 0.02),
        "k_norm_g": 1.0 + nrm(ks[12], (L, HEAD_DIM), 0.02),
        "b_forget": 2.0 + nrm(ks[13], (L, N_HEADS), 0.1),
        "w_attn_out": nrm(ks[14], (L, ATTN_DIM, D), ATTN_DIM ** -0.5),
        "w_out": nrm(ks[15], (L, D, D), D ** -0.5),
        "norm2_g": 1.0 + nrm(ks[16], (L, D), 0.02),
        "w_router": nrm(ks[17], (L, D, N_EXPERTS), D ** -0.5),
        "router_bias": nrm(ks[18], (L, N_EXPERTS), 0.01),
        "w_experts_gate_up": nrm(ks[19], (L, N_EXPERTS, D, 2 * EXPERT_DIM), D ** -0.5),
        "w_experts_down": nrm(ks[20], (L, N_EXPERTS, EXPERT_DIM, D), EXPERT_DIM ** -0.5),
        "w_shared_gate_up": nrm(ks[21], (L, D, 2 * SHARED_DIM), D ** -0.5),
        "w_shared_down": nrm(ks[22], (L, SHARED_DIM, D), SHARED_DIM ** -0.5),
    }


def reference(x, c, w_ada, b_ada, norm1_g, w_in, w_dw, b_dw, conv_gn_g, conv_gn_b,
              w_conv_out, q_norm_g, k_norm_g, b_forget, w_attn_out, w_out, norm2_g,
              w_router, router_bias, w_experts_gate_up, w_experts_down,
              w_shared_gate_up, w_shared_down):
    for l in range(DEPTH):
        mod = jax.nn.silu(c) @ w_ada[l] + b_ada[l]
        shift1, scale1, gate1, shift2, scale2, gate2 = jnp.split(mod[:, None, :], 6, axis=-1)
        h = rms_norm(x, norm1_g[l]) * (1.0 + scale1) + shift1
        x = x + gate1 * mixer_sublayer(h, w_in[l], w_dw[l], b_dw[l], conv_gn_g[l], conv_gn_b[l],
                                       w_conv_out[l], q_norm_g[l], k_norm_g[l], b_forget[l],
                                       w_attn_out[l], w_out[l])
        h = rms_norm(x, norm2_g[l]) * (1.0 + scale2) + shift2
        x = x + gate2 * moe_sublayer(h, w_router[l], router_bias[l], w_experts_gate_up[l],
                                     w_experts_down[l], w_shared_gate_up[l], w_shared_down[l])
    return x
```

```cpp
#include <hip/hip_runtime.h>
#include <hip/hip_bf16.h>
#include <cstdio>
#include <cstdint>
#include <cmath>

#ifndef ATTN_SKIP
#define ATTN_SKIP 0
#endif
#ifndef FWD_LEVEL
#define FWD_LEVEL 2
#endif

namespace pg8 {
#define PG8_LAS __attribute__((address_space(3)))
typedef unsigned short bf16_t;
typedef short bf16x8 __attribute__((ext_vector_type(8)));
typedef float f32x4 __attribute__((ext_vector_type(4)));
typedef unsigned u32x4 __attribute__((ext_vector_type(4)));
constexpr int BM = 256, BK = 64, HALF = 128, HTB = HALF * BK * 2  , STAGE_BYTES = 8 * HTB, NXCD = 8, WGM = 8;

__host__ __device__ __forceinline__ int lds_byte(int r, int c) { const int st = (r >> 4) * 2 + (c >> 5), rr = r & 15, cc = c & 31, ob = rr * 64 + cc * 2; return st * 1024 + (ob ^ (((ob >> 9) & 1) << 5)); }
__host__ __device__ __forceinline__ void stage_rc(int b, int& R, int& C) { const int st = b / 1024, sb = b % 1024, swz = sb ^ (((sb >> 9) & 1) << 5); R = (st >> 1) * 16 + swz / 64; C = (st & 1) * 32 + (swz % 64) / 2; }
__host__ __device__ __forceinline__ int perm32(int rho) { const int n = rho >> 4, i = rho & 15; return 8 * (i >> 2) + 4 * n + (i & 3); }

struct Unit { int pm, pn, e, mt; const char* A; const char* B; };

__host__ __device__ __forceinline__ void tile_of(int L, int nM, int nN, int& pm, int& pn) {
    const int nwg = nM * nN; int wgid = L; { const int q = nwg / NXCD, r = nwg % NXCD, xcd = wgid % NXCD, off = wgid / NXCD; wgid = (xcd < r ? xcd * (q + 1) : r * (q + 1) + (xcd - r) * q) + off; }
    const int nig = WGM * nN, gid = wgid / nig, fm = gid * WGM, gsz = (nM - fm) < WGM ? (nM - fm) : WGM;
    pm = fm + ((wgid % nig) % gsz); pn = (wgid % nig) / gsz;
}
typedef float f32x2_c __attribute__((ext_vector_type(2))); typedef __bf16 bf16x2_c __attribute__((ext_vector_type(2)));
__device__ __forceinline__ unsigned cvt_pk_bf16(float lo, float hi) { f32x2_c v = {lo, hi}; bf16x2_c b = __builtin_convertvector(v, bf16x2_c); return __builtin_bit_cast(unsigned, b); }
__device__ __forceinline__ float bf_lo(unsigned w) { return __builtin_bit_cast(float, w << 16); }
__device__ __forceinline__ float bf_hi(unsigned w) { return __builtin_bit_cast(float, w & 0xffff0000u); }
__device__ __forceinline__ float sigmoidf_fast(float x) { return __builtin_amdgcn_rcpf(1.0f + __builtin_amdgcn_exp2f(-1.4426950408889634f * x)); }

template <class Epi, class Sched, bool ALIGN_EPI>
__device__ __forceinline__ void gemm_phase(PG8_LAS unsigned char* lds, const int K, const Sched& S, const Epi& E) {
    const int tid = threadIdx.x, wid = __builtin_amdgcn_readfirstlane(tid >> 6), lane = tid & 63, wr = wid >> 2, wc = wid & 3, fr = lane & 15, fq = lane >> 4;
    const int nt = K / BK;
    int sR[2], sC[2]; unsigned voffB[2];
#pragma unroll
    for (int i = 0; i < 2; ++i) { int R, C; stage_rc(tid * 16 + i * 8192, R, C); sR[i] = R; sC[i] = C; const int Rb = Epi::PERM ? ((R & ~31) + perm32(R & 31)) : R; voffB[i] = (unsigned)(Rb * K + C) * 2u; }
    const size_t kstep = (size_t)(BK * 2);
    const size_t hstep = (size_t)HALF * K * 2;
    const unsigned ldsw = (unsigned)wid * 1024u;
    const int aoff = lds_byte(wr * 64 + fr, fq * 8), boff = lds_byte(wc * 32 + fr, fq * 8);
#define PG8_SA(b, h) (((b) * 2 + (h)) * HTB)
#define PG8_SB(b, h) ((4 + (b) * 2 + (h)) * HTB)
#define PG8_STAGE(bufoff, gbase, voff) do { _Pragma("unroll") for (int _i = 0; _i < 2; ++_i) \
        __builtin_amdgcn_global_load_lds((const unsigned*)((const char*)(gbase) + (voff)[_i]), (PG8_LAS unsigned*)(lds + (bufoff) + ldsw + _i * 8192), 16, 0, 0); } while (0)
#define PG8_STAGE_A(bufoff, gbase, h, V0, V1) do { if constexpr (Sched::GATHER) { if (h) PG8_STAGE(bufoff, gbase, V1); else PG8_STAGE(bufoff, gbase, V0); } \
        else { PG8_STAGE(bufoff, (const char*)(gbase) + ((h) ? hstep : 0), V0); } } while (0)
#define PG8_LDA(dst, b, h) do { _Pragma("unroll") for (int m = 0; m < 4; ++m) _Pragma("unroll") for (int k = 0; k < 2; ++k) dst[m][k] = *(const PG8_LAS bf16x8*)(lds + PG8_SA(b, h) + aoff + m * 2048 + k * 1024); } while (0)
#define PG8_LDB(dst, b, h) do { _Pragma("unroll") for (int n = 0; n < 2; ++n) _Pragma("unroll") for (int k = 0; k < 2; ++k) dst[n][k] = *(const PG8_LAS bf16x8*)(lds + PG8_SB(b, h) + boff + n * 2048 + k * 1024); } while (0)
#define PG8_MMA(ai, bj, At, Bt) do { __builtin_amdgcn_s_setprio(1); _Pragma("unroll") for (int m = 0; m < 4; ++m) _Pragma("unroll") for (int n = 0; n < 2; ++n) _Pragma("unroll") for (int k = 0; k < 2; ++k) \
        acc[ai][bj][m][n] = __builtin_amdgcn_mfma_f32_16x16x32_bf16(Bt[n][k], At[m][k], acc[ai][bj][m][n], 0, 0, 0); __builtin_amdgcn_s_setprio(0); } while (0)
#define PG8_WAIT_V(n) asm volatile("s_waitcnt vmcnt(" #n ")" ::: "memory")
#define PG8_WAIT_L(n) asm volatile("s_waitcnt lgkmcnt(" #n ")" ::: "memory")
#define PG8_BAR __builtin_amdgcn_s_barrier()
#define PG8_SCHED __builtin_amdgcn_sched_barrier(0)
    Unit cur, nxt; int ui = 0;
    if (!S.next(0, cur)) return;
    unsigned vc0[2], vc1[2], vn0[2], vn1[2];
#pragma unroll
    for (int i = 0; i < 2; ++i) {
        if constexpr (Sched::GATHER) { vc0[i] = (unsigned)(S.row(cur, sR[i]) * K + sC[i]) * 2u; vc1[i] = (unsigned)(S.row(cur, HALF + sR[i]) * K + sC[i]) * 2u; }
        else { vc0[i] = (unsigned)(sR[i] * K + sC[i]) * 2u; vc1[i] = 0u; }
        vn0[i] = vc0[i]; vn1[i] = vc1[i];
    }
    f32x4 acc[2][2][4][2];
#pragma unroll
    for (int a = 0; a < 2; ++a)
#pragma unroll
        for (int b = 0; b < 2; ++b)
#pragma unroll
            for (int m = 0; m < 4; ++m)
#pragma unroll
                for (int n = 0; n < 2; ++n) acc[a][b][m][n] = (f32x4){0.f, 0.f, 0.f, 0.f};
    bf16x8 At[4][2], B0[2][2], B1[2][2];
    const char* cA = cur.A; const char* cB = cur.B;
    PG8_STAGE(PG8_SB(0, 0), cB, voffB); PG8_STAGE(PG8_SB(0, 1), cB + hstep, voffB); PG8_STAGE_A(PG8_SA(0, 0), cA, 0, vc0, vc1); PG8_STAGE_A(PG8_SA(0, 1), cA, 1, vc0, vc1);
    if (wr == 1) PG8_BAR;
    PG8_WAIT_V(2); PG8_BAR;
    PG8_STAGE(PG8_SB(1, 0), cB + kstep, voffB); PG8_STAGE_A(PG8_SA(1, 0), cA + kstep, 0, vc0, vc1); PG8_STAGE(PG8_SB(1, 1), cB + hstep + kstep, voffB);
    PG8_WAIT_V(6); PG8_BAR;
    for (;;) {
        const bool has_next = S.next(ui + 1, nxt);
        const char* nA = has_next ? nxt.A : cA; const char* nB = has_next ? nxt.B : cB;
        if constexpr (Sched::GATHER) {
            if (has_next) {
#pragma unroll
                for (int i = 0; i < 2; ++i) { vn0[i] = (unsigned)(S.row(nxt, sR[i]) * K + sC[i]) * 2u; vn1[i] = (unsigned)(S.row(nxt, HALF + sR[i]) * K + sC[i]) * 2u; }
            }
        }
#pragma nounroll
        for (int t = 0; t < nt; t += 2) {
            const bool last = (t == nt - 2);
            const char* a1 = cA + (size_t)(t + 1) * kstep;
            const char* a2 = last ? nA : cA + (size_t)(t + 2) * kstep; const char* b2 = last ? nB : cB + (size_t)(t + 2) * kstep;
            const char* a3 = a2 + kstep; const char* b3 = b2 + kstep;
            unsigned w0[2], w1[2];
#pragma unroll
            for (int i = 0; i < 2; ++i) { if constexpr (Sched::GATHER) { w0[i] = last ? vn0[i] : vc0[i]; w1[i] = last ? vn1[i] : vc1[i]; } else { w0[i] = vc0[i]; w1[i] = 0u; } }
            PG8_LDB(B0, 0, 0); PG8_LDB(B1, 0, 1); PG8_SCHED; PG8_LDA(At, 0, 0); PG8_STAGE_A(PG8_SA(1, 1), a1, 1, vc0, vc1);
            PG8_WAIT_V(8); PG8_WAIT_L(0); PG8_BAR; PG8_MMA(0, 0, At, B0); PG8_MMA(0, 1, At, B1); PG8_BAR; PG8_SCHED;
            PG8_LDA(At, 0, 1); PG8_STAGE(PG8_SB(0, 0), b2, voffB); PG8_STAGE(PG8_SB(0, 1), b2 + hstep, voffB); PG8_STAGE_A(PG8_SA(0, 0), a2, 0, w0, w1);
            PG8_WAIT_V(8); PG8_WAIT_L(0); PG8_BAR; PG8_MMA(1, 0, At, B0); PG8_MMA(1, 1, At, B1); PG8_BAR; PG8_SCHED;
            PG8_LDB(B0, 1, 0); PG8_LDB(B1, 1, 1); PG8_SCHED; PG8_LDA(At, 1, 0); PG8_STAGE_A(PG8_SA(0, 1), a2, 1, w0, w1);
            PG8_WAIT_V(8); PG8_WAIT_L(0); PG8_BAR; PG8_MMA(0, 0, At, B0); PG8_MMA(0, 1, At, B1); PG8_BAR; PG8_SCHED;
            PG8_LDA(At, 1, 1); PG8_STAGE(PG8_SB(1, 0), b3, voffB); PG8_STAGE(PG8_SB(1, 1), b3 + hstep, voffB); PG8_STAGE_A(PG8_SA(1, 0), a3, 0, w0, w1);
            PG8_WAIT_V(8); PG8_WAIT_L(0); PG8_BAR; PG8_MMA(1, 0, At, B0); PG8_MMA(1, 1, At, B1); PG8_BAR; PG8_SCHED;
        }
        if constexpr (ALIGN_EPI) { if (wr == 0) PG8_BAR; }
        E(acc, cur, wr, wc, fr, fq);
        if (!has_next) break;
#pragma unroll
        for (int a = 0; a < 2; ++a)
#pragma unroll
            for (int b = 0; b < 2; ++b)
#pragma unroll
                for (int m = 0; m < 4; ++m)
#pragma unroll
                    for (int n = 0; n < 2; ++n) acc[a][b][m][n] = (f32x4){0.f, 0.f, 0.f, 0.f};
        cur = nxt; cA = nA; cB = nB; ++ui;
#pragma unroll
        for (int i = 0; i < 2; ++i) { vc0[i] = vn0[i]; vc1[i] = vn1[i]; }
        if constexpr (ALIGN_EPI) { if (wr == 1) PG8_BAR; }
    }
    PG8_WAIT_V(0);
    if constexpr (!ALIGN_EPI) { if (wr == 0) PG8_BAR; }
    PG8_BAR;
#undef PG8_SA
#undef PG8_SB
#undef PG8_STAGE
#undef PG8_STAGE_A
#undef PG8_LDA
#undef PG8_LDB
#undef PG8_MMA
#undef PG8_WAIT_V
#undef PG8_WAIT_L
#undef PG8_BAR
#undef PG8_SCHED
}
}
#include <hip/hip_bf16.h>
#include <cmath>
namespace attn_body {
using bf16=__hip_bfloat16;
using bf16x8=__attribute__((ext_vector_type(8)))short;
using s16x4=__attribute__((ext_vector_type(4)))short;
using f32x16=__attribute__((ext_vector_type(16)))float;
using u32x4=__attribute__((ext_vector_type(4)))unsigned;
constexpr int BATCH=2,NHEAD=8,SEQ=8192,D=64,DM=NHEAD*D;
constexpr int NW=8,QBLK=32,QB=QBLK*NW,KVBLK=64,NQB=SEQ/QB;
constexpr int ATTN_PITCH=DM, ATTN_UNIT_ROWS=QB;
__device__ __forceinline__ int crow(int r,int hi){return (r&3)+8*(r>>2)+4*hi;}
#define SBAR() __builtin_amdgcn_sched_barrier(0)
__device__ __forceinline__ void cmask(f32x16&p0,f32x16&p1,int jb,int qrel,int hi){
  const float NEG=-INFINITY; const int dq=qrel-(64*jb+4*hi);
  #pragma unroll
  for(int r=0;r<16;++r){const int c=(r&3)+8*(r>>2); if(c>dq)p0[r]=NEG; if(c+32>dq)p1[r]=NEG;}
}

constexpr int NSLOT=3, SLOTB=8192;
constexpr int LDS_K=0, LDS_V=NSLOT*SLOTB, LDS_WS=2*NSLOT*SLOTB, LDS_OST=LDS_WS+NW*64*4, LDS_DK=LDS_OST+NW*4096, LDS_BYTES=LDS_DK+SEQ*4;
constexpr float C2=0.125f*1.4426950408889634f;
__device__ __forceinline__ void glds16(const void*gsrc,unsigned lds_dst){unsigned keep;
  asm volatile("s_mov_b32 %0, m0\n\ts_mov_b32 m0, %2\n\ts_nop 0\n\tglobal_load_lds_dwordx4 %1, off\n\ts_mov_b32 m0, %0":"=&s"(keep):"v"(gsrc),"s"(lds_dst):"memory");}
__device__ __forceinline__ float max3f(float a,float b,float c){float r;asm("v_max3_f32 %0, %1, %2, %3":"=v"(r):"v"(a),"v"(b),"v"(c));return r;}
__device__ __forceinline__ float max2f(float a,float b){float r;asm("v_max_f32_e32 %0, %1, %2":"=v"(r):"v"(a),"v"(b));return r;}
__device__ __forceinline__ float fadd_s(float a,float b){float r;asm("v_add_f32_e32 %0, %1, %2":"=v"(r):"v"(a),"v"(b));return r;}
__device__ __forceinline__ float fsub_s(float a,float b){float r;asm("v_sub_f32_e32 %0, %1, %2":"=v"(r):"v"(a),"v"(b));return r;}
typedef float f32x2_t __attribute__((ext_vector_type(2))); typedef float f32x4_t __attribute__((ext_vector_type(4))); typedef __bf16 bf16x2_t __attribute__((ext_vector_type(2)));
__device__ __forceinline__ unsigned cvtpk_s(float lo,float hi){f32x2_t v={lo,hi};bf16x2_t b=__builtin_convertvector(v,bf16x2_t);return __builtin_bit_cast(unsigned,b);}
#define WAIT_BAR(N) asm volatile("s_waitcnt vmcnt(" #N ") lgkmcnt(0)\n\ts_barrier":::"memory")

__device__ __forceinline__ void qkt(f32x16&p0,f32x16&p1,const char*Kslot,const bf16x8*qr,const f32x16&negm,int r32,int hi){
  const char*kb=Kslot+hi*1024+r32*16;
  #pragma unroll
  for(int d0=0;d0<4;++d0){
    const bf16x8 b0=*reinterpret_cast<const bf16x8*>(kb+d0*2048);
    const bf16x8 b1=*reinterpret_cast<const bf16x8*>(kb+d0*2048+512);
    if(d0==0){p0=__builtin_amdgcn_mfma_f32_32x32x16_bf16(b0,qr[0],negm,0,0,0);p1=__builtin_amdgcn_mfma_f32_32x32x16_bf16(b1,qr[0],negm,0,0,0);}
    else{p0=__builtin_amdgcn_mfma_f32_32x32x16_bf16(b0,qr[d0],p0,0,0,0);p1=__builtin_amdgcn_mfma_f32_32x32x16_bf16(b1,qr[d0],p1,0,0,0);}}
}
typedef __attribute__((address_space(3))) const char* lds_cptr;
typedef short v4i16_t __attribute__((ext_vector_type(4)));
__device__ __forceinline__ void kload8(bf16x8*kf,lds_cptr kp){
  kf[0]=*(const __attribute__((address_space(3))) bf16x8*)(kp);      kf[1]=*(const __attribute__((address_space(3))) bf16x8*)(kp+512);
  kf[2]=*(const __attribute__((address_space(3))) bf16x8*)(kp+2048); kf[3]=*(const __attribute__((address_space(3))) bf16x8*)(kp+2560);
  kf[4]=*(const __attribute__((address_space(3))) bf16x8*)(kp+4096); kf[5]=*(const __attribute__((address_space(3))) bf16x8*)(kp+4608);
  kf[6]=*(const __attribute__((address_space(3))) bf16x8*)(kp+6144); kf[7]=*(const __attribute__((address_space(3))) bf16x8*)(kp+6656);
}
__device__ __forceinline__ void kload2(bf16x8*kf,lds_cptr kp,int j){ kf[2*j]=*(const __attribute__((address_space(3))) bf16x8*)(kp+j*2048); kf[2*j+1]=*(const __attribute__((address_space(3))) bf16x8*)(kp+j*2048+512); }
__device__ __forceinline__ s16x4 vtr(lds_cptr p){ return __builtin_bit_cast(s16x4,__builtin_amdgcn_ds_read_tr16_b64_v4i16((__attribute__((address_space(3))) v4i16_t*)p)); }
__device__ __forceinline__ float rowmax(const f32x16&p0,const f32x16&p1){
  float a=max3f(p0[0],p0[1],p1[0]),b=max3f(p0[2],p0[3],p1[1]);a=max3f(a,p1[2],p1[3]);
  #pragma unroll
  for(int r=4;r<16;r+=4){a=max3f(a,p0[r],p0[r+1]);b=max3f(b,p0[r+2],p0[r+3]);a=max3f(a,p1[r],p1[r+1]);b=max3f(b,p1[r+2],p1[r+3]);}
  const float m=max2f(a,b);
  auto rr=__builtin_amdgcn_permlane32_swap(__float_as_uint(m),__float_as_uint(m),false,false);
  return max2f(__uint_as_float(rr[0]),__uint_as_float(rr[1]));
}
__device__ __forceinline__ void pv(f32x16*o,int vb,bf16x8 pa0,bf16x8 pa1,bf16x8 pa2,bf16x8 pa3){
  #pragma unroll
  for(int d0=0;d0<2;++d0){s16x4 lo[4],hi[4];
    #pragma unroll
    for(int ks=0;ks<4;++ks){
      asm volatile("ds_read_b64_tr_b16 %0,%1 offset:%c2":"=&v"(lo[ks]):"v"(vb),"i"(d0*4096+ks*1024):"memory");
      asm volatile("ds_read_b64_tr_b16 %0,%1 offset:%c2":"=&v"(hi[ks]):"v"(vb),"i"(d0*4096+ks*1024+512):"memory");}
    asm volatile("s_waitcnt lgkmcnt(0)":::"memory");SBAR();
    #define PK(k) (bf16x8){lo[k][0],lo[k][1],lo[k][2],lo[k][3],hi[k][0],hi[k][1],hi[k][2],hi[k][3]}
    o[d0]=__builtin_amdgcn_mfma_f32_32x32x16_bf16(pa0,PK(0),o[d0],0,0,0);
    o[d0]=__builtin_amdgcn_mfma_f32_32x32x16_bf16(pa1,PK(1),o[d0],0,0,0);
    o[d0]=__builtin_amdgcn_mfma_f32_32x32x16_bf16(pa2,PK(2),o[d0],0,0,0);
    o[d0]=__builtin_amdgcn_mfma_f32_32x32x16_bf16(pa3,PK(3),o[d0],0,0,0);
    #undef PK
  }
}

#ifndef ATTN_STORE16
#define ATTN_STORE16(p,v) (*(u32x4*)(p)=(v))
#endif
template<int THRL> __device__ __forceinline__ void attn_unit(int b,int h,int qb,const bf16*Q,const bf16*__restrict__ K,const bf16*__restrict__ V,bf16*O,const float*cum,float thr2,char*shm){
  const int tid=threadIdx.x,lane=tid&63,r32=lane&31,hi=lane>>5; const int wid=__builtin_amdgcn_readfirstlane(tid>>6);
  const long rowbase=(long)b*SEQ; const int q0=qb*QB;
  const bf16*Qw=Q+(rowbase+q0+wid*QBLK)*DM+h*D;
  const float*cb=cum+(long)(b*NHEAD+h)*SEQ; const int NTF=(q0+QB)/KVBLK; int t0=0;
#if ATTN_SKIP
  { const float cq0=cb[q0]; int cnt=0;
    for(int base=0;base<NTF;base+=64){ const int t_=base+lane; const bool c_=(t_<NTF)&&((cb[64*t_+63]-cq0)*1.4426950408889634f>thr2); cnt+=__popcll(__ballot(c_)); }
    cnt&=~1; if(cnt>NTF-4)cnt=NTF-4; t0=__builtin_amdgcn_readfirstlane(cnt); }
#endif
  const int kv0=t0*KVBLK;
  { const float cref=cb[q0+QB-1]; __attribute__((address_space(3))) float*dkw=(__attribute__((address_space(3))) float*)((__attribute__((address_space(3))) char*)shm+LDS_DK);
    int tv_=tid; asm volatile("":"+v"(tv_));
    for(int j=tv_;j<q0+QB-kv0;j+=NW*64)dkw[j]=(cb[kv0+j]-cref)*1.4426950408889634f; }
  asm volatile("s_waitcnt vmcnt(0) lgkmcnt(0)\n\ts_barrier":::"memory");
  const bf16*Kh=K+(rowbase+kv0)*DM+h*D,*Vh=V+(rowbase+kv0)*DM+h*D;
  const unsigned lds0=(unsigned)(uintptr_t)shm;
  float*wsf=(float*)(shm+LDS_WS)+wid*64;
  const bf16*ksrc=Kh+(long)lane*DM+wid*8;
  const bf16*vsrc=Vh+(long)(16*(wid&3)+(lane>>2))*DM+(wid>>2)*32+(lane&3)*8;
  const unsigned kdst=lds0+LDS_K+wid*1024, vdst=lds0+LDS_V+wid*1024;
  #define DMA_K(t,slot) glds16(ksrc+(long)(t)*KVBLK*DM,(unsigned)__builtin_amdgcn_readfirstlane(kdst+(slot)))
  #define DMA_V(t,slot) glds16(vsrc+(long)(t)*KVBLK*DM,(unsigned)__builtin_amdgcn_readfirstlane(vdst+(slot)))
  const int vb0=(int)(lds0+LDS_V)+((lane>>4)&1)*32+(lane&3)*8+(4*hi+((lane&15)>>2))*64;
  const char*Kbase=shm+LDS_K; bf16x8 kf[8];
  const lds_cptr shm3=(lds_cptr)shm; const lds_cptr kp0=shm3+LDS_K+hi*1024+r32*16; const lds_cptr vp0=shm3+LDS_V+((lane>>4)&1)*32+(lane&3)*8+(4*hi+((lane&15)>>2))*64;
  int hiv_=hi; asm volatile("":"+v"(hiv_));
  const int NT=NTF-t0;
  const __attribute__((address_space(3))) float*dkp0=(const __attribute__((address_space(3))) float*)(shm3+LDS_DK)+4*hiv_;
  #define CINIT(C,t,o) do{ const __attribute__((address_space(3))) float*dp_=dkp0+(t)*64+(o); _Pragma("unroll") for(int g_=0;g_<4;++g_){ const f32x4_t a_=*(const __attribute__((address_space(3))) f32x4_t*)(dp_+8*g_); \
      C[4*g_]=negms-a_[0];C[4*g_+1]=negms-a_[1];C[4*g_+2]=negms-a_[2];C[4*g_+3]=negms-a_[3]; } }while(0)
  #define DECAY(P0,P1,t) do{ const __attribute__((address_space(3))) float*dp_=dkp0+(t)*64; _Pragma("unroll") for(int g_=0;g_<4;++g_){ const f32x4_t a_=*(const __attribute__((address_space(3))) f32x4_t*)(dp_+8*g_), b_=*(const __attribute__((address_space(3))) f32x4_t*)(dp_+32+8*g_); \
      P0[4*g_]-=a_[0];P0[4*g_+1]-=a_[1];P0[4*g_+2]-=a_[2];P0[4*g_+3]-=a_[3]; P1[4*g_]-=b_[0];P1[4*g_+1]-=b_[1];P1[4*g_+2]-=b_[2];P1[4*g_+3]-=b_[3]; } }while(0)
  DMA_K(0,0);DMA_V(0,0);DMA_K(1,SLOTB);
  bf16x8 qr[4];
  #pragma unroll
  for(int d0=0;d0<4;++d0)qr[d0]=*reinterpret_cast<const bf16x8*>(&Qw[(long)r32*DM+d0*16+hi*8]);
  float mhat=0.f,l_reg=0.f;f32x16 o[2];o[0]=f32x16{};o[1]=f32x16{};float negms=0.f; const f32x16 zero16=f32x16{};
  const int qrel=wid*QBLK+r32;
  #define CMASK(P0,P1,t) do{int jb_=(t)-(NT-4); if(jb_>=0)cmask(P0,P1,jb_,qrel,hi);}while(0)
  bool resc=false;
  #define START(P0,P1) do{ const float rm=rowmax(P0,P1); resc=false; \
    { const float dl=rm; mhat=fadd_s(mhat,dl); \
      _Pragma("unroll") for(int r=0;r<16;++r){P0[r]=fsub_s(P0[r],dl);P1[r]=fsub_s(P1[r],dl);} \
      negms=-mhat; } \
    _Pragma("unroll") for(int r=0;r<16;++r)P0[r]=__builtin_amdgcn_exp2f(P0[r]); }while(0)
  #define RESC() do{ if(resc){ asm volatile("s_waitcnt lgkmcnt(0)":::"memory"); \
      _Pragma("unroll") for(int d_=0;d_<2;++d_) _Pragma("unroll") for(int r=0;r<16;++r)o[d_][r]*=wsf[crow(r,hi)]; } }while(0)
  f32x16 pA0,pA1,pB0,pB1;
  int sl_prev=0,sl_cur=0,sl_next=SLOTB;
  #define ROT() do{sl_prev=sl_cur;sl_cur=sl_next;sl_next=(sl_next==(NSLOT-1)*SLOTB)?0:sl_next+SLOTB;}while(0)
  DMA_K(2,2*SLOTB);
  WAIT_BAR(3);
  qkt(pA0,pA1,Kbase,qr,zero16,r32,hi);asm volatile("s_nop 15\n\ts_nop 7":"+v"(pA0),"+v"(pA1));CMASK(pA0,pA1,0);DECAY(pA0,pA1,0);
  START(pA0,pA1);
  _Pragma("unroll") for(int r=0;r<16;++r)pA1[r]=__builtin_amdgcn_exp2f(pA1[r]);
  WAIT_BAR(0);
  DMA_K(3,0);DMA_V(1,SLOTB);
  ROT();
  kload8(kf,kp0+sl_cur);
  WAIT_BAR(2);
  s16x4 vlo[8],vhi[8]; u32x4 pw0,pw1,pw2,pw3;
  #define PKW(P,B) cvtpk_s(P[B],P[B+1])
  #define PAF(k) __builtin_bit_cast(bf16x8,pw##k)
  #define VFR(i) (bf16x8){vlo[i][0],vlo[i][1],vlo[i][2],vlo[i][3],vhi[i][0],vhi[i][1],vhi[i][2],vhi[i][3]}
  #define PIN(x) asm volatile("":"+v"(x))
  #define MX3(a,b,c) __builtin_fmaxf(__builtin_fmaxf((a),(b)),(c))
  #define GAPA(MF,A0,A1,A2,A3,W0,W1,PW) do{ MF; sacc+=A0; sacc+=A1; sacc+=A2; sacc+=A3; PIN(sacc); W0; W1; PIN(PW); SBAR(); }while(0)
  #define EX(v) __builtin_amdgcn_exp2f(v)
  #define GAPB(MF,X,B) do{ MF; X[B]=EX(X[B]); X[B+1]=EX(X[B+1]); X[B+2]=EX(X[B+2]); X[B+3]=EX(X[B+3]); PIN(X); SBAR(); }while(0)
  #define VRD(i) do{ vlo[i]=vtr(vp_+(((i)>>2)*4096+((i)&3)*1024)); vhi[i]=vtr(vp_+(((i)>>2)*4096+((i)&3)*1024+512)); }while(0)
  #define KRD(G,j) do{ if(G){ kload2(kf,kp0+sl_next,j); SBAR(); } }while(0)
  #define STEP(C0,C1,P0,P1,t,GK,GV,GL) do{ SBAR(); \
    const lds_cptr vp_=vp0+sl_prev; \
    CINIT(C0,t,0); VRD(0); SBAR(); float sacc=(P0[0]+P0[1]); \
    GAPA(C0=__builtin_amdgcn_mfma_f32_32x32x16_bf16(kf[0],qr[0],C0,0,0,0), P0[2],P0[3],P0[4],P0[5],     pw0[0]=PKW(P0,0), pw0[1]=PKW(P0,2), pw0); \
    CINIT(C1,t,32); VRD(4); SBAR(); GAPA(C1=__builtin_amdgcn_mfma_f32_32x32x16_bf16(kf[1],qr[0],C1,0,0,0), P0[6],P0[7],P0[8],P0[9],     pw0[2]=PKW(P0,4), pw0[3]=PKW(P0,6), pw0); \
    VRD(1); SBAR(); GAPA(C0=__builtin_amdgcn_mfma_f32_32x32x16_bf16(kf[2],qr[1],C0,0,0,0),   P0[10],P0[11],P0[12],P0[13], pw1[0]=PKW(P0,8), pw1[1]=PKW(P0,10), pw1); \
    VRD(5); SBAR(); GAPA(C1=__builtin_amdgcn_mfma_f32_32x32x16_bf16(kf[3],qr[1],C1,0,0,0),   P0[14],P0[15],P1[0],P1[1],   pw1[2]=PKW(P0,12),pw1[3]=PKW(P0,14), pw1); \
    VRD(2); SBAR(); GAPA(C0=__builtin_amdgcn_mfma_f32_32x32x16_bf16(kf[4],qr[2],C0,0,0,0),   P1[2],P1[3],P1[4],P1[5],     pw2[0]=PKW(P1,0), pw2[1]=PKW(P1,2), pw2); \
    VRD(6); SBAR(); GAPA(C1=__builtin_amdgcn_mfma_f32_32x32x16_bf16(kf[5],qr[2],C1,0,0,0),   P1[6],P1[7],P1[8],P1[9],     pw2[2]=PKW(P1,4), pw2[3]=PKW(P1,6), pw2); \
    VRD(3); SBAR(); GAPA(C0=__builtin_amdgcn_mfma_f32_32x32x16_bf16(kf[6],qr[3],C0,0,0,0),   P1[10],P1[11],P1[12],P1[13], pw3[0]=PKW(P1,8), pw3[1]=PKW(P1,10), pw3); \
    VRD(7); SBAR(); GAPA(C1=__builtin_amdgcn_mfma_f32_32x32x16_bf16(kf[7],qr[3],C1,0,0,0),   P1[14],P1[15],0.f,0.f,       pw3[2]=PKW(P1,12),pw3[3]=PKW(P1,14), pw3); \
    l_reg+=sacc; \
    if(GK){DMA_K((t)+3,sl_cur);} if(GV){DMA_V((t)+1,sl_next);} \
    CMASK(C0,C1,t); \
    { float a=MX3(C0[0],C0[1],C1[0]),b=MX3(C0[2],C0[3],C1[1]); a=MX3(a,C1[2],C1[3]); \
      _Pragma("unroll") for(int r=4;r<16;r+=4){a=MX3(a,C0[r],C0[r+1]);b=MX3(b,C0[r+2],C0[r+3]);a=MX3(a,C1[r],C1[r+1]);b=MX3(b,C1[r+2],C1[r+3]);} \
      float rm=__builtin_fmaxf(a,b); { auto rr=__builtin_amdgcn_permlane32_swap(__float_as_uint(rm),__float_as_uint(rm),false,false); rm=__builtin_fmaxf(__uint_as_float(rr[0]),__uint_as_float(rr[1])); } \
      resc=false; \
      if(__builtin_expect(__any(rm>(float)THRL),0)){ const float dl=__builtin_fmaxf(rm,0.f); mhat+=dl; \
        _Pragma("unroll") for(int r=0;r<16;++r){C0[r]-=dl;C1[r]-=dl;} \
        negms=-mhat; \
        const float f=__builtin_amdgcn_exp2f(-dl); l_reg*=f; if(hi==0)wsf[r32]=f; resc=true; } } \
    SBAR(); \
    GAPB(o[0]=__builtin_amdgcn_mfma_f32_32x32x16_bf16(PAF(0),VFR(0),o[0],0,0,0), C0,0); \
    GAPB(o[1]=__builtin_amdgcn_mfma_f32_32x32x16_bf16(PAF(0),VFR(4),o[1],0,0,0), C0,4); \
    KRD(GL,0); GAPB(o[0]=__builtin_amdgcn_mfma_f32_32x32x16_bf16(PAF(1),VFR(1),o[0],0,0,0), C0,8); \
    KRD(GL,1); GAPB(o[1]=__builtin_amdgcn_mfma_f32_32x32x16_bf16(PAF(1),VFR(5),o[1],0,0,0), C0,12); \
    KRD(GL,2); GAPB(o[0]=__builtin_amdgcn_mfma_f32_32x32x16_bf16(PAF(2),VFR(2),o[0],0,0,0), C1,0); \
    KRD(GL,3); GAPB(o[1]=__builtin_amdgcn_mfma_f32_32x32x16_bf16(PAF(2),VFR(6),o[1],0,0,0), C1,4); \
    GAPB(o[0]=__builtin_amdgcn_mfma_f32_32x32x16_bf16(PAF(3),VFR(3),o[0],0,0,0), C1,8); \
    GAPB(o[1]=__builtin_amdgcn_mfma_f32_32x32x16_bf16(PAF(3),VFR(7),o[1],0,0,0), C1,12); \
    }while(0)
  int t=1;
  #undef CMASK
  #define CMASK(P0,P1,t) do{}while(0)
  for(;t+5<NT;t+=2){
    STEP(pB0,pB1,pA0,pA1,t,true,true,true);     WAIT_BAR(2); RESC(); ROT();
    STEP(pA0,pA1,pB0,pB1,t+1,true,true,true);   WAIT_BAR(2); RESC(); ROT();
  }
  #undef CMASK
  #define CMASK(P0,P1,t) do{int jb_=(t)-(NT-4); if(jb_>=0)cmask(P0,P1,jb_,qrel,hi);}while(0)
  #define ENDW(tt) do{ if((tt)+3<NT){WAIT_BAR(2);} else if((tt)+2<NT){WAIT_BAR(1);} else {WAIT_BAR(0);} }while(0)
  for(;t+1<NT;t+=2){
    STEP(pB0,pB1,pA0,pA1,t,(t+3<NT),(t+1<NT),(t+1<NT));       ENDW(t);   RESC(); ROT();
    STEP(pA0,pA1,pB0,pB1,t+1,(t+4<NT),(t+2<NT),(t+2<NT));     ENDW(t+1); RESC(); ROT();
  }
  STEP(pB0,pB1,pA0,pA1,NT-1,false,false,false); RESC();
  { float sacc=pB0[0]+pB0[1]; _Pragma("unroll") for(int r=2;r<16;++r)sacc+=pB0[r]; _Pragma("unroll") for(int r=0;r<16;++r)sacc+=pB1[r]; l_reg+=sacc;
    pw0=(u32x4){PKW(pB0,0),PKW(pB0,2),PKW(pB0,4),PKW(pB0,6)};pw1=(u32x4){PKW(pB0,8),PKW(pB0,10),PKW(pB0,12),PKW(pB0,14)};pw2=(u32x4){PKW(pB1,0),PKW(pB1,2),PKW(pB1,4),PKW(pB1,6)};pw3=(u32x4){PKW(pB1,8),PKW(pB1,10),PKW(pB1,12),PKW(pB1,14)};
    SBAR(); pv(o,vb0+sl_cur,PAF(0),PAF(1),PAF(2),PAF(3)); }
  #undef PKW
  #undef PAF
  #undef VFR
  #undef PIN
  #undef MX3
  #undef GAPA
  #undef GAPB
  #undef EX
  #undef VRD
  #undef KRD
  #undef STEP
  #undef ENDW
  {auto rr=__builtin_amdgcn_permlane32_swap(__float_as_uint(l_reg),__float_as_uint(l_reg),false,false);l_reg=__uint_as_float(rr[0])+__uint_as_float(rr[1]);}
  if(hi==0)wsf[32+r32]=l_reg;asm volatile("s_waitcnt lgkmcnt(0)":::"memory");
  float rli[16];
  #pragma unroll
  for(int r=0;r<16;++r)rli[r]=__builtin_amdgcn_rcpf(wsf[32+crow(r,hi)]);
  bf16*Ow=O+(rowbase+q0+wid*QBLK)*DM+h*D;
  { bf16*stg=(bf16*)(shm+LDS_OST)+wid*2048;
    #pragma unroll
    for(int r=0;r<16;++r){const int orow=crow(r,hi);
      #pragma unroll
      for(int d0=0;d0<2;++d0)stg[orow*64+d0*32+r32]=__float2bfloat16(o[d0][r]*rli[r]);}
    asm volatile("s_waitcnt lgkmcnt(0)":::"memory");
    #pragma unroll
    for(int i=0;i<4;++i){const int row=i*8+(lane>>3),ch=lane&7; const u32x4 v=*(const u32x4*)(stg+row*64+ch*8); ATTN_STORE16(Ow+(long)row*DM+ch*8,v);} }
  asm volatile("s_waitcnt lgkmcnt(0)\n\ts_barrier":::"memory");
  #undef DECAY
  #undef CINIT
  #undef DMA_K
  #undef DMA_V
  #undef CMASK
  #undef START
  #undef RESC
  #undef ROT
}
constexpr int ATTN_LDS_BYTES=LDS_BYTES;
struct AttnTensors { const bf16* Q; const bf16* K; const bf16* V; bf16* O; const float* cum; float thr2; };
struct AttnUnit { int bh; int qb; };
struct StaticOrder {
  int vcu;
  __device__ __forceinline__ explicit StaticOrder(int grid,int block):vcu((block%8)*(grid/8)+block/8){}
  __device__ __forceinline__ bool next(int i,AttnUnit&u)const{ if(i>=2)return false; const int s=vcu&15; u.bh=vcu>>4; u.qb=(i==0)?s:31-s; return true; }
  __device__ __forceinline__ void a_ready(const AttnUnit&)const{}
  __device__ __forceinline__ void done(const AttnUnit&)const{}
};
template<class Sched,int THRL=8> __device__ __forceinline__ void attn_phase(char*lds,const AttnTensors&T,const Sched&S){
  AttnUnit u;
  for(int i=0;S.next(i,u);++i){ S.a_ready(u); attn_unit<THRL>(u.bh/NHEAD,u.bh%NHEAD,u.qb,T.Q,T.K,T.V,T.O,T.cum,T.thr2,lds); S.done(u); }
}
#undef SBAR
#undef WAIT_BAR
}

constexpr int NWAVES = 8;
constexpr int BATCH = 2, SEQ = 8192, DMODEL = 1024, T = BATCH * SEQ;
constexpr int CONVD = 512, CONVW = 31, NHEAD = 8, HD = 64, ATT = 512;
constexpr int NE = 64, TOPK = 8, EF = 256, SF = 256;
constexpr int INCOLS = 4616, OFF_Q = 1024, OFF_K = 1536, OFF_V = 2048, OFF_F = 2560, OFF_GC = 2568, OFF_GA = 3592;
constexpr int NIN = 4608;
constexpr float EPS = 1e-6f, LOG2E = 1.4426950408889634f, ROUTED_SCALE = 2.5f;
constexpr float C2Q = 0.125f * 1.4426950408889634f;
constexpr int LISTCAP = T;
constexpr int ACT_ROWS = T * TOPK + NE * 256;

constexpr size_t MiB = 1u << 20, KiB = 1u << 10;
constexpr size_t WS_CTL = 0, CTL_ZERO_BYTES = 1 * MiB;
constexpr size_t WS_MODP = 1 * MiB;
constexpr size_t WS_MOD = WS_MODP + 768 * KiB;
constexpr size_t WS_LOGF = 2 * MiB;
constexpr size_t WS_CUM = 2 * MiB + 512 * KiB;
constexpr size_t WS_SSQ = 3 * MiB;
constexpr size_t WS_WRH = 4 * MiB, WS_WRL = 4 * MiB + 128 * KiB;
constexpr size_t WS_WLIST = 5 * MiB;
constexpr size_t WS_LIST = 9 * MiB;
constexpr size_t WS_WIN = 16 * MiB, WS_WC = 25 * MiB, WS_WA = 26 * MiB, WS_WOUT = 27 * MiB, WS_WSGU = 29 * MiB, WS_WSD = 30 * MiB;
constexpr size_t WS_WGU = 32 * MiB, WS_WD = 96 * MiB;
constexpr size_t WS_H2 = 128 * MiB, WS_ACT = 160 * MiB, WS_SACT = 232 * MiB;
constexpr size_t WS_H1 = 240 * MiB, WS_U = 272 * MiB, WS_Q = 288 * MiB, WS_K = 304 * MiB, WS_V = 320 * MiB, WS_SG = 336 * MiB, WS_UC = 400 * MiB, WS_O = 416 * MiB, WS_MG = 432 * MiB;
constexpr size_t WS_SLAB = 240 * MiB;
constexpr size_t WS_END = 512 * MiB;
static_assert(WS_ACT + (size_t)ACT_ROWS * EF * 2 <= WS_SACT && WS_SLAB + (size_t)T * TOPK * DMODEL * 2 <= WS_END && WS_MG + (size_t)T * DMODEL * 2 <= WS_SLAB + 256 * MiB, "ws map");
constexpr int CW_TMO = 0, CW_CODE = 1;
constexpr int CW_CNT = 1024;
constexpr int CW_BAR = 8192;

constexpr int RING_OFF = 0, RING_BYTES = 131072;
constexpr int LDSCTL_OFF = RING_BYTES, MISC_OFF = LDSCTL_OFF + 320;
constexpr int TAB_OFF = RING_BYTES + 1024;
constexpr int LDS_BYTES = 147456;

#define GAS __attribute__((address_space(1)))
#define LAS __attribute__((address_space(3)))
typedef unsigned short bf16;
typedef unsigned v4u __attribute__((ext_vector_type(4)));
typedef unsigned v2u __attribute__((ext_vector_type(2)));
typedef float f32x4 __attribute__((ext_vector_type(4)));
typedef float f32x16 __attribute__((ext_vector_type(16)));
typedef short bf16x8 __attribute__((ext_vector_type(8)));
typedef GAS unsigned gu32;
#define RLX_AGENT __ATOMIC_RELAXED, __HIP_MEMORY_SCOPE_AGENT
#define LDS_WAIT() asm volatile("s_waitcnt lgkmcnt(0)" ::: "memory")
#define VM_WAIT() asm volatile("s_waitcnt vmcnt(0)" ::: "memory")
__device__ __forceinline__ unsigned f2bf(float f) { unsigned u = __builtin_bit_cast(unsigned, f); return (u + 0x7fffu + ((u >> 16) & 1u)) >> 16; }
__device__ __forceinline__ unsigned pk2(float lo, float hi) { return f2bf(lo) | (f2bf(hi) << 16); }
__device__ __forceinline__ float bf2f(unsigned h) { return __builtin_bit_cast(float, h << 16); }
__device__ __forceinline__ float wave_sum(float v) {
#pragma unroll
    for (int o = 1; o < 64; o <<= 1) v += __shfl_xor(v, o);
    return v;
}
using pg8::cvt_pk_bf16; using pg8::bf_lo; using pg8::bf_hi; using pg8::sigmoidf_fast;
#define XB_TMO      128
#define XB_XCNT(j)  (256  + 64 * (j))
#define XB_XSUB(j)  (1280 + 64 * (j))
#define XB_XGEN(j)  (2304 + 64 * (j))
#define XB_TOP      3328
#define XB_TOPGEN   3392
#define XCD_BAR_WORDS 3456
#define XB_SPIN_CAP (1u << 18)

__device__ __forceinline__ unsigned xb_ld(unsigned* p)              { return __hip_atomic_load(p, __ATOMIC_RELAXED, __HIP_MEMORY_SCOPE_AGENT); }
__device__ __forceinline__ unsigned xb_add(unsigned* p, unsigned v) { return __hip_atomic_fetch_add(p, v, __ATOMIC_RELAXED, __HIP_MEMORY_SCOPE_AGENT); }
__device__ __forceinline__ unsigned xb_xcc_id() { return (unsigned)__builtin_amdgcn_s_getreg((3 << 11) | 20) & 0xFu; }
#define XB_SPIN(cond, bar) do { unsigned _sp = 0; while (cond) { __builtin_amdgcn_s_sleep(1); \
    if ((++_sp & 255u) == 0u) { if (xb_ld(&(bar)[XB_TMO])) break; if (_sp > XB_SPIN_CAP) { atomicAdd(&(bar)[XB_TMO], 1u); break; } } } } while (0)

struct XcdBarrier {
    unsigned* bar; unsigned x;
    volatile LAS unsigned* st;
};

__device__ __forceinline__ XcdBarrier xcd_barrier_post(unsigned* bar, volatile LAS unsigned* st) {
    XcdBarrier b; b.bar = bar; b.x = xb_xcc_id(); b.st = st;
    if (threadIdx.x == 0) (void)xb_add(&bar[XB_XCNT(b.x)], 1u);
    return b;
}
__device__ __forceinline__ void xcd_barrier_complete(unsigned* bar, unsigned x, unsigned& nloc, unsigned& nx) {
    const unsigned G = gridDim.x * gridDim.y * gridDim.z;
    unsigned sum, cnt, mine, sp = 0u;
    for (;;) {
        sum = 0u; cnt = 0u; mine = 0u;
#pragma unroll
        for (unsigned j = 0; j < 16; ++j) { const unsigned c = xb_ld(&bar[XB_XCNT(j)]); sum += c; cnt += (c > 0u) ? 1u : 0u; mine = (j == x) ? c : mine; }
        if (sum == G) break;
        __builtin_amdgcn_s_sleep(1);
        if ((++sp & 255u) == 0u) { if (xb_ld(&bar[XB_TMO])) break; if (sp > XB_SPIN_CAP) { atomicAdd(&bar[XB_TMO], 1u); break; } }
    }
    nloc = mine > 0u ? mine : 1u; nx = cnt > 0u ? cnt : 1u;
}

__device__ __forceinline__ void xcd_barrier(const XcdBarrier& b) {
    asm volatile("s_waitcnt vmcnt(0)" ::: "memory");
    __syncthreads();
    if (threadIdx.x == 0) {
        unsigned* bar = b.bar;
        __builtin_amdgcn_s_waitcnt(0);
        unsigned nloc = b.st[0], nx = b.st[1];
        if (nloc == 0u) { xcd_barrier_complete(bar, b.x, nloc, nx); b.st[0] = nloc; b.st[1] = nx; }
        const unsigned old = xb_add(&bar[XB_XSUB(b.x)], 1u);
        const unsigned gen = old / nloc;
        if (old + 1u == (gen + 1u) * nloc) {
            __builtin_amdgcn_fence(__ATOMIC_RELEASE, "agent");
            asm volatile("s_waitcnt vmcnt(0)" ::: "memory");
            const unsigned og = xb_add(&bar[XB_TOP], 1u);
            const unsigned tg = og / nx;
            if (og + 1u == (tg + 1u) * nx) xb_add(&bar[XB_TOPGEN], 1u);
            else XB_SPIN(xb_ld(&bar[XB_TOPGEN]) == tg, bar);
            __builtin_amdgcn_fence(__ATOMIC_ACQUIRE, "agent");
            xb_add(&bar[XB_XGEN(b.x)], 1u);
            asm volatile("s_waitcnt vmcnt(0)" ::: "memory");
        } else {
            XB_SPIN(xb_ld(&bar[XB_XGEN(b.x)]) == gen, bar);
            __builtin_amdgcn_fence(__ATOMIC_ACQUIRE, "agent");
            asm volatile("s_waitcnt vmcnt(0)" ::: "memory");
        }
    }
    __syncthreads();
}

__device__ __forceinline__ int win_dst_row(int n) {
    if (n < 512) return 256 * (n >> 7) + (n & 127);
    if (n < 1024) { const int f = n - 512; return 256 * (f >> 7) + 128 + (f & 127); }
    if (n < 2048) { const int isk = n >= OFF_K, j = n - (isk ? OFF_K : OFF_Q), head = j >> 6, d = j & 63;
        return 256 * (4 + 2 * isk + (head >> 2)) + 128 * (d >> 5) + 32 * (head & 3) + (d & 31); }
    if (n < OFF_F) return 256 * 8 + (n - OFF_V);
    if (n < OFF_GC) return -1;
    return 256 * 10 + (n - OFF_GC);
}
__device__ __forceinline__ int glu_dst_row(int n, int F) { const int isu = n >= F, f = n - (isu ? F : 0); return 256 * (f >> 7) + 128 * isu + (f & 127); }

template <int MODE>
__device__ __forceinline__ void tr_item(const float* W, int ldw, int K, bf16* WT, bf16* WT2, int k0, int n0, LAS float* scr, int lane) {
#pragma unroll 8
    for (int i = 0; i < 32; ++i) { const int kk = 2 * i + (lane >> 5); scr[kk * 33 + (lane & 31)] = W[(size_t)(k0 + kk) * ldw + n0 + (lane & 31)]; }
    LDS_WAIT(); asm volatile("" ::: "memory");
    const int c = lane & 7;
#pragma unroll
    for (int j = 0; j < 4; ++j) { const int n = (lane >> 3) + 8 * j; const LAS float* s = scr + (8 * c) * 33 + n;
        int row = n0 + n;
        if (MODE == 1) row = win_dst_row(row);
        if (MODE == 2) row = glu_dst_row(row, ldw >> 1);
        float v[8];
#pragma unroll
        for (int q = 0; q < 8; ++q) v[q] = s[q * 33];
        if (MODE == 1 && row < 0) continue;
        v4u o; o.x = pk2(v[0], v[1]); o.y = pk2(v[2], v[3]); o.z = pk2(v[4], v[5]); o.w = pk2(v[6], v[7]);
        *(GAS v4u*)(WT + (size_t)row * K + k0 + 8 * c) = o;
        if (MODE == 3) { float r[8];
#pragma unroll
            for (int q = 0; q < 8; ++q) r[q] = v[q] - bf2f(f2bf(v[q]));
            v4u o2; o2.x = pk2(r[0], r[1]); o2.y = pk2(r[2], r[3]); o2.z = pk2(r[4], r[5]); o2.w = pk2(r[6], r[7]);
            *(GAS v4u*)(WT2 + (size_t)row * K + k0 + 8 * c) = o2; }
    }
    LDS_WAIT(); asm volatile("" ::: "memory");
}

struct KArgs { const float* in[23]; float* out; unsigned char* ws; int ph_lo, ph_hi; };

__device__ __forceinline__ void p0_prologue(const KArgs& a, LAS unsigned char* lds, int vcu, int G, int wave, int lane) {
    LAS float* scr = (LAS float*)(lds + RING_OFF + wave * 16384);
    const int gw = vcu * NWAVES + wave, NGW = G * NWAVES;
    unsigned char* ws = a.ws;
    {
        const float* c = a.in[1]; const float* wada = a.in[2]; float* modp = (float*)(ws + WS_MODP);
        for (int it = gw; it < 96 * 16; it += NGW) {
            const int cg = it % 96, kc = it / 96, n = 64 * cg + lane; float s0 = 0.f, s1 = 0.f;
            const float* wp = wada + (size_t)(64 * kc) * 6144 + n;
#pragma unroll 8
            for (int k = 0; k < 64; ++k) { const float w = wp[(size_t)k * 6144]; const float c0 = c[64 * kc + k], c1 = c[1024 + 64 * kc + k];
                s0 += (c0 / (1.0f + __expf(-c0))) * w; s1 += (c1 / (1.0f + __expf(-c1))) * w; }
            modp[(size_t)(kc * 2 + 0) * 6144 + n] = s0; modp[(size_t)(kc * 2 + 1) * 6144 + n] = s1;
        }
    }
    constexpr int I_WIN = 144 * 16, I_WC = 8 * 32, I_WA = 8 * 32, I_WOUT = 16 * 32, I_WSGU = 16 * 16, I_WSD = 4 * 32, I_WR = 16 * 2, I_WGU = 64 * 256, I_WD = 64 * 128;
    constexpr int NITEMS = I_WIN + I_WC + I_WA + I_WOUT + I_WSGU + I_WSD + I_WR + I_WGU + I_WD;
    for (int it = gw; it < NITEMS; it += NGW) {
        int r = it;
        if (r < I_WIN) { const int cb = r % 144, kb = r / 144; const int n0 = cb < 80 ? 32 * cb : OFF_GC + 32 * (cb - 80);
            tr_item<1>(a.in[5], INCOLS, 1024, (bf16*)(ws + WS_WIN), nullptr, 64 * kb, n0, scr, lane); continue; } r -= I_WIN;
        if (r < I_WC) { tr_item<0>(a.in[10], 1024, 512, (bf16*)(ws + WS_WC), nullptr, 64 * (r / 32), 32 * (r % 32), scr, lane); continue; } r -= I_WC;
        if (r < I_WA) { tr_item<0>(a.in[14], 1024, 512, (bf16*)(ws + WS_WA), nullptr, 64 * (r / 32), 32 * (r % 32), scr, lane); continue; } r -= I_WA;
        if (r < I_WOUT) { tr_item<0>(a.in[15], 1024, 1024, (bf16*)(ws + WS_WOUT), nullptr, 64 * (r / 32), 32 * (r % 32), scr, lane); continue; } r -= I_WOUT;
        if (r < I_WSGU) { tr_item<2>(a.in[21], 512, 1024, (bf16*)(ws + WS_WSGU), nullptr, 64 * (r / 16), 32 * (r % 16), scr, lane); continue; } r -= I_WSGU;
        if (r < I_WSD) { tr_item<0>(a.in[22], 1024, 256, (bf16*)(ws + WS_WSD), nullptr, 64 * (r / 32), 32 * (r % 32), scr, lane); continue; } r -= I_WSD;
        if (r < I_WR) { tr_item<3>(a.in[17], 64, 1024, (bf16*)(ws + WS_WRH), (bf16*)(ws + WS_WRL), 64 * (r / 2), 32 * (r % 2), scr, lane); continue; } r -= I_WR;
        if (r < I_WGU) { const int e = r / 256, q = r % 256;
            tr_item<2>(a.in[19] + (size_t)e * 1024 * 512, 512, 1024, (bf16*)(ws + WS_WGU) + (size_t)e * 512 * 1024, nullptr, 64 * (q / 16), 32 * (q % 16), scr, lane); continue; } r -= I_WGU;
        { const int e = r / 128, q = r % 128;
            tr_item<0>(a.in[20] + (size_t)e * 256 * 1024, 1024, 256, (bf16*)(ws + WS_WD) + (size_t)e * 1024 * 256, nullptr, 64 * (q / 32), 32 * (q % 32), scr, lane); }
    }
}

__device__ __forceinline__ void p1_rows(const KArgs& a, LAS unsigned char* lds, int vcu, int tid, int wave, int lane) {
    unsigned char* ws = a.ws;
    const float* modp = (const float*)(ws + WS_MODP); const float* bada = a.in[3];
    LAS float* gs1 = (LAS float*)(lds + RING_OFF); LAS float* sh1 = gs1 + 1024; LAS float* wfl = gs1 + 2048;
    const int b = vcu >> 7;
    {
        const int col = 4 * tid; f32x4 s = *(const f32x4*)(bada + col);
#pragma unroll
        for (int kc = 0; kc < 16; ++kc) s += *(const f32x4*)(modp + (size_t)(kc * 2 + b) * 6144 + col);
        if (col < 1024) { *(LAS f32x4*)(sh1 + col) = s; }
        else { const f32x4 g = *(const f32x4*)(a.in[4] + col - 1024); *(LAS f32x4*)(gs1 + col - 1024) = g * (1.0f + s); }
    }
    if (blockIdx.x < 2) {
        float* mod = (float*)(ws + WS_MOD); const int bb = blockIdx.x;
        for (int col = 4 * tid; col < 6144; col += 4 * NWAVES * 64) { f32x4 s = *(const f32x4*)(bada + col);
#pragma unroll
            for (int kc = 0; kc < 16; ++kc) s += *(const f32x4*)(modp + (size_t)(kc * 2 + bb) * 6144 + col);
            *(f32x4*)(mod + (size_t)bb * 6144 + col) = s; }
    }
    for (int idx = tid; idx < 8192; idx += NWAVES * 64) { const int k = idx >> 3, f = idx & 7; wfl[f * 1024 + k] = a.in[5][(size_t)k * INCOLS + OFF_F + f]; }
    __syncthreads();
    const float* x = a.in[0]; bf16* h1 = (bf16*)(ws + WS_H1); float* logf_ = (float*)(ws + WS_LOGF); const float* bfg = a.in[13];
    for (int j = 0; j < 8; ++j) {
        const int row = 64 * vcu + 8 * wave + j, t = row & (SEQ - 1);
        const GAS f32x4* xr = (const GAS f32x4*)(x + (size_t)row * DMODEL) + lane;
        f32x4 v[4]; float ss = 0.f;
#pragma unroll
        for (int q = 0; q < 4; ++q) { v[q] = xr[64 * q]; ss += (v[q].x * v[q].x + v[q].y * v[q].y) + (v[q].z * v[q].z + v[q].w * v[q].w); }
        const float rstd = 1.0f / sqrtf(wave_sum(ss) * (1.0f / DMODEL) + EPS);
        GAS unsigned long long* o8 = (GAS unsigned long long*)(h1 + (size_t)row * DMODEL) + lane;
#pragma unroll
        for (int q = 0; q < 4; ++q) { const f32x4 g = *(const LAS f32x4*)(gs1 + 4 * lane + 256 * q), s = *(const LAS f32x4*)(sh1 + 4 * lane + 256 * q);
            v[q] = v[q] * rstd * g + s;
            o8[64 * q] = (unsigned long long)pk2(v[q].x, v[q].y) | ((unsigned long long)pk2(v[q].z, v[q].w) << 32); }
        float mine = 0.f;
#pragma unroll
        for (int f = 0; f < 8; ++f) { float p = 0.f;
#pragma unroll
            for (int q = 0; q < 4; ++q) { const f32x4 w = *(const LAS f32x4*)(wfl + f * 1024 + 4 * lane + 256 * q); p += (v[q].x * w.x + v[q].y * w.y) + (v[q].z * w.z + v[q].w * w.w); }
            p = wave_sum(p); if (lane == f) mine = p; }
        if (lane < 8) { const float z = mine + bfg[lane]; const float ls = fminf(z, 0.f) - log1pf(expf(-fabsf(z)));
            logf_[(size_t)(b * 8 + lane) * SEQ + t] = ls; }
    }
}

__device__ __forceinline__ void p2_cumsum(const KArgs& a, LAS unsigned char* lds, int seq, int tid, int wave, int lane) {
    const float* lf = (const float*)(a.ws + WS_LOGF) + (size_t)seq * SEQ + 16 * tid; float* cm = (float*)(a.ws + WS_CUM) + (size_t)seq * SEQ + 16 * tid;
    LAS double* wt = (LAS double*)(lds + RING_OFF);
    float v[16];
#pragma unroll
    for (int q = 0; q < 4; ++q) { const f32x4 x = *(const f32x4*)(lf + 4 * q); v[4 * q] = x.x; v[4 * q + 1] = x.y; v[4 * q + 2] = x.z; v[4 * q + 3] = x.w; }
    double pre[16]; double run = 0.0;
#pragma unroll
    for (int i = 0; i < 16; ++i) { run += (double)v[i]; pre[i] = run; }
    double sc = run;
#pragma unroll
    for (int o = 1; o < 64; o <<= 1) { const double up = __shfl_up(sc, o); if (lane >= o) sc += up; }
    if (lane == 63) wt[wave] = sc;
    __syncthreads();
    double off = sc - run;
    for (int w = 0; w < wave; ++w) off += wt[w];
#pragma unroll
    for (int q = 0; q < 4; ++q) { f32x4 o; o.x = (float)(off + pre[4 * q]); o.y = (float)(off + pre[4 * q + 1]); o.z = (float)(off + pre[4 * q + 2]); o.w = (float)(off + pre[4 * q + 3]); *(f32x4*)(cm + 4 * q) = o; }
    __syncthreads();
}

__device__ __forceinline__ void conv_item(const KArgs& a, LAS unsigned char* lds, int item, int tid) {
    const int tt = item >> 3, g = item & 7, row0 = 128 * tt, t0 = row0 & (SEQ - 1), c0 = 64 * g;
    const bf16* U = (const bf16*)(a.ws + WS_U); bf16* UC = (bf16*)(a.ws + WS_UC);
    LAS unsigned char* ut = lds + RING_OFF;
    LAS float* wl = (LAS float*)(lds + RING_OFF + 24576);
    constexpr int RS = 144;
    for (int idx = tid; idx < 158 * 8; idx += NWAVES * 64) { const int r = idx >> 3, ch = idx & 7, tq = t0 - 30 + r;
        v4u val = (v4u){0u, 0u, 0u, 0u};
        if (tq >= 0) val = *(const GAS v4u*)(U + (size_t)(row0 - 30 + r) * CONVD + c0 + 8 * ch);
        *(LAS v4u*)(ut + r * RS + 16 * ch) = val; }
    for (int idx = tid; idx < 31 * 64; idx += NWAVES * 64) wl[idx] = a.in[6][(size_t)(idx >> 6) * CONVD + c0 + (idx & 63)];
    __syncthreads();
    const int tok = tid >> 2, q = tid & 3;
    float acc[16];
#pragma unroll
    for (int i = 0; i < 16; ++i) acc[i] = a.in[7][c0 + 16 * q + i];
    for (int j = 0; j < CONVW; ++j) {
        const LAS unsigned char* up = ut + (tok + j) * RS + 32 * q; const v4u u0 = *(const LAS v4u*)up, u1 = *(const LAS v4u*)(up + 16);
        const LAS float* wp = wl + j * 64 + 16 * q;
        const f32x4 w0 = *(const LAS f32x4*)wp, w1 = *(const LAS f32x4*)(wp + 4), w2 = *(const LAS f32x4*)(wp + 8), w3 = *(const LAS f32x4*)(wp + 12);
        acc[0] += bf_lo(u0.x) * w0.x; acc[1] += bf_hi(u0.x) * w0.y; acc[2] += bf_lo(u0.y) * w0.z; acc[3] += bf_hi(u0.y) * w0.w;
        acc[4] += bf_lo(u0.z) * w1.x; acc[5] += bf_hi(u0.z) * w1.y; acc[6] += bf_lo(u0.w) * w1.z; acc[7] += bf_hi(u0.w) * w1.w;
        acc[8] += bf_lo(u1.x) * w2.x; acc[9] += bf_hi(u1.x) * w2.y; acc[10] += bf_lo(u1.y) * w2.z; acc[11] += bf_hi(u1.y) * w2.w;
        acc[12] += bf_lo(u1.z) * w3.x; acc[13] += bf_hi(u1.z) * w3.y; acc[14] += bf_lo(u1.w) * w3.z; acc[15] += bf_hi(u1.w) * w3.w;
    }
    float s = 0.f;
#pragma unroll
    for (int i = 0; i < 16; ++i) s += acc[i];
    s += __shfl_xor(s, 1); s += __shfl_xor(s, 2);
    const float mu = s * (1.0f / 64.0f); float qv = 0.f;
#pragma unroll
    for (int i = 0; i < 16; ++i) { acc[i] -= mu; qv += acc[i] * acc[i]; }
    qv += __shfl_xor(qv, 1); qv += __shfl_xor(qv, 2);
    const float rstd = 1.0f / sqrtf(qv * (1.0f / 64.0f) + EPS);
    unsigned o[8];
#pragma unroll
    for (int i = 0; i < 16; i += 2) { float y0 = acc[i] * rstd * a.in[8][c0 + 16 * q + i] + a.in[9][c0 + 16 * q + i], y1 = acc[i + 1] * rstd * a.in[8][c0 + 16 * q + i + 1] + a.in[9][c0 + 16 * q + i + 1];
        y0 = y0 * sigmoidf_fast(y0); y1 = y1 * sigmoidf_fast(y1); o[i >> 1] = pk2(y0, y1); }
    GAS v4u* dst = (GAS v4u*)(UC + (size_t)(row0 + tok) * CONVD + c0 + 16 * q);
    dst[0] = (v4u){o[0], o[1], o[2], o[3]}; dst[1] = (v4u){o[4], o[5], o[6], o[7]};
    __syncthreads();
}

struct SchedDense {
    static constexpr bool GATHER = false;
    int nM, nN, G, c, K; const char* A; const char* B;
    __device__ __forceinline__ bool next(int i, pg8::Unit& u) const {
        const long L = (long)i * G + c; if (L >= (long)nM * nN) return false;
        pg8::tile_of((int)L, nM, nN, u.pm, u.pn); u.e = 0; u.mt = 0;
        u.A = A + (size_t)u.pm * 256 * K * 2; u.B = B + (size_t)u.pn * 256 * K * 2; return true; }
    __device__ __forceinline__ int row(const pg8::Unit&, int) const { return 0; }
};
struct SchedMerge {
    static constexpr bool GATHER = false;
    int c; const char* A0; const char* B0; const char* A1; const char* B1;
    __device__ __forceinline__ bool next(int i, pg8::Unit& u) const {
        if (i >= 2 || c >= 256) return false;
        pg8::tile_of(c, 64, 4, u.pm, u.pn); u.e = i; u.mt = 0;
        u.A = (i ? A1 : A0) + (size_t)u.pm * 256 * 512 * 2; u.B = (i ? B1 : B0) + (size_t)u.pn * 256 * 512 * 2; return true; }
    __device__ __forceinline__ int row(const pg8::Unit&, int) const { return 0; }
};
struct MoeTab { const LAS int* tstart; const LAS int* cnt; };
struct SchedMoe1 {
    static constexpr bool GATHER = true;
    MoeTab tb; int nmoe, ntot, per, c, lane; const char* h2; const char* wgu; const char* wsgu; const int* list;
    __device__ __forceinline__ bool next(int i, pg8::Unit& u) const {
        const int L = c * per + i; if (i >= per || L >= ntot) return false;
        if (L < nmoe) { const int tt = L >> 1; const int e = __popcll(__ballot(tb.tstart[lane + 1] <= tt));
            u.e = e; u.mt = tt - tb.tstart[e]; u.pm = tt; u.pn = L & 1; u.A = h2; u.B = wgu + ((size_t)e * 512 + (size_t)u.pn * 256) * 1024 * 2; }
        else { const int s = L - nmoe; u.e = -1; u.mt = 0; u.pm = s >> 1; u.pn = s & 1; u.A = h2; u.B = wsgu + (size_t)u.pn * 256 * 1024 * 2; }
        return true; }
    __device__ __forceinline__ int row(const pg8::Unit& u, int r) const {
        if (u.e < 0) return u.pm * 256 + r;
        const int idx = u.mt * 256 + r; return idx < tb.cnt[u.e] ? (list[(size_t)u.e * LISTCAP + idx] >> 3) : 0; }
};
struct SchedMoe2 {
    static constexpr bool GATHER = false;
    MoeTab tb; int ntot, per, c, lane; const char* act; const char* wd;
    __device__ __forceinline__ bool next(int i, pg8::Unit& u) const {
        const int L = c * per + i; if (i >= per || L >= ntot) return false;
        const int tt = L >> 2; const int e = __popcll(__ballot(tb.tstart[lane + 1] <= tt));
        u.e = e; u.mt = tt - tb.tstart[e]; u.pm = tt; u.pn = L & 3; u.A = act + (size_t)tt * 256 * 256 * 2; u.B = wd + ((size_t)e * 1024 + (size_t)u.pn * 256) * 256 * 2; return true; }
    __device__ __forceinline__ int row(const pg8::Unit&, int) const { return 0; }
};

typedef pg8::f32x4 (AccT)[2][2][4][2];
__device__ __forceinline__ v4u pack8(const f32x4& a, const f32x4& b) { v4u w; w.x = cvt_pk_bf16(a[0], a[1]); w.y = cvt_pk_bf16(a[2], a[3]); w.z = cvt_pk_bf16(b[0], b[1]); w.w = cvt_pk_bf16(b[2], b[3]); return w; }
__device__ __forceinline__ void unpack8(const v4u& w, f32x4& a, f32x4& b) { a = (f32x4){bf_lo(w.x), bf_hi(w.x), bf_lo(w.y), bf_hi(w.y)}; b = (f32x4){bf_lo(w.z), bf_hi(w.z), bf_lo(w.w), bf_hi(w.w)}; }
__device__ __forceinline__ f32x4 sig4(const f32x4& v) { return (f32x4){sigmoidf_fast(v[0]), sigmoidf_fast(v[1]), sigmoidf_fast(v[2]), sigmoidf_fast(v[3])}; }

struct EpiIn {
    static constexpr bool PERM = true;
    bf16 *U, *Q, *Kb, *V, *SG; const float *gq, *gk;
    __device__ __forceinline__ void operator()(const AccT& acc, const pg8::Unit& u, int wr, int wc, int fr_, int fq_) const {
        int fr = fr_, fq = fq_; asm volatile("" : "+v"(fr), "+v"(fq));
        const int row0 = u.pm * 256 + wr * 64 + fr, pn = u.pn;
        if (pn < 4) {
            const int col0 = 128 * pn + 32 * wc + 8 * fq;
#pragma unroll
            for (int ai = 0; ai < 2; ++ai)
#pragma unroll
                for (int m = 0; m < 4; ++m) { const f32x4 v0 = acc[ai][0][m][0] * sig4(acc[ai][1][m][0]), v1 = acc[ai][0][m][1] * sig4(acc[ai][1][m][1]);
                    *(v4u*)(U + (size_t)(row0 + ai * 128 + m * 16) * CONVD + col0) = pack8(v0, v1); }
        } else if (pn < 8) {
            const bool isk = pn >= 6; const int head = 4 * ((pn - 4) & 1) + wc; const float* g = isk ? gk : gq; bf16* dst = isk ? Kb : Q; const float sc = isk ? 1.0f : C2Q;
            f32x4 gv[2][2];
#pragma unroll
            for (int bj = 0; bj < 2; ++bj)
#pragma unroll
                for (int n = 0; n < 2; ++n) gv[bj][n] = *(const f32x4*)(g + 32 * bj + 8 * fq + 4 * n) * sc;
#pragma unroll
            for (int ai = 0; ai < 2; ++ai)
#pragma unroll
                for (int m = 0; m < 4; ++m) { float ss = 0.f;
#pragma unroll
                    for (int bj = 0; bj < 2; ++bj)
#pragma unroll
                        for (int n = 0; n < 2; ++n) { const f32x4 x = acc[ai][bj][m][n]; ss += (x[0] * x[0] + x[1] * x[1]) + (x[2] * x[2] + x[3] * x[3]); }
                    ss += __shfl_xor(ss, 16); ss += __shfl_xor(ss, 32);
                    const float r = 1.0f / sqrtf(ss * (1.0f / 64.0f) + EPS);
                    bf16* rowp = dst + (size_t)(row0 + ai * 128 + m * 16) * ATT + head * 64 + 8 * fq;
#pragma unroll
                    for (int bj = 0; bj < 2; ++bj) *(v4u*)(rowp + 32 * bj) = pack8(acc[ai][bj][m][0] * r * gv[bj][0], acc[ai][bj][m][1] * r * gv[bj][1]); }
        } else if (pn < 10) {
            const int col0 = 256 * (pn - 8) + 32 * wc + 8 * fq;
#pragma unroll
            for (int ai = 0; ai < 2; ++ai)
#pragma unroll
                for (int m = 0; m < 4; ++m)
#pragma unroll
                    for (int bj = 0; bj < 2; ++bj) *(v4u*)(V + (size_t)(row0 + ai * 128 + m * 16) * ATT + col0 + 128 * bj) = pack8(acc[ai][bj][m][0], acc[ai][bj][m][1]);
        } else {
            bf16* dst = SG + (size_t)((pn - 10) >> 2) * T * DMODEL; const int col0 = 256 * ((pn - 10) & 3) + 32 * wc + 8 * fq;
#pragma unroll
            for (int ai = 0; ai < 2; ++ai)
#pragma unroll
                for (int m = 0; m < 4; ++m)
#pragma unroll
                    for (int bj = 0; bj < 2; ++bj) *(v4u*)(dst + (size_t)(row0 + ai * 128 + m * 16) * DMODEL + col0 + 128 * bj) = pack8(sig4(acc[ai][bj][m][0]), sig4(acc[ai][bj][m][1]));
        }
    }
};
struct EpiMerge {
    static constexpr bool PERM = true;
    const bf16* SG; bf16* MG;
    __device__ __forceinline__ void operator()(const AccT& acc, const pg8::Unit& u, int wr, int wc, int fr_, int fq_) const {
        int fr = fr_, fq = fq_; asm volatile("" : "+v"(fr), "+v"(fq));
        const int row0 = u.pm * 256 + wr * 64 + fr, col0 = u.pn * 256 + 32 * wc + 8 * fq; const bf16* sg = SG + (size_t)u.e * T * DMODEL;
#pragma unroll
        for (int ai = 0; ai < 2; ++ai)
#pragma unroll
            for (int m = 0; m < 4; ++m)
#pragma unroll
                for (int bj = 0; bj < 2; ++bj) { const size_t off = (size_t)(row0 + ai * 128 + m * 16) * DMODEL + col0 + 128 * bj;
                    f32x4 g0, g1; unpack8(*(const v4u*)(sg + off), g0, g1);
                    f32x4 v0 = g0 * acc[ai][bj][m][0], v1 = g1 * acc[ai][bj][m][1];
                    if (u.e) { f32x4 p0, p1; unpack8(*(const v4u*)(MG + off), p0, p1); v0 += p0; v1 += p1; }
                    *(v4u*)(MG + off) = pack8(v0, v1); }
    }
};
struct EpiX1 {
    static constexpr bool PERM = false;
    const float* x; float* out; const float* mod; float* ssq;
    __device__ __forceinline__ void operator()(const AccT& acc, const pg8::Unit& u, int wr, int wc, int fr_, int fq_) const {
        int fr = fr_, fq = fq_; asm volatile("" : "+v"(fr), "+v"(fq));
        const int row0 = u.pm * 256 + wr * 64 + fr, col0 = u.pn * 256 + 32 * wc + 4 * fq; const float* g1 = mod + (size_t)(u.pm >> 5) * 6144 + 2048;
        f32x4 gv[2][2];
#pragma unroll
        for (int bj = 0; bj < 2; ++bj)
#pragma unroll
            for (int n = 0; n < 2; ++n) gv[bj][n] = *(const f32x4*)(g1 + col0 + 128 * bj + 16 * n);
#pragma unroll
        for (int ai = 0; ai < 2; ++ai)
#pragma unroll
            for (int m = 0; m < 4; ++m) { const int row = row0 + ai * 128 + m * 16; float ss = 0.f;
#pragma unroll
                for (int bj = 0; bj < 2; ++bj)
#pragma unroll
                    for (int n = 0; n < 2; ++n) { const size_t off = (size_t)row * DMODEL + col0 + 128 * bj + 16 * n;
                        const f32x4 v = *(const f32x4*)(x + off) + gv[bj][n] * acc[ai][bj][m][n]; *(f32x4*)(out + off) = v;
                        ss += (v[0] * v[0] + v[1] * v[1]) + (v[2] * v[2] + v[3] * v[3]); }
                ss += __shfl_xor(ss, 16); ss += __shfl_xor(ss, 32);
                if (fq == 0) ssq[(size_t)(u.pn * 4 + wc) * T + row] = ss; }
    }
};
struct EpiGlu {
    static constexpr bool PERM = true;
    bf16 *ACT, *SACT; const float* wlist; MoeTab tb;
    __device__ __forceinline__ void operator()(const AccT& acc, const pg8::Unit& u, int wr, int wc, int fr_, int fq_) const {
        int fr = fr_, fq = fq_; asm volatile("" : "+v"(fr), "+v"(fq));
        const int rl0 = wr * 64 + fr, col0 = 128 * u.pn + 32 * wc + 8 * fq; bf16* dst = (u.e >= 0 ? ACT : SACT) + (size_t)u.pm * 256 * EF;
        const int cnt = u.e >= 0 ? tb.cnt[u.e] : 0;
#pragma unroll
        for (int ai = 0; ai < 2; ++ai)
#pragma unroll
            for (int m = 0; m < 4; ++m) { const int rl = rl0 + ai * 128 + m * 16; float w = 1.0f;
                if (u.e >= 0) { const int idx = u.mt * 256 + rl; w = idx < cnt ? wlist[(size_t)u.e * LISTCAP + idx] : 0.0f; }
                const f32x4 g0 = acc[ai][0][m][0], g1 = acc[ai][0][m][1];
                const f32x4 v0 = g0 * sig4(g0) * acc[ai][1][m][0] * w, v1 = g1 * sig4(g1) * acc[ai][1][m][1] * w;
                *(v4u*)(dst + (size_t)rl * EF + col0) = pack8(v0, v1); asm volatile("" ::: "memory"); }
    }
};
struct EpiSlab {
    static constexpr bool PERM = true;
    bf16* SLAB; const int* list; MoeTab tb;
    __device__ __forceinline__ void operator()(const AccT& acc, const pg8::Unit& u, int wr, int wc, int fr_, int fq_) const {
        int fr = fr_, fq = fq_; asm volatile("" : "+v"(fr), "+v"(fq));
        const int rl0 = wr * 64 + fr, col0 = 256 * u.pn + 32 * wc + 8 * fq, cnt = tb.cnt[u.e];
#pragma unroll
        for (int ai = 0; ai < 2; ++ai)
#pragma unroll
            for (int m = 0; m < 4; ++m) { const int idx = u.mt * 256 + rl0 + ai * 128 + m * 16;
                if (idx < cnt) { const int slot = list[(size_t)u.e * LISTCAP + idx]; bf16* rowp = SLAB + (size_t)slot * DMODEL + col0;
#pragma unroll
                    for (int bj = 0; bj < 2; ++bj) *(v4u*)(rowp + 128 * bj) = pack8(acc[ai][bj][m][0], acc[ai][bj][m][1]); }
                asm volatile("" ::: "memory"); }
    }
};
struct EpiFinal {
    static constexpr bool PERM = true;
    float* out; const bf16* SLAB; const float* mod;
    __device__ __forceinline__ void operator()(const AccT& acc, const pg8::Unit& u, int wr, int wc, int fr_, int fq_) const {
        int fr = fr_, fq = fq_; asm volatile("" : "+v"(fr), "+v"(fq));
        const int row0 = u.pm * 256 + wr * 64 + fr, col0 = u.pn * 256 + 32 * wc + 8 * fq; const float* g2 = mod + (size_t)(u.pm >> 5) * 6144 + 5120;
        f32x4 gv[2][2];
#pragma unroll
        for (int bj = 0; bj < 2; ++bj)
#pragma unroll
            for (int n = 0; n < 2; ++n) gv[bj][n] = *(const f32x4*)(g2 + col0 + 128 * bj + 4 * n);
#pragma unroll
        for (int ai = 0; ai < 2; ++ai)
#pragma unroll
            for (int m = 0; m < 4; ++m) { const int row = row0 + ai * 128 + m * 16;
#pragma unroll
                for (int bj = 0; bj < 2; ++bj) { f32x4 s0 = acc[ai][bj][m][0], s1 = acc[ai][bj][m][1]; const bf16* sp = SLAB + (size_t)row * TOPK * DMODEL + col0 + 128 * bj;
#if FWD_LEVEL >= 2
#pragma unroll
                    for (int k = 0; k < TOPK; ++k) { f32x4 a0, a1; unpack8(*(const v4u*)(sp + (size_t)k * DMODEL), a0, a1); s0 += a0; s1 += a1; }
#endif
                    float* op = out + (size_t)row * DMODEL + col0 + 128 * bj;
                    *(f32x4*)op = *(const f32x4*)op + gv[bj][0] * s0; *(f32x4*)(op + 4) = *(const f32x4*)(op + 4) + gv[bj][1] * s1; asm volatile("" ::: "memory"); } }
    }
};

__device__ __forceinline__ void p6_item(const KArgs& a, LAS unsigned char* lds, int item, int tid, int wave, int lane) {
    unsigned char* ws = a.ws;
    const int row0 = 32 * item, r = lane & 31, h = lane >> 5, row = row0 + r, b = row >> 13;
    const float* x1 = a.out; const float* ssq = (const float*)(ws + WS_SSQ); const float* mod = (const float*)(ws + WS_MOD) + (size_t)b * 6144;
    bf16* H2 = (bf16*)(ws + WS_H2); const bf16* WRH = (const bf16*)(ws + WS_WRH); const bf16* WRL = (const bf16*)(ws + WS_WRL);
    LAS float* part = (LAS float*)(lds + RING_OFF);
    LAS float* scl = (LAS float*)(lds + RING_OFF + 65536);
    LAS float* bil = scl + 32 * 65;
    LAS int* hist = (LAS int*)(bil + 32 * 65);
    LAS int* gbase = hist + 64;
    float ss = 0.f;
#pragma unroll
    for (int p = 0; p < 16; ++p) ss += ssq[(size_t)p * T + row];
    const float rstd = 1.0f / sqrtf(ss * (1.0f / DMODEL) + EPS);
    f32x16 acc0, acc1;
#pragma unroll
    for (int i = 0; i < 16; ++i) { acc0[i] = 0.f; acc1[i] = 0.f; }
    if (tid < 64) hist[tid] = 0;
#pragma unroll
    for (int ms = 0; ms < 2; ++ms) {
        const int kb = 128 * wave + 64 * ms + 32 * h;
        const float* xp = x1 + (size_t)row * DMODEL + kb; const float* g2 = a.in[16] + kb; const float* sc2 = mod + 4096 + kb; const float* sh2 = mod + 3072 + kb;
        bf16x8 ahi[4], alo[4];
#pragma unroll
        for (int s = 0; s < 4; ++s) {
            const f32x4 xa = *(const f32x4*)(xp + 8 * s), xb = *(const f32x4*)(xp + 8 * s + 4);
            const f32x4 ga = *(const f32x4*)(g2 + 8 * s) * (1.0f + *(const f32x4*)(sc2 + 8 * s)), gb = *(const f32x4*)(g2 + 8 * s + 4) * (1.0f + *(const f32x4*)(sc2 + 8 * s + 4));
            const f32x4 ha = xa * rstd * ga + *(const f32x4*)(sh2 + 8 * s), hb = xb * rstd * gb + *(const f32x4*)(sh2 + 8 * s + 4);
            float hv[8] = {ha[0], ha[1], ha[2], ha[3], hb[0], hb[1], hb[2], hb[3]};
            unsigned hi[8]; float lo[8];
#pragma unroll
            for (int j = 0; j < 8; ++j) { hi[j] = f2bf(hv[j]); lo[j] = hv[j] - bf2f(hi[j]); }
            v4u whi = (v4u){hi[0] | (hi[1] << 16), hi[2] | (hi[3] << 16), hi[4] | (hi[5] << 16), hi[6] | (hi[7] << 16)};
            v4u wlo = (v4u){pk2(lo[0], lo[1]), pk2(lo[2], lo[3]), pk2(lo[4], lo[5]), pk2(lo[6], lo[7])};
            *(GAS v4u*)(H2 + (size_t)row * DMODEL + kb + 8 * s) = whi;
            ahi[s] = __builtin_bit_cast(bf16x8, whi); alo[s] = __builtin_bit_cast(bf16x8, wlo);
        }
#pragma unroll
        for (int s = 0; s < 4; ++s) {
            const bf16x8 bh0 = *(const bf16x8*)(WRH + (size_t)r * DMODEL + kb + 8 * s), bh1 = *(const bf16x8*)(WRH + (size_t)(32 + r) * DMODEL + kb + 8 * s);
            const bf16x8 bl0 = *(const bf16x8*)(WRL + (size_t)r * DMODEL + kb + 8 * s), bl1 = *(const bf16x8*)(WRL + (size_t)(32 + r) * DMODEL + kb + 8 * s);
            acc0 = __builtin_amdgcn_mfma_f32_32x32x16_bf16(alo[s], bh0, acc0, 0, 0, 0); acc1 = __builtin_amdgcn_mfma_f32_32x32x16_bf16(alo[s], bh1, acc1, 0, 0, 0);
            acc0 = __builtin_amdgcn_mfma_f32_32x32x16_bf16(ahi[s], bl0, acc0, 0, 0, 0); acc1 = __builtin_amdgcn_mfma_f32_32x32x16_bf16(ahi[s], bl1, acc1, 0, 0, 0);
            acc0 = __builtin_amdgcn_mfma_f32_32x32x16_bf16(ahi[s], bh0, acc0, 0, 0, 0); acc1 = __builtin_amdgcn_mfma_f32_32x32x16_bf16(ahi[s], bh1, acc1, 0, 0, 0);
        }
    }
#pragma unroll
    for (int i = 0; i < 16; ++i) { const int tr = (i & 3) + 8 * (i >> 2) + 4 * h; part[(wave * 32 + tr) * 64 + r] = acc0[i]; part[(wave * 32 + tr) * 64 + 32 + r] = acc1[i]; }
    __syncthreads();
    {
        const int tr = tid >> 4, e4 = (tid & 15) * 4; f32x4 s = *(const LAS f32x4*)(part + tr * 64 + e4);
#pragma unroll
        for (int w = 1; w < 8; ++w) s += *(const LAS f32x4*)(part + (w * 32 + tr) * 64 + e4);
        const f32x4 rb = *(const f32x4*)(a.in[18] + e4);
#pragma unroll
        for (int j = 0; j < 4; ++j) { const float sc = 1.0f / (1.0f + expf(-s[j])); scl[tr * 65 + e4 + j] = sc; bil[tr * 65 + e4 + j] = sc + rb[j]; }
    }
    __syncthreads();
    int sel_e[TOPK], sel_p[TOPK]; float sel_w[TOPK];
    if (tid < 32) {
        const LAS float* bi = bil + tid * 65; const LAS float* sc = scl + tid * 65;
        float gsc[8];
#pragma unroll
        for (int g = 0; g < 8; ++g) { float m1 = -INFINITY, m2 = -INFINITY;
#pragma unroll
            for (int j = 0; j < 8; ++j) { const float v = bi[8 * g + j]; if (v > m1) { m2 = m1; m1 = v; } else if (v > m2) m2 = v; }
            gsc[g] = m1 + m2; }
        unsigned gmask = 0;
#pragma unroll
        for (int g = 0; g < 8; ++g) { int rank = 0;
#pragma unroll
            for (int g2 = 0; g2 < 8; ++g2) rank += (gsc[g2] > gsc[g]) || (gsc[g2] == gsc[g] && g2 < g);
            if (rank < 4) gmask |= 1u << g; }
        unsigned long long taken = 0ull; float wsum = 0.f;
#pragma unroll
        for (int k = 0; k < TOPK; ++k) { float best = -INFINITY; int be = 0;
            for (int e = 0; e < NE; ++e) { const bool ok = ((gmask >> (e >> 3)) & 1u) && !((taken >> e) & 1ull); const float v = bi[e]; if (ok && v > best) { best = v; be = e; } }
            taken |= 1ull << be; sel_e[k] = be; sel_w[k] = sc[be]; wsum += sel_w[k]; }
        const float inv = ROUTED_SCALE / wsum;
#pragma unroll
        for (int k = 0; k < TOPK; ++k) { sel_w[k] *= inv; sel_p[k] = __hip_atomic_fetch_add(&hist[sel_e[k]], 1, __ATOMIC_RELAXED, __HIP_MEMORY_SCOPE_WORKGROUP); }
    }
    __syncthreads();
    if (tid < 64) { const int n = hist[tid]; gbase[tid] = n ? (int)__hip_atomic_fetch_add((unsigned*)(ws + WS_CTL) + CW_CNT + 64 * tid, (unsigned)n, RLX_AGENT) : 0; }
    __syncthreads();
    if (tid < 32) { int* list = (int*)(ws + WS_LIST); float* wl = (float*)(ws + WS_WLIST);
#pragma unroll
        for (int k = 0; k < TOPK; ++k) { const size_t p = (size_t)sel_e[k] * LISTCAP + gbase[sel_e[k]] + sel_p[k]; list[p] = (row0 + tid) * TOPK + k; wl[p] = sel_w[k]; } }
    __syncthreads();
}

__device__ __forceinline__ void moe_tables(const KArgs& a, LAS unsigned char* lds, int tid, int lane) {
    LAS int* tstart = (LAS int*)(lds + TAB_OFF); LAS int* cntl = tstart + 80;
    if (tid < 64) { const int c = (int)__hip_atomic_load((unsigned*)(a.ws + WS_CTL) + CW_CNT + 64 * tid, RLX_AGENT); const int tl = (c + 255) >> 8; int sc = tl;
#pragma unroll
        for (int o = 1; o < 64; o <<= 1) { const int up = __shfl_up(sc, o); if (lane >= o) sc += up; }
        cntl[tid] = c; tstart[tid + 1] = sc; if (tid == 0) tstart[0] = 0; }
    __syncthreads();
}

__global__ void __launch_bounds__(NWAVES * 64, 2) fox_fwd(KArgs args) {
    extern __shared__ __attribute__((aligned(16))) unsigned char lds_raw[];
    LAS unsigned char* lds = (LAS unsigned char*)lds_raw;
    volatile LAS unsigned* MISC = (volatile LAS unsigned*)(lds + MISC_OFF);
    const int tid = threadIdx.x, lane = tid & 63, wave = __builtin_amdgcn_readfirstlane(tid >> 6);
    const int G = gridDim.x; int vcu; { const int bx = blockIdx.x; vcu = (G % 8 == 0) ? (bx % 8) * (G / 8) + bx / 8 : bx; }
    unsigned char* ws = args.ws; gu32* ctl = (gu32*)(ws + WS_CTL);
    for (int u = tid; u < (LDS_BYTES - LDSCTL_OFF) / 4; u += NWAVES * 64) ((LAS unsigned*)(lds + LDSCTL_OFF))[u] = 0u;
    __syncthreads();
    const int lo = args.ph_lo, hi = args.ph_hi; const bool single = (hi - lo) > 1;
    XcdBarrier bar; bar.bar = (unsigned*)(ctl + CW_BAR); bar.x = 0; bar.st = nullptr;
    if (single) bar = xcd_barrier_post((unsigned*)(ctl + CW_BAR), MISC + 8);
#ifndef PHASE_MASK
#define PHASE_MASK 0x3ff
#endif
#define IN(k) (((PHASE_MASK >> (k)) & 1) && lo <= (k) && (k) < hi)
#define GRID_BAR(k) do { if (IN(k) && IN((k) + 1)) xcd_barrier(bar); } while (0)
    bf16* H1 = (bf16*)(ws + WS_H1); bf16* Ub = (bf16*)(ws + WS_U); bf16* Qb = (bf16*)(ws + WS_Q); bf16* Kb = (bf16*)(ws + WS_K); bf16* Vb = (bf16*)(ws + WS_V);
    bf16* SG = (bf16*)(ws + WS_SG); bf16* UC = (bf16*)(ws + WS_UC); bf16* Ob = (bf16*)(ws + WS_O); bf16* MG = (bf16*)(ws + WS_MG);
    const float* mod = (const float*)(ws + WS_MOD);

#if FWD_LEVEL == 0
    if (IN(0)) { const f32x4* xs = (const f32x4*)args.in[0]; f32x4* od = (f32x4*)args.out;
        for (size_t i = (size_t)blockIdx.x * 512 + tid; i < (size_t)T * DMODEL / 4; i += (size_t)G * 512) od[i] = xs[i]; }
    for (int k = 0; k < 9; ++k) GRID_BAR(k);
#else
    if (IN(0)) p0_prologue(args, lds, vcu, G, wave, lane);
    GRID_BAR(0);
    if (IN(1)) { if (G == 256) p1_rows(args, lds, vcu, tid, wave, lane); }
    GRID_BAR(1);
    if (IN(2)) {
        if (blockIdx.x < 16) p2_cumsum(args, lds, blockIdx.x, tid, wave, lane);
        SchedDense S{64, NIN / 256, G, (int)blockIdx.x, 1024, (const char*)H1, (const char*)(ws + WS_WIN)};
        EpiIn E{Ub, Qb, Kb, Vb, SG, args.in[11], args.in[12]};
        pg8::gemm_phase<EpiIn, SchedDense, true>(lds + RING_OFF, 1024, S, E);
    }
    GRID_BAR(2);
#if defined(DBG_STAGE) && (DBG_STAGE == 24 || DBG_STAGE == 4)
    {   const bf16* src = (DBG_STAGE == 24) ? SG : (const bf16*)(ws + WS_WIN) + (size_t)2560 * 1024;
        for (size_t i = (size_t)blockIdx.x * 512 + tid; i < (size_t)T * 1024; i += (size_t)G * 512) { const size_t r = i >> 10, c = i & 1023; args.out[i] = bf2f(src[((DBG_STAGE == 24) ? r : (r & 2047)) * 1024 + c]); }
        return; }
#endif
    if (IN(3)) {
        float gq = fabsf(args.in[11][lane]), gk = fabsf(args.in[12][lane]);
#pragma unroll
        for (int o = 1; o < 64; o <<= 1) { gq = fmaxf(gq, __shfl_xor(gq, o)); gk = fmaxf(gk, __shfl_xor(gk, o)); }
        const float thr2 = 2.0f * (8.0f * gq * gk * LOG2E) + 40.0f;
        const attn_body::AttnTensors AT{(const attn_body::bf16*)Qb, (const attn_body::bf16*)Kb, (const attn_body::bf16*)Vb, (attn_body::bf16*)Ob, (const float*)(ws + WS_CUM), thr2};
        if (G == 256) { const attn_body::StaticOrder S(G, (int)blockIdx.x); attn_body::attn_phase<attn_body::StaticOrder>((char*)lds_raw + RING_OFF, AT, S); }
        for (int it = vcu; it < 1024; it += G) conv_item(args, lds, it, tid);
    }
    GRID_BAR(3);
#if defined(DBG_STAGE)
    {
#if DBG_STAGE == 2
        const bf16* bA = Qb; const bf16* bB = Kb;
#elif DBG_STAGE == 21
        const bf16* bA = Vb; const bf16* bB = Ub;
#elif DBG_STAGE == 22
        const bf16* bA = SG; const bf16* bB = SG + 512;
#elif DBG_STAGE == 23
        const bf16* bA = SG + (size_t)T * 1024; const bf16* bB = SG + (size_t)T * 1024 + 512;
#elif DBG_STAGE == 3
        const bf16* bA = Ob; const bf16* bB = UC;
#else
        const bf16* bA = H1; const bf16* bB = H1 + 512;
#endif
        const int ldA = (DBG_STAGE == 1 || DBG_STAGE == 22 || DBG_STAGE == 23) ? 1024 : 512;
        for (size_t i = (size_t)blockIdx.x * 512 + tid; i < (size_t)T * 512; i += (size_t)G * 512) { const size_t r = i >> 9, c = i & 511;
            args.out[r * 1024 + c] = bf2f(bA[r * ldA + c]); args.out[r * 1024 + 512 + c] = bf2f(bB[r * ldA + c]); }
        return;
    }
#endif
    if (IN(4)) {
        SchedMerge S{(int)blockIdx.x, (const char*)UC, (const char*)(ws + WS_WC), (const char*)Ob, (const char*)(ws + WS_WA)};
        EpiMerge E{SG, MG};
        pg8::gemm_phase<EpiMerge, SchedMerge, false>(lds + RING_OFF, 512, S, E);
    }
    GRID_BAR(4);
#if defined(DBG_STAGE2)
    {   for (size_t i = (size_t)blockIdx.x * 512 + tid; i < (size_t)T * 1024; i += (size_t)G * 512) args.out[i] = bf2f(MG[i]);
        return; }
#endif
    if (IN(5)) {
        SchedDense S{64, 4, G, (int)blockIdx.x, 1024, (const char*)MG, (const char*)(ws + WS_WOUT)};
        EpiX1 E{args.in[0], args.out, mod, (float*)(ws + WS_SSQ)};
        pg8::gemm_phase<EpiX1, SchedDense, false>(lds + RING_OFF, 1024, S, E);
    }
    GRID_BAR(5);
#if FWD_LEVEL >= 2
    if (IN(6)) { for (int it = vcu; it < T / 32; it += G) p6_item(args, lds, it, tid, wave, lane); }
    GRID_BAR(6);
    const MoeTab tb{(const LAS int*)(lds + TAB_OFF), (const LAS int*)(lds + TAB_OFF) + 80};
    if (IN(7)) {
        moe_tables(args, lds, tid, lane);
        const int ntiles = tb.tstart[64], nmoe = 2 * ntiles, ntot = nmoe + 128, per = (ntot + G - 1) / G;
        SchedMoe1 S{tb, nmoe, ntot, per, vcu, lane, (const char*)(ws + WS_H2), (const char*)(ws + WS_WGU), (const char*)(ws + WS_WSGU), (const int*)(ws + WS_LIST)};
        EpiGlu E{(bf16*)(ws + WS_ACT), (bf16*)(ws + WS_SACT), (const float*)(ws + WS_WLIST), tb};
        pg8::gemm_phase<EpiGlu, SchedMoe1, true>(lds + RING_OFF, 1024, S, E);
    }
    GRID_BAR(7);
    if (IN(8)) {
        moe_tables(args, lds, tid, lane);
        const int ntiles = tb.tstart[64], ntot = 4 * ntiles, per = (ntot + G - 1) / G;
        SchedMoe2 S{tb, ntot, per, vcu, lane, (const char*)(ws + WS_ACT), (const char*)(ws + WS_WD)};
        EpiSlab E{(bf16*)(ws + WS_SLAB), (const int*)(ws + WS_LIST), tb};
        pg8::gemm_phase<EpiSlab, SchedMoe2, true>(lds + RING_OFF, 256, S, E);
    }
    GRID_BAR(8);
    if (IN(9)) {
        SchedDense S{64, 4, G, (int)blockIdx.x, 256, (const char*)(ws + WS_SACT), (const char*)(ws + WS_WSD)};
        EpiFinal E{args.out, (const bf16*)(ws + WS_SLAB), mod};
        pg8::gemm_phase<EpiFinal, SchedDense, false>(lds + RING_OFF, 256, S, E);
    }
#endif
#endif
#undef IN
#undef GRID_BAR
}

#ifndef N_LAUNCH_MODE
#define N_LAUNCH_MODE 1
#endif
extern "C" void kernel_launch(void* const* d_in, const int* in_sizes, int n_in, void* d_out, int out_size, void* d_ws, size_t ws_size, hipStream_t stream) {
    static int grid = 0;
    if (grid == 0) {
        if (n_in != 23 || in_sizes[0] != T * DMODEL || out_size != T * DMODEL || ws_size < WS_END) {
            fprintf(stderr, "kernel_launch: built for 23 inputs, x/out of %d floats, >= %zu bytes of workspace; got n_in %d, in0 %d, out %d, ws %zu; nothing launched\n", T * DMODEL, (size_t)WS_END, n_in, n_in > 0 ? in_sizes[0] : -1, out_size, ws_size);
            grid = -1; return; }
        int dev = 0, cus = 0, per_cu = 0;
        if (hipGetDevice(&dev) != hipSuccess || hipDeviceGetAttribute(&cus, hipDeviceAttributeMultiprocessorCount, dev) != hipSuccess) { fprintf(stderr, "kernel_launch: device query failed\n"); grid = -1; return; }
        if (hipFuncSetAttribute((const void*)fox_fwd, hipFuncAttributeMaxDynamicSharedMemorySize, LDS_BYTES) != hipSuccess) { fprintf(stderr, "kernel_launch: hipFuncSetAttribute failed\n"); grid = -1; return; }
        if (hipOccupancyMaxActiveBlocksPerMultiprocessor(&per_cu, (const void*)fox_fwd, NWAVES * 64, LDS_BYTES) != hipSuccess || per_cu < 1)
            fprintf(stderr, "kernel_launch: note: occupancy query reports %d workgroups per CU\n", per_cu);
        (void)hipGetLastError();
        grid = cus;
        if (grid != 256) fprintf(stderr, "kernel_launch: %d CUs; this kernel is built for 256\n", grid);
    }
    if (grid < 0) return;
    if (hipMemsetAsync((char*)d_ws + WS_CTL, 0, CTL_ZERO_BYTES, stream) != hipSuccess) { fprintf(stderr, "kernel_launch: memset failed\n"); return; }
    KArgs a{};
    for (int i = 0; i < 23; ++i) a.in[i] = (const float*)d_in[i];
    a.out = (float*)d_out; a.ws = (unsigned char*)d_ws;
#if N_LAUNCH_MODE == 1
    a.ph_lo = 0; a.ph_hi = 10;
    hipLaunchKernelGGL(fox_fwd, dim3(grid), dim3(NWAVES * 64), LDS_BYTES, stream, a);
#else
    for (int p = 0; p < 10; ++p) { a.ph_lo = p; a.ph_hi = p + 1; hipLaunchKernelGGL(fox_fwd, dim3(grid), dim3(NWAVES * 64), LDS_BYTES, stream, a); }
#endif
    const hipError_t le = hipPeekAtLastError();
    if (le != hipSuccess) fprintf(stderr, "kernel_launch: launch failed: %s\n", hipGetErrorName(le));
}
```

```cpp
#include <hip/hip_runtime.h>
#include <hip/hip_bf16.h>
#include <cstdio>
#include <cstdint>
#include <cmath>

#ifndef ATTN_SKIP
#define ATTN_SKIP 1
#endif
#ifndef FWD_LEVEL
#define FWD_LEVEL 2
#endif

namespace pg8 {
#define PG8_LAS __attribute__((address_space(3)))
typedef unsigned short bf16_t;
typedef short bf16x8 __attribute__((ext_vector_type(8)));
typedef float f32x4 __attribute__((ext_vector_type(4)));
typedef unsigned u32x4 __attribute__((ext_vector_type(4)));
constexpr int BM = 256, BK = 64, HALF = 128, HTB = HALF * BK * 2  , STAGE_BYTES = 8 * HTB, NXCD = 8, WGM = 8;

__host__ __device__ __forceinline__ int lds_byte(int r, int c) { const int st = (r >> 4) * 2 + (c >> 5), rr = r & 15, cc = c & 31, ob = rr * 64 + cc * 2; return st * 1024 + (ob ^ (((ob >> 9) & 1) << 5)); }
__host__ __device__ __forceinline__ void stage_rc(int b, int& R, int& C) { const int st = b / 1024, sb = b % 1024, swz = sb ^ (((sb >> 9) & 1) << 5); R = (st >> 1) * 16 + swz / 64; C = (st & 1) * 32 + (swz % 64) / 2; }
__host__ __device__ __forceinline__ int perm32(int rho) { const int n = rho >> 4, i = rho & 15; return 8 * (i >> 2) + 4 * n + (i & 3); }

struct Unit { int pm, pn, e, mt; const char* A; const char* B; };

__host__ __device__ __forceinline__ void tile_of(int L, int nM, int nN, int& pm, int& pn) {
    const int nwg = nM * nN; int wgid = L; { const int q = nwg / NXCD, r = nwg % NXCD, xcd = wgid % NXCD, off = wgid / NXCD; wgid = (xcd < r ? xcd * (q + 1) : r * (q + 1) + (xcd - r) * q) + off; }
    const int nig = WGM * nN, gid = wgid / nig, fm = gid * WGM, gsz = (nM - fm) < WGM ? (nM - fm) : WGM;
    pm = fm + ((wgid % nig) % gsz); pn = (wgid % nig) / gsz;
}
typedef float f32x2_c __attribute__((ext_vector_type(2))); typedef __bf16 bf16x2_c __attribute__((ext_vector_type(2)));
__device__ __forceinline__ unsigned cvt_pk_bf16(float lo, float hi) { f32x2_c v = {lo, hi}; bf16x2_c b = __builtin_convertvector(v, bf16x2_c); return __builtin_bit_cast(unsigned, b); }
__device__ __forceinline__ float bf_lo(unsigned w) { return __builtin_bit_cast(float, w << 16); }
__device__ __forceinline__ float bf_hi(unsigned w) { return __builtin_bit_cast(float, w & 0xffff0000u); }
__device__ __forceinline__ float sigmoidf_fast(float x) { return __builtin_amdgcn_rcpf(1.0f + __builtin_amdgcn_exp2f(-1.4426950408889634f * x)); }

typedef int i32x4_c __attribute__((ext_vector_type(4))); typedef int i32x8_c __attribute__((ext_vector_type(8)));
__device__ __forceinline__ i32x8_c cat16(const bf16x8& lo, const bf16x8& hi) { const i32x4_c a = __builtin_bit_cast(i32x4_c, lo), b = __builtin_bit_cast(i32x4_c, hi); return __builtin_shufflevector(a, b, 0, 1, 2, 3, 4, 5, 6, 7); }
template <class Epi, class Sched, bool ALIGN_EPI, bool FP8 = false>
__device__ __forceinline__ void gemm_phase(PG8_LAS unsigned char* lds, const int K, const Sched& S, const Epi& E) {
    const int tid = threadIdx.x, wid = __builtin_amdgcn_readfirstlane(tid >> 6), lane = tid & 63, wr = wid >> 2, wc = wid & 3, fr = lane & 15, fq = lane >> 4;
    const int nt = K / BK;
    int sR[2], sC[2]; unsigned voffB[2];
#pragma unroll
    for (int i = 0; i < 2; ++i) { int R, C; stage_rc(tid * 16 + i * 8192, R, C); sR[i] = R; sC[i] = C; const int Rb = Epi::PERM ? ((R & ~31) + perm32(R & 31)) : R; voffB[i] = (unsigned)(Rb * K + C) * 2u; }
    const size_t kstep = (size_t)(BK * 2);
    const size_t hstep = (size_t)HALF * K * 2;
    const unsigned ldsw = (unsigned)wid * 1024u;
    const int aoff = lds_byte(wr * 64 + fr, fq * 8), boff = lds_byte(wc * 32 + fr, fq * 8);
#define PG8_SA(b, h) (((b) * 2 + (h)) * HTB)
#define PG8_SB(b, h) ((4 + (b) * 2 + (h)) * HTB)
#define PG8_STAGE(bufoff, gbase, voff) do { _Pragma("unroll") for (int _i = 0; _i < 2; ++_i) \
        __builtin_amdgcn_global_load_lds((const unsigned*)((const char*)(gbase) + (voff)[_i]), (PG8_LAS unsigned*)(lds + (bufoff) + ldsw + _i * 8192), 16, 0, 0); } while (0)
#define PG8_STAGE_A(bufoff, gbase, h, V0, V1) do { if constexpr (Sched::GATHER) { if (h) PG8_STAGE(bufoff, gbase, V1); else PG8_STAGE(bufoff, gbase, V0); } \
        else { PG8_STAGE(bufoff, (const char*)(gbase) + ((h) ? hstep : 0), V0); } } while (0)
#define PG8_LDA(dst, b, h) do { _Pragma("unroll") for (int m = 0; m < 4; ++m) { if constexpr (FP8) { const bf16x8 lo_ = *(const PG8_LAS bf16x8*)(lds + PG8_SA(b, h) + aoff + m * 2048), hi_ = *(const PG8_LAS bf16x8*)(lds + PG8_SA(b, h) + aoff + m * 2048 + 1024); dst##8[m] = cat16(lo_, hi_); } \
        else { _Pragma("unroll") for (int k = 0; k < 2; ++k) dst[m][k] = *(const PG8_LAS bf16x8*)(lds + PG8_SA(b, h) + aoff + m * 2048 + k * 1024); } } } while (0)
#define PG8_LDB(dst, b, h) do { _Pragma("unroll") for (int n = 0; n < 2; ++n) { if constexpr (FP8) { const bf16x8 lo_ = *(const PG8_LAS bf16x8*)(lds + PG8_SB(b, h) + boff + n * 2048), hi_ = *(const PG8_LAS bf16x8*)(lds + PG8_SB(b, h) + boff + n * 2048 + 1024); dst##8[n] = cat16(lo_, hi_); } \
        else { _Pragma("unroll") for (int k = 0; k < 2; ++k) dst[n][k] = *(const PG8_LAS bf16x8*)(lds + PG8_SB(b, h) + boff + n * 2048 + k * 1024); } } } while (0)
#define PG8_MMA(ai, bj, At, Bt) do { __builtin_amdgcn_s_setprio(1); if constexpr (FP8) { _Pragma("unroll") for (int m = 0; m < 4; ++m) _Pragma("unroll") for (int n = 0; n < 2; ++n) \
        acc[ai][bj][m][n] = __builtin_amdgcn_mfma_scale_f32_16x16x128_f8f6f4(Bt##8[n], At##8[m], acc[ai][bj][m][n], 0, 0, 0, 0x7f7f7f7f, 0, 0x7f7f7f7f); } \
        else { _Pragma("unroll") for (int m = 0; m < 4; ++m) _Pragma("unroll") for (int n = 0; n < 2; ++n) _Pragma("unroll") for (int k = 0; k < 2; ++k) \
        acc[ai][bj][m][n] = __builtin_amdgcn_mfma_f32_16x16x32_bf16(Bt[n][k], At[m][k], acc[ai][bj][m][n], 0, 0, 0); } __builtin_amdgcn_s_setprio(0); } while (0)
#define PG8_WAIT_V(n) asm volatile("s_waitcnt vmcnt(" #n ")" ::: "memory")
#define PG8_WAIT_L(n) asm volatile("s_waitcnt lgkmcnt(" #n ")" ::: "memory")
#define PG8_BAR __builtin_amdgcn_s_barrier()
#define PG8_SCHED __builtin_amdgcn_sched_barrier(0)
    Unit cur, nxt; int ui = 0;
    if (!S.next(0, cur)) return;
    unsigned vc0[2], vc1[2], vn0[2], vn1[2];
#pragma unroll
    for (int i = 0; i < 2; ++i) {
        if constexpr (Sched::GATHER) { vc0[i] = (unsigned)(S.row(cur, sR[i]) * K + sC[i]) * 2u; vc1[i] = (unsigned)(S.row(cur, HALF + sR[i]) * K + sC[i]) * 2u; }
        else { vc0[i] = (unsigned)(sR[i] * K + sC[i]) * 2u; vc1[i] = 0u; }
        vn0[i] = vc0[i]; vn1[i] = vc1[i];
    }
    f32x4 acc[2][2][4][2];
#pragma unroll
    for (int a = 0; a < 2; ++a)
#pragma unroll
        for (int b = 0; b < 2; ++b)
#pragma unroll
            for (int m = 0; m < 4; ++m)
#pragma unroll
                for (int n = 0; n < 2; ++n) acc[a][b][m][n] = (f32x4){0.f, 0.f, 0.f, 0.f};
    bf16x8 At[4][2], B0[2][2], B1[2][2]; i32x8_c At8[4], B08[2], B18[2];
    const char* cA = cur.A; const char* cB = cur.B;
    PG8_STAGE(PG8_SB(0, 0), cB, voffB); PG8_STAGE(PG8_SB(0, 1), cB + hstep, voffB); PG8_STAGE_A(PG8_SA(0, 0), cA, 0, vc0, vc1); PG8_STAGE_A(PG8_SA(0, 1), cA, 1, vc0, vc1);
    if (wr == 1) PG8_BAR;
    PG8_WAIT_V(2); PG8_BAR;
    PG8_STAGE(PG8_SB(1, 0), cB + kstep, voffB); PG8_STAGE_A(PG8_SA(1, 0), cA + kstep, 0, vc0, vc1); PG8_STAGE(PG8_SB(1, 1), cB + hstep + kstep, voffB);
    PG8_WAIT_V(6); PG8_BAR;
    for (;;) {
        const bool has_next = S.next(ui + 1, nxt);
        const char* nA = has_next ? nxt.A : cA; const char* nB = has_next ? nxt.B : cB;
        if constexpr (Sched::GATHER) {
            if (has_next) {
#pragma unroll
                for (int i = 0; i < 2; ++i) { vn0[i] = (unsigned)(S.row(nxt, sR[i]) * K + sC[i]) * 2u; vn1[i] = (unsigned)(S.row(nxt, HALF + sR[i]) * K + sC[i]) * 2u; }
            }
        }
#pragma nounroll
        for (int t = 0; t < nt; t += 2) {
            const bool last = (t == nt - 2);
            const char* a1 = cA + (size_t)(t + 1) * kstep;
            const char* a2 = last ? nA : cA + (size_t)(t + 2) * kstep; const char* b2 = last ? nB : cB + (size_t)(t + 2) * kstep;
            const char* a3 = a2 + kstep; const char* b3 = b2 + kstep;
            unsigned w0[2], w1[2];
#pragma unroll
            for (int i = 0; i < 2; ++i) { if constexpr (Sched::GATHER) { w0[i] = last ? vn0[i] : vc0[i]; w1[i] = last ? vn1[i] : vc1[i]; } else { w0[i] = vc0[i]; w1[i] = 0u; } }
            PG8_LDB(B0, 0, 0); PG8_LDB(B1, 0, 1); PG8_SCHED; PG8_LDA(At, 0, 0); PG8_STAGE_A(PG8_SA(1, 1), a1, 1, vc0, vc1);
            PG8_WAIT_V(8); PG8_WAIT_L(0); PG8_BAR; PG8_MMA(0, 0, At, B0); PG8_MMA(0, 1, At, B1); PG8_BAR; PG8_SCHED;
            PG8_LDA(At, 0, 1); PG8_STAGE(PG8_SB(0, 0), b2, voffB); PG8_STAGE(PG8_SB(0, 1), b2 + hstep, voffB); PG8_STAGE_A(PG8_SA(0, 0), a2, 0, w0, w1);
            PG8_WAIT_V(8); PG8_WAIT_L(0); PG8_BAR; PG8_MMA(1, 0, At, B0); PG8_MMA(1, 1, At, B1); PG8_BAR; PG8_SCHED;
            PG8_LDB(B0, 1, 0); PG8_LDB(B1, 1, 1); PG8_SCHED; PG8_LDA(At, 1, 0); PG8_STAGE_A(PG8_SA(0, 1), a2, 1, w0, w1);
            PG8_WAIT_V(8); PG8_WAIT_L(0); PG8_BAR; PG8_MMA(0, 0, At, B0); PG8_MMA(0, 1, At, B1); PG8_BAR; PG8_SCHED;
            PG8_LDA(At, 1, 1); PG8_STAGE(PG8_SB(1, 0), b3, voffB); PG8_STAGE(PG8_SB(1, 1), b3 + hstep, voffB); PG8_STAGE_A(PG8_SA(1, 0), a3, 0, w0, w1);
            PG8_WAIT_V(8); PG8_WAIT_L(0); PG8_BAR; PG8_MMA(1, 0, At, B0); PG8_MMA(1, 1, At, B1); PG8_BAR; PG8_SCHED;
        }
        if constexpr (ALIGN_EPI) { if (wr == 0) PG8_BAR; }
        E(acc, cur, wr, wc, fr, fq);
        if (!has_next) break;
#pragma unroll
        for (int a = 0; a < 2; ++a)
#pragma unroll
            for (int b = 0; b < 2; ++b)
#pragma unroll
                for (int m = 0; m < 4; ++m)
#pragma unroll
                    for (int n = 0; n < 2; ++n) acc[a][b][m][n] = (f32x4){0.f, 0.f, 0.f, 0.f};
        cur = nxt; cA = nA; cB = nB; ++ui;
#pragma unroll
        for (int i = 0; i < 2; ++i) { vc0[i] = vn0[i]; vc1[i] = vn1[i]; }
        if constexpr (ALIGN_EPI) { if (wr == 1) PG8_BAR; }
    }
    PG8_WAIT_V(0);
    if constexpr (!ALIGN_EPI) { if (wr == 0) PG8_BAR; }
    PG8_BAR;
#undef PG8_SA
#undef PG8_SB
#undef PG8_STAGE
#undef PG8_STAGE_A
#undef PG8_LDA
#undef PG8_LDB
#undef PG8_MMA
#undef PG8_WAIT_V
#undef PG8_WAIT_L
#undef PG8_BAR
#undef PG8_SCHED
}
}
#include <hip/hip_bf16.h>
#include <cmath>
namespace attn_body {
using bf16=__hip_bfloat16;
using bf16x8=__attribute__((ext_vector_type(8)))short;
using s16x4=__attribute__((ext_vector_type(4)))short;
using f32x16=__attribute__((ext_vector_type(16)))float;
using u32x4=__attribute__((ext_vector_type(4)))unsigned;
constexpr int BATCH=2,NHEAD=8,SEQ=8192,D=64,DM=NHEAD*D;
constexpr int NW=8,QBLK=32,QB=QBLK*NW,KVBLK=64,NQB=SEQ/QB;
constexpr int ATTN_PITCH=DM, ATTN_UNIT_ROWS=QB;
__device__ __forceinline__ int crow(int r,int hi){return (r&3)+8*(r>>2)+4*hi;}
#define SBAR() __builtin_amdgcn_sched_barrier(0)
__device__ __forceinline__ void cmask(f32x16&p0,f32x16&p1,int jb,int qrel,int hi){
  const float NEG=-INFINITY; const int dq=qrel-(64*jb+4*hi);
  #pragma unroll
  for(int r=0;r<16;++r){const int c=(r&3)+8*(r>>2); if(c>dq)p0[r]=NEG; if(c+32>dq)p1[r]=NEG;}
}

constexpr int NSLOT=3, SLOTB=8192;
constexpr int LDS_K=0, LDS_V=NSLOT*SLOTB, LDS_WS=2*NSLOT*SLOTB, LDS_OST=LDS_WS+NW*64*4, LDS_DK=LDS_OST+NW*4096, LDS_BYTES=LDS_DK+SEQ*4;
constexpr float C2=0.125f*1.4426950408889634f;
__device__ __forceinline__ void glds16(const void*gsrc,unsigned lds_dst){unsigned keep;
  asm volatile("s_mov_b32 %0, m0\n\ts_mov_b32 m0, %2\n\ts_nop 0\n\tglobal_load_lds_dwordx4 %1, off\n\ts_mov_b32 m0, %0":"=&s"(keep):"v"(gsrc),"s"(lds_dst):"memory");}
__device__ __forceinline__ float max3f(float a,float b,float c){float r;asm("v_max3_f32 %0, %1, %2, %3":"=v"(r):"v"(a),"v"(b),"v"(c));return r;}
__device__ __forceinline__ float max2f(float a,float b){float r;asm("v_max_f32_e32 %0, %1, %2":"=v"(r):"v"(a),"v"(b));return r;}
__device__ __forceinline__ float fadd_s(float a,float b){float r;asm("v_add_f32_e32 %0, %1, %2":"=v"(r):"v"(a),"v"(b));return r;}
__device__ __forceinline__ float fsub_s(float a,float b){float r;asm("v_sub_f32_e32 %0, %1, %2":"=v"(r):"v"(a),"v"(b));return r;}
typedef float f32x2_t __attribute__((ext_vector_type(2))); typedef float f32x4_t __attribute__((ext_vector_type(4))); typedef __bf16 bf16x2_t __attribute__((ext_vector_type(2)));
__device__ __forceinline__ unsigned cvtpk_s(float lo,float hi){f32x2_t v={lo,hi};bf16x2_t b=__builtin_convertvector(v,bf16x2_t);return __builtin_bit_cast(unsigned,b);}
#define WAIT_BAR(N) asm volatile("s_waitcnt vmcnt(" #N ") lgkmcnt(0)\n\ts_barrier":::"memory")

__device__ __forceinline__ void qkt(f32x16&p0,f32x16&p1,const char*Kslot,const bf16x8*qr,const f32x16&negm,int r32,int hi){
  const char*kb=Kslot+hi*1024+r32*16;
  #pragma unroll
  for(int d0=0;d0<4;++d0){
    const bf16x8 b0=*reinterpret_cast<const bf16x8*>(kb+d0*2048);
    const bf16x8 b1=*reinterpret_cast<const bf16x8*>(kb+d0*2048+512);
    if(d0==0){p0=__builtin_amdgcn_mfma_f32_32x32x16_bf16(b0,qr[0],negm,0,0,0);p1=__builtin_amdgcn_mfma_f32_32x32x16_bf16(b1,qr[0],negm,0,0,0);}
    else{p0=__builtin_amdgcn_mfma_f32_32x32x16_bf16(b0,qr[d0],p0,0,0,0);p1=__builtin_amdgcn_mfma_f32_32x32x16_bf16(b1,qr[d0],p1,0,0,0);}}
}
typedef __attribute__((address_space(3))) const char* lds_cptr;
typedef short v4i16_t __attribute__((ext_vector_type(4)));
__device__ __forceinline__ void kload8(bf16x8*kf,lds_cptr kp){
  kf[0]=*(const __attribute__((address_space(3))) bf16x8*)(kp);      kf[1]=*(const __attribute__((address_space(3))) bf16x8*)(kp+512);
  kf[2]=*(const __attribute__((address_space(3))) bf16x8*)(kp+2048); kf[3]=*(const __attribute__((address_space(3))) bf16x8*)(kp+2560);
  kf[4]=*(const __attribute__((address_space(3))) bf16x8*)(kp+4096); kf[5]=*(const __attribute__((address_space(3))) bf16x8*)(kp+4608);
  kf[6]=*(const __attribute__((address_space(3))) bf16x8*)(kp+6144); kf[7]=*(const __attribute__((address_space(3))) bf16x8*)(kp+6656);
}
__device__ __forceinline__ void kload2(bf16x8*kf,lds_cptr kp,int j){ kf[2*j]=*(const __attribute__((address_space(3))) bf16x8*)(kp+j*2048); kf[2*j+1]=*(const __attribute__((address_space(3))) bf16x8*)(kp+j*2048+512); }
__device__ __forceinline__ s16x4 vtr(lds_cptr p){ return __builtin_bit_cast(s16x4,__builtin_amdgcn_ds_read_tr16_b64_v4i16((__attribute__((address_space(3))) v4i16_t*)p)); }
__device__ __forceinline__ float rowmax(const f32x16&p0,const f32x16&p1){
  float a=max3f(p0[0],p0[1],p1[0]),b=max3f(p0[2],p0[3],p1[1]);a=max3f(a,p1[2],p1[3]);
  #pragma unroll
  for(int r=4;r<16;r+=4){a=max3f(a,p0[r],p0[r+1]);b=max3f(b,p0[r+2],p0[r+3]);a=max3f(a,p1[r],p1[r+1]);b=max3f(b,p1[r+2],p1[r+3]);}
  const float m=max2f(a,b);
  auto rr=__builtin_amdgcn_permlane32_swap(__float_as_uint(m),__float_as_uint(m),false,false);
  return max2f(__uint_as_float(rr[0]),__uint_as_float(rr[1]));
}
__device__ __forceinline__ void pv(f32x16*o,int vb,bf16x8 pa0,bf16x8 pa1,bf16x8 pa2,bf16x8 pa3){
  #pragma unroll
  for(int d0=0;d0<2;++d0){s16x4 lo[4],hi[4];
    #pragma unroll
    for(int ks=0;ks<4;++ks){
      asm volatile("ds_read_b64_tr_b16 %0,%1 offset:%c2":"=&v"(lo[ks]):"v"(vb),"i"(d0*4096+ks*1024):"memory");
      asm volatile("ds_read_b64_tr_b16 %0,%1 offset:%c2":"=&v"(hi[ks]):"v"(vb),"i"(d0*4096+ks*1024+512):"memory");}
    asm volatile("s_waitcnt lgkmcnt(0)":::"memory");SBAR();
    #define PK(k) (bf16x8){lo[k][0],lo[k][1],lo[k][2],lo[k][3],hi[k][0],hi[k][1],hi[k][2],hi[k][3]}
    o[d0]=__builtin_amdgcn_mfma_f32_32x32x16_bf16(pa0,PK(0),o[d0],0,0,0);
    o[d0]=__builtin_amdgcn_mfma_f32_32x32x16_bf16(pa1,PK(1),o[d0],0,0,0);
    o[d0]=__builtin_amdgcn_mfma_f32_32x32x16_bf16(pa2,PK(2),o[d0],0,0,0);
    o[d0]=__builtin_amdgcn_mfma_f32_32x32x16_bf16(pa3,PK(3),o[d0],0,0,0);
    #undef PK
  }
}

#ifndef ATTN_STORE16
#define ATTN_STORE16(p,v) (*(u32x4*)(p)=(v))
#endif
template<int THRL> __device__ __forceinline__ void attn_unit(int b,int h,int qb,const bf16*Q,const bf16*__restrict__ K,const bf16*__restrict__ V,bf16*O,const float*cum,float thr2,char*shm){
  const int tid=threadIdx.x,lane=tid&63,r32=lane&31,hi=lane>>5; const int wid=__builtin_amdgcn_readfirstlane(tid>>6);
  const long rowbase=(long)b*SEQ; const int q0=qb*QB;
  const bf16*Qw=Q+(rowbase+q0+wid*QBLK)*DM+h*D;
  const float*cb=cum+(long)(b*NHEAD+h)*SEQ; const int NTF=(q0+QB)/KVBLK; int t0=0;
#if ATTN_SKIP
  { const float cq0=cb[q0]; int cnt=0;
    for(int base=0;base<NTF;base+=64){ const int t_=base+lane; const bool c_=(t_<NTF)&&((cb[64*t_+63]-cq0)*1.4426950408889634f>thr2); cnt+=__popcll(__ballot(c_)); }
    cnt&=~1; if(cnt>NTF-4)cnt=NTF-4; t0=__builtin_amdgcn_readfirstlane(cnt); }
#endif
  const int kv0=t0*KVBLK;
  { const float cref=cb[q0+QB-1]; __attribute__((address_space(3))) float*dkw=(__attribute__((address_space(3))) float*)((__attribute__((address_space(3))) char*)shm+LDS_DK);
    int tv_=tid; asm volatile("":"+v"(tv_));
    for(int j=tv_;j<q0+QB-kv0;j+=NW*64)dkw[j]=(cb[kv0+j]-cref)*1.4426950408889634f; }
  asm volatile("s_waitcnt vmcnt(0) lgkmcnt(0)\n\ts_barrier":::"memory");
  const bf16*Kh=K+(rowbase+kv0)*DM+h*D,*Vh=V+(rowbase+kv0)*DM+h*D;
  const unsigned lds0=(unsigned)(uintptr_t)shm;
  float*wsf=(float*)(shm+LDS_WS)+wid*64;
  const bf16*ksrc=Kh+(long)lane*DM+wid*8;
  const bf16*vsrc=Vh+(long)(16*(wid&3)+(lane>>2))*DM+(wid>>2)*32+(lane&3)*8;
  const unsigned kdst=lds0+LDS_K+wid*1024, vdst=lds0+LDS_V+wid*1024;
  #define DMA_K(t,slot) glds16(ksrc+(long)(t)*KVBLK*DM,(unsigned)__builtin_amdgcn_readfirstlane(kdst+(slot)))
  #define DMA_V(t,slot) glds16(vsrc+(long)(t)*KVBLK*DM,(unsigned)__builtin_amdgcn_readfirstlane(vdst+(slot)))
  const int vb0=(int)(lds0+LDS_V)+((lane>>4)&1)*32+(lane&3)*8+(4*hi+((lane&15)>>2))*64;
  const char*Kbase=shm+LDS_K; bf16x8 kf[8];
  const lds_cptr shm3=(lds_cptr)shm; const lds_cptr kp0=shm3+LDS_K+hi*1024+r32*16; const lds_cptr vp0=shm3+LDS_V+((lane>>4)&1)*32+(lane&3)*8+(4*hi+((lane&15)>>2))*64;
  int hiv_=hi; asm volatile("":"+v"(hiv_));
  const int NT=NTF-t0;
  const __attribute__((address_space(3))) float*dkp0=(const __attribute__((address_space(3))) float*)(shm3+LDS_DK)+4*hiv_;
  #define CINIT(C,t,o) do{ const __attribute__((address_space(3))) float*dp_=dkp0+(t)*64+(o); _Pragma("unroll") for(int g_=0;g_<4;++g_){ const f32x4_t a_=*(const __attribute__((address_space(3))) f32x4_t*)(dp_+8*g_); \
      C[4*g_]=negms-a_[0];C[4*g_+1]=negms-a_[1];C[4*g_+2]=negms-a_[2];C[4*g_+3]=negms-a_[3]; } }while(0)
  #define DECAY(P0,P1,t) do{ const __attribute__((address_space(3))) float*dp_=dkp0+(t)*64; _Pragma("unroll") for(int g_=0;g_<4;++g_){ const f32x4_t a_=*(const __attribute__((address_space(3))) f32x4_t*)(dp_+8*g_), b_=*(const __attribute__((address_space(3))) f32x4_t*)(dp_+32+8*g_); \
      P0[4*g_]-=a_[0];P0[4*g_+1]-=a_[1];P0[4*g_+2]-=a_[2];P0[4*g_+3]-=a_[3]; P1[4*g_]-=b_[0];P1[4*g_+1]-=b_[1];P1[4*g_+2]-=b_[2];P1[4*g_+3]-=b_[3]; } }while(0)
  DMA_K(0,0);DMA_V(0,0);DMA_K(1,SLOTB);
  bf16x8 qr[4];
  #pragma unroll
  for(int d0=0;d0<4;++d0)qr[d0]=*reinterpret_cast<const bf16x8*>(&Qw[(long)r32*DM+d0*16+hi*8]);
  float mhat=0.f,l_reg=0.f;f32x16 o[2];o[0]=f32x16{};o[1]=f32x16{};float negms=0.f; const f32x16 zero16=f32x16{};
  const int qrel=wid*QBLK+r32;
  #define CMASK(P0,P1,t) do{int jb_=(t)-(NT-4); if(jb_>=0)cmask(P0,P1,jb_,qrel,hi);}while(0)
  bool resc=false;
  #define START(P0,P1) do{ const float rm=rowmax(P0,P1); resc=false; \
    { const float dl=rm; mhat=fadd_s(mhat,dl); \
      _Pragma("unroll") for(int r=0;r<16;++r){P0[r]=fsub_s(P0[r],dl);P1[r]=fsub_s(P1[r],dl);} \
      negms=-mhat; } \
    _Pragma("unroll") for(int r=0;r<16;++r)P0[r]=__builtin_amdgcn_exp2f(P0[r]); }while(0)
  #define RESC() do{ if(resc){ asm volatile("s_waitcnt lgkmcnt(0)":::"memory"); \
      _Pragma("unroll") for(int d_=0;d_<2;++d_) _Pragma("unroll") for(int r=0;r<16;++r)o[d_][r]*=wsf[crow(r,hi)]; } }while(0)
  f32x16 pA0,pA1,pB0,pB1;
  int sl_prev=0,sl_cur=0,sl_next=SLOTB;
  #define ROT() do{sl_prev=sl_cur;sl_cur=sl_next;sl_next=(sl_next==(NSLOT-1)*SLOTB)?0:sl_next+SLOTB;}while(0)
  DMA_K(2,2*SLOTB);
  WAIT_BAR(3);
  qkt(pA0,pA1,Kbase,qr,zero16,r32,hi);asm volatile("s_nop 15\n\ts_nop 7":"+v"(pA0),"+v"(pA1));CMASK(pA0,pA1,0);DECAY(pA0,pA1,0);
  START(pA0,pA1);
  _Pragma("unroll") for(int r=0;r<16;++r)pA1[r]=__builtin_amdgcn_exp2f(pA1[r]);
  WAIT_BAR(0);
  DMA_K(3,0);DMA_V(1,SLOTB);
  ROT();
  kload8(kf,kp0+sl_cur);
  WAIT_BAR(2);
  s16x4 vlo[8],vhi[8]; u32x4 pw0,pw1,pw2,pw3;
  #define PKW(P,B) cvtpk_s(P[B],P[B+1])
  #define PAF(k) __builtin_bit_cast(bf16x8,pw##k)
  #define VFR(i) (bf16x8){vlo[i][0],vlo[i][1],vlo[i][2],vlo[i][3],vhi[i][0],vhi[i][1],vhi[i][2],vhi[i][3]}
  #define PIN(x) asm volatile("":"+v"(x))
  #define MX3(a,b,c) __builtin_fmaxf(__builtin_fmaxf((a),(b)),(c))
  #define GAPA(MF,A0,A1,A2,A3,W0,W1,PW) do{ MF; sacc+=A0; sacc+=A1; sacc+=A2; sacc+=A3; PIN(sacc); W0; W1; PIN(PW); SBAR(); }while(0)
  #define EX(v) __builtin_amdgcn_exp2f(v)
  #define GAPB(MF,X,B) do{ MF; X[B]=EX(X[B]); X[B+1]=EX(X[B+1]); X[B+2]=EX(X[B+2]); X[B+3]=EX(X[B+3]); PIN(X); SBAR(); }while(0)
  #define VRD(i) do{ vlo[i]=vtr(vp_+(((i)>>2)*4096+((i)&3)*1024)); vhi[i]=vtr(vp_+(((i)>>2)*4096+((i)&3)*1024+512)); }while(0)
  #define KRD(G,j) do{ if(G){ kload2(kf,kp0+sl_next,j); SBAR(); } }while(0)
  #define STEP(C0,C1,P0,P1,t,GK,GV,GL) do{ SBAR(); \
    const lds_cptr vp_=vp0+sl_prev; \
    CINIT(C0,t,0); VRD(0); SBAR(); float sacc=(P0[0]+P0[1]); \
    GAPA(C0=__builtin_amdgcn_mfma_f32_32x32x16_bf16(kf[0],qr[0],C0,0,0,0), P0[2],P0[3],P0[4],P0[5],     pw0[0]=PKW(P0,0), pw0[1]=PKW(P0,2), pw0); \
    CINIT(C1,t,32); VRD(4); SBAR(); GAPA(C1=__builtin_amdgcn_mfma_f32_32x32x16_bf16(kf[1],qr[0],C1,0,0,0), P0[6],P0[7],P0[8],P0[9],     pw0[2]=PKW(P0,4), pw0[3]=PKW(P0,6), pw0); \
    VRD(1); SBAR(); GAPA(C0=__builtin_amdgcn_mfma_f32_32x32x16_bf16(kf[2],qr[1],C0,0,0,0),   P0[10],P0[11],P0[12],P0[13], pw1[0]=PKW(P0,8), pw1[1]=PKW(P0,10), pw1); \
    VRD(5); SBAR(); GAPA(C1=__builtin_amdgcn_mfma_f32_32x32x16_bf16(kf[3],qr[1],C1,0,0,0),   P0[14],P0[15],P1[0],P1[1],   pw1[2]=PKW(P0,12),pw1[3]=PKW(P0,14), pw1); \
    VRD(2); SBAR(); GAPA(C0=__builtin_amdgcn_mfma_f32_32x32x16_bf16(kf[4],qr[2],C0,0,0,0),   P1[2],P1[3],P1[4],P1[5],     pw2[0]=PKW(P1,0), pw2[1]=PKW(P1,2), pw2); \
    VRD(6); SBAR(); GAPA(C1=__builtin_amdgcn_mfma_f32_32x32x16_bf16(kf[5],qr[2],C1,0,0,0),   P1[6],P1[7],P1[8],P1[9],     pw2[2]=PKW(P1,4), pw2[3]=PKW(P1,6), pw2); \
    VRD(3); SBAR(); GAPA(C0=__builtin_amdgcn_mfma_f32_32x32x16_bf16(kf[6],qr[3],C0,0,0,0),   P1[10],P1[11],P1[12],P1[13], pw3[0]=PKW(P1,8), pw3[1]=PKW(P1,10), pw3); \
    VRD(7); SBAR(); GAPA(C1=__builtin_amdgcn_mfma_f32_32x32x16_bf16(kf[7],qr[3],C1,0,0,0),   P1[14],P1[15],0.f,0.f,       pw3[2]=PKW(P1,12),pw3[3]=PKW(P1,14), pw3); \
    l_reg+=sacc; \
    if(GK){DMA_K((t)+3,sl_cur);} if(GV){DMA_V((t)+1,sl_next);} \
    CMASK(C0,C1,t); \
    { float a=MX3(C0[0],C0[1],C1[0]),b=MX3(C0[2],C0[3],C1[1]); a=MX3(a,C1[2],C1[3]); \
      _Pragma("unroll") for(int r=4;r<16;r+=4){a=MX3(a,C0[r],C0[r+1]);b=MX3(b,C0[r+2],C0[r+3]);a=MX3(a,C1[r],C1[r+1]);b=MX3(b,C1[r+2],C1[r+3]);} \
      float rm=__builtin_fmaxf(a,b); { auto rr=__builtin_amdgcn_permlane32_swap(__float_as_uint(rm),__float_as_uint(rm),false,false); rm=__builtin_fmaxf(__uint_as_float(rr[0]),__uint_as_float(rr[1])); } \
      resc=false; \
      if(__builtin_expect(__any(rm>(float)THRL),0)){ const float dl=__builtin_fmaxf(rm,0.f); mhat+=dl; \
        _Pragma("unroll") for(int r=0;r<16;++r){C0[r]-=dl;C1[r]-=dl;} \
        negms=-mhat; \
        const float f=__builtin_amdgcn_exp2f(-dl); l_reg*=f; if(hi==0)wsf[r32]=f; resc=true; } } \
    SBAR(); \
    GAPB(o[0]=__builtin_amdgcn_mfma_f32_32x32x16_bf16(PAF(0),VFR(0),o[0],0,0,0), C0,0); \
    GAPB(o[1]=__builtin_amdgcn_mfma_f32_32x32x16_bf16(PAF(0),VFR(4),o[1],0,0,0), C0,4); \
    KRD(GL,0); GAPB(o[0]=__builtin_amdgcn_mfma_f32_32x32x16_bf16(PAF(1),VFR(1),o[0],0,0,0), C0,8); \
    KRD(GL,1); GAPB(o[1]=__builtin_amdgcn_mfma_f32_32x32x16_bf16(PAF(1),VFR(5),o[1],0,0,0), C0,12); \
    KRD(GL,2); GAPB(o[0]=__builtin_amdgcn_mfma_f32_32x32x16_bf16(PAF(2),VFR(2),o[0],0,0,0), C1,0); \
    KRD(GL,3); GAPB(o[1]=__builtin_amdgcn_mfma_f32_32x32x16_bf16(PAF(2),VFR(6),o[1],0,0,0), C1,4); \
    GAPB(o[0]=__builtin_amdgcn_mfma_f32_32x32x16_bf16(PAF(3),VFR(3),o[0],0,0,0), C1,8); \
    GAPB(o[1]=__builtin_amdgcn_mfma_f32_32x32x16_bf16(PAF(3),VFR(7),o[1],0,0,0), C1,12); \
    }while(0)
  int t=1;
  #undef CMASK
  #define CMASK(P0,P1,t) do{}while(0)
  for(;t+5<NT;t+=2){
    STEP(pB0,pB1,pA0,pA1,t,true,true,true);     WAIT_BAR(2); RESC(); ROT();
    STEP(pA0,pA1,pB0,pB1,t+1,true,true,true);   WAIT_BAR(2); RESC(); ROT();
  }
  #undef CMASK
  #define CMASK(P0,P1,t) do{int jb_=(t)-(NT-4); if(jb_>=0)cmask(P0,P1,jb_,qrel,hi);}while(0)
  #define ENDW(tt) do{ if((tt)+3<NT){WAIT_BAR(2);} else if((tt)+2<NT){WAIT_BAR(1);} else {WAIT_BAR(0);} }while(0)
  for(;t+1<NT;t+=2){
    STEP(pB0,pB1,pA0,pA1,t,(t+3<NT),(t+1<NT),(t+1<NT));       ENDW(t);   RESC(); ROT();
    STEP(pA0,pA1,pB0,pB1,t+1,(t+4<NT),(t+2<NT),(t+2<NT));     ENDW(t+1); RESC(); ROT();
  }
  STEP(pB0,pB1,pA0,pA1,NT-1,false,false,false); RESC();
  { float sacc=pB0[0]+pB0[1]; _Pragma("unroll") for(int r=2;r<16;++r)sacc+=pB0[r]; _Pragma("unroll") for(int r=0;r<16;++r)sacc+=pB1[r]; l_reg+=sacc;
    pw0=(u32x4){PKW(pB0,0),PKW(pB0,2),PKW(pB0,4),PKW(pB0,6)};pw1=(u32x4){PKW(pB0,8),PKW(pB0,10),PKW(pB0,12),PKW(pB0,14)};pw2=(u32x4){PKW(pB1,0),PKW(pB1,2),PKW(pB1,4),PKW(pB1,6)};pw3=(u32x4){PKW(pB1,8),PKW(pB1,10),PKW(pB1,12),PKW(pB1,14)};
    SBAR(); pv(o,vb0+sl_cur,PAF(0),PAF(1),PAF(2),PAF(3)); }
  #undef PKW
  #undef PAF
  #undef VFR
  #undef PIN
  #undef MX3
  #undef GAPA
  #undef GAPB
  #undef EX
  #undef VRD
  #undef KRD
  #undef STEP
  #undef ENDW
  {auto rr=__builtin_amdgcn_permlane32_swap(__float_as_uint(l_reg),__float_as_uint(l_reg),false,false);l_reg=__uint_as_float(rr[0])+__uint_as_float(rr[1]);}
  if(hi==0)wsf[32+r32]=l_reg;asm volatile("s_waitcnt lgkmcnt(0)":::"memory");
  float rli[16];
  #pragma unroll
  for(int r=0;r<16;++r)rli[r]=__builtin_amdgcn_rcpf(wsf[32+crow(r,hi)]);
  bf16*Ow=O+(rowbase+q0+wid*QBLK)*DM+h*D;
  { bf16*stg=(bf16*)(shm+LDS_OST)+wid*2048;
    #pragma unroll
    for(int r=0;r<16;++r){const int orow=crow(r,hi);
      #pragma unroll
      for(int d0=0;d0<2;++d0)stg[orow*64+d0*32+r32]=__float2bfloat16(o[d0][r]*rli[r]);}
    asm volatile("s_waitcnt lgkmcnt(0)":::"memory");
    #pragma unroll
    for(int i=0;i<4;++i){const int row=i*8+(lane>>3),ch=lane&7; const u32x4 v=*(const u32x4*)(stg+row*64+ch*8); ATTN_STORE16(Ow+(long)row*DM+ch*8,v);} }
  asm volatile("s_waitcnt lgkmcnt(0)\n\ts_barrier":::"memory");
  #undef DECAY
  #undef CINIT
  #undef DMA_K
  #undef DMA_V
  #undef CMASK
  #undef START
  #undef RESC
  #undef ROT
}
constexpr int ATTN_LDS_BYTES=LDS_BYTES;
struct AttnTensors { const bf16* Q; const bf16* K; const bf16* V; bf16* O; const float* cum; float thr2; };
struct AttnUnit { int bh; int qb; };
struct StaticOrder {
  int vcu;
  __device__ __forceinline__ explicit StaticOrder(int grid,int block):vcu((block%8)*(grid/8)+block/8){}
  __device__ __forceinline__ bool next(int i,AttnUnit&u)const{ if(i>=2)return false; const int s=vcu&15; u.bh=vcu>>4; u.qb=(i==0)?s:31-s; return true; }
  __device__ __forceinline__ void a_ready(const AttnUnit&)const{}
  __device__ __forceinline__ void done(const AttnUnit&)const{}
};
template<class Sched,int THRL=8> __device__ __forceinline__ void attn_phase(char*lds,const AttnTensors&T,const Sched&S){
  AttnUnit u;
  for(int i=0;S.next(i,u);++i){ S.a_ready(u); attn_unit<THRL>(u.bh/NHEAD,u.bh%NHEAD,u.qb,T.Q,T.K,T.V,T.O,T.cum,T.thr2,lds); S.done(u); }
}
#undef SBAR
#undef WAIT_BAR
}

constexpr int NWAVES = 8;
constexpr int BATCH = 2, SEQ = 8192, DMODEL = 1024, T = BATCH * SEQ;
constexpr int CONVD = 512, CONVW = 31, NHEAD = 8, HD = 64, ATT = 512;
constexpr int NE = 64, TOPK = 8, EF = 256, SF = 256;
constexpr int INCOLS = 4616, OFF_Q = 1024, OFF_K = 1536, OFF_V = 2048, OFF_F = 2560, OFF_GC = 2568, OFF_GA = 3592;
constexpr int NIN = 4608;
constexpr float EPS = 1e-6f, LOG2E = 1.4426950408889634f, ROUTED_SCALE = 2.5f;
constexpr float C2Q = 0.125f * 1.4426950408889634f;
constexpr int LISTCAP = T;
constexpr int ACT_ROWS = T * TOPK + NE * 256;

constexpr size_t MiB = 1u << 20, KiB = 1u << 10;
constexpr size_t WS_CTL = 0, CTL_ZERO_BYTES = 1 * MiB;
constexpr size_t WS_MODP = 1 * MiB;
constexpr size_t WS_MOD = WS_MODP + 768 * KiB;
constexpr size_t WS_LOGF = 2 * MiB;
constexpr size_t WS_CUM = 2 * MiB + 512 * KiB;
constexpr size_t WS_SSQ = 3 * MiB;
constexpr size_t WS_WRH = 4 * MiB, WS_WRL = 4 * MiB + 128 * KiB;
constexpr size_t WS_WLIST = 5 * MiB;
constexpr size_t WS_LIST = 9 * MiB;
constexpr size_t WS_WIN = 16 * MiB, WS_WC = 25 * MiB, WS_WA = 26 * MiB, WS_WOUT = 27 * MiB, WS_WSGU = 29 * MiB, WS_WSD = 30 * MiB;
constexpr size_t WS_WGU = 32 * MiB, WS_WD = 96 * MiB;
constexpr size_t WS_H2 = 128 * MiB, WS_ACT = 160 * MiB, WS_SACT = 232 * MiB;
constexpr size_t WS_H1 = 240 * MiB, WS_U = 272 * MiB, WS_Q = 288 * MiB, WS_K = 304 * MiB, WS_V = 320 * MiB, WS_SG = 336 * MiB, WS_UC = 400 * MiB, WS_O = 416 * MiB, WS_MG = 432 * MiB;
constexpr size_t WS_SLAB = 240 * MiB;
constexpr size_t WS_END = 512 * MiB;
static_assert(WS_ACT + (size_t)ACT_ROWS * EF * 2 <= WS_SACT && WS_SLAB + (size_t)T * TOPK * DMODEL * 2 <= WS_END && WS_MG + (size_t)T * DMODEL * 2 <= WS_SLAB + 256 * MiB, "ws map");
constexpr int CW_TMO = 0, CW_CODE = 1;
constexpr int CW_CNT = 1024;
constexpr int CW_BAR = 8192;

constexpr int RING_OFF = 0, RING_BYTES = 131072;
constexpr int LDSCTL_OFF = RING_BYTES, MISC_OFF = LDSCTL_OFF + 320;
constexpr int TAB_OFF = RING_BYTES + 1024;
constexpr int LDS_BYTES = 147456;

#define GAS __attribute__((address_space(1)))
#define LAS __attribute__((address_space(3)))
typedef unsigned short bf16;
typedef unsigned v4u __attribute__((ext_vector_type(4)));
typedef unsigned v2u __attribute__((ext_vector_type(2)));
typedef float f32x4 __attribute__((ext_vector_type(4)));
typedef float f32x16 __attribute__((ext_vector_type(16)));
typedef short bf16x8 __attribute__((ext_vector_type(8)));
typedef GAS unsigned gu32;
#define RLX_AGENT __ATOMIC_RELAXED, __HIP_MEMORY_SCOPE_AGENT
#define LDS_WAIT() asm volatile("s_waitcnt lgkmcnt(0)" ::: "memory")
#define VM_WAIT() asm volatile("s_waitcnt vmcnt(0)" ::: "memory")
__device__ __forceinline__ unsigned f2bf(float f) { unsigned u = __builtin_bit_cast(unsigned, f); return (u + 0x7fffu + ((u >> 16) & 1u)) >> 16; }
__device__ __forceinline__ unsigned pk2(float lo, float hi) { return f2bf(lo) | (f2bf(hi) << 16); }
__device__ __forceinline__ float bf2f(unsigned h) { return __builtin_bit_cast(float, h << 16); }
__device__ __forceinline__ float wave_sum(float v) {
#pragma unroll
    for (int o = 1; o < 64; o <<= 1) v += __shfl_xor(v, o);
    return v;
}
using pg8::cvt_pk_bf16; using pg8::bf_lo; using pg8::bf_hi; using pg8::sigmoidf_fast;
#define XB_TMO      128
#define XB_XCNT(j)  (256  + 64 * (j))
#define XB_XSUB(j)  (1280 + 64 * (j))
#define XB_XGEN(j)  (2304 + 64 * (j))
#define XB_TOP      3328
#define XB_TOPGEN   3392
#define XCD_BAR_WORDS 3456
#define XB_SPIN_CAP (1u << 18)

__device__ __forceinline__ unsigned xb_ld(unsigned* p)              { return __hip_atomic_load(p, __ATOMIC_RELAXED, __HIP_MEMORY_SCOPE_AGENT); }
__device__ __forceinline__ unsigned xb_add(unsigned* p, unsigned v) { return __hip_atomic_fetch_add(p, v, __ATOMIC_RELAXED, __HIP_MEMORY_SCOPE_AGENT); }
__device__ __forceinline__ unsigned xb_xcc_id() { return (unsigned)__builtin_amdgcn_s_getreg((3 << 11) | 20) & 0xFu; }
#define XB_SPIN(cond, bar) do { unsigned _sp = 0; while (cond) { __builtin_amdgcn_s_sleep(1); \
    if ((++_sp & 255u) == 0u) { if (xb_ld(&(bar)[XB_TMO])) break; if (_sp > XB_SPIN_CAP) { atomicAdd(&(bar)[XB_TMO], 1u); break; } } } } while (0)

struct XcdBarrier {
    unsigned* bar; unsigned x;
    volatile LAS unsigned* st;
};

__device__ __forceinline__ XcdBarrier xcd_barrier_post(unsigned* bar, volatile LAS unsigned* st) {
    XcdBarrier b; b.bar = bar; b.x = xb_xcc_id(); b.st = st;
    if (threadIdx.x == 0) (void)xb_add(&bar[XB_XCNT(b.x)], 1u);
    return b;
}
__device__ __forceinline__ void xcd_barrier_complete(unsigned* bar, unsigned x, unsigned& nloc, unsigned& nx) {
    const unsigned G = gridDim.x * gridDim.y * gridDim.z;
    unsigned sum, cnt, mine, sp = 0u;
    for (;;) {
        sum = 0u; cnt = 0u; mine = 0u;
#pragma unroll
        for (unsigned j = 0; j < 16; ++j) { const unsigned c = xb_ld(&bar[XB_XCNT(j)]); sum += c; cnt += (c > 0u) ? 1u : 0u; mine = (j == x) ? c : mine; }
        if (sum == G) break;
        __builtin_amdgcn_s_sleep(1);
        if ((++sp & 255u) == 0u) { if (xb_ld(&bar[XB_TMO])) break; if (sp > XB_SPIN_CAP) { atomicAdd(&bar[XB_TMO], 1u); break; } }
    }
    nloc = mine > 0u ? mine : 1u; nx = cnt > 0u ? cnt : 1u;
}

__device__ __forceinline__ void xcd_barrier(const XcdBarrier& b) {
    asm volatile("s_waitcnt vmcnt(0)" ::: "memory");
    __syncthreads();
    if (threadIdx.x == 0) {
        unsigned* bar = b.bar;
        __builtin_amdgcn_s_waitcnt(0);
        unsigned nloc = b.st[0], nx = b.st[1];
        if (nloc == 0u) { xcd_barrier_complete(bar, b.x, nloc, nx); b.st[0] = nloc; b.st[1] = nx; }
        const unsigned old = xb_add(&bar[XB_XSUB(b.x)], 1u);
        const unsigned gen = old / nloc;
        if (old + 1u == (gen + 1u) * nloc) {
            __builtin_amdgcn_fence(__ATOMIC_RELEASE, "agent");
            asm volatile("s_waitcnt vmcnt(0)" ::: "memory");
            const unsigned og = xb_add(&bar[XB_TOP], 1u);
            const unsigned tg = og / nx;
            if (og + 1u == (tg + 1u) * nx) xb_add(&bar[XB_TOPGEN], 1u);
            else XB_SPIN(xb_ld(&bar[XB_TOPGEN]) == tg, bar);
            __builtin_amdgcn_fence(__ATOMIC_ACQUIRE, "agent");
            xb_add(&bar[XB_XGEN(b.x)], 1u);
            asm volatile("s_waitcnt vmcnt(0)" ::: "memory");
        } else {
            XB_SPIN(xb_ld(&bar[XB_XGEN(b.x)]) == gen, bar);
            __builtin_amdgcn_fence(__ATOMIC_ACQUIRE, "agent");
            asm volatile("s_waitcnt vmcnt(0)" ::: "memory");
        }
    }
    __syncthreads();
}

__device__ __forceinline__ int win_dst_row(int n) {
    if (n < 512) return 256 * (n >> 7) + (n & 127);
    if (n < 1024) { const int f = n - 512; return 256 * (f >> 7) + 128 + (f & 127); }
    if (n < 2048) { const int isk = n >= OFF_K, j = n - (isk ? OFF_K : OFF_Q), head = j >> 6, d = j & 63;
        return 256 * (4 + 2 * isk + (head >> 2)) + 128 * (d >> 5) + 32 * (head & 3) + (d & 31); }
    if (n < OFF_F) return 256 * 8 + (n - OFF_V);
    if (n < OFF_GC) return -1;
    return 256 * 10 + (n - OFF_GC);
}
__device__ __forceinline__ int glu_dst_row(int n, int F) { const int isu = n >= F, f = n - (isu ? F : 0); return 256 * (f >> 7) + 128 * isu + (f & 127); }

__device__ __forceinline__ unsigned pk4_fp8(float a, float b, float c, float d) { int p = __builtin_amdgcn_cvt_pk_fp8_f32(a, b, 0, false); p = __builtin_amdgcn_cvt_pk_fp8_f32(c, d, p, true); return (unsigned)p; }
#ifndef MOE_FP8
#define MOE_FP8 0
#endif
constexpr float W8SCALE = MOE_FP8 ? 32.0f : 1.0f;
template <int MODE>
__device__ __forceinline__ void tr_item(const float* W, int ldw, int K, bf16* WT, bf16* WT2, int k0, int n0, LAS float* scr, int lane) {
#pragma unroll 8
    for (int i = 0; i < 32; ++i) { const int kk = 2 * i + (lane >> 5); scr[kk * 33 + (lane & 31)] = W[(size_t)(k0 + kk) * ldw + n0 + (lane & 31)]; }
    LDS_WAIT(); asm volatile("" ::: "memory");
    const int c = lane & 7;
#pragma unroll
    for (int j = 0; j < 4; ++j) { const int n = (lane >> 3) + 8 * j; const LAS float* s = scr + (8 * c) * 33 + n;
        int row = n0 + n;
        if (MODE == 1) row = win_dst_row(row);
        if (MODE == 2 || MODE == 4) row = glu_dst_row(row, ldw >> 1);
        float v[8];
#pragma unroll
        for (int q = 0; q < 8; ++q) v[q] = s[q * 33];
        if (MODE == 1 && row < 0) continue;
        if (MODE == 4) { v2u o8; o8.x = pk4_fp8(v[0] * W8SCALE, v[1] * W8SCALE, v[2] * W8SCALE, v[3] * W8SCALE); o8.y = pk4_fp8(v[4] * W8SCALE, v[5] * W8SCALE, v[6] * W8SCALE, v[7] * W8SCALE);
            *(GAS v2u*)((unsigned char*)WT + (size_t)row * K + k0 + 8 * c) = o8; continue; }
        v4u o; o.x = pk2(v[0], v[1]); o.y = pk2(v[2], v[3]); o.z = pk2(v[4], v[5]); o.w = pk2(v[6], v[7]);
        *(GAS v4u*)(WT + (size_t)row * K + k0 + 8 * c) = o;
        if (MODE == 3) { float r[8];
#pragma unroll
            for (int q = 0; q < 8; ++q) r[q] = v[q] - bf2f(f2bf(v[q]));
            v4u o2; o2.x = pk2(r[0], r[1]); o2.y = pk2(r[2], r[3]); o2.z = pk2(r[4], r[5]); o2.w = pk2(r[6], r[7]);
            *(GAS v4u*)(WT2 + (size_t)row * K + k0 + 8 * c) = o2; }
    }
    LDS_WAIT(); asm volatile("" ::: "memory");
}

struct KArgs { const float* in[23]; float* out; unsigned char* ws; int ph_lo, ph_hi; };

__device__ __forceinline__ void p0_prologue(const KArgs& a, LAS unsigned char* lds, int vcu, int G, int wave, int lane) {
    LAS float* scr = (LAS float*)(lds + RING_OFF + wave * 16384);
    const int gw = vcu * NWAVES + wave, NGW = G * NWAVES;
    unsigned char* ws = a.ws;
    {
        const float* c = a.in[1]; const float* wada = a.in[2]; float* modp = (float*)(ws + WS_MODP);
        for (int it = gw; it < 96 * 16; it += NGW) {
            const int cg = it % 96, kc = it / 96, n = 64 * cg + lane; float s0 = 0.f, s1 = 0.f;
            const float* wp = wada + (size_t)(64 * kc) * 6144 + n;
#pragma unroll 8
            for (int k = 0; k < 64; ++k) { const float w = wp[(size_t)k * 6144]; const float c0 = c[64 * kc + k], c1 = c[1024 + 64 * kc + k];
                s0 += (c0 / (1.0f + __expf(-c0))) * w; s1 += (c1 / (1.0f + __expf(-c1))) * w; }
            modp[(size_t)(kc * 2 + 0) * 6144 + n] = s0; modp[(size_t)(kc * 2 + 1) * 6144 + n] = s1;
        }
    }
    constexpr int I_WIN = 144 * 16, I_WC = 8 * 32, I_WA = 8 * 32, I_WOUT = 16 * 32, I_WSGU = 16 * 16, I_WSD = 4 * 32, I_WR = 16 * 2, I_WGU = 64 * 256, I_WD = 64 * 128;
    constexpr int NITEMS = I_WIN + I_WC + I_WA + I_WOUT + I_WSGU + I_WSD + I_WR + I_WGU + I_WD;
    for (int it = gw; it < NITEMS; it += NGW) {
        int r = it;
        if (r < I_WIN) { const int cb = r % 144, kb = r / 144; const int n0 = cb < 80 ? 32 * cb : OFF_GC + 32 * (cb - 80);
            tr_item<1>(a.in[5], INCOLS, 1024, (bf16*)(ws + WS_WIN), nullptr, 64 * kb, n0, scr, lane); continue; } r -= I_WIN;
        if (r < I_WC) { tr_item<0>(a.in[10], 1024, 512, (bf16*)(ws + WS_WC), nullptr, 64 * (r / 32), 32 * (r % 32), scr, lane); continue; } r -= I_WC;
        if (r < I_WA) { tr_item<0>(a.in[14], 1024, 512, (bf16*)(ws + WS_WA), nullptr, 64 * (r / 32), 32 * (r % 32), scr, lane); continue; } r -= I_WA;
        if (r < I_WOUT) { tr_item<0>(a.in[15], 1024, 1024, (bf16*)(ws + WS_WOUT), nullptr, 64 * (r / 32), 32 * (r % 32), scr, lane); continue; } r -= I_WOUT;
        if (r < I_WSGU) { tr_item<MOE_FP8 ? 4 : 2>(a.in[21], 512, 1024, (bf16*)(ws + WS_WSGU), nullptr, 64 * (r / 16), 32 * (r % 16), scr, lane); continue; } r -= I_WSGU;
        if (r < I_WSD) { tr_item<0>(a.in[22], 1024, 256, (bf16*)(ws + WS_WSD), nullptr, 64 * (r / 32), 32 * (r % 32), scr, lane); continue; } r -= I_WSD;
        if (r < I_WR) { tr_item<3>(a.in[17], 64, 1024, (bf16*)(ws + WS_WRH), (bf16*)(ws + WS_WRL), 64 * (r / 2), 32 * (r % 2), scr, lane); continue; } r -= I_WR;
        if (r < I_WGU) { const int e = r / 256, q = r % 256;
            tr_item<MOE_FP8 ? 4 : 2>(a.in[19] + (size_t)e * 1024 * 512, 512, 1024, (bf16*)(ws + WS_WGU + (size_t)e * 512 * 1024 * (MOE_FP8 ? 1 : 2)), nullptr, 64 * (q / 16), 32 * (q % 16), scr, lane); continue; } r -= I_WGU;
        { const int e = r / 128, q = r % 128;
            tr_item<0>(a.in[20] + (size_t)e * 256 * 1024, 1024, 256, (bf16*)(ws + WS_WD) + (size_t)e * 1024 * 256, nullptr, 64 * (q / 32), 32 * (q % 32), scr, lane); }
    }
}

__device__ __forceinline__ void p1_rows(const KArgs& a, LAS unsigned char* lds, int vcu, int tid, int wave, int lane) {
    unsigned char* ws = a.ws;
    const float* modp = (const float*)(ws + WS_MODP); const float* bada = a.in[3];
    LAS float* gs1 = (LAS float*)(lds + RING_OFF); LAS float* sh1 = gs1 + 1024; LAS float* wfl = gs1 + 2048;
    const int b = vcu >> 7;
    {
        const int col = 4 * tid; f32x4 s = *(const f32x4*)(bada + col);
#pragma unroll
        for (int kc = 0; kc < 16; ++kc) s += *(const f32x4*)(modp + (size_t)(kc * 2 + b) * 6144 + col);
        if (col < 1024) { *(LAS f32x4*)(sh1 + col) = s; }
        else { const f32x4 g = *(const f32x4*)(a.in[4] + col - 1024); *(LAS f32x4*)(gs1 + col - 1024) = g * (1.0f + s); }
    }
    if (blockIdx.x < 2) {
        float* mod = (float*)(ws + WS_MOD); const int bb = blockIdx.x;
        for (int col = 4 * tid; col < 6144; col += 4 * NWAVES * 64) { f32x4 s = *(const f32x4*)(bada + col);
#pragma unroll
            for (int kc = 0; kc < 16; ++kc) s += *(const f32x4*)(modp + (size_t)(kc * 2 + bb) * 6144 + col);
            *(f32x4*)(mod + (size_t)bb * 6144 + col) = s; }
    }
    for (int idx = tid; idx < 8192; idx += NWAVES * 64) { const int k = idx >> 3, f = idx & 7; wfl[f * 1024 + k] = a.in[5][(size_t)k * INCOLS + OFF_F + f]; }
    __syncthreads();
    const float* x = a.in[0]; bf16* h1 = (bf16*)(ws + WS_H1); float* logf_ = (float*)(ws + WS_LOGF); const float* bfg = a.in[13];
#pragma nounroll
    for (int jb = 0; jb < 2; ++jb) {
    f32x4 vv[4][4];
#pragma unroll
    for (int j = 0; j < 4; ++j) { const GAS f32x4* xr = (const GAS f32x4*)(x + (size_t)(64 * vcu + 8 * wave + 4 * jb + j) * DMODEL) + lane;
#pragma unroll
        for (int q = 0; q < 4; ++q) vv[j][q] = xr[64 * q]; }
#pragma unroll
    for (int j = 0; j < 4; ++j) {
        const int row = 64 * vcu + 8 * wave + 4 * jb + j, t = row & (SEQ - 1);
        LAS float* gs1_ = gs1; asm volatile("" : "+v"(gs1_));
        LAS float* sh1_ = gs1_ + 1024; LAS float* wfl_ = gs1_ + 2048;
        f32x4 v[4]; float ss = 0.f;
#pragma unroll
        for (int q = 0; q < 4; ++q) { v[q] = vv[j][q]; ss += (v[q].x * v[q].x + v[q].y * v[q].y) + (v[q].z * v[q].z + v[q].w * v[q].w); }
        const float rstd = 1.0f / sqrtf(wave_sum(ss) * (1.0f / DMODEL) + EPS);
        GAS unsigned long long* o8 = (GAS unsigned long long*)(h1 + (size_t)row * DMODEL) + lane;
#pragma unroll
        for (int q = 0; q < 4; ++q) { const f32x4 g = *(const LAS f32x4*)(gs1_ + 4 * lane + 256 * q), s = *(const LAS f32x4*)(sh1_ + 4 * lane + 256 * q);
            v[q] = v[q] * rstd * g + s;
            o8[64 * q] = (unsigned long long)pk2(v[q].x, v[q].y) | ((unsigned long long)pk2(v[q].z, v[q].w) << 32); }
        float pf[8];
#pragma unroll
        for (int f = 0; f < 8; ++f) { float p = 0.f;
#pragma unroll
            for (int q = 0; q < 4; ++q) { const f32x4 w = *(const LAS f32x4*)(wfl_ + f * 1024 + 4 * lane + 256 * q); p += (v[q].x * w.x + v[q].y * w.y) + (v[q].z * w.z + v[q].w * w.w); }
            pf[f] = p; }
        float r4[4], r2[2], mine;
#pragma unroll
        for (int i = 0; i < 4; ++i) { const float keep = (lane & 1) ? pf[2 * i + 1] : pf[2 * i], send = (lane & 1) ? pf[2 * i] : pf[2 * i + 1]; r4[i] = keep + __shfl_xor(send, 1); }
#pragma unroll
        for (int i = 0; i < 2; ++i) { const float keep = (lane & 2) ? r4[2 * i + 1] : r4[2 * i], send = (lane & 2) ? r4[2 * i] : r4[2 * i + 1]; r2[i] = keep + __shfl_xor(send, 2); }
        { const float keep = (lane & 4) ? r2[1] : r2[0], send = (lane & 4) ? r2[0] : r2[1]; mine = keep + __shfl_xor(send, 4); }
        mine += __shfl_xor(mine, 8); mine += __shfl_xor(mine, 16); mine += __shfl_xor(mine, 32);
        if (lane < 8) { const float z = mine + bfg[lane]; const float ls = fminf(z, 0.f) - log1pf(expf(-fabsf(z)));
            logf_[(size_t)(b * 8 + lane) * SEQ + t] = ls; }
    }
    }
}

__device__ __forceinline__ void p2_cumsum(const KArgs& a, LAS unsigned char* lds, int seq, int tid, int wave, int lane) {
    const float* lf = (const float*)(a.ws + WS_LOGF) + (size_t)seq * SEQ + 16 * tid; float* cm = (float*)(a.ws + WS_CUM) + (size_t)seq * SEQ + 16 * tid;
    LAS double* wt = (LAS double*)(lds + RING_OFF);
    float v[16];
#pragma unroll
    for (int q = 0; q < 4; ++q) { const f32x4 x = *(const f32x4*)(lf + 4 * q); v[4 * q] = x.x; v[4 * q + 1] = x.y; v[4 * q + 2] = x.z; v[4 * q + 3] = x.w; }
    double pre[16]; double run = 0.0;
#pragma unroll
    for (int i = 0; i < 16; ++i) { run += (double)v[i]; pre[i] = run; }
    double sc = run;
#pragma unroll
    for (int o = 1; o < 64; o <<= 1) { const double up = __shfl_up(sc, o); if (lane >= o) sc += up; }
    if (lane == 63) wt[wave] = sc;
    __syncthreads();
    double off = sc - run;
    for (int w = 0; w < wave; ++w) off += wt[w];
#pragma unroll
    for (int q = 0; q < 4; ++q) { f32x4 o; o.x = (float)(off + pre[4 * q]); o.y = (float)(off + pre[4 * q + 1]); o.z = (float)(off + pre[4 * q + 2]); o.w = (float)(off + pre[4 * q + 3]); *(f32x4*)(cm + 4 * q) = o; }
    __syncthreads();
}

__device__ __forceinline__ void conv_item(const KArgs& a, LAS unsigned char* lds, int item, int tid) {
    const int tt = item >> 3, g = item & 7, row0 = 128 * tt, t0 = row0 & (SEQ - 1), c0 = 64 * g;
    const bf16* U = (const bf16*)(a.ws + WS_U); bf16* UC = (bf16*)(a.ws + WS_UC);
    LAS unsigned char* ut = lds + RING_OFF;
    LAS float* wl = (LAS float*)(lds + RING_OFF + 24576);
    constexpr int RS = 144;
    for (int idx = tid; idx < 158 * 8; idx += NWAVES * 64) { const int r = idx >> 3, ch = idx & 7, tq = t0 - 30 + r;
        v4u val = (v4u){0u, 0u, 0u, 0u};
        if (tq >= 0) val = *(const GAS v4u*)(U + (size_t)(row0 - 30 + r) * CONVD + c0 + 8 * ch);
        *(LAS v4u*)(ut + r * RS + 16 * ch) = val; }
    for (int idx = tid; idx < 31 * 64; idx += NWAVES * 64) wl[idx] = a.in[6][(size_t)(idx >> 6) * CONVD + c0 + (idx & 63)];
    __syncthreads();
    const int tok = tid >> 2, q = tid & 3;
    float acc[16];
#pragma unroll
    for (int i = 0; i < 16; ++i) acc[i] = a.in[7][c0 + 16 * q + i];
    for (int j = 0; j < CONVW; ++j) {
        const LAS unsigned char* up = ut + (tok + j) * RS + 32 * q; const v4u u0 = *(const LAS v4u*)up, u1 = *(const LAS v4u*)(up + 16);
        const LAS float* wp = wl + j * 64 + 16 * q;
        const f32x4 w0 = *(const LAS f32x4*)wp, w1 = *(const LAS f32x4*)(wp + 4), w2 = *(const LAS f32x4*)(wp + 8), w3 = *(const LAS f32x4*)(wp + 12);
        acc[0] += bf_lo(u0.x) * w0.x; acc[1] += bf_hi(u0.x) * w0.y; acc[2] += bf_lo(u0.y) * w0.z; acc[3] += bf_hi(u0.y) * w0.w;
        acc[4] += bf_lo(u0.z) * w1.x; acc[5] += bf_hi(u0.z) * w1.y; acc[6] += bf_lo(u0.w) * w1.z; acc[7] += bf_hi(u0.w) * w1.w;
        acc[8] += bf_lo(u1.x) * w2.x; acc[9] += bf_hi(u1.x) * w2.y; acc[10] += bf_lo(u1.y) * w2.z; acc[11] += bf_hi(u1.y) * w2.w;
        acc[12] += bf_lo(u1.z) * w3.x; acc[13] += bf_hi(u1.z) * w3.y; acc[14] += bf_lo(u1.w) * w3.z; acc[15] += bf_hi(u1.w) * w3.w;
    }
    float s = 0.f;
#pragma unroll
    for (int i = 0; i < 16; ++i) s += acc[i];
    s += __shfl_xor(s, 1); s += __shfl_xor(s, 2);
    const float mu = s * (1.0f / 64.0f); float qv = 0.f;
#pragma unroll
    for (int i = 0; i < 16; ++i) { acc[i] -= mu; qv += acc[i] * acc[i]; }
    qv += __shfl_xor(qv, 1); qv += __shfl_xor(qv, 2);
    const float rstd = 1.0f / sqrtf(qv * (1.0f / 64.0f) + EPS);
    unsigned o[8];
#pragma unroll
    for (int i = 0; i < 16; i += 2) { float y0 = acc[i] * rstd * a.in[8][c0 + 16 * q + i] + a.in[9][c0 + 16 * q + i], y1 = acc[i + 1] * rstd * a.in[8][c0 + 16 * q + i + 1] + a.in[9][c0 + 16 * q + i + 1];
        y0 = y0 * sigmoidf_fast(y0); y1 = y1 * sigmoidf_fast(y1); o[i >> 1] = pk2(y0, y1); }
    GAS v4u* dst = (GAS v4u*)(UC + (size_t)(row0 + tok) * CONVD + c0 + 16 * q);
    dst[0] = (v4u){o[0], o[1], o[2], o[3]}; dst[1] = (v4u){o[4], o[5], o[6], o[7]};
    __syncthreads();
}

struct SchedDense {
    static constexpr bool GATHER = false;
    int nM, nN, G, c, K; const char* A; const char* B;
    __device__ __forceinline__ bool next(int i, pg8::Unit& u) const {
        const long L = (long)i * G + c; if (L >= (long)nM * nN) return false;
        pg8::tile_of((int)L, nM, nN, u.pm, u.pn); u.e = 0; u.mt = 0;
        u.A = A + (size_t)u.pm * 256 * K * 2; u.B = B + (size_t)u.pn * 256 * K * 2; return true; }
    __device__ __forceinline__ int row(const pg8::Unit&, int) const { return 0; }
};
struct SchedMerge {
    static constexpr bool GATHER = false;
    int c; const char* A0; const char* B0; const char* A1; const char* B1;
    __device__ __forceinline__ bool next(int i, pg8::Unit& u) const {
        if (i >= 2 || c >= 256) return false;
        pg8::tile_of(c, 64, 4, u.pm, u.pn); u.e = i; u.mt = 0;
        u.A = (i ? A1 : A0) + (size_t)u.pm * 256 * 512 * 2; u.B = (i ? B1 : B0) + (size_t)u.pn * 256 * 512 * 2; return true; }
    __device__ __forceinline__ int row(const pg8::Unit&, int) const { return 0; }
};
struct MoeTab { const LAS int* tstart; const LAS int* cnt; };
struct SchedMoe1 {
    static constexpr bool GATHER = true;
    MoeTab tb; int nmoe, ntot, per, c, lane; const char* h2; const char* wgu; const char* wsgu; const int* list;
    __device__ __forceinline__ bool next(int i, pg8::Unit& u) const {
        const int L = c * per + i; if (i >= per || L >= ntot) return false;
        if (L < nmoe) { const int tt = L >> 1; const int e = __popcll(__ballot(tb.tstart[lane + 1] <= tt));
            u.e = e; u.mt = tt - tb.tstart[e]; u.pm = tt; u.pn = L & 1; u.A = h2; u.B = wgu + ((size_t)e * 512 + (size_t)u.pn * 256) * 1024 * (MOE_FP8 ? 1 : 2); }
        else { const int s = L - nmoe; u.e = -1; u.mt = 0; u.pm = s >> 1; u.pn = s & 1; u.A = h2; u.B = wsgu + (size_t)u.pn * 256 * 1024 * (MOE_FP8 ? 1 : 2); }
        return true; }
    __device__ __forceinline__ int row(const pg8::Unit& u, int r) const {
        if (u.e < 0) return u.pm * 256 + r;
        const int idx = u.mt * 256 + r; return idx < tb.cnt[u.e] ? (list[(size_t)u.e * LISTCAP + idx] >> 3) : 0; }
};
struct SchedMoe2 {
    static constexpr bool GATHER = false;
    MoeTab tb; int ntot, per, c, lane; const char* act; const char* wd;
    __device__ __forceinline__ bool next(int i, pg8::Unit& u) const {
        const int L = c * per + i; if (i >= per || L >= ntot) return false;
        const int tt = L >> 2; const int e = __popcll(__ballot(tb.tstart[lane + 1] <= tt));
        u.e = e; u.mt = tt - tb.tstart[e]; u.pm = tt; u.pn = L & 3; u.A = act + (size_t)tt * 256 * 256 * 2; u.B = wd + ((size_t)e * 1024 + (size_t)u.pn * 256) * 256 * 2; return true; }
    __device__ __forceinline__ int row(const pg8::Unit&, int) const { return 0; }
};

typedef pg8::f32x4 (AccT)[2][2][4][2];
__device__ __forceinline__ v4u pack8(const f32x4& a, const f32x4& b) { v4u w; w.x = cvt_pk_bf16(a[0], a[1]); w.y = cvt_pk_bf16(a[2], a[3]); w.z = cvt_pk_bf16(b[0], b[1]); w.w = cvt_pk_bf16(b[2], b[3]); return w; }
__device__ __forceinline__ void unpack8(const v4u& w, f32x4& a, f32x4& b) { a = (f32x4){bf_lo(w.x), bf_hi(w.x), bf_lo(w.y), bf_hi(w.y)}; b = (f32x4){bf_lo(w.z), bf_hi(w.z), bf_lo(w.w), bf_hi(w.w)}; }
__device__ __forceinline__ f32x4 sig4(const f32x4& v) { return (f32x4){sigmoidf_fast(v[0]), sigmoidf_fast(v[1]), sigmoidf_fast(v[2]), sigmoidf_fast(v[3])}; }

struct EpiIn {
    static constexpr bool PERM = true;
    bf16 *U, *Q, *Kb, *V, *SG; const float *gq, *gk;
    __device__ __forceinline__ void operator()(const AccT& acc, const pg8::Unit& u, int wr, int wc, int fr_, int fq_) const {
        int fr = fr_, fq = fq_; asm volatile("" : "+v"(fr), "+v"(fq));
        const int row0 = u.pm * 256 + wr * 64 + fr, pn = u.pn;
        if (pn < 4) {
            const int col0 = 128 * pn + 32 * wc + 8 * fq;
#pragma unroll
            for (int ai = 0; ai < 2; ++ai)
#pragma unroll
                for (int m = 0; m < 4; ++m) { const f32x4 v0 = acc[ai][0][m][0] * sig4(acc[ai][1][m][0]), v1 = acc[ai][0][m][1] * sig4(acc[ai][1][m][1]);
                    *(v4u*)(U + (size_t)(row0 + ai * 128 + m * 16) * CONVD + col0) = pack8(v0, v1); }
        } else if (pn < 8) {
            const bool isk = pn >= 6; const int head = 4 * ((pn - 4) & 1) + wc; const float* g = isk ? gk : gq; bf16* dst = isk ? Kb : Q; const float sc = isk ? 1.0f : C2Q;
            f32x4 gv[2][2];
#pragma unroll
            for (int bj = 0; bj < 2; ++bj)
#pragma unroll
                for (int n = 0; n < 2; ++n) gv[bj][n] = *(const f32x4*)(g + 32 * bj + 8 * fq + 4 * n) * sc;
#pragma unroll
            for (int ai = 0; ai < 2; ++ai)
#pragma unroll
                for (int m = 0; m < 4; ++m) { float ss = 0.f;
#pragma unroll
                    for (int bj = 0; bj < 2; ++bj)
#pragma unroll
                        for (int n = 0; n < 2; ++n) { const f32x4 x = acc[ai][bj][m][n]; ss += (x[0] * x[0] + x[1] * x[1]) + (x[2] * x[2] + x[3] * x[3]); }
                    ss += __shfl_xor(ss, 16); ss += __shfl_xor(ss, 32);
                    const float r = 1.0f / sqrtf(ss * (1.0f / 64.0f) + EPS);
                    bf16* rowp = dst + (size_t)(row0 + ai * 128 + m * 16) * ATT + head * 64 + 8 * fq;
#pragma unroll
                    for (int bj = 0; bj < 2; ++bj) *(v4u*)(rowp + 32 * bj) = pack8(acc[ai][bj][m][0] * r * gv[bj][0], acc[ai][bj][m][1] * r * gv[bj][1]); }
        } else if (pn < 10) {
            const int col0 = 256 * (pn - 8) + 32 * wc + 8 * fq;
#pragma unroll
            for (int ai = 0; ai < 2; ++ai)
#pragma unroll
                for (int m = 0; m < 4; ++m)
#pragma unroll
                    for (int bj = 0; bj < 2; ++bj) *(v4u*)(V + (size_t)(row0 + ai * 128 + m * 16) * ATT + col0 + 128 * bj) = pack8(acc[ai][bj][m][0], acc[ai][bj][m][1]);
        } else {
            bf16* dst = SG + (size_t)((pn - 10) >> 2) * T * DMODEL; const int col0 = 256 * ((pn - 10) & 3) + 32 * wc + 8 * fq;
#pragma unroll
            for (int ai = 0; ai < 2; ++ai)
#pragma unroll
                for (int m = 0; m < 4; ++m)
#pragma unroll
                    for (int bj = 0; bj < 2; ++bj) *(v4u*)(dst + (size_t)(row0 + ai * 128 + m * 16) * DMODEL + col0 + 128 * bj) = pack8(sig4(acc[ai][bj][m][0]), sig4(acc[ai][bj][m][1]));
        }
    }
};
struct EpiMerge {
    static constexpr bool PERM = true;
    const bf16* SG; bf16* MG;
    __device__ __forceinline__ void operator()(const AccT& acc, const pg8::Unit& u, int wr, int wc, int fr_, int fq_) const {
        int fr = fr_, fq = fq_; asm volatile("" : "+v"(fr), "+v"(fq));
        const int row0 = u.pm * 256 + wr * 64 + fr, col0 = u.pn * 256 + 32 * wc + 8 * fq; const bf16* sg = SG + (size_t)u.e * T * DMODEL;
#pragma unroll
        for (int ai = 0; ai < 2; ++ai)
#pragma unroll
            for (int m = 0; m < 4; ++m)
#pragma unroll
                for (int bj = 0; bj < 2; ++bj) { const size_t off = (size_t)(row0 + ai * 128 + m * 16) * DMODEL + col0 + 128 * bj;
                    f32x4 g0, g1; unpack8(*(const v4u*)(sg + off), g0, g1);
                    f32x4 v0 = g0 * acc[ai][bj][m][0], v1 = g1 * acc[ai][bj][m][1];
                    if (u.e) { f32x4 p0, p1; unpack8(*(const v4u*)(MG + off), p0, p1); v0 += p0; v1 += p1; }
                    *(v4u*)(MG + off) = pack8(v0, v1); }
    }
};
struct EpiX1 {
    static constexpr bool PERM = false;
    const float* x; float* out; const float* mod; float* ssq;
    __device__ __forceinline__ void operator()(const AccT& acc, const pg8::Unit& u, int wr, int wc, int fr_, int fq_) const {
        int fr = fr_, fq = fq_; asm volatile("" : "+v"(fr), "+v"(fq));
        const int row0 = u.pm * 256 + wr * 64 + fr, col0 = u.pn * 256 + 32 * wc + 4 * fq; const float* g1 = mod + (size_t)(u.pm >> 5) * 6144 + 2048;
        f32x4 gv[2][2];
#pragma unroll
        for (int bj = 0; bj < 2; ++bj)
#pragma unroll
            for (int n = 0; n < 2; ++n) gv[bj][n] = *(const f32x4*)(g1 + col0 + 128 * bj + 16 * n);
#pragma unroll
        for (int ai = 0; ai < 2; ++ai)
#pragma unroll
            for (int m = 0; m < 4; ++m) { const int row = row0 + ai * 128 + m * 16; float ss = 0.f;
#pragma unroll
                for (int bj = 0; bj < 2; ++bj)
#pragma unroll
                    for (int n = 0; n < 2; ++n) { const size_t off = (size_t)row * DMODEL + col0 + 128 * bj + 16 * n;
                        const f32x4 v = *(const f32x4*)(x + off) + gv[bj][n] * acc[ai][bj][m][n]; *(f32x4*)(out + off) = v;
                        ss += (v[0] * v[0] + v[1] * v[1]) + (v[2] * v[2] + v[3] * v[3]); }
                ss += __shfl_xor(ss, 16); ss += __shfl_xor(ss, 32);
                if (fq == 0) ssq[(size_t)(u.pn * 4 + wc) * T + row] = ss; }
    }
};
struct EpiGlu {
    static constexpr bool PERM = true;
    bf16 *ACT, *SACT; const float* wlist; MoeTab tb;
    __device__ __forceinline__ void operator()(const AccT& acc, const pg8::Unit& u, int wr, int wc, int fr_, int fq_) const {
        int fr = fr_, fq = fq_; asm volatile("" : "+v"(fr), "+v"(fq));
        const int rl0 = wr * 64 + fr, col0 = 128 * u.pn + 32 * wc + 8 * fq; bf16* dst = (u.e >= 0 ? ACT : SACT) + (size_t)u.pm * 256 * EF;
        const int cnt = u.e >= 0 ? tb.cnt[u.e] : 0;
        float wv[2][4];
#pragma unroll
        for (int ai = 0; ai < 2; ++ai)
#pragma unroll
            for (int m = 0; m < 4; ++m) { const int idx = u.mt * 256 + rl0 + ai * 128 + m * 16; wv[ai][m] = (u.e >= 0) ? (idx < cnt ? wlist[(size_t)u.e * LISTCAP + idx] : 0.0f) : 1.0f; }
#pragma unroll
        for (int ai = 0; ai < 2; ++ai)
#pragma unroll
            for (int m = 0; m < 4; ++m) { const int rl = rl0 + ai * 128 + m * 16; const float w = wv[ai][m];
                const f32x4 g0 = acc[ai][0][m][0] * (1.0f / W8SCALE), g1 = acc[ai][0][m][1] * (1.0f / W8SCALE);
                const f32x4 v0 = g0 * sig4(g0) * acc[ai][1][m][0] * (w * (1.0f / W8SCALE)), v1 = g1 * sig4(g1) * acc[ai][1][m][1] * (w * (1.0f / W8SCALE));
                *(v4u*)(dst + (size_t)rl * EF + col0) = pack8(v0, v1); asm volatile("" ::: "memory"); }
    }
};
struct EpiSlab {
    static constexpr bool PERM = true;
    bf16* SLAB; const int* list; MoeTab tb;
    __device__ __forceinline__ void operator()(const AccT& acc, const pg8::Unit& u, int wr, int wc, int fr_, int fq_) const {
        int fr = fr_, fq = fq_; asm volatile("" : "+v"(fr), "+v"(fq));
        const int rl0 = wr * 64 + fr, col0 = 256 * u.pn + 64 * wc + 8 * fq, cnt = tb.cnt[u.e];
        int sl[2][4];
#pragma unroll
        for (int ai = 0; ai < 2; ++ai)
#pragma unroll
            for (int m = 0; m < 4; ++m) { const int idx = u.mt * 256 + rl0 + ai * 128 + m * 16; sl[ai][m] = idx < cnt ? list[(size_t)u.e * LISTCAP + idx] : -1; }
#pragma unroll
        for (int ai = 0; ai < 2; ++ai)
#pragma unroll
            for (int m = 0; m < 4; ++m) { const int slot = sl[ai][m];
                if (slot >= 0) { bf16* rowp = SLAB + (size_t)slot * DMODEL + col0;
#pragma unroll
                    for (int bj = 0; bj < 2; ++bj) *(v4u*)(rowp + 32 * bj) = pack8(acc[ai][bj][m][0], acc[ai][bj][m][1]); }
                asm volatile("" ::: "memory"); }
    }
};
struct EpiFinal {
    static constexpr bool PERM = true;
    float* out; const bf16* SLAB; const float* mod;
    __device__ __forceinline__ void operator()(const AccT& acc, const pg8::Unit& u, int wr, int wc, int fr_, int fq_) const {
        int fr = fr_, fq = fq_; asm volatile("" : "+v"(fr), "+v"(fq));
        const int row0 = u.pm * 256 + wr * 64 + fr, col0 = u.pn * 256 + 32 * wc + 8 * fq; const float* g2 = mod + (size_t)(u.pm >> 5) * 6144 + 5120;
        f32x4 gv[2][2];
#pragma unroll
        for (int bj = 0; bj < 2; ++bj)
#pragma unroll
            for (int n = 0; n < 2; ++n) gv[bj][n] = *(const f32x4*)(g2 + col0 + 128 * bj + 4 * n);
#pragma unroll
        for (int ai = 0; ai < 2; ++ai)
#pragma unroll
            for (int m = 0; m < 4; ++m) { const int row = row0 + ai * 128 + m * 16;
#pragma unroll
                for (int bj = 0; bj < 2; ++bj) { f32x4 s0 = acc[ai][bj][m][0], s1 = acc[ai][bj][m][1]; const bf16* sp = SLAB + (size_t)row * TOPK * DMODEL + u.pn * 256 + 64 * wc + 8 * fq + 32 * bj;
#if FWD_LEVEL >= 2
#pragma unroll
                    for (int k = 0; k < TOPK; ++k) { f32x4 a0, a1; unpack8(*(const v4u*)(sp + (size_t)k * DMODEL), a0, a1); s0 += a0; s1 += a1; }
#endif
                    float* op = out + (size_t)row * DMODEL + col0 + 128 * bj;
                    *(f32x4*)op = *(const f32x4*)op + gv[bj][0] * s0; *(f32x4*)(op + 4) = *(const f32x4*)(op + 4) + gv[bj][1] * s1; }
                asm volatile("" ::: "memory"); }
    }
};

__device__ __forceinline__ void p6_item(const KArgs& a, LAS unsigned char* lds, int item, int tid, int wave, int lane) {
    unsigned char* ws = a.ws;
    const int row0 = 32 * item, r = lane & 31, h = lane >> 5, row = row0 + r, b = row >> 13;
    const float* x1 = a.out; const float* ssq = (const float*)(ws + WS_SSQ); const float* mod = (const float*)(ws + WS_MOD) + (size_t)b * 6144;
    unsigned char* H2 = ws + WS_H2;
    const bf16* WRH = (const bf16*)(ws + WS_WRH); const bf16* WRL = (const bf16*)(ws + WS_WRL);
    constexpr int WREG = 9216, TROW = 144;
    LAS unsigned char* wreg = lds + RING_OFF + wave * WREG;
    LAS float* scl = (LAS float*)(lds + RING_OFF + 8 * WREG);
    LAS float* bil = scl + 32 * 65;
    LAS int* hist = (LAS int*)(bil + 32 * 65);
    LAS int* gbase = hist + 512;
    LAS float* rstl = (LAS float*)(gbase + 64);
    if (tid < 32) { float ss = 0.f;
#pragma unroll
        for (int p = 0; p < 16; ++p) ss += ssq[(size_t)p * T + row0 + tid];
        rstl[tid] = 1.0f / sqrtf(ss * (1.0f / DMODEL) + EPS); }
    const int lr = lane >> 4, lc4 = (lane & 15) * 4;
    __syncthreads();
    f32x16 acc0, acc1;
#pragma unroll
    for (int i = 0; i < 16; ++i) { acc0[i] = 0.f; acc1[i] = 0.f; }
#pragma nounroll
    for (int ms = 0; ms < 2; ++ms) {
        const int kb = 128 * wave + 64 * ms;
        f32x4 xv[8];
#pragma unroll
        for (int i = 0; i < 8; ++i) xv[i] = *(const f32x4*)(x1 + (size_t)(row0 + 4 * i + lr) * DMODEL + kb + lc4);
        const f32x4 gs = *(const f32x4*)(a.in[16] + kb + lc4) * (1.0f + *(const f32x4*)(mod + 4096 + kb + lc4)), sh = *(const f32x4*)(mod + 3072 + kb + lc4);
#pragma unroll
        for (int i = 0; i < 8; ++i) { const int rr = 4 * i + lr; const f32x4 hv = xv[i] * rstl[rr] * gs + sh;
            const unsigned h0 = f2bf(hv[0]), h1_ = f2bf(hv[1]), h2_ = f2bf(hv[2]), h3 = f2bf(hv[3]);
            const v2u whi = (v2u){h0 | (h1_ << 16), h2_ | (h3 << 16)};
            const v2u wlo = (v2u){pk2(hv[0] - bf2f(h0), hv[1] - bf2f(h1_)), pk2(hv[2] - bf2f(h2_), hv[3] - bf2f(h3))};
#if MOE_FP8
            *(GAS unsigned*)(H2 + (size_t)(row0 + rr) * DMODEL + kb + lc4) = pk4_fp8(hv[0], hv[1], hv[2], hv[3]);
#else
            *(GAS v2u*)(H2 + ((size_t)(row0 + rr) * DMODEL + kb + lc4) * 2) = whi;
#endif
            *(LAS v2u*)(wreg + rr * TROW + lc4 * 2) = whi; *(LAS v2u*)(wreg + 32 * TROW + rr * TROW + lc4 * 2) = wlo; }
#pragma unroll
        for (int sp = 0; sp < 2; ++sp) {
            bf16x8 bh0[2], bh1[2], bl0[2], bl1[2];
#pragma unroll
            for (int s2 = 0; s2 < 2; ++s2) { const size_t o = (size_t)r * DMODEL + kb + 16 * (2 * sp + s2) + 8 * h;
                bh0[s2] = *(const bf16x8*)(WRH + o); bh1[s2] = *(const bf16x8*)(WRH + o + 32 * DMODEL); bl0[s2] = *(const bf16x8*)(WRL + o); bl1[s2] = *(const bf16x8*)(WRL + o + 32 * DMODEL); }
#pragma unroll
            for (int s2 = 0; s2 < 2; ++s2) { const int s_ = 2 * sp + s2;
                const bf16x8 ahi = *(const LAS bf16x8*)(wreg + r * TROW + (16 * s_ + 8 * h) * 2), alo = *(const LAS bf16x8*)(wreg + 32 * TROW + r * TROW + (16 * s_ + 8 * h) * 2);
                acc0 = __builtin_amdgcn_mfma_f32_32x32x16_bf16(alo, bh0[s2], acc0, 0, 0, 0); acc1 = __builtin_amdgcn_mfma_f32_32x32x16_bf16(alo, bh1[s2], acc1, 0, 0, 0);
                acc0 = __builtin_amdgcn_mfma_f32_32x32x16_bf16(ahi, bl0[s2], acc0, 0, 0, 0); acc1 = __builtin_amdgcn_mfma_f32_32x32x16_bf16(ahi, bl1[s2], acc1, 0, 0, 0);
                acc0 = __builtin_amdgcn_mfma_f32_32x32x16_bf16(ahi, bh0[s2], acc0, 0, 0, 0); acc1 = __builtin_amdgcn_mfma_f32_32x32x16_bf16(ahi, bh1[s2], acc1, 0, 0, 0); }
            asm volatile("" ::: "memory");
        }
        asm volatile("" ::: "memory");
    }
    { LAS float* part = (LAS float*)wreg;
#pragma unroll
      for (int i = 0; i < 16; ++i) { const int tr = (i & 3) + 8 * (i >> 2) + 4 * h; part[tr * 64 + r] = acc0[i]; part[tr * 64 + 32 + r] = acc1[i]; } }
    __syncthreads();
    {
        const int tr = tid >> 4, e4 = (tid & 15) * 4; f32x4 s = *(const LAS f32x4*)(lds + RING_OFF + tr * 256 + e4 * 4);
#pragma unroll
        for (int w = 1; w < 8; ++w) s += *(const LAS f32x4*)(lds + RING_OFF + w * WREG + tr * 256 + e4 * 4);
        const f32x4 rb = *(const f32x4*)(a.in[18] + e4);
#pragma unroll
        for (int j = 0; j < 4; ++j) { const float sc = 1.0f / (1.0f + expf(-s[j])); scl[tr * 65 + e4 + j] = sc; bil[tr * 65 + e4 + j] = sc + rb[j]; }
    }
    __syncthreads();
    LAS int* selk = (LAS int*)(rstl + 32); LAS float* selw = (LAS float*)(selk + 32 * 64);
    int lc = 0;
#pragma nounroll
    for (int j = 0; j < 4; ++j) {
        const int tr = wave * 4 + j; const float v = bil[tr * 65 + lane], sc = scl[tr * 65 + lane];
        int rk = 0;
#pragma unroll
        for (int d = 1; d < 8; ++d) { const int src = (lane & ~7) | ((lane + d) & 7); const float o = __shfl(v, src); rk += (o > v) || (o == v && src < lane); }
        float t2 = rk < 2 ? v : 0.f; t2 += __shfl_xor(t2, 1); t2 += __shfl_xor(t2, 2); t2 += __shfl_xor(t2, 4);
        int grk = 0; const int g = lane >> 3;
#pragma unroll
        for (int g2 = 0; g2 < 8; ++g2) { const float og = __builtin_bit_cast(float, __builtin_amdgcn_readlane(__builtin_bit_cast(int, t2), g2 * 8)); grk += (og > t2) || (og == t2 && g2 < g); }
        const bool gsel = grk < 4;
        const float c = gsel ? v : -INFINITY; int erk = 0;
#pragma nounroll
        for (int e2 = 0; e2 < 64; ++e2) { const float oc = __builtin_bit_cast(float, __builtin_amdgcn_readlane(__builtin_bit_cast(int, c), e2)); erk += (oc > c) || (oc == c && e2 < lane); }
        const bool sel = gsel && erk < TOPK;
        const float wsum = wave_sum(sel ? sc : 0.f);
        selk[tr * 64 + lane] = sel ? erk : -1; selw[tr * 64 + lane] = sc * (ROUTED_SCALE / wsum); lc += sel ? 1 : 0;
    }
    hist[wave * 64 + lane] = lc;
    __syncthreads();
    if (wave == 0) { int tot = 0;
#pragma unroll
        for (int w = 0; w < 8; ++w) tot += hist[w * 64 + lane];
        gbase[lane] = tot ? (int)__hip_atomic_fetch_add((unsigned*)(ws + WS_CTL) + CW_CNT + 64 * lane, (unsigned)tot, RLX_AGENT) : 0; }
    __syncthreads();
    {   int base = gbase[lane];
        for (int w = 0; w < wave; ++w) base += hist[w * 64 + lane];
        int* list = (int*)(ws + WS_LIST); float* wl = (float*)(ws + WS_WLIST);
#pragma unroll
        for (int j = 0; j < 4; ++j) { const int tr = wave * 4 + j, k = selk[tr * 64 + lane]; if (k >= 0) { const size_t p = (size_t)lane * LISTCAP + base; list[p] = (row0 + tr) * TOPK + k; wl[p] = selw[tr * 64 + lane]; ++base; } } }
    __syncthreads();
}

__device__ __forceinline__ void moe_tables(const KArgs& a, LAS unsigned char* lds, int tid, int lane) {
    LAS int* tstart = (LAS int*)(lds + TAB_OFF); LAS int* cntl = tstart + 80;
    if (tid < 64) { const int c = (int)__hip_atomic_load((unsigned*)(a.ws + WS_CTL) + CW_CNT + 64 * tid, RLX_AGENT); const int tl = (c + 255) >> 8; int sc = tl;
#pragma unroll
        for (int o = 1; o < 64; o <<= 1) { const int up = __shfl_up(sc, o); if (lane >= o) sc += up; }
        cntl[tid] = c; tstart[tid + 1] = sc; if (tid == 0) tstart[0] = 0; }
    __syncthreads();
}

__global__ void __launch_bounds__(NWAVES * 64, 2) fox_fwd(KArgs args) {
    extern __shared__ __attribute__((aligned(16))) unsigned char lds_raw[];
    LAS unsigned char* lds = (LAS unsigned char*)lds_raw;
    volatile LAS unsigned* MISC = (volatile LAS unsigned*)(lds + MISC_OFF);
    const int tid = threadIdx.x, lane = tid & 63, wave = __builtin_amdgcn_readfirstlane(tid >> 6);
    const int G = gridDim.x; int vcu; { const int bx = blockIdx.x; vcu = (G % 8 == 0) ? (bx % 8) * (G / 8) + bx / 8 : bx; }
    unsigned char* ws = args.ws; gu32* ctl = (gu32*)(ws + WS_CTL);
    for (int u = tid; u < (LDS_BYTES - LDSCTL_OFF) / 4; u += NWAVES * 64) ((LAS unsigned*)(lds + LDSCTL_OFF))[u] = 0u;
    __syncthreads();
    const int lo = args.ph_lo, hi = args.ph_hi; const bool single = (hi - lo) > 1;
    XcdBarrier bar; bar.bar = (unsigned*)(ctl + CW_BAR); bar.x = 0; bar.st = nullptr;
    if (single) bar = xcd_barrier_post((unsigned*)(ctl + CW_BAR), MISC + 8);
#ifndef PHASE_MASK
#define PHASE_MASK 0x3ff
#endif
#define IN(k) (((PHASE_MASK >> (k)) & 1) && lo <= (k) && (k) < hi)
#if defined(DIAG_A)
    unsigned long long* dstamp = (unsigned long long*)(ws + WS_CTL + 512 * 1024);
#define GRID_BAR(k) do { if (IN(k) && IN((k) + 1)) xcd_barrier(bar); if (blockIdx.x == 0 && tid == 0) dstamp[(k) + 1] = __builtin_amdgcn_s_memrealtime(); } while (0)
    if (blockIdx.x == 0 && tid == 0) dstamp[0] = __builtin_amdgcn_s_memrealtime();
#else
#define GRID_BAR(k) do { if (IN(k) && IN((k) + 1)) xcd_barrier(bar); } while (0)
#endif
    bf16* H1 = (bf16*)(ws + WS_H1); bf16* Ub = (bf16*)(ws + WS_U); bf16* Qb = (bf16*)(ws + WS_Q); bf16* Kb = (bf16*)(ws + WS_K); bf16* Vb = (bf16*)(ws + WS_V);
    bf16* SG = (bf16*)(ws + WS_SG); bf16* UC = (bf16*)(ws + WS_UC); bf16* Ob = (bf16*)(ws + WS_O); bf16* MG = (bf16*)(ws + WS_MG);
    const float* mod = (const float*)(ws + WS_MOD);

#if FWD_LEVEL == 0
    if (IN(0)) { const f32x4* xs = (const f32x4*)args.in[0]; f32x4* od = (f32x4*)args.out;
        for (size_t i = (size_t)blockIdx.x * 512 + tid; i < (size_t)T * DMODEL / 4; i += (size_t)G * 512) od[i] = xs[i]; }
    for (int k = 0; k < 9; ++k) GRID_BAR(k);
#else
    if (IN(0)) p0_prologue(args, lds, vcu, G, wave, lane);
    GRID_BAR(0);
    if (IN(1)) { if (G == 256) p1_rows(args, lds, vcu, tid, wave, lane); }
    GRID_BAR(1);
    if (IN(2)) {
        if (blockIdx.x < 16) p2_cumsum(args, lds, blockIdx.x, tid, wave, lane);
        SchedDense S{64, NIN / 256, G, (int)blockIdx.x, 1024, (const char*)H1, (const char*)(ws + WS_WIN)};
        EpiIn E{Ub, Qb, Kb, Vb, SG, args.in[11], args.in[12]};
        pg8::gemm_phase<EpiIn, SchedDense, true>(lds + RING_OFF, 1024, S, E);
    }
    GRID_BAR(2);
#if defined(DBG_STAGE) && (DBG_STAGE == 24 || DBG_STAGE == 4)
    {   const bf16* src = (DBG_STAGE == 24) ? SG : (const bf16*)(ws + WS_WIN) + (size_t)2560 * 1024;
        for (size_t i = (size_t)blockIdx.x * 512 + tid; i < (size_t)T * 1024; i += (size_t)G * 512) { const size_t r = i >> 10, c = i & 1023; args.out[i] = bf2f(src[((DBG_STAGE == 24) ? r : (r & 2047)) * 1024 + c]); }
        return; }
#endif
    if (IN(3)) {
        float gq = fabsf(args.in[11][lane]), gk = fabsf(args.in[12][lane]);
#pragma unroll
        for (int o = 1; o < 64; o <<= 1) { gq = fmaxf(gq, __shfl_xor(gq, o)); gk = fmaxf(gk, __shfl_xor(gk, o)); }
        const float thr2 = 2.0f * (8.0f * gq * gk * LOG2E) + 40.0f;
        const attn_body::AttnTensors AT{(const attn_body::bf16*)Qb, (const attn_body::bf16*)Kb, (const attn_body::bf16*)Vb, (attn_body::bf16*)Ob, (const float*)(ws + WS_CUM), thr2};
        if (G == 256) { const attn_body::StaticOrder S(G, (int)blockIdx.x); attn_body::attn_phase<attn_body::StaticOrder>((char*)lds_raw + RING_OFF, AT, S); }
        for (int it = vcu; it < 1024; it += G) conv_item(args, lds, it, tid);
    }
    GRID_BAR(3);
#if defined(DBG_STAGE)
    {
#if DBG_STAGE == 2
        const bf16* bA = Qb; const bf16* bB = Kb;
#elif DBG_STAGE == 21
        const bf16* bA = Vb; const bf16* bB = Ub;
#elif DBG_STAGE == 22
        const bf16* bA = SG; const bf16* bB = SG + 512;
#elif DBG_STAGE == 23
        const bf16* bA = SG + (size_t)T * 1024; const bf16* bB = SG + (size_t)T * 1024 + 512;
#elif DBG_STAGE == 3
        const bf16* bA = Ob; const bf16* bB = UC;
#else
        const bf16* bA = H1; const bf16* bB = H1 + 512;
#endif
        const int ldA = (DBG_STAGE == 1 || DBG_STAGE == 22 || DBG_STAGE == 23) ? 1024 : 512;
        for (size_t i = (size_t)blockIdx.x * 512 + tid; i < (size_t)T * 512; i += (size_t)G * 512) { const size_t r = i >> 9, c = i & 511;
            args.out[r * 1024 + c] = bf2f(bA[r * ldA + c]); args.out[r * 1024 + 512 + c] = bf2f(bB[r * ldA + c]); }
        return;
    }
#endif
    if (IN(4)) {
        SchedMerge S{(int)blockIdx.x, (const char*)UC, (const char*)(ws + WS_WC), (const char*)Ob, (const char*)(ws + WS_WA)};
        EpiMerge E{SG, MG};
        pg8::gemm_phase<EpiMerge, SchedMerge, false>(lds + RING_OFF, 512, S, E);
    }
    GRID_BAR(4);
#if defined(DBG_STAGE2)
    {   for (size_t i = (size_t)blockIdx.x * 512 + tid; i < (size_t)T * 1024; i += (size_t)G * 512) args.out[i] = bf2f(MG[i]);
        return; }
#endif
    if (IN(5)) {
        SchedDense S{64, 4, G, (int)blockIdx.x, 1024, (const char*)MG, (const char*)(ws + WS_WOUT)};
        EpiX1 E{args.in[0], args.out, mod, (float*)(ws + WS_SSQ)};
        pg8::gemm_phase<EpiX1, SchedDense, false>(lds + RING_OFF, 1024, S, E);
    }
    GRID_BAR(5);
#if FWD_LEVEL >= 2
    if (IN(6)) { for (int it = vcu; it < T / 32; it += G) p6_item(args, lds, it, tid, wave, lane); }
    GRID_BAR(6);
    const MoeTab tb{(const LAS int*)(lds + TAB_OFF), (const LAS int*)(lds + TAB_OFF) + 80};
    if (IN(7)) {
        moe_tables(args, lds, tid, lane);
        const int ntiles = tb.tstart[64], nmoe = 2 * ntiles, ntot = nmoe + 128, per = (ntot + G - 1) / G;
        SchedMoe1 S{tb, nmoe, ntot, per, vcu, lane, (const char*)(ws + WS_H2), (const char*)(ws + WS_WGU), (const char*)(ws + WS_WSGU), (const int*)(ws + WS_LIST)};
        EpiGlu E{(bf16*)(ws + WS_ACT), (bf16*)(ws + WS_SACT), (const float*)(ws + WS_WLIST), tb};
        pg8::gemm_phase<EpiGlu, SchedMoe1, true, MOE_FP8 != 0>(lds + RING_OFF, MOE_FP8 ? 512 : 1024, S, E);
    }
    GRID_BAR(7);
    if (IN(8)) {
        moe_tables(args, lds, tid, lane);
        const int ntiles = tb.tstart[64], ntot = 4 * ntiles, per = (ntot + G - 1) / G;
        SchedMoe2 S{tb, ntot, per, vcu, lane, (const char*)(ws + WS_ACT), (const char*)(ws + WS_WD)};
        EpiSlab E{(bf16*)(ws + WS_SLAB), (const int*)(ws + WS_LIST), tb};
        pg8::gemm_phase<EpiSlab, SchedMoe2, true>(lds + RING_OFF, 256, S, E);
    }
    GRID_BAR(8);
    if (IN(9)) {
        SchedDense S{64, 4, G, (int)blockIdx.x, 256, (const char*)(ws + WS_SACT), (const char*)(ws + WS_WSD)};
        EpiFinal E{args.out, (const bf16*)(ws + WS_SLAB), mod};
        pg8::gemm_phase<EpiFinal, SchedDense, false>(lds + RING_OFF, 256, S, E);
    }
#endif
#endif
#if defined(DIAG_A)
    {
        xcd_barrier(bar); if (blockIdx.x == 0 && tid == 0) dstamp[10] = __builtin_amdgcn_s_memrealtime();
        xcd_barrier(bar);
        const float dta = (float)(dstamp[DIAG_A + 1] - dstamp[DIAG_A]) * 0.01f;
        if (blockIdx.x == 0 && tid == 0) args.out[0] += 0.5f + dta * 0.01f;
    }
#endif
#undef IN
#undef GRID_BAR
}

#ifndef N_LAUNCH_MODE
#define N_LAUNCH_MODE 1
#endif
extern "C" void kernel_launch(void* const* d_in, const int* in_sizes, int n_in, void* d_out, int out_size, void* d_ws, size_t ws_size, hipStream_t stream) {
    static int grid = 0;
    if (grid == 0) {
        if (n_in != 23 || in_sizes[0] != T * DMODEL || out_size != T * DMODEL || ws_size < WS_END) {
            fprintf(stderr, "kernel_launch: built for 23 inputs, x/out of %d floats, >= %zu bytes of workspace; got n_in %d, in0 %d, out %d, ws %zu; nothing launched\n", T * DMODEL, (size_t)WS_END, n_in, n_in > 0 ? in_sizes[0] : -1, out_size, ws_size);
            grid = -1; return; }
        int dev = 0, cus = 0, per_cu = 0;
        if (hipGetDevice(&dev) != hipSuccess || hipDeviceGetAttribute(&cus, hipDeviceAttributeMultiprocessorCount, dev) != hipSuccess) { fprintf(stderr, "kernel_launch: device query failed\n"); grid = -1; return; }
        if (hipFuncSetAttribute((const void*)fox_fwd, hipFuncAttributeMaxDynamicSharedMemorySize, LDS_BYTES) != hipSuccess) { fprintf(stderr, "kernel_launch: hipFuncSetAttribute failed\n"); grid = -1; return; }
        if (hipOccupancyMaxActiveBlocksPerMultiprocessor(&per_cu, (const void*)fox_fwd, NWAVES * 64, LDS_BYTES) != hipSuccess || per_cu < 1)
            fprintf(stderr, "kernel_launch: note: occupancy query reports %d workgroups per CU\n", per_cu);
        (void)hipGetLastError();
        grid = cus;
        if (grid != 256) fprintf(stderr, "kernel_launch: %d CUs; this kernel is built for 256\n", grid);
    }
    if (grid < 0) return;
    if (hipMemsetAsync((char*)d_ws + WS_CTL, 0, CTL_ZERO_BYTES, stream) != hipSuccess) { fprintf(stderr, "kernel_launch: memset failed\n"); return; }
    KArgs a{};
    for (int i = 0; i < 23; ++i) a.in[i] = (const float*)d_in[i];
    a.out = (float*)d_out; a.ws = (unsigned char*)d_ws;
#if N_LAUNCH_MODE == 1
    a.ph_lo = 0; a.ph_hi = 10;
    hipLaunchKernelGGL(fox_fwd, dim3(grid), dim3(NWAVES * 64), LDS_BYTES, stream, a);
#else
    for (int p = 0; p < 10; ++p) { a.ph_lo = p; a.ph_hi = p + 1; hipLaunchKernelGGL(fox_fwd, dim3(grid), dim3(NWAVES * 64), LDS_BYTES, stream, a); }
#endif
    const hipError_t le = hipPeekAtLastError();
    if (le != hipSuccess) fprintf(stderr, "kernel_launch: launch failed: %s\n", hipGetErrorName(le));
}
```

```cpp
#include <hip/hip_runtime.h>
#include <hip/hip_bf16.h>
#include <cstdio>
#include <cstdint>
#include <cmath>

#ifndef ATTN_SKIP
#define ATTN_SKIP 1
#endif
#ifndef FWD_LEVEL
#define FWD_LEVEL 2
#endif

namespace pg8 {
#define PG8_LAS __attribute__((address_space(3)))
typedef unsigned short bf16_t;
typedef short bf16x8 __attribute__((ext_vector_type(8)));
typedef float f32x4 __attribute__((ext_vector_type(4)));
typedef unsigned u32x4 __attribute__((ext_vector_type(4)));
constexpr int BM = 256, BK = 64, HALF = 128, HTB = HALF * BK * 2  , STAGE_BYTES = 8 * HTB, NXCD = 8, WGM = 8;

__host__ __device__ __forceinline__ int lds_byte(int r, int c) { const int st = (r >> 4) * 2 + (c >> 5), rr = r & 15, cc = c & 31, ob = rr * 64 + cc * 2; return st * 1024 + (ob ^ (((ob >> 9) & 1) << 5)); }
__host__ __device__ __forceinline__ void stage_rc(int b, int& R, int& C) { const int st = b / 1024, sb = b % 1024, swz = sb ^ (((sb >> 9) & 1) << 5); R = (st >> 1) * 16 + swz / 64; C = (st & 1) * 32 + (swz % 64) / 2; }
__host__ __device__ __forceinline__ int perm32(int rho) { const int n = rho >> 4, i = rho & 15; return 8 * (i >> 2) + 4 * n + (i & 3); }

struct Unit { int pm, pn, e, mt; const char* A; const char* B; };

__host__ __device__ __forceinline__ void tile_of(int L, int nM, int nN, int& pm, int& pn) {
    const int nwg = nM * nN; int wgid = L; { const int q = nwg / NXCD, r = nwg % NXCD, xcd = wgid % NXCD, off = wgid / NXCD; wgid = (xcd < r ? xcd * (q + 1) : r * (q + 1) + (xcd - r) * q) + off; }
    const int nig = WGM * nN, gid = wgid / nig, fm = gid * WGM, gsz = (nM - fm) < WGM ? (nM - fm) : WGM;
    pm = fm + ((wgid % nig) % gsz); pn = (wgid % nig) / gsz;
}
typedef float f32x2_c __attribute__((ext_vector_type(2))); typedef __bf16 bf16x2_c __attribute__((ext_vector_type(2)));
__device__ __forceinline__ unsigned cvt_pk_bf16(float lo, float hi) { f32x2_c v = {lo, hi}; bf16x2_c b = __builtin_convertvector(v, bf16x2_c); return __builtin_bit_cast(unsigned, b); }
__device__ __forceinline__ float bf_lo(unsigned w) { return __builtin_bit_cast(float, w << 16); }
__device__ __forceinline__ float bf_hi(unsigned w) { return __builtin_bit_cast(float, w & 0xffff0000u); }
__device__ __forceinline__ float sigmoidf_fast(float x) { return __builtin_amdgcn_rcpf(1.0f + __builtin_amdgcn_exp2f(-1.4426950408889634f * x)); }

typedef int i32x4_c __attribute__((ext_vector_type(4))); typedef int i32x8_c __attribute__((ext_vector_type(8)));
__device__ __forceinline__ i32x8_c cat16(const bf16x8& lo, const bf16x8& hi) { const i32x4_c a = __builtin_bit_cast(i32x4_c, lo), b = __builtin_bit_cast(i32x4_c, hi); return __builtin_shufflevector(a, b, 0, 1, 2, 3, 4, 5, 6, 7); }
template <class Epi, class Sched, bool ALIGN_EPI, bool FP8 = false>
__device__ __forceinline__ void gemm_phase(PG8_LAS unsigned char* lds, const int K, const Sched& S, const Epi& E) {
    const int tid = threadIdx.x, wid = __builtin_amdgcn_readfirstlane(tid >> 6), lane = tid & 63, wr = wid >> 2, wc = wid & 3, fr = lane & 15, fq = lane >> 4;
    const int nt = K / BK;
    int sR[2], sC[2]; unsigned voffB[2];
#pragma unroll
    for (int i = 0; i < 2; ++i) { int R, C; stage_rc(tid * 16 + i * 8192, R, C); sR[i] = R; sC[i] = C; const int Rb = Epi::PERM ? ((R & ~31) + perm32(R & 31)) : R; voffB[i] = (unsigned)(Rb * K + C) * 2u; }
    const size_t kstep = (size_t)(BK * 2);
    const size_t hstep = (size_t)HALF * K * 2;
    const unsigned ldsw = (unsigned)wid * 1024u;
    const int aoff = lds_byte(wr * 64 + fr, fq * 8), boff = lds_byte(wc * 32 + fr, fq * 8);
#define PG8_SA(b, h) (((b) * 2 + (h)) * HTB)
#define PG8_SB(b, h) ((4 + (b) * 2 + (h)) * HTB)
#define PG8_STAGE(bufoff, gbase, voff) do { _Pragma("unroll") for (int _i = 0; _i < 2; ++_i) \
        __builtin_amdgcn_global_load_lds((const unsigned*)((const char*)(gbase) + (voff)[_i]), (PG8_LAS unsigned*)(lds + (bufoff) + ldsw + _i * 8192), 16, 0, 0); } while (0)
#define PG8_STAGE_A(bufoff, gbase, h, V0, V1) do { if constexpr (Sched::GATHER) { if (h) PG8_STAGE(bufoff, gbase, V1); else PG8_STAGE(bufoff, gbase, V0); } \
        else { PG8_STAGE(bufoff, (const char*)(gbase) + ((h) ? hstep : 0), V0); } } while (0)
#define PG8_LDA(dst, b, h) do { _Pragma("unroll") for (int m = 0; m < 4; ++m) { if constexpr (FP8) { const bf16x8 lo_ = *(const PG8_LAS bf16x8*)(lds + PG8_SA(b, h) + aoff + m * 2048), hi_ = *(const PG8_LAS bf16x8*)(lds + PG8_SA(b, h) + aoff + m * 2048 + 1024); dst##8[m] = cat16(lo_, hi_); } \
        else { _Pragma("unroll") for (int k = 0; k < 2; ++k) dst[m][k] = *(const PG8_LAS bf16x8*)(lds + PG8_SA(b, h) + aoff + m * 2048 + k * 1024); } } } while (0)
#define PG8_LDB(dst, b, h) do { _Pragma("unroll") for (int n = 0; n < 2; ++n) { if constexpr (FP8) { const bf16x8 lo_ = *(const PG8_LAS bf16x8*)(lds + PG8_SB(b, h) + boff + n * 2048), hi_ = *(const PG8_LAS bf16x8*)(lds + PG8_SB(b, h) + boff + n * 2048 + 1024); dst##8[n] = cat16(lo_, hi_); } \
        else { _Pragma("unroll") for (int k = 0; k < 2; ++k) dst[n][k] = *(const PG8_LAS bf16x8*)(lds + PG8_SB(b, h) + boff + n * 2048 + k * 1024); } } } while (0)
#define PG8_MMA(ai, bj, At, Bt) do { __builtin_amdgcn_s_setprio(1); if constexpr (FP8) { _Pragma("unroll") for (int m = 0; m < 4; ++m) _Pragma("unroll") for (int n = 0; n < 2; ++n) \
        acc[ai][bj][m][n] = __builtin_amdgcn_mfma_scale_f32_16x16x128_f8f6f4(Bt##8[n], At##8[m], acc[ai][bj][m][n], 0, 0, 0, 0x7f7f7f7f, 0, 0x7f7f7f7f); } \
        else { _Pragma("unroll") for (int m = 0; m < 4; ++m) _Pragma("unroll") for (int n = 0; n < 2; ++n) _Pragma("unroll") for (int k = 0; k < 2; ++k) \
        acc[ai][bj][m][n] = __builtin_amdgcn_mfma_f32_16x16x32_bf16(Bt[n][k], At[m][k], acc[ai][bj][m][n], 0, 0, 0); } __builtin_amdgcn_s_setprio(0); } while (0)
#define PG8_WAIT_V(n) asm volatile("s_waitcnt vmcnt(" #n ")" ::: "memory")
#define PG8_WAIT_L(n) asm volatile("s_waitcnt lgkmcnt(" #n ")" ::: "memory")
#define PG8_BAR __builtin_amdgcn_s_barrier()
#define PG8_SCHED __builtin_amdgcn_sched_barrier(0)
    Unit cur, nxt; int ui = 0;
    if (!S.next(0, cur)) return;
    unsigned vc0[2], vc1[2], vn0[2], vn1[2];
#pragma unroll
    for (int i = 0; i < 2; ++i) {
        if constexpr (Sched::GATHER) { vc0[i] = (unsigned)(S.row(cur, sR[i]) * K + sC[i]) * 2u; vc1[i] = (unsigned)(S.row(cur, HALF + sR[i]) * K + sC[i]) * 2u; }
        else { vc0[i] = (unsigned)(sR[i] * K + sC[i]) * 2u; vc1[i] = 0u; }
        vn0[i] = vc0[i]; vn1[i] = vc1[i];
    }
    f32x4 acc[2][2][4][2];
#pragma unroll
    for (int a = 0; a < 2; ++a)
#pragma unroll
        for (int b = 0; b < 2; ++b)
#pragma unroll
            for (int m = 0; m < 4; ++m)
#pragma unroll
                for (int n = 0; n < 2; ++n) acc[a][b][m][n] = (f32x4){0.f, 0.f, 0.f, 0.f};
    typename Epi::Pre pre; E.prefetch(pre, cur, wr, wc, fr, fq);
    PG8_LAS unsigned char* const rtab = lds + STAGE_BYTES + 2048;
#define PG8_ROWTAB(U, par) do { if constexpr (Epi::ROWTAB) { const char* src_ = E.tab_src(U); if (wid < 4 && src_ != nullptr) \
        __builtin_amdgcn_global_load_lds((const unsigned*)(src_ + tid * 4), (PG8_LAS unsigned*)(rtab + (par) * 1024 + wid * 256), 4, 0, 0); } } while (0)
    PG8_ROWTAB(cur, 0);
    bf16x8 At[4][2], B0[2][2], B1[2][2]; i32x8_c At8[4], B08[2], B18[2];
    const char* cA = cur.A; const char* cB = cur.B;
    PG8_STAGE(PG8_SB(0, 0), cB, voffB); PG8_STAGE(PG8_SB(0, 1), cB + hstep, voffB); PG8_STAGE_A(PG8_SA(0, 0), cA, 0, vc0, vc1); PG8_STAGE_A(PG8_SA(0, 1), cA, 1, vc0, vc1);
    if (wr == 1) PG8_BAR;
    PG8_WAIT_V(2); PG8_BAR;
    PG8_STAGE(PG8_SB(1, 0), cB + kstep, voffB); PG8_STAGE_A(PG8_SA(1, 0), cA + kstep, 0, vc0, vc1); PG8_STAGE(PG8_SB(1, 1), cB + hstep + kstep, voffB);
    PG8_WAIT_V(6); PG8_BAR;
    for (;;) {
        const bool has_next = S.next(ui + 1, nxt);
        const char* nA = has_next ? nxt.A : cA; const char* nB = has_next ? nxt.B : cB;
        if constexpr (Sched::GATHER) {
            if (has_next) {
#pragma unroll
                for (int i = 0; i < 2; ++i) { vn0[i] = (unsigned)(S.row(nxt, sR[i]) * K + sC[i]) * 2u; vn1[i] = (unsigned)(S.row(nxt, HALF + sR[i]) * K + sC[i]) * 2u; }
            }
        }
#pragma nounroll
        for (int t = 0; t < nt; t += 2) {
            const bool last = (t == nt - 2);
            const char* a1 = cA + (size_t)(t + 1) * kstep;
            const char* a2 = last ? nA : cA + (size_t)(t + 2) * kstep; const char* b2 = last ? nB : cB + (size_t)(t + 2) * kstep;
            const char* a3 = a2 + kstep; const char* b3 = b2 + kstep;
            unsigned w0[2], w1[2];
#pragma unroll
            for (int i = 0; i < 2; ++i) { if constexpr (Sched::GATHER) { w0[i] = last ? vn0[i] : vc0[i]; w1[i] = last ? vn1[i] : vc1[i]; } else { w0[i] = vc0[i]; w1[i] = 0u; } }
            PG8_LDB(B0, 0, 0); PG8_LDB(B1, 0, 1); PG8_SCHED; PG8_LDA(At, 0, 0); PG8_STAGE_A(PG8_SA(1, 1), a1, 1, vc0, vc1);
            PG8_WAIT_V(8); PG8_WAIT_L(0); PG8_BAR; PG8_MMA(0, 0, At, B0); PG8_MMA(0, 1, At, B1); PG8_BAR; PG8_SCHED;
            PG8_LDA(At, 0, 1); PG8_STAGE(PG8_SB(0, 0), b2, voffB); PG8_STAGE(PG8_SB(0, 1), b2 + hstep, voffB); PG8_STAGE_A(PG8_SA(0, 0), a2, 0, w0, w1);
            PG8_WAIT_V(8); PG8_WAIT_L(0); PG8_BAR; PG8_MMA(1, 0, At, B0); PG8_MMA(1, 1, At, B1); PG8_BAR; PG8_SCHED;
            PG8_LDB(B0, 1, 0); PG8_LDB(B1, 1, 1); PG8_SCHED; PG8_LDA(At, 1, 0); PG8_STAGE_A(PG8_SA(0, 1), a2, 1, w0, w1);
            PG8_WAIT_V(8); PG8_WAIT_L(0); PG8_BAR; PG8_MMA(0, 0, At, B0); PG8_MMA(0, 1, At, B1); PG8_BAR; PG8_SCHED;
            PG8_LDA(At, 1, 1); PG8_STAGE(PG8_SB(1, 0), b3, voffB); PG8_STAGE(PG8_SB(1, 1), b3 + hstep, voffB); PG8_STAGE_A(PG8_SA(1, 0), a3, 0, w0, w1);
            PG8_WAIT_V(8); PG8_WAIT_L(0); PG8_BAR; PG8_MMA(1, 0, At, B0); PG8_MMA(1, 1, At, B1); PG8_BAR; PG8_SCHED;
        }
        if constexpr (ALIGN_EPI) { if (wr == 0) PG8_BAR; }
        if constexpr (!Epi::AFTER_DRAIN) E(acc, cur, wr, wc, fr, fq, pre, (const PG8_LAS unsigned*)(rtab + (ui & 1) * 1024));
        if (!has_next) break;
#pragma unroll
        for (int a = 0; a < 2; ++a)
#pragma unroll
            for (int b = 0; b < 2; ++b)
#pragma unroll
                for (int m = 0; m < 4; ++m)
#pragma unroll
                    for (int n = 0; n < 2; ++n) acc[a][b][m][n] = (f32x4){0.f, 0.f, 0.f, 0.f};
        cur = nxt; cA = nA; cB = nB; ++ui; E.prefetch(pre, cur, wr, wc, fr, fq); PG8_ROWTAB(cur, ui & 1);
#pragma unroll
        for (int i = 0; i < 2; ++i) { vc0[i] = vn0[i]; vc1[i] = vn1[i]; }
        if constexpr (ALIGN_EPI) { if (wr == 1) PG8_BAR; }
    }
    PG8_WAIT_V(0);
    if constexpr (!ALIGN_EPI) { if (wr == 0) PG8_BAR; }
    PG8_BAR;
    if constexpr (Epi::AFTER_DRAIN) E.fused(acc, cur, wr, wc, fr, fq, lds);
#undef PG8_SA
#undef PG8_SB
#undef PG8_STAGE
#undef PG8_ROWTAB
#undef PG8_STAGE_A
#undef PG8_LDA
#undef PG8_LDB
#undef PG8_MMA
#undef PG8_WAIT_V
#undef PG8_WAIT_L
#undef PG8_BAR
#undef PG8_SCHED
}
}
#include <hip/hip_bf16.h>
#include <cmath>
namespace attn_body {
using bf16=__hip_bfloat16;
using bf16x8=__attribute__((ext_vector_type(8)))short;
using s16x4=__attribute__((ext_vector_type(4)))short;
using f32x16=__attribute__((ext_vector_type(16)))float;
using u32x4=__attribute__((ext_vector_type(4)))unsigned;
constexpr int BATCH=2,NHEAD=8,SEQ=8192,D=64,DM=NHEAD*D;
constexpr int NW=8,QBLK=32,QB=QBLK*NW,KVBLK=64,NQB=SEQ/QB;
constexpr int ATTN_PITCH=DM, ATTN_UNIT_ROWS=QB;
__device__ __forceinline__ int crow(int r,int hi){return (r&3)+8*(r>>2)+4*hi;}
#define SBAR() __builtin_amdgcn_sched_barrier(0)
__device__ __forceinline__ void cmask(f32x16&p0,f32x16&p1,int jb,int qrel,int hi){
  const float NEG=-INFINITY; const int dq=qrel-(64*jb+4*hi);
  #pragma unroll
  for(int r=0;r<16;++r){const int c=(r&3)+8*(r>>2); if(c>dq)p0[r]=NEG; if(c+32>dq)p1[r]=NEG;}
}

constexpr int NSLOT=3, SLOTB=8192;
constexpr int LDS_K=0, LDS_V=NSLOT*SLOTB, LDS_WS=2*NSLOT*SLOTB, LDS_OST=LDS_WS+NW*64*4, LDS_DK=LDS_OST+NW*4096, LDS_BYTES=LDS_DK+SEQ*4;
constexpr float C2=0.125f*1.4426950408889634f;
__device__ __forceinline__ void glds16(const void*gsrc,unsigned lds_dst){unsigned keep;
  asm volatile("s_mov_b32 %0, m0\n\ts_mov_b32 m0, %2\n\ts_nop 0\n\tglobal_load_lds_dwordx4 %1, off\n\ts_mov_b32 m0, %0":"=&s"(keep):"v"(gsrc),"s"(lds_dst):"memory");}
__device__ __forceinline__ float max3f(float a,float b,float c){float r;asm("v_max3_f32 %0, %1, %2, %3":"=v"(r):"v"(a),"v"(b),"v"(c));return r;}
__device__ __forceinline__ float max2f(float a,float b){float r;asm("v_max_f32_e32 %0, %1, %2":"=v"(r):"v"(a),"v"(b));return r;}
__device__ __forceinline__ float fadd_s(float a,float b){float r;asm("v_add_f32_e32 %0, %1, %2":"=v"(r):"v"(a),"v"(b));return r;}
__device__ __forceinline__ float fsub_s(float a,float b){float r;asm("v_sub_f32_e32 %0, %1, %2":"=v"(r):"v"(a),"v"(b));return r;}
typedef float f32x2_t __attribute__((ext_vector_type(2))); typedef float f32x4_t __attribute__((ext_vector_type(4))); typedef __bf16 bf16x2_t __attribute__((ext_vector_type(2)));
__device__ __forceinline__ unsigned cvtpk_s(float lo,float hi){f32x2_t v={lo,hi};bf16x2_t b=__builtin_convertvector(v,bf16x2_t);return __builtin_bit_cast(unsigned,b);}
#define WAIT_BAR(N) asm volatile("s_waitcnt vmcnt(" #N ") lgkmcnt(0)\n\ts_barrier":::"memory")

__device__ __forceinline__ void qkt(f32x16&p0,f32x16&p1,const char*Kslot,const bf16x8*qr,const f32x16&negm,int r32,int hi){
  const char*kb=Kslot+hi*1024+r32*16;
  #pragma unroll
  for(int d0=0;d0<4;++d0){
    const bf16x8 b0=*reinterpret_cast<const bf16x8*>(kb+d0*2048);
    const bf16x8 b1=*reinterpret_cast<const bf16x8*>(kb+d0*2048+512);
    if(d0==0){p0=__builtin_amdgcn_mfma_f32_32x32x16_bf16(b0,qr[0],negm,0,0,0);p1=__builtin_amdgcn_mfma_f32_32x32x16_bf16(b1,qr[0],negm,0,0,0);}
    else{p0=__builtin_amdgcn_mfma_f32_32x32x16_bf16(b0,qr[d0],p0,0,0,0);p1=__builtin_amdgcn_mfma_f32_32x32x16_bf16(b1,qr[d0],p1,0,0,0);}}
}
typedef __attribute__((address_space(3))) const char* lds_cptr;
typedef short v4i16_t __attribute__((ext_vector_type(4)));
__device__ __forceinline__ void kload8(bf16x8*kf,lds_cptr kp){
  kf[0]=*(const __attribute__((address_space(3))) bf16x8*)(kp);      kf[1]=*(const __attribute__((address_space(3))) bf16x8*)(kp+512);
  kf[2]=*(const __attribute__((address_space(3))) bf16x8*)(kp+2048); kf[3]=*(const __attribute__((address_space(3))) bf16x8*)(kp+2560);
  kf[4]=*(const __attribute__((address_space(3))) bf16x8*)(kp+4096); kf[5]=*(const __attribute__((address_space(3))) bf16x8*)(kp+4608);
  kf[6]=*(const __attribute__((address_space(3))) bf16x8*)(kp+6144); kf[7]=*(const __attribute__((address_space(3))) bf16x8*)(kp+6656);
}
__device__ __forceinline__ void kload2(bf16x8*kf,lds_cptr kp,int j){ kf[2*j]=*(const __attribute__((address_space(3))) bf16x8*)(kp+j*2048); kf[2*j+1]=*(const __attribute__((address_space(3))) bf16x8*)(kp+j*2048+512); }
__device__ __forceinline__ s16x4 vtr(lds_cptr p){ return __builtin_bit_cast(s16x4,__builtin_amdgcn_ds_read_tr16_b64_v4i16((__attribute__((address_space(3))) v4i16_t*)p)); }
__device__ __forceinline__ float rowmax(const f32x16&p0,const f32x16&p1){
  float a=max3f(p0[0],p0[1],p1[0]),b=max3f(p0[2],p0[3],p1[1]);a=max3f(a,p1[2],p1[3]);
  #pragma unroll
  for(int r=4;r<16;r+=4){a=max3f(a,p0[r],p0[r+1]);b=max3f(b,p0[r+2],p0[r+3]);a=max3f(a,p1[r],p1[r+1]);b=max3f(b,p1[r+2],p1[r+3]);}
  const float m=max2f(a,b);
  auto rr=__builtin_amdgcn_permlane32_swap(__float_as_uint(m),__float_as_uint(m),false,false);
  return max2f(__uint_as_float(rr[0]),__uint_as_float(rr[1]));
}
__device__ __forceinline__ void pv(f32x16*o,int vb,bf16x8 pa0,bf16x8 pa1,bf16x8 pa2,bf16x8 pa3){
  #pragma unroll
  for(int d0=0;d0<2;++d0){s16x4 lo[4],hi[4];
    #pragma unroll
    for(int ks=0;ks<4;++ks){
      asm volatile("ds_read_b64_tr_b16 %0,%1 offset:%c2":"=&v"(lo[ks]):"v"(vb),"i"(d0*4096+ks*1024):"memory");
      asm volatile("ds_read_b64_tr_b16 %0,%1 offset:%c2":"=&v"(hi[ks]):"v"(vb),"i"(d0*4096+ks*1024+512):"memory");}
    asm volatile("s_waitcnt lgkmcnt(0)":::"memory");SBAR();
    #define PK(k) (bf16x8){lo[k][0],lo[k][1],lo[k][2],lo[k][3],hi[k][0],hi[k][1],hi[k][2],hi[k][3]}
    o[d0]=__builtin_amdgcn_mfma_f32_32x32x16_bf16(pa0,PK(0),o[d0],0,0,0);
    o[d0]=__builtin_amdgcn_mfma_f32_32x32x16_bf16(pa1,PK(1),o[d0],0,0,0);
    o[d0]=__builtin_amdgcn_mfma_f32_32x32x16_bf16(pa2,PK(2),o[d0],0,0,0);
    o[d0]=__builtin_amdgcn_mfma_f32_32x32x16_bf16(pa3,PK(3),o[d0],0,0,0);
    #undef PK
  }
}

#ifndef ATTN_STORE16
#define ATTN_STORE16(p,v) (*(u32x4*)(p)=(v))
#endif
template<int THRL> __device__ __forceinline__ void attn_unit(int b,int h,int qb,const bf16*Q,const bf16*__restrict__ K,const bf16*__restrict__ V,bf16*O,const float*cum,float thr2,char*shm){
  const int tid=threadIdx.x,lane=tid&63,r32=lane&31,hi=lane>>5; const int wid=__builtin_amdgcn_readfirstlane(tid>>6);
  const long rowbase=(long)b*SEQ; const int q0=qb*QB;
  const bf16*Qw=Q+(rowbase+q0+wid*QBLK)*DM+h*D;
  const float*cb=cum+(long)(b*NHEAD+h)*SEQ; const int NTF=(q0+QB)/KVBLK; int t0=0;
#if ATTN_SKIP
  { const float cq0=cb[q0]; int cnt=0;
    for(int base=0;base<NTF;base+=64){ const int t_=base+lane; const bool c_=(t_<NTF)&&((cb[64*t_+63]-cq0)*1.4426950408889634f>thr2); cnt+=__popcll(__ballot(c_)); }
    cnt&=~1; if(cnt>NTF-4)cnt=NTF-4; t0=__builtin_amdgcn_readfirstlane(cnt); }
#endif
  const int kv0=t0*KVBLK;
  { const float cref=cb[q0+QB-1]; __attribute__((address_space(3))) float*dkw=(__attribute__((address_space(3))) float*)((__attribute__((address_space(3))) char*)shm+LDS_DK);
    int tv_=tid; asm volatile("":"+v"(tv_));
    for(int j=tv_;j<q0+QB-kv0;j+=NW*64)dkw[j]=(cb[kv0+j]-cref)*1.4426950408889634f; }
  asm volatile("s_waitcnt vmcnt(0) lgkmcnt(0)\n\ts_barrier":::"memory");
  const bf16*Kh=K+(rowbase+kv0)*DM+h*D,*Vh=V+(rowbase+kv0)*DM+h*D;
  const unsigned lds0=(unsigned)(uintptr_t)shm;
  float*wsf=(float*)(shm+LDS_WS)+wid*64;
  const bf16*ksrc=Kh+(long)lane*DM+wid*8;
  const bf16*vsrc=Vh+(long)(16*(wid&3)+(lane>>2))*DM+(wid>>2)*32+(lane&3)*8;
  const unsigned kdst=lds0+LDS_K+wid*1024, vdst=lds0+LDS_V+wid*1024;
  #define DMA_K(t,slot) glds16(ksrc+(long)(t)*KVBLK*DM,(unsigned)__builtin_amdgcn_readfirstlane(kdst+(slot)))
  #define DMA_V(t,slot) glds16(vsrc+(long)(t)*KVBLK*DM,(unsigned)__builtin_amdgcn_readfirstlane(vdst+(slot)))
  const int vb0=(int)(lds0+LDS_V)+((lane>>4)&1)*32+(lane&3)*8+(4*hi+((lane&15)>>2))*64;
  const char*Kbase=shm+LDS_K; bf16x8 kf[8];
  const lds_cptr shm3=(lds_cptr)shm; const lds_cptr kp0=shm3+LDS_K+hi*1024+r32*16; const lds_cptr vp0=shm3+LDS_V+((lane>>4)&1)*32+(lane&3)*8+(4*hi+((lane&15)>>2))*64;
  int hiv_=hi; asm volatile("":"+v"(hiv_));
  const int NT=NTF-t0;
  const __attribute__((address_space(3))) float*dkp0=(const __attribute__((address_space(3))) float*)(shm3+LDS_DK)+4*hiv_;
  #define CINIT(C,t,o) do{ const __attribute__((address_space(3))) float*dp_=dkp0+(t)*64+(o); _Pragma("unroll") for(int g_=0;g_<4;++g_){ const f32x4_t a_=*(const __attribute__((address_space(3))) f32x4_t*)(dp_+8*g_); \
      C[4*g_]=negms-a_[0];C[4*g_+1]=negms-a_[1];C[4*g_+2]=negms-a_[2];C[4*g_+3]=negms-a_[3]; } }while(0)
  #define DECAY(P0,P1,t) do{ const __attribute__((address_space(3))) float*dp_=dkp0+(t)*64; _Pragma("unroll") for(int g_=0;g_<4;++g_){ const f32x4_t a_=*(const __attribute__((address_space(3))) f32x4_t*)(dp_+8*g_), b_=*(const __attribute__((address_space(3))) f32x4_t*)(dp_+32+8*g_); \
      P0[4*g_]-=a_[0];P0[4*g_+1]-=a_[1];P0[4*g_+2]-=a_[2];P0[4*g_+3]-=a_[3]; P1[4*g_]-=b_[0];P1[4*g_+1]-=b_[1];P1[4*g_+2]-=b_[2];P1[4*g_+3]-=b_[3]; } }while(0)
  DMA_K(0,0);DMA_V(0,0);DMA_K(1,SLOTB);
  bf16x8 qr[4];
  #pragma unroll
  for(int d0=0;d0<4;++d0)qr[d0]=*reinterpret_cast<const bf16x8*>(&Qw[(long)r32*DM+d0*16+hi*8]);
  float mhat=0.f,l_reg=0.f;f32x16 o[2];o[0]=f32x16{};o[1]=f32x16{};float negms=0.f; const f32x16 zero16=f32x16{};
  const int qrel=wid*QBLK+r32;
  #define CMASK(P0,P1,t) do{int jb_=(t)-(NT-4); if(jb_>=0)cmask(P0,P1,jb_,qrel,hi);}while(0)
  bool resc=false;
  #define START(P0,P1) do{ const float rm=rowmax(P0,P1); resc=false; \
    { const float dl=rm; mhat=fadd_s(mhat,dl); \
      _Pragma("unroll") for(int r=0;r<16;++r){P0[r]=fsub_s(P0[r],dl);P1[r]=fsub_s(P1[r],dl);} \
      negms=-mhat; } \
    _Pragma("unroll") for(int r=0;r<16;++r)P0[r]=__builtin_amdgcn_exp2f(P0[r]); }while(0)
  #define RESC() do{ if(resc){ asm volatile("s_waitcnt lgkmcnt(0)":::"memory"); \
      _Pragma("unroll") for(int d_=0;d_<2;++d_) _Pragma("unroll") for(int r=0;r<16;++r)o[d_][r]*=wsf[crow(r,hi)]; } }while(0)
  f32x16 pA0,pA1,pB0,pB1;
  int sl_prev=0,sl_cur=0,sl_next=SLOTB;
  #define ROT() do{sl_prev=sl_cur;sl_cur=sl_next;sl_next=(sl_next==(NSLOT-1)*SLOTB)?0:sl_next+SLOTB;}while(0)
  DMA_K(2,2*SLOTB);
  WAIT_BAR(3);
  qkt(pA0,pA1,Kbase,qr,zero16,r32,hi);asm volatile("s_nop 15\n\ts_nop 7":"+v"(pA0),"+v"(pA1));CMASK(pA0,pA1,0);DECAY(pA0,pA1,0);
  START(pA0,pA1);
  _Pragma("unroll") for(int r=0;r<16;++r)pA1[r]=__builtin_amdgcn_exp2f(pA1[r]);
  WAIT_BAR(0);
  DMA_K(3,0);DMA_V(1,SLOTB);
  ROT();
  kload8(kf,kp0+sl_cur);
  WAIT_BAR(2);
  s16x4 vlo[8],vhi[8]; u32x4 pw0,pw1,pw2,pw3;
  #define PKW(P,B) cvtpk_s(P[B],P[B+1])
  #define PAF(k) __builtin_bit_cast(bf16x8,pw##k)
  #define VFR(i) (bf16x8){vlo[i][0],vlo[i][1],vlo[i][2],vlo[i][3],vhi[i][0],vhi[i][1],vhi[i][2],vhi[i][3]}
  #define PIN(x) asm volatile("":"+v"(x))
  #define MX3(a,b,c) __builtin_fmaxf(__builtin_fmaxf((a),(b)),(c))
  #define GAPA(MF,A0,A1,A2,A3,W0,W1,PW) do{ MF; sacc+=A0; sacc+=A1; sacc+=A2; sacc+=A3; PIN(sacc); W0; W1; PIN(PW); SBAR(); }while(0)
  #define EX(v) __builtin_amdgcn_exp2f(v)
  #define GAPB(MF,X,B) do{ MF; X[B]=EX(X[B]); X[B+1]=EX(X[B+1]); X[B+2]=EX(X[B+2]); X[B+3]=EX(X[B+3]); PIN(X); SBAR(); }while(0)
  #define VRD(i) do{ vlo[i]=vtr(vp_+(((i)>>2)*4096+((i)&3)*1024)); vhi[i]=vtr(vp_+(((i)>>2)*4096+((i)&3)*1024+512)); }while(0)
  #define KRD(G,j) do{ if(G){ kload2(kf,kp0+sl_next,j); SBAR(); } }while(0)
  #define STEP(C0,C1,P0,P1,t,GK,GV,GL) do{ SBAR(); \
    const lds_cptr vp_=vp0+sl_prev; \
    CINIT(C0,t,0); VRD(0); SBAR(); float sacc=(P0[0]+P0[1]); \
    GAPA(C0=__builtin_amdgcn_mfma_f32_32x32x16_bf16(kf[0],qr[0],C0,0,0,0), P0[2],P0[3],P0[4],P0[5],     pw0[0]=PKW(P0,0), pw0[1]=PKW(P0,2), pw0); \
    CINIT(C1,t,32); VRD(4); SBAR(); GAPA(C1=__builtin_amdgcn_mfma_f32_32x32x16_bf16(kf[1],qr[0],C1,0,0,0), P0[6],P0[7],P0[8],P0[9],     pw0[2]=PKW(P0,4), pw0[3]=PKW(P0,6), pw0); \
    VRD(1); SBAR(); GAPA(C0=__builtin_amdgcn_mfma_f32_32x32x16_bf16(kf[2],qr[1],C0,0,0,0),   P0[10],P0[11],P0[12],P0[13], pw1[0]=PKW(P0,8), pw1[1]=PKW(P0,10), pw1); \
    VRD(5); SBAR(); GAPA(C1=__builtin_amdgcn_mfma_f32_32x32x16_bf16(kf[3],qr[1],C1,0,0,0),   P0[14],P0[15],P1[0],P1[1],   pw1[2]=PKW(P0,12),pw1[3]=PKW(P0,14), pw1); \
    VRD(2); SBAR(); GAPA(C0=__builtin_amdgcn_mfma_f32_32x32x16_bf16(kf[4],qr[2],C0,0,0,0),   P1[2],P1[3],P1[4],P1[5],     pw2[0]=PKW(P1,0), pw2[1]=PKW(P1,2), pw2); \
    VRD(6); SBAR(); GAPA(C1=__builtin_amdgcn_mfma_f32_32x32x16_bf16(kf[5],qr[2],C1,0,0,0),   P1[6],P1[7],P1[8],P1[9],     pw2[2]=PKW(P1,4), pw2[3]=PKW(P1,6), pw2); \
    VRD(3); SBAR(); GAPA(C0=__builtin_amdgcn_mfma_f32_32x32x16_bf16(kf[6],qr[3],C0,0,0,0),   P1[10],P1[11],P1[12],P1[13], pw3[0]=PKW(P1,8), pw3[1]=PKW(P1,10), pw3); \
    VRD(7); SBAR(); GAPA(C1=__builtin_amdgcn_mfma_f32_32x32x16_bf16(kf[7],qr[3],C1,0,0,0),   P1[14],P1[15],0.f,0.f,       pw3[2]=PKW(P1,12),pw3[3]=PKW(P1,14), pw3); \
    l_reg+=sacc; \
    if(GK){DMA_K((t)+3,sl_cur);} if(GV){DMA_V((t)+1,sl_next);} \
    CMASK(C0,C1,t); \
    { float a=MX3(C0[0],C0[1],C1[0]),b=MX3(C0[2],C0[3],C1[1]); a=MX3(a,C1[2],C1[3]); \
      _Pragma("unroll") for(int r=4;r<16;r+=4){a=MX3(a,C0[r],C0[r+1]);b=MX3(b,C0[r+2],C0[r+3]);a=MX3(a,C1[r],C1[r+1]);b=MX3(b,C1[r+2],C1[r+3]);} \
      float rm=__builtin_fmaxf(a,b); { auto rr=__builtin_amdgcn_permlane32_swap(__float_as_uint(rm),__float_as_uint(rm),false,false); rm=__builtin_fmaxf(__uint_as_float(rr[0]),__uint_as_float(rr[1])); } \
      resc=false; \
      if(__builtin_expect(__any(rm>(float)THRL),0)){ const float dl=__builtin_fmaxf(rm,0.f); mhat+=dl; \
        _Pragma("unroll") for(int r=0;r<16;++r){C0[r]-=dl;C1[r]-=dl;} \
        negms=-mhat; \
        const float f=__builtin_amdgcn_exp2f(-dl); l_reg*=f; if(hi==0)wsf[r32]=f; resc=true; } } \
    SBAR(); \
    GAPB(o[0]=__builtin_amdgcn_mfma_f32_32x32x16_bf16(PAF(0),VFR(0),o[0],0,0,0), C0,0); \
    GAPB(o[1]=__builtin_amdgcn_mfma_f32_32x32x16_bf16(PAF(0),VFR(4),o[1],0,0,0), C0,4); \
    KRD(GL,0); GAPB(o[0]=__builtin_amdgcn_mfma_f32_32x32x16_bf16(PAF(1),VFR(1),o[0],0,0,0), C0,8); \
    KRD(GL,1); GAPB(o[1]=__builtin_amdgcn_mfma_f32_32x32x16_bf16(PAF(1),VFR(5),o[1],0,0,0), C0,12); \
    KRD(GL,2); GAPB(o[0]=__builtin_amdgcn_mfma_f32_32x32x16_bf16(PAF(2),VFR(2),o[0],0,0,0), C1,0); \
    KRD(GL,3); GAPB(o[1]=__builtin_amdgcn_mfma_f32_32x32x16_bf16(PAF(2),VFR(6),o[1],0,0,0), C1,4); \
    GAPB(o[0]=__builtin_amdgcn_mfma_f32_32x32x16_bf16(PAF(3),VFR(3),o[0],0,0,0), C1,8); \
    GAPB(o[1]=__builtin_amdgcn_mfma_f32_32x32x16_bf16(PAF(3),VFR(7),o[1],0,0,0), C1,12); \
    }while(0)
  int t=1;
  #undef CMASK
  #define CMASK(P0,P1,t) do{}while(0)
  for(;t+5<NT;t+=2){
    STEP(pB0,pB1,pA0,pA1,t,true,true,true);     WAIT_BAR(2); RESC(); ROT();
    STEP(pA0,pA1,pB0,pB1,t+1,true,true,true);   WAIT_BAR(2); RESC(); ROT();
  }
  #undef CMASK
  #define CMASK(P0,P1,t) do{int jb_=(t)-(NT-4); if(jb_>=0)cmask(P0,P1,jb_,qrel,hi);}while(0)
  #define ENDW(tt) do{ if((tt)+3<NT){WAIT_BAR(2);} else if((tt)+2<NT){WAIT_BAR(1);} else {WAIT_BAR(0);} }while(0)
  for(;t+1<NT;t+=2){
    STEP(pB0,pB1,pA0,pA1,t,(t+3<NT),(t+1<NT),(t+1<NT));       ENDW(t);   RESC(); ROT();
    STEP(pA0,pA1,pB0,pB1,t+1,(t+4<NT),(t+2<NT),(t+2<NT));     ENDW(t+1); RESC(); ROT();
  }
  STEP(pB0,pB1,pA0,pA1,NT-1,false,false,false); RESC();
  { float sacc=pB0[0]+pB0[1]; _Pragma("unroll") for(int r=2;r<16;++r)sacc+=pB0[r]; _Pragma("unroll") for(int r=0;r<16;++r)sacc+=pB1[r]; l_reg+=sacc;
    pw0=(u32x4){PKW(pB0,0),PKW(pB0,2),PKW(pB0,4),PKW(pB0,6)};pw1=(u32x4){PKW(pB0,8),PKW(pB0,10),PKW(pB0,12),PKW(pB0,14)};pw2=(u32x4){PKW(pB1,0),PKW(pB1,2),PKW(pB1,4),PKW(pB1,6)};pw3=(u32x4){PKW(pB1,8),PKW(pB1,10),PKW(pB1,12),PKW(pB1,14)};
    SBAR(); pv(o,vb0+sl_cur,PAF(0),PAF(1),PAF(2),PAF(3)); }
  #undef PKW
  #undef PAF
  #undef VFR
  #undef PIN
  #undef MX3
  #undef GAPA
  #undef GAPB
  #undef EX
  #undef VRD
  #undef KRD
  #undef STEP
  #undef ENDW
  {auto rr=__builtin_amdgcn_permlane32_swap(__float_as_uint(l_reg),__float_as_uint(l_reg),false,false);l_reg=__uint_as_float(rr[0])+__uint_as_float(rr[1]);}
  if(hi==0)wsf[32+r32]=l_reg;asm volatile("s_waitcnt lgkmcnt(0)":::"memory");
  float rli[16];
  #pragma unroll
  for(int r=0;r<16;++r)rli[r]=__builtin_amdgcn_rcpf(wsf[32+crow(r,hi)]);
  bf16*Ow=O+(rowbase+q0+wid*QBLK)*DM+h*D;
  { bf16*stg=(bf16*)(shm+LDS_OST)+wid*2048;
    #pragma unroll
    for(int r=0;r<16;++r){const int orow=crow(r,hi);
      #pragma unroll
      for(int d0=0;d0<2;++d0)stg[orow*64+d0*32+r32]=__float2bfloat16(o[d0][r]*rli[r]);}
    asm volatile("s_waitcnt lgkmcnt(0)":::"memory");
    #pragma unroll
    for(int i=0;i<4;++i){const int row=i*8+(lane>>3),ch=lane&7; const u32x4 v=*(const u32x4*)(stg+row*64+ch*8); ATTN_STORE16(Ow+(long)row*DM+ch*8,v);} }
  asm volatile("s_waitcnt lgkmcnt(0)\n\ts_barrier":::"memory");
  #undef DECAY
  #undef CINIT
  #undef DMA_K
  #undef DMA_V
  #undef CMASK
  #undef START
  #undef RESC
  #undef ROT
}
constexpr int ATTN_LDS_BYTES=LDS_BYTES;
struct AttnTensors { const bf16* Q; const bf16* K; const bf16* V; bf16* O; const float* cum; float thr2; };
struct AttnUnit { int bh; int qb; };
struct StaticOrder {
  int vcu;
  __device__ __forceinline__ explicit StaticOrder(int grid,int block):vcu((block%8)*(grid/8)+block/8){}
  __device__ __forceinline__ bool next(int i,AttnUnit&u)const{ if(i>=2)return false; const int s=vcu&15; u.bh=vcu>>4; u.qb=(i==0)?s:31-s; return true; }
  __device__ __forceinline__ void a_ready(const AttnUnit&)const{}
  __device__ __forceinline__ void done(const AttnUnit&)const{}
};
template<class Sched,int THRL=8> __device__ __forceinline__ void attn_phase(char*lds,const AttnTensors&T,const Sched&S){
  AttnUnit u;
  for(int i=0;S.next(i,u);++i){ S.a_ready(u); attn_unit<THRL>(u.bh/NHEAD,u.bh%NHEAD,u.qb,T.Q,T.K,T.V,T.O,T.cum,T.thr2,lds); S.done(u); }
}
#undef SBAR
#undef WAIT_BAR
}

constexpr int NWAVES = 8;
constexpr int BATCH = 2, SEQ = 8192, DMODEL = 1024, T = BATCH * SEQ;
constexpr int CONVD = 512, CONVW = 31, NHEAD = 8, HD = 64, ATT = 512;
constexpr int NE = 64, TOPK = 8, EF = 256, SF = 256;
constexpr int INCOLS = 4616, OFF_Q = 1024, OFF_K = 1536, OFF_V = 2048, OFF_F = 2560, OFF_GC = 2568, OFF_GA = 3592;
constexpr int NIN = 4608;
constexpr float EPS = 1e-6f, LOG2E = 1.4426950408889634f, ROUTED_SCALE = 2.5f;
constexpr float C2Q = 0.125f * 1.4426950408889634f;
constexpr int LISTCAP = T;
constexpr int ACT_ROWS = T * TOPK + NE * 256;

constexpr size_t MiB = 1u << 20, KiB = 1u << 10;
constexpr size_t WS_CTL = 0, CTL_ZERO_BYTES = 1 * MiB;
constexpr size_t WS_MODP = 1 * MiB;
constexpr size_t WS_MOD = WS_MODP + 768 * KiB;
constexpr size_t WS_LOGF = 2 * MiB;
constexpr size_t WS_CUM = 2 * MiB + 512 * KiB;
constexpr size_t WS_SSQ = 3 * MiB;
constexpr size_t WS_WRH = 4 * MiB, WS_WRL = 4 * MiB + 128 * KiB;
constexpr size_t WS_WLIST = 5 * MiB;
constexpr size_t WS_LIST = 9 * MiB;
constexpr size_t WS_WIN = 16 * MiB, WS_WC = 25 * MiB, WS_WA = 26 * MiB, WS_WOUT = 27 * MiB, WS_WSGU = 29 * MiB, WS_WSD = 30 * MiB;
constexpr size_t WS_WGU = 32 * MiB, WS_WD = 96 * MiB;
constexpr size_t WS_H2 = 128 * MiB, WS_ACT = 160 * MiB, WS_SACT = 232 * MiB;
constexpr size_t WS_H1 = 240 * MiB, WS_U = 272 * MiB, WS_Q = 288 * MiB, WS_K = 304 * MiB, WS_V = 320 * MiB, WS_SG = 336 * MiB, WS_UC = 400 * MiB, WS_O = 416 * MiB, WS_MG = 432 * MiB;
constexpr size_t WS_SLAB = 240 * MiB;
constexpr size_t WS_END = 512 * MiB;
static_assert(WS_ACT + (size_t)ACT_ROWS * EF * 2 <= WS_SACT && WS_SLAB + (size_t)T * TOPK * DMODEL * 2 <= WS_END && WS_MG + (size_t)T * DMODEL * 2 <= WS_SLAB + 256 * MiB, "ws map");
constexpr int CW_TMO = 0, CW_CODE = 1;
constexpr int CW_CNT = 1024;
constexpr int CW_BAR = 8192;

constexpr int RING_OFF = 0, RING_BYTES = 131072;
constexpr int LDSCTL_OFF = RING_BYTES, MISC_OFF = LDSCTL_OFF + 320;
constexpr int TAB_OFF = RING_BYTES + 1024;
constexpr int LDS_BYTES = 147456;

#define GAS __attribute__((address_space(1)))
#define LAS __attribute__((address_space(3)))
typedef unsigned short bf16;
typedef unsigned v4u __attribute__((ext_vector_type(4)));
typedef unsigned v2u __attribute__((ext_vector_type(2)));
typedef float f32x4 __attribute__((ext_vector_type(4)));
typedef float f32x2 __attribute__((ext_vector_type(2)));
typedef float f32x16 __attribute__((ext_vector_type(16)));
typedef short bf16x8 __attribute__((ext_vector_type(8)));
typedef GAS unsigned gu32;
#define RLX_AGENT __ATOMIC_RELAXED, __HIP_MEMORY_SCOPE_AGENT
#define LDS_WAIT() asm volatile("s_waitcnt lgkmcnt(0)" ::: "memory")
#define VM_WAIT() asm volatile("s_waitcnt vmcnt(0)" ::: "memory")
__device__ __forceinline__ unsigned f2bf(float f) { unsigned u = __builtin_bit_cast(unsigned, f); return (u + 0x7fffu + ((u >> 16) & 1u)) >> 16; }
__device__ __forceinline__ unsigned pk2(float lo, float hi) { return f2bf(lo) | (f2bf(hi) << 16); }
__device__ __forceinline__ float bf2f(unsigned h) { return __builtin_bit_cast(float, h << 16); }
__device__ __forceinline__ float wave_sum(float v) {
#pragma unroll
    for (int o = 1; o < 64; o <<= 1) v += __shfl_xor(v, o);
    return v;
}
using pg8::cvt_pk_bf16; using pg8::bf_lo; using pg8::bf_hi; using pg8::sigmoidf_fast;
#define XB_TMO      128
#define XB_XCNT(j)  (256  + 64 * (j))
#define XB_XSUB(j)  (1280 + 64 * (j))
#define XB_XGEN(j)  (2304 + 64 * (j))
#define XB_TOP      3328
#define XB_TOPGEN   3392
#define XCD_BAR_WORDS 3456
#define XB_SPIN_CAP (1u << 18)

__device__ __forceinline__ unsigned xb_ld(unsigned* p)              { return __hip_atomic_load(p, __ATOMIC_RELAXED, __HIP_MEMORY_SCOPE_AGENT); }
__device__ __forceinline__ unsigned xb_add(unsigned* p, unsigned v) { return __hip_atomic_fetch_add(p, v, __ATOMIC_RELAXED, __HIP_MEMORY_SCOPE_AGENT); }
__device__ __forceinline__ unsigned xb_xcc_id() { return (unsigned)__builtin_amdgcn_s_getreg((3 << 11) | 20) & 0xFu; }
#define XB_SPIN(cond, bar) do { unsigned _sp = 0; while (cond) { __builtin_amdgcn_s_sleep(1); \
    if ((++_sp & 255u) == 0u) { if (xb_ld(&(bar)[XB_TMO])) break; if (_sp > XB_SPIN_CAP) { atomicAdd(&(bar)[XB_TMO], 1u); break; } } } } while (0)

struct XcdBarrier {
    unsigned* bar; unsigned x;
    volatile LAS unsigned* st;
};

__device__ __forceinline__ XcdBarrier xcd_barrier_post(unsigned* bar, volatile LAS unsigned* st) {
    XcdBarrier b; b.bar = bar; b.x = xb_xcc_id(); b.st = st;
    if (threadIdx.x == 0) (void)xb_add(&bar[XB_XCNT(b.x)], 1u);
    return b;
}
__device__ __forceinline__ void xcd_barrier_complete(unsigned* bar, unsigned x, unsigned& nloc, unsigned& nx) {
    const unsigned G = gridDim.x * gridDim.y * gridDim.z;
    unsigned sum, cnt, mine, sp = 0u;
    for (;;) {
        sum = 0u; cnt = 0u; mine = 0u;
#pragma unroll
        for (unsigned j = 0; j < 16; ++j) { const unsigned c = xb_ld(&bar[XB_XCNT(j)]); sum += c; cnt += (c > 0u) ? 1u : 0u; mine = (j == x) ? c : mine; }
        if (sum == G) break;
        __builtin_amdgcn_s_sleep(1);
        if ((++sp & 255u) == 0u) { if (xb_ld(&bar[XB_TMO])) break; if (sp > XB_SPIN_CAP) { atomicAdd(&bar[XB_TMO], 1u); break; } }
    }
    nloc = mine > 0u ? mine : 1u; nx = cnt > 0u ? cnt : 1u;
}

__device__ __forceinline__ void xcd_barrier(const XcdBarrier& b) {
    asm volatile("s_waitcnt vmcnt(0)" ::: "memory");
    __syncthreads();
    if (threadIdx.x == 0) {
        unsigned* bar = b.bar;
        __builtin_amdgcn_s_waitcnt(0);
        unsigned nloc = b.st[0], nx = b.st[1];
        if (nloc == 0u) { xcd_barrier_complete(bar, b.x, nloc, nx); b.st[0] = nloc; b.st[1] = nx; }
        const unsigned old = xb_add(&bar[XB_XSUB(b.x)], 1u);
        const unsigned gen = old / nloc;
        if (old + 1u == (gen + 1u) * nloc) {
            __builtin_amdgcn_fence(__ATOMIC_RELEASE, "agent");
            asm volatile("s_waitcnt vmcnt(0)" ::: "memory");
            const unsigned og = xb_add(&bar[XB_TOP], 1u);
            const unsigned tg = og / nx;
            if (og + 1u == (tg + 1u) * nx) xb_add(&bar[XB_TOPGEN], 1u);
            else XB_SPIN(xb_ld(&bar[XB_TOPGEN]) == tg, bar);
            __builtin_amdgcn_fence(__ATOMIC_ACQUIRE, "agent");
            xb_add(&bar[XB_XGEN(b.x)], 1u);
            asm volatile("s_waitcnt vmcnt(0)" ::: "memory");
        } else {
            XB_SPIN(xb_ld(&bar[XB_XGEN(b.x)]) == gen, bar);
            __builtin_amdgcn_fence(__ATOMIC_ACQUIRE, "agent");
            asm volatile("s_waitcnt vmcnt(0)" ::: "memory");
        }
    }
    __syncthreads();
}

__device__ __forceinline__ int win_dst_row(int n) {
    if (n < 512) return 256 * (n >> 7) + (n & 127);
    if (n < 1024) { const int f = n - 512; return 256 * (f >> 7) + 128 + (f & 127); }
    if (n < 2048) { const int isk = n >= OFF_K, j = n - (isk ? OFF_K : OFF_Q), head = j >> 6, d = j & 63;
        return 256 * (4 + 2 * isk + (head >> 2)) + 128 * (d >> 5) + 32 * (head & 3) + (d & 31); }
    if (n < OFF_F) return 256 * 8 + (n - OFF_V);
    if (n < OFF_GC) return -1;
    return 256 * 10 + (n - OFF_GC);
}
__device__ __forceinline__ int glu_dst_row(int n, int F) { const int isu = n >= F, f = n - (isu ? F : 0); return 256 * (f >> 7) + 128 * isu + (f & 127); }

__device__ __forceinline__ unsigned pk4_fp8(float a, float b, float c, float d) { int p = __builtin_amdgcn_cvt_pk_fp8_f32(a, b, 0, false); p = __builtin_amdgcn_cvt_pk_fp8_f32(c, d, p, true); return (unsigned)p; }
#ifndef MOE_FP8
#define MOE_FP8 0
#endif
constexpr float W8SCALE = MOE_FP8 ? 32.0f : 1.0f;
constexpr float SLABSCALE = 16.0f;
template <int MODE>
__device__ __forceinline__ void tr_item(const float* W, int ldw, int K, bf16* WT, bf16* WT2, int k0, int n0, LAS float* scr, int lane) {
#pragma unroll 8
    for (int i = 0; i < 32; ++i) { const int kk = 2 * i + (lane >> 5); scr[kk * 33 + (lane & 31)] = W[(size_t)(k0 + kk) * ldw + n0 + (lane & 31)]; }
    LDS_WAIT(); asm volatile("" ::: "memory");
    const int c = lane & 7;
#pragma unroll
    for (int j = 0; j < 4; ++j) { const int n = (lane >> 3) + 8 * j; const LAS float* s = scr + (8 * c) * 33 + n;
        int row = n0 + n;
        if (MODE == 1) row = win_dst_row(row);
        if (MODE == 2 || MODE == 4) row = glu_dst_row(row, ldw >> 1);
        float v[8];
#pragma unroll
        for (int q = 0; q < 8; ++q) v[q] = s[q * 33];
        if (MODE == 1 && row < 0) continue;
        if (MODE == 4) { v2u o8; o8.x = pk4_fp8(v[0] * W8SCALE, v[1] * W8SCALE, v[2] * W8SCALE, v[3] * W8SCALE); o8.y = pk4_fp8(v[4] * W8SCALE, v[5] * W8SCALE, v[6] * W8SCALE, v[7] * W8SCALE);
            *(GAS v2u*)((unsigned char*)WT + (size_t)row * K + k0 + 8 * c) = o8; continue; }
        v4u o; o.x = pk2(v[0], v[1]); o.y = pk2(v[2], v[3]); o.z = pk2(v[4], v[5]); o.w = pk2(v[6], v[7]);
        *(GAS v4u*)(WT + (size_t)row * K + k0 + 8 * c) = o;
        if (MODE == 3) { float r[8];
#pragma unroll
            for (int q = 0; q < 8; ++q) r[q] = v[q] - bf2f(f2bf(v[q]));
            v4u o2; o2.x = pk2(r[0], r[1]); o2.y = pk2(r[2], r[3]); o2.z = pk2(r[4], r[5]); o2.w = pk2(r[6], r[7]);
            *(GAS v4u*)(WT2 + (size_t)row * K + k0 + 8 * c) = o2; }
    }
    LDS_WAIT(); asm volatile("" ::: "memory");
}

struct KArgs { const float* in[23]; float* out; unsigned char* ws; int ph_lo, ph_hi; };

__device__ __forceinline__ void p0_prologue(const KArgs& a, LAS unsigned char* lds, int vcu, int G, int wave, int lane) {
    LAS float* scr = (LAS float*)(lds + RING_OFF + wave * 16384);
    const int gw = vcu * NWAVES + wave, NGW = G * NWAVES;
    unsigned char* ws = a.ws;
    {
        const float* c = a.in[1]; const float* wada = a.in[2]; float* modp = (float*)(ws + WS_MODP);
        for (int it = gw; it < 96 * 16; it += NGW) {
            const int cg = it % 96, kc = it / 96, n = 64 * cg + lane; float s0 = 0.f, s1 = 0.f;
            const float* wp = wada + (size_t)(64 * kc) * 6144 + n;
#pragma unroll 8
            for (int k = 0; k < 64; ++k) { const float w = wp[(size_t)k * 6144]; const float c0 = c[64 * kc + k], c1 = c[1024 + 64 * kc + k];
                s0 += (c0 / (1.0f + __expf(-c0))) * w; s1 += (c1 / (1.0f + __expf(-c1))) * w; }
            modp[(size_t)(kc * 2 + 0) * 6144 + n] = s0; modp[(size_t)(kc * 2 + 1) * 6144 + n] = s1;
        }
    }
    constexpr int I_WIN = 144 * 16, I_WC = 8 * 32, I_WA = 8 * 32, I_WOUT = 16 * 32, I_WSGU = 16 * 16, I_WSD = 4 * 32, I_WR = 16 * 2, I_WGU = 64 * 256, I_WD = 64 * 128;
    constexpr int NITEMS = I_WIN + I_WC + I_WA + I_WOUT + I_WSGU + I_WSD + I_WR + I_WGU + I_WD;
    for (int it = gw; it < NITEMS; it += NGW) {
        int r = it;
        if (r < I_WIN) { const int cb = r % 144, kb = r / 144; const int n0 = cb < 80 ? 32 * cb : OFF_GC + 32 * (cb - 80);
            tr_item<1>(a.in[5], INCOLS, 1024, (bf16*)(ws + WS_WIN), nullptr, 64 * kb, n0, scr, lane); continue; } r -= I_WIN;
        if (r < I_WC) { tr_item<0>(a.in[10], 1024, 512, (bf16*)(ws + WS_WC), nullptr, 64 * (r / 32), 32 * (r % 32), scr, lane); continue; } r -= I_WC;
        if (r < I_WA) { tr_item<0>(a.in[14], 1024, 512, (bf16*)(ws + WS_WA), nullptr, 64 * (r / 32), 32 * (r % 32), scr, lane); continue; } r -= I_WA;
        if (r < I_WOUT) { tr_item<0>(a.in[15], 1024, 1024, (bf16*)(ws + WS_WOUT), nullptr, 64 * (r / 32), 32 * (r % 32), scr, lane); continue; } r -= I_WOUT;
        if (r < I_WSGU) { tr_item<MOE_FP8 ? 4 : 2>(a.in[21], 512, 1024, (bf16*)(ws + WS_WSGU), nullptr, 64 * (r / 16), 32 * (r % 16), scr, lane); continue; } r -= I_WSGU;
        if (r < I_WSD) { tr_item<0>(a.in[22], 1024, 256, (bf16*)(ws + WS_WSD), nullptr, 64 * (r / 32), 32 * (r % 32), scr, lane); continue; } r -= I_WSD;
        if (r < I_WR) { tr_item<3>(a.in[17], 64, 1024, (bf16*)(ws + WS_WRH), (bf16*)(ws + WS_WRL), 64 * (r / 2), 32 * (r % 2), scr, lane); continue; } r -= I_WR;
        if (r < I_WGU) { const int e = r / 256, q = r % 256;
            tr_item<MOE_FP8 ? 4 : 2>(a.in[19] + (size_t)e * 1024 * 512, 512, 1024, (bf16*)(ws + WS_WGU + (size_t)e * 512 * 1024 * (MOE_FP8 ? 1 : 2)), nullptr, 64 * (q / 16), 32 * (q % 16), scr, lane); continue; } r -= I_WGU;
        { const int e = r / 128, q = r % 128;
            tr_item<0>(a.in[20] + (size_t)e * 256 * 1024, 1024, 256, (bf16*)(ws + WS_WD) + (size_t)e * 1024 * 256, nullptr, 64 * (q / 32), 32 * (q % 32), scr, lane); }
    }
}

__device__ __forceinline__ void p1_rows(const KArgs& a, LAS unsigned char* lds, int vcu, int tid, int wave, int lane) {
    unsigned char* ws = a.ws;
    const float* modp = (const float*)(ws + WS_MODP); const float* bada = a.in[3];
    LAS float* gs1 = (LAS float*)(lds + RING_OFF); LAS float* sh1 = gs1 + 1024; LAS float* wfl = gs1 + 2048;
    const int b = vcu >> 7;
    {
        const int col = 4 * tid; f32x4 s = *(const f32x4*)(bada + col);
#pragma unroll
        for (int kc = 0; kc < 16; ++kc) s += *(const f32x4*)(modp + (size_t)(kc * 2 + b) * 6144 + col);
        if (col < 1024) { *(LAS f32x4*)(sh1 + col) = s; }
        else { const f32x4 g = *(const f32x4*)(a.in[4] + col - 1024); *(LAS f32x4*)(gs1 + col - 1024) = g * (1.0f + s); }
    }
    if (blockIdx.x < 2) {
        float* mod = (float*)(ws + WS_MOD); const int bb = blockIdx.x;
        for (int col = 4 * tid; col < 6144; col += 4 * NWAVES * 64) { f32x4 s = *(const f32x4*)(bada + col);
#pragma unroll
            for (int kc = 0; kc < 16; ++kc) s += *(const f32x4*)(modp + (size_t)(kc * 2 + bb) * 6144 + col);
            *(f32x4*)(mod + (size_t)bb * 6144 + col) = s; }
    }
    for (int idx = tid; idx < 8192; idx += NWAVES * 64) { const int k = idx >> 3, f = idx & 7; wfl[f * 1024 + k] = a.in[5][(size_t)k * INCOLS + OFF_F + f]; }
    __syncthreads();
    const float* x = a.in[0]; bf16* h1 = (bf16*)(ws + WS_H1); float* logf_ = (float*)(ws + WS_LOGF); const float* bfg = a.in[13];
#pragma nounroll
    for (int jb = 0; jb < 2; ++jb) {
    f32x4 vv[4][4];
#pragma unroll
    for (int j = 0; j < 4; ++j) { const GAS f32x4* xr = (const GAS f32x4*)(x + (size_t)(64 * vcu + 8 * wave + 4 * jb + j) * DMODEL) + lane;
#pragma unroll
        for (int q = 0; q < 4; ++q) vv[j][q] = xr[64 * q]; }
#pragma unroll
    for (int j = 0; j < 4; ++j) {
        const int row = 64 * vcu + 8 * wave + 4 * jb + j, t = row & (SEQ - 1);
        LAS float* gs1_ = gs1; asm volatile("" : "+v"(gs1_));
        LAS float* sh1_ = gs1_ + 1024; LAS float* wfl_ = gs1_ + 2048;
        f32x4 v[4]; float ss = 0.f;
#pragma unroll
        for (int q = 0; q < 4; ++q) { v[q] = vv[j][q]; ss += (v[q].x * v[q].x + v[q].y * v[q].y) + (v[q].z * v[q].z + v[q].w * v[q].w); }
        const float rstd = 1.0f / sqrtf(wave_sum(ss) * (1.0f / DMODEL) + EPS);
        GAS unsigned long long* o8 = (GAS unsigned long long*)(h1 + (size_t)row * DMODEL) + lane;
#pragma unroll
        for (int q = 0; q < 4; ++q) { const f32x4 g = *(const LAS f32x4*)(gs1_ + 4 * lane + 256 * q), s = *(const LAS f32x4*)(sh1_ + 4 * lane + 256 * q);
            v[q] = v[q] * rstd * g + s;
            o8[64 * q] = (unsigned long long)pk2(v[q].x, v[q].y) | ((unsigned long long)pk2(v[q].z, v[q].w) << 32); }
        float pf[8];
#pragma unroll
        for (int f = 0; f < 8; ++f) { float p = 0.f;
#pragma unroll
            for (int q = 0; q < 4; ++q) { const f32x4 w = *(const LAS f32x4*)(wfl_ + f * 1024 + 4 * lane + 256 * q); p += (v[q].x * w.x + v[q].y * w.y) + (v[q].z * w.z + v[q].w * w.w); }
            pf[f] = p; }
        float r4[4], r2[2], mine;
#pragma unroll
        for (int i = 0; i < 4; ++i) { const float keep = (lane & 1) ? pf[2 * i + 1] : pf[2 * i], send = (lane & 1) ? pf[2 * i] : pf[2 * i + 1]; r4[i] = keep + __shfl_xor(send, 1); }
#pragma unroll
        for (int i = 0; i < 2; ++i) { const float keep = (lane & 2) ? r4[2 * i + 1] : r4[2 * i], send = (lane & 2) ? r4[2 * i] : r4[2 * i + 1]; r2[i] = keep + __shfl_xor(send, 2); }
        { const float keep = (lane & 4) ? r2[1] : r2[0], send = (lane & 4) ? r2[0] : r2[1]; mine = keep + __shfl_xor(send, 4); }
        mine += __shfl_xor(mine, 8); mine += __shfl_xor(mine, 16); mine += __shfl_xor(mine, 32);
        if (lane < 8) { const float z = mine + bfg[lane]; const float ls = fminf(z, 0.f) - log1pf(expf(-fabsf(z)));
            logf_[(size_t)(b * 8 + lane) * SEQ + t] = ls; }
    }
    }
}

__device__ __forceinline__ void p2_cumsum(const KArgs& a, LAS unsigned char* lds, int seq, int tid, int wave, int lane) {
    const float* lf = (const float*)(a.ws + WS_LOGF) + (size_t)seq * SEQ + 16 * tid; float* cm = (float*)(a.ws + WS_CUM) + (size_t)seq * SEQ + 16 * tid;
    LAS double* wt = (LAS double*)(lds + RING_OFF);
    float v[16];
#pragma unroll
    for (int q = 0; q < 4; ++q) { const f32x4 x = *(const f32x4*)(lf + 4 * q); v[4 * q] = x.x; v[4 * q + 1] = x.y; v[4 * q + 2] = x.z; v[4 * q + 3] = x.w; }
    double pre[16]; double run = 0.0;
#pragma unroll
    for (int i = 0; i < 16; ++i) { run += (double)v[i]; pre[i] = run; }
    double sc = run;
#pragma unroll
    for (int o = 1; o < 64; o <<= 1) { const double up = __shfl_up(sc, o); if (lane >= o) sc += up; }
    if (lane == 63) wt[wave] = sc;
    __syncthreads();
    double off = sc - run;
    for (int w = 0; w < wave; ++w) off += wt[w];
#pragma unroll
    for (int q = 0; q < 4; ++q) { f32x4 o; o.x = (float)(off + pre[4 * q]); o.y = (float)(off + pre[4 * q + 1]); o.z = (float)(off + pre[4 * q + 2]); o.w = (float)(off + pre[4 * q + 3]); *(f32x4*)(cm + 4 * q) = o; }
    __syncthreads();
}

__device__ __forceinline__ void conv_item(const KArgs& a, LAS unsigned char* lds, int item, int tid) {
    const int tt = item >> 3, g = item & 7, row0 = 128 * tt, t0 = row0 & (SEQ - 1), c0 = 64 * g;
    const bf16* U = (const bf16*)(a.ws + WS_U); bf16* UC = (bf16*)(a.ws + WS_UC);
    constexpr int RS = 132;
    LAS unsigned char* ut = lds + RING_OFF;
    LAS float* yt = (LAS float*)(lds + RING_OFF + 24576);
    constexpr int YS = 68;
    for (int idx = tid; idx < 158 * 16; idx += NWAVES * 64) { const int r = idx >> 4, ch = idx & 15, tq = t0 - 30 + r;
        v2u val = (v2u){0u, 0u};
        if (tq >= 0) val = *(const GAS v2u*)(U + (size_t)(row0 - 30 + r) * CONVD + c0 + 4 * ch);
        *(LAS unsigned*)(ut + r * RS + 8 * ch) = val.x; *(LAS unsigned*)(ut + r * RS + 8 * ch + 4) = val.y; }
    const int c2 = tid & 31, seg = tid >> 5;
    float w0[CONVW], w1[CONVW];
#pragma unroll
    for (int j = 0; j < CONVW; ++j) { const f32x2 wv = *(const f32x2*)(a.in[6] + (size_t)j * CONVD + c0 + 2 * c2); w0[j] = wv[0]; w1[j] = wv[1]; }
    const f32x2 bv = *(const f32x2*)(a.in[7] + c0 + 2 * c2);
    __syncthreads();
    float y0[8], y1[8];
#pragma unroll
    for (int t = 0; t < 8; ++t) { y0[t] = bv[0]; y1[t] = bv[1]; }
#pragma unroll
    for (int r = 0; r < 38; ++r) { const unsigned uu = *(const LAS unsigned*)(ut + (8 * seg + r) * RS + 4 * c2); const float x0 = bf_lo(uu), x1v = bf_hi(uu);
#pragma unroll
        for (int t = 0; t < 8; ++t) { const int j = r - t; if (j >= 0 && j < CONVW) { y0[t] += x0 * w0[j]; y1[t] += x1v * w1[j]; } } }
#pragma unroll
    for (int t = 0; t < 8; ++t) *(LAS f32x2*)(yt + (8 * seg + t) * YS + 2 * c2) = (f32x2){y0[t], y1[t]};
    __syncthreads();
    const int tok = tid >> 2, q = tid & 3;
    float acc[16];
#pragma unroll
    for (int i = 0; i < 4; ++i) { const f32x4 v = *(const LAS f32x4*)(yt + tok * YS + 16 * q + 4 * i); acc[4 * i] = v[0]; acc[4 * i + 1] = v[1]; acc[4 * i + 2] = v[2]; acc[4 * i + 3] = v[3]; }
    float s = 0.f;
#pragma unroll
    for (int i = 0; i < 16; ++i) s += acc[i];
    s += __shfl_xor(s, 1); s += __shfl_xor(s, 2);
    const float mu = s * (1.0f / 64.0f); float qv = 0.f;
#pragma unroll
    for (int i = 0; i < 16; ++i) { acc[i] -= mu; qv += acc[i] * acc[i]; }
    qv += __shfl_xor(qv, 1); qv += __shfl_xor(qv, 2);
    const float rstd = 1.0f / sqrtf(qv * (1.0f / 64.0f) + EPS);
    unsigned o[8];
#pragma unroll
    for (int i = 0; i < 16; i += 2) { float v0 = acc[i] * rstd * a.in[8][c0 + 16 * q + i] + a.in[9][c0 + 16 * q + i], v1 = acc[i + 1] * rstd * a.in[8][c0 + 16 * q + i + 1] + a.in[9][c0 + 16 * q + i + 1];
        v0 = v0 * sigmoidf_fast(v0); v1 = v1 * sigmoidf_fast(v1); o[i >> 1] = pk2(v0, v1); }
    GAS v4u* dst = (GAS v4u*)(UC + (size_t)(row0 + tok) * CONVD + c0 + 16 * q);
    dst[0] = (v4u){o[0], o[1], o[2], o[3]}; dst[1] = (v4u){o[4], o[5], o[6], o[7]};
    __syncthreads();
}

struct SchedDense {
    static constexpr bool GATHER = false;
    int nM, nN, G, c, K; const char* A; const char* B;
    __device__ __forceinline__ bool next(int i, pg8::Unit& u) const {
        const long L = (long)i * G + c; if (L >= (long)nM * nN) return false;
        pg8::tile_of((int)L, nM, nN, u.pm, u.pn); u.e = 0; u.mt = 0;
        u.A = A + (size_t)u.pm * 256 * K * 2; u.B = B + (size_t)u.pn * 256 * K * 2; return true; }
    __device__ __forceinline__ int row(const pg8::Unit&, int) const { return 0; }
};
struct SchedMerge {
    static constexpr bool GATHER = false;
    int c; const char* A0; const char* B0; const char* A1; const char* B1;
    __device__ __forceinline__ bool next(int i, pg8::Unit& u) const {
        if (i >= 2 || c >= 256) return false;
        pg8::tile_of(c, 64, 4, u.pm, u.pn); u.e = i; u.mt = 0;
        u.A = (i ? A1 : A0) + (size_t)u.pm * 256 * 512 * 2; u.B = (i ? B1 : B0) + (size_t)u.pn * 256 * 512 * 2; return true; }
    __device__ __forceinline__ int row(const pg8::Unit&, int) const { return 0; }
};
struct MoeTab { const LAS int* tstart; const LAS int* cnt; };
struct SchedMoe1 {
    static constexpr bool GATHER = true;
    MoeTab tb; int nmoe, ntot, per, c, lane; const char* h2; const char* wgu; const char* wsgu; const int* list;
    __device__ __forceinline__ bool next(int i, pg8::Unit& u) const {
        const int L = i * per + c; if (L >= ntot) return false;
        if (L < nmoe) { const int nti = nmoe >> 1, tt = L % nti; const int e = __popcll(__ballot(tb.tstart[lane + 1] <= tt));
            u.e = e; u.mt = tt - tb.tstart[e]; u.pm = tt; u.pn = L / nti; u.A = h2; u.B = wgu + ((size_t)e * 512 + (size_t)u.pn * 256) * 1024 * (MOE_FP8 ? 1 : 2); }
        else { const int s = L - nmoe; u.e = -1; u.mt = 0; u.pm = s & 63; u.pn = s >> 6; u.A = h2; u.B = wsgu + (size_t)u.pn * 256 * 1024 * (MOE_FP8 ? 1 : 2); }
        return true; }
    __device__ __forceinline__ int row(const pg8::Unit& u, int r) const {
        if (u.e < 0) return u.pm * 256 + r;
        const int idx = u.mt * 256 + r; return idx < tb.cnt[u.e] ? (list[(size_t)u.e * LISTCAP + idx] >> 3) : 0; }
};
struct SchedMoe2 {
    static constexpr bool GATHER = false;
    MoeTab tb; int ntot, per, c, lane; const char* act; const char* wd;
    __device__ __forceinline__ bool next(int i, pg8::Unit& u) const {
        const int nti = ntot >> 2, j = (i >> 1) * per + c; if (j >= 2 * nti) return false;
        const int tt = j % nti; const int e = __popcll(__ballot(tb.tstart[lane + 1] <= tt));
        u.e = e; u.mt = tt - tb.tstart[e]; u.pm = tt; u.pn = 2 * (j / nti) + (i & 1); u.A = act + (size_t)tt * 256 * 256 * 2; u.B = wd + ((size_t)e * 1024 + (size_t)u.pn * 256) * 256 * 2; return true; }
    __device__ __forceinline__ int row(const pg8::Unit&, int) const { return 0; }
};

typedef pg8::f32x4 (AccT)[2][2][4][2];
#define NO_PRE_MEMBERS static constexpr bool AFTER_DRAIN = false; struct Pre {}; __device__ __forceinline__ void prefetch(Pre&, const pg8::Unit&, int, int, int, int) const {} static constexpr bool ROWTAB = false; __device__ __forceinline__ const char* tab_src(const pg8::Unit&) const { return nullptr; }
__device__ __forceinline__ v4u pack8(const f32x4& a, const f32x4& b) { v4u w; w.x = cvt_pk_bf16(a[0], a[1]); w.y = cvt_pk_bf16(a[2], a[3]); w.z = cvt_pk_bf16(b[0], b[1]); w.w = cvt_pk_bf16(b[2], b[3]); return w; }
__device__ __forceinline__ void unpack8(const v4u& w, f32x4& a, f32x4& b) { a = (f32x4){bf_lo(w.x), bf_hi(w.x), bf_lo(w.y), bf_hi(w.y)}; b = (f32x4){bf_lo(w.z), bf_hi(w.z), bf_lo(w.w), bf_hi(w.w)}; }
__device__ __forceinline__ f32x4 sig4(const f32x4& v) { return (f32x4){sigmoidf_fast(v[0]), sigmoidf_fast(v[1]), sigmoidf_fast(v[2]), sigmoidf_fast(v[3])}; }

struct EpiIn {
    static constexpr bool PERM = true; NO_PRE_MEMBERS
    bf16 *U, *Q, *Kb, *V, *SG; const float *gq, *gk;
    __device__ __forceinline__ void operator()(const AccT& acc, const pg8::Unit& u, int wr, int wc, int fr_, int fq_, const Pre& pre, const LAS unsigned* rtab) const {
        int fr = fr_, fq = fq_; asm volatile("" : "+v"(fr), "+v"(fq));
        const int row0 = u.pm * 256 + wr * 64 + fr, pn = u.pn;
        if (pn < 4) {
            const int col0 = 128 * pn + 32 * wc + 8 * fq;
#pragma unroll
            for (int ai = 0; ai < 2; ++ai)
#pragma unroll
                for (int m = 0; m < 4; ++m) { const f32x4 v0 = acc[ai][0][m][0] * sig4(acc[ai][1][m][0]), v1 = acc[ai][0][m][1] * sig4(acc[ai][1][m][1]);
                    *(v4u*)(U + (size_t)(row0 + ai * 128 + m * 16) * CONVD + col0) = pack8(v0, v1); }
        } else if (pn < 8) {
            const bool isk = pn >= 6; const int head = 4 * ((pn - 4) & 1) + wc; const float* g = isk ? gk : gq; bf16* dst = isk ? Kb : Q; const float sc = isk ? 1.0f : C2Q;
            f32x4 gv[2][2];
#pragma unroll
            for (int bj = 0; bj < 2; ++bj)
#pragma unroll
                for (int n = 0; n < 2; ++n) gv[bj][n] = *(const f32x4*)(g + 32 * bj + 8 * fq + 4 * n) * sc;
#pragma unroll
            for (int ai = 0; ai < 2; ++ai)
#pragma unroll
                for (int m = 0; m < 4; ++m) { float ss = 0.f;
#pragma unroll
                    for (int bj = 0; bj < 2; ++bj)
#pragma unroll
                        for (int n = 0; n < 2; ++n) { const f32x4 x = acc[ai][bj][m][n]; ss += (x[0] * x[0] + x[1] * x[1]) + (x[2] * x[2] + x[3] * x[3]); }
                    ss += __shfl_xor(ss, 16); ss += __shfl_xor(ss, 32);
                    const float r = 1.0f / sqrtf(ss * (1.0f / 64.0f) + EPS);
                    bf16* rowp = dst + (size_t)(row0 + ai * 128 + m * 16) * ATT + head * 64 + 8 * fq;
#pragma unroll
                    for (int bj = 0; bj < 2; ++bj) *(v4u*)(rowp + 32 * bj) = pack8(acc[ai][bj][m][0] * r * gv[bj][0], acc[ai][bj][m][1] * r * gv[bj][1]); }
        } else if (pn < 10) {
            const int col0 = 256 * (pn - 8) + 32 * wc + 8 * fq;
#pragma unroll
            for (int ai = 0; ai < 2; ++ai)
#pragma unroll
                for (int m = 0; m < 4; ++m)
#pragma unroll
                    for (int bj = 0; bj < 2; ++bj) *(v4u*)(V + (size_t)(row0 + ai * 128 + m * 16) * ATT + col0 + 128 * bj) = pack8(acc[ai][bj][m][0], acc[ai][bj][m][1]);
        } else {
            bf16* dst = SG + (size_t)((pn - 10) >> 2) * T * DMODEL; const int col0 = 256 * ((pn - 10) & 3) + 32 * wc + 8 * fq;
#pragma unroll
            for (int ai = 0; ai < 2; ++ai)
#pragma unroll
                for (int m = 0; m < 4; ++m)
#pragma unroll
                    for (int bj = 0; bj < 2; ++bj) *(v4u*)(dst + (size_t)(row0 + ai * 128 + m * 16) * DMODEL + col0 + 128 * bj) = pack8(sig4(acc[ai][bj][m][0]), sig4(acc[ai][bj][m][1]));
        }
    }
};
struct EpiMerge {
    static constexpr bool PERM = true; NO_PRE_MEMBERS
    const bf16* SG; bf16* MG;
    __device__ __forceinline__ void operator()(const AccT& acc, const pg8::Unit& u, int wr, int wc, int fr_, int fq_, const Pre& pre, const LAS unsigned* rtab) const {
        int fr = fr_, fq = fq_; asm volatile("" : "+v"(fr), "+v"(fq));
        const int row0 = u.pm * 256 + wr * 64 + fr, col0 = u.pn * 256 + 32 * wc + 8 * fq; const bf16* sg = SG + (size_t)u.e * T * DMODEL;
#pragma unroll
        for (int ai = 0; ai < 2; ++ai)
#pragma unroll
            for (int m = 0; m < 4; ++m)
#pragma unroll
                for (int bj = 0; bj < 2; ++bj) { const size_t off = (size_t)(row0 + ai * 128 + m * 16) * DMODEL + col0 + 128 * bj;
                    f32x4 g0, g1; unpack8(*(const v4u*)(sg + off), g0, g1);
                    f32x4 v0 = g0 * acc[ai][bj][m][0], v1 = g1 * acc[ai][bj][m][1];
                    if (u.e) { f32x4 p0, p1; unpack8(*(const v4u*)(MG + off), p0, p1); v0 += p0; v1 += p1; }
                    *(v4u*)(MG + off) = pack8(v0, v1); }
    }
};
struct EpiX1 {
    static constexpr bool PERM = true; static constexpr bool AFTER_DRAIN = true; struct Pre {}; __device__ __forceinline__ void prefetch(Pre&, const pg8::Unit&, int, int, int, int) const {}
    static constexpr bool ROWTAB = false; __device__ __forceinline__ const char* tab_src(const pg8::Unit&) const { return nullptr; }
    const float* x; float* out; const float* mod; float* ssq;
    __device__ __forceinline__ void operator()(const AccT&, const pg8::Unit&, int, int, int, int, const Pre&, const LAS unsigned*) const {}
    __device__ __forceinline__ void fused(const AccT& acc, const pg8::Unit& u, int wr, int wc, int fr, int fq, LAS unsigned char* lds) const;
};
struct EpiGlu {
    static constexpr bool PERM = true;
    bf16 *ACT, *SACT; const float* wlist; MoeTab tb;
    struct Pre {}; __device__ __forceinline__ void prefetch(Pre&, const pg8::Unit&, int, int, int, int) const {}
    static constexpr bool AFTER_DRAIN = false;
    static constexpr bool ROWTAB = true;
    __device__ __forceinline__ const char* tab_src(const pg8::Unit& u) const { return u.e >= 0 ? (const char*)(wlist + (size_t)u.e * LISTCAP + u.mt * 256) : nullptr; }
    __device__ __forceinline__ void operator()(const AccT& acc, const pg8::Unit& u, int wr, int wc, int fr_, int fq_, const Pre& pre, const LAS unsigned* rtab) const {
        int fr = fr_, fq = fq_; asm volatile("" : "+v"(fr), "+v"(fq));
        const int rl0 = wr * 64 + fr, col0 = 128 * u.pn + 32 * wc + 8 * fq; bf16* dst = (u.e >= 0 ? ACT : SACT) + (size_t)u.pm * 256 * EF;
        const int cnt = u.e >= 0 ? tb.cnt[u.e] : 0;
#pragma unroll
        for (int ai = 0; ai < 2; ++ai)
#pragma unroll
            for (int m = 0; m < 4; ++m) { const int rl = rl0 + ai * 128 + m * 16; const float w = (u.e >= 0) ? ((u.mt * 256 + rl < cnt) ? __builtin_bit_cast(float, rtab[rl]) : 0.0f) : 1.0f;
                const f32x4 g0 = acc[ai][0][m][0] * (1.0f / W8SCALE), g1 = acc[ai][0][m][1] * (1.0f / W8SCALE);
                const f32x4 v0 = g0 * sig4(g0) * acc[ai][1][m][0] * (w * (1.0f / W8SCALE)), v1 = g1 * sig4(g1) * acc[ai][1][m][1] * (w * (1.0f / W8SCALE));
                *(v4u*)(dst + (size_t)rl * EF + col0) = pack8(v0, v1); asm volatile("" ::: "memory"); }
    }
};
struct EpiSlab {
    static constexpr bool PERM = true;
    unsigned char* SLAB; const int* list; MoeTab tb;
    struct Pre {}; __device__ __forceinline__ void prefetch(Pre&, const pg8::Unit&, int, int, int, int) const {}
    static constexpr bool AFTER_DRAIN = false;
    static constexpr bool ROWTAB = true;
    __device__ __forceinline__ const char* tab_src(const pg8::Unit& u) const { return (const char*)(list + (size_t)u.e * LISTCAP + u.mt * 256); }
    __device__ __forceinline__ void operator()(const AccT& acc, const pg8::Unit& u, int wr, int wc, int fr_, int fq_, const Pre& pre, const LAS unsigned* rtab) const {
        int fr = fr_, fq = fq_; asm volatile("" : "+v"(fr), "+v"(fq));
        const int col0 = 256 * u.pn + 64 * wc + 8 * fq;
#pragma unroll
        for (int ai = 0; ai < 2; ++ai)
#pragma unroll
            for (int m = 0; m < 4; ++m) { const int rl = wr * 64 + fr + ai * 128 + m * 16; const int slot = (int)rtab[rl];
                if (u.mt * 256 + rl < tb.cnt[u.e]) { unsigned char* rowp = SLAB + (size_t)slot * DMODEL + col0;
#pragma unroll
                    for (int bj = 0; bj < 2; ++bj) { const f32x4 a0 = acc[ai][bj][m][0] * SLABSCALE, a1 = acc[ai][bj][m][1] * SLABSCALE;
                        *(v2u*)(rowp + 32 * bj) = (v2u){pk4_fp8(a0[0], a0[1], a0[2], a0[3]), pk4_fp8(a1[0], a1[1], a1[2], a1[3])}; } }
                asm volatile("" ::: "memory"); }
    }
};
__device__ __forceinline__ void park_tile(const AccT& acc, LAS unsigned char* lds, int wr, int wc, int fr, int fq) {
#pragma unroll
    for (int ai = 0; ai < 2; ++ai)
#pragma unroll
        for (int m = 0; m < 4; ++m) { const int row = 128 * ai + 64 * wr + 16 * m + fr;
#pragma unroll
            for (int bj = 0; bj < 2; ++bj) { const int c16 = 16 * bj + 4 * wc + fq; *(LAS v4u*)(lds + row * 512 + ((c16 ^ (row & 31)) << 4)) = pack8(acc[ai][bj][m][0], acc[ai][bj][m][1]); } }
    asm volatile("s_waitcnt lgkmcnt(0)" ::: "memory"); __builtin_amdgcn_s_barrier(); asm volatile("" ::: "memory");
}
struct EpiFinal {
    static constexpr bool PERM = true; static constexpr bool AFTER_DRAIN = true; struct Pre {}; __device__ __forceinline__ void prefetch(Pre&, const pg8::Unit&, int, int, int, int) const {}
    static constexpr bool ROWTAB = false; __device__ __forceinline__ const char* tab_src(const pg8::Unit&) const { return nullptr; }
    float* out; const unsigned char* SLAB; const float* mod;
    __device__ __forceinline__ void operator()(const AccT&, const pg8::Unit&, int, int, int, int, const Pre&, const LAS unsigned*) const {}
    __device__ __forceinline__ void fused(const AccT& acc, const pg8::Unit& u, int wr, int wc, int fr, int fq, LAS unsigned char* lds) const {
        typedef float f32x2v __attribute__((ext_vector_type(2)));
        park_tile(acc, lds, wr, wc, fr, fq);
        const int tid = threadIdx.x, wave = tid >> 6, lane = tid & 63, hl = lane >> 5, i = lane & 31;
        const int col0 = 128 * ((i >> 2) & 1) + 32 * (i >> 3) + 8 * (i & 3);
        const float* g2 = mod + (size_t)(u.pm >> 5) * 6144 + 5120 + u.pn * 256 + col0;
        const f32x4 gv0 = *(const f32x4*)g2, gv1 = *(const f32x4*)(g2 + 4);
#pragma unroll 4
        for (int s = 0; s < 16; ++s) { const int rl = 32 * wave + 2 * s + hl; const size_t row = (size_t)u.pm * 256 + rl;
            const unsigned char* sp = SLAB + row * TOPK * DMODEL + u.pn * 256 + 8 * i;
            v2u sv[TOPK];
#if FWD_LEVEL >= 2
#pragma unroll
            for (int k = 0; k < TOPK; ++k) sv[k] = *(const v2u*)(sp + (size_t)k * DMODEL);
#endif
            float* op = out + row * DMODEL + u.pn * 256 + col0; const f32x4 x0 = *(const f32x4*)op, x1v = *(const f32x4*)(op + 4);
            f32x4 a0, a1; { const v4u pk_ = *(const LAS v4u*)(lds + rl * 512 + ((((col0 >> 3)) ^ (rl & 31)) << 4)); unpack8(pk_, a0, a1); }
            f32x4 s0 = (f32x4){0.f, 0.f, 0.f, 0.f}, s1 = s0;
#if FWD_LEVEL >= 2
#pragma unroll
            for (int k = 0; k < TOPK; ++k) { const f32x2v a = __builtin_amdgcn_cvt_pk_f32_fp8((int)sv[k].x, false), b = __builtin_amdgcn_cvt_pk_f32_fp8((int)sv[k].x, true), c = __builtin_amdgcn_cvt_pk_f32_fp8((int)sv[k].y, false), d = __builtin_amdgcn_cvt_pk_f32_fp8((int)sv[k].y, true);
                s0 += (f32x4){a[0], a[1], b[0], b[1]}; s1 += (f32x4){c[0], c[1], d[0], d[1]}; }
#endif
            s0 = s0 * (1.0f / SLABSCALE) + a0; s1 = s1 * (1.0f / SLABSCALE) + a1;
            *(f32x4*)op = x0 + gv0 * s0; *(f32x4*)(op + 4) = x1v + gv1 * s1; }
    }
};
__device__ __forceinline__ void EpiX1::fused(const AccT& acc, const pg8::Unit& u, int wr, int wc, int fr, int fq, LAS unsigned char* lds) const {
    park_tile(acc, lds, wr, wc, fr, fq);
    const int tid = threadIdx.x, wave = tid >> 6, lane = tid & 63, hl = lane >> 5, i = lane & 31;
    const float* g1 = mod + (size_t)(u.pm >> 5) * 6144 + 2048 + u.pn * 256 + 8 * i;
    const f32x4 gv0 = *(const f32x4*)g1, gv1 = *(const f32x4*)(g1 + 4);
#pragma unroll 4
    for (int s = 0; s < 16; ++s) { const int rl = 32 * wave + 2 * s + hl; const size_t off = ((size_t)u.pm * 256 + rl) * DMODEL + u.pn * 256 + 8 * i;
        const f32x4 x0 = *(const f32x4*)(x + off), x1v = *(const f32x4*)(x + off + 4);
        f32x4 a0, a1; { const v4u pk_ = *(const LAS v4u*)(lds + rl * 512 + ((i ^ (rl & 31)) << 4)); unpack8(pk_, a0, a1); }
        const f32x4 v0 = x0 + gv0 * a0, v1 = x1v + gv1 * a1;
        *(f32x4*)(out + off) = v0; *(f32x4*)(out + off + 4) = v1;
        float ss = ((v0[0] * v0[0] + v0[1] * v0[1]) + (v0[2] * v0[2] + v0[3] * v0[3])) + ((v1[0] * v1[0] + v1[1] * v1[1]) + (v1[2] * v1[2] + v1[3] * v1[3]));
        ss += __shfl_xor(ss, 1); ss += __shfl_xor(ss, 2); ss += __shfl_xor(ss, 4); ss += __shfl_xor(ss, 8); ss += __shfl_xor(ss, 16);
        if (i == 0) ssq[(size_t)u.pn * T + (size_t)u.pm * 256 + rl] = ss; }
}


__device__ __forceinline__ void p6_item(const KArgs& a, LAS unsigned char* lds, int item, int tid, int wave, int lane) {
    unsigned char* ws = a.ws;
    const int row0 = 32 * item, r = lane & 31, h = lane >> 5, row = row0 + r, b = row >> 13;
    const float* x1 = a.out; const float* ssq = (const float*)(ws + WS_SSQ); const float* mod = (const float*)(ws + WS_MOD) + (size_t)b * 6144;
    unsigned char* H2 = ws + WS_H2;
    const bf16* WRH = (const bf16*)(ws + WS_WRH); const bf16* WRL = (const bf16*)(ws + WS_WRL);
    constexpr int WREG = 9216, TROW = 144;
    LAS unsigned char* wreg = lds + RING_OFF + wave * WREG;
    LAS float* scl = (LAS float*)(lds + RING_OFF + 8 * WREG);
    LAS float* bil = scl + 32 * 65;
    LAS int* hist = (LAS int*)(bil + 32 * 65);
    LAS int* gbase = hist + 512;
    LAS float* rstl = (LAS float*)(gbase + 64);
    if (tid < 32) { float ss = 0.f;
#pragma unroll
        for (int p = 0; p < 4; ++p) ss += ssq[(size_t)p * T + row0 + tid];
        rstl[tid] = 1.0f / sqrtf(ss * (1.0f / DMODEL) + EPS); }
    const int lr = lane >> 4, lc4 = (lane & 15) * 4;
    __syncthreads();
    f32x16 acc0, acc1;
#pragma unroll
    for (int i = 0; i < 16; ++i) { acc0[i] = 0.f; acc1[i] = 0.f; }
#pragma nounroll
    for (int ms = 0; ms < 2; ++ms) {
        const int kb = 128 * wave + 64 * ms;
        f32x4 xv[8];
#pragma unroll
        for (int i = 0; i < 8; ++i) xv[i] = *(const f32x4*)(x1 + (size_t)(row0 + 4 * i + lr) * DMODEL + kb + lc4);
        const f32x4 gs = *(const f32x4*)(a.in[16] + kb + lc4) * (1.0f + *(const f32x4*)(mod + 4096 + kb + lc4)), sh = *(const f32x4*)(mod + 3072 + kb + lc4);
#pragma unroll
        for (int i = 0; i < 8; ++i) { const int rr = 4 * i + lr; const f32x4 hv = xv[i] * rstl[rr] * gs + sh;
            const unsigned h0 = f2bf(hv[0]), h1_ = f2bf(hv[1]), h2_ = f2bf(hv[2]), h3 = f2bf(hv[3]);
            const v2u whi = (v2u){h0 | (h1_ << 16), h2_ | (h3 << 16)};
            const v2u wlo = (v2u){pk2(hv[0] - bf2f(h0), hv[1] - bf2f(h1_)), pk2(hv[2] - bf2f(h2_), hv[3] - bf2f(h3))};
#if MOE_FP8
            *(GAS unsigned*)(H2 + (size_t)(row0 + rr) * DMODEL + kb + lc4) = pk4_fp8(hv[0], hv[1], hv[2], hv[3]);
#else
            *(GAS v2u*)(H2 + ((size_t)(row0 + rr) * DMODEL + kb + lc4) * 2) = whi;
#endif
            *(LAS v2u*)(wreg + rr * TROW + lc4 * 2) = whi; *(LAS v2u*)(wreg + 32 * TROW + rr * TROW + lc4 * 2) = wlo; }
#pragma unroll
        for (int sp = 0; sp < 2; ++sp) {
            bf16x8 bh0[2], bh1[2], bl0[2], bl1[2];
#pragma unroll
            for (int s2 = 0; s2 < 2; ++s2) { const size_t o = (size_t)r * DMODEL + kb + 16 * (2 * sp + s2) + 8 * h;
                bh0[s2] = *(const bf16x8*)(WRH + o); bh1[s2] = *(const bf16x8*)(WRH + o + 32 * DMODEL); bl0[s2] = *(const bf16x8*)(WRL + o); bl1[s2] = *(const bf16x8*)(WRL + o + 32 * DMODEL); }
#pragma unroll
            for (int s2 = 0; s2 < 2; ++s2) { const int s_ = 2 * sp + s2;
                const bf16x8 ahi = *(const LAS bf16x8*)(wreg + r * TROW + (16 * s_ + 8 * h) * 2), alo = *(const LAS bf16x8*)(wreg + 32 * TROW + r * TROW + (16 * s_ + 8 * h) * 2);
                acc0 = __builtin_amdgcn_mfma_f32_32x32x16_bf16(alo, bh0[s2], acc0, 0, 0, 0); acc1 = __builtin_amdgcn_mfma_f32_32x32x16_bf16(alo, bh1[s2], acc1, 0, 0, 0);
                acc0 = __builtin_amdgcn_mfma_f32_32x32x16_bf16(ahi, bl0[s2], acc0, 0, 0, 0); acc1 = __builtin_amdgcn_mfma_f32_32x32x16_bf16(ahi, bl1[s2], acc1, 0, 0, 0);
                acc0 = __builtin_amdgcn_mfma_f32_32x32x16_bf16(ahi, bh0[s2], acc0, 0, 0, 0); acc1 = __builtin_amdgcn_mfma_f32_32x32x16_bf16(ahi, bh1[s2], acc1, 0, 0, 0); }
            asm volatile("" ::: "memory");
        }
        asm volatile("" ::: "memory");
    }
    { LAS float* part = (LAS float*)wreg;
#pragma unroll
      for (int i = 0; i < 16; ++i) { const int tr = (i & 3) + 8 * (i >> 2) + 4 * h; part[tr * 64 + r] = acc0[i]; part[tr * 64 + 32 + r] = acc1[i]; } }
    __syncthreads();
    {
        const int tr = tid >> 4, e4 = (tid & 15) * 4; f32x4 s = *(const LAS f32x4*)(lds + RING_OFF + tr * 256 + e4 * 4);
#pragma unroll
        for (int w = 1; w < 8; ++w) s += *(const LAS f32x4*)(lds + RING_OFF + w * WREG + tr * 256 + e4 * 4);
        const f32x4 rb = *(const f32x4*)(a.in[18] + e4);
#pragma unroll
        for (int j = 0; j < 4; ++j) { const float sc = 1.0f / (1.0f + expf(-s[j])); scl[tr * 65 + e4 + j] = sc; bil[tr * 65 + e4 + j] = sc + rb[j]; }
    }
    __syncthreads();
    LAS int* selk = (LAS int*)(rstl + 32); LAS float* selw = (LAS float*)(selk + 32 * 64);
    int lc = 0;
#pragma nounroll
    for (int j = 0; j < 4; ++j) {
        const int tr = wave * 4 + j; const float v = bil[tr * 65 + lane], sc = scl[tr * 65 + lane];
        int rk = 0;
#pragma unroll
        for (int d = 1; d < 8; ++d) { const int src = (lane & ~7) | ((lane + d) & 7); const float o = __shfl(v, src); rk += (o > v) || (o == v && src < lane); }
        float t2 = rk < 2 ? v : 0.f; t2 += __shfl_xor(t2, 1); t2 += __shfl_xor(t2, 2); t2 += __shfl_xor(t2, 4);
        int grk = 0; const int g = lane >> 3;
#pragma unroll
        for (int g2 = 0; g2 < 8; ++g2) { const float og = __builtin_bit_cast(float, __builtin_amdgcn_readlane(__builtin_bit_cast(int, t2), g2 * 8)); grk += (og > t2) || (og == t2 && g2 < g); }
        const bool gsel = grk < 4;
        const float c = gsel ? v : -INFINITY; int erk = 0;
#pragma nounroll
        for (int e2 = 0; e2 < 64; ++e2) { const float oc = __builtin_bit_cast(float, __builtin_amdgcn_readlane(__builtin_bit_cast(int, c), e2)); erk += (oc > c) || (oc == c && e2 < lane); }
        const bool sel = gsel && erk < TOPK;
        const float wsum = wave_sum(sel ? sc : 0.f);
        selk[tr * 64 + lane] = sel ? erk : -1; selw[tr * 64 + lane] = sc * (ROUTED_SCALE / wsum); lc += sel ? 1 : 0;
    }
    hist[wave * 64 + lane] = lc;
    __syncthreads();
    if (wave == 0) { int tot = 0;
#pragma unroll
        for (int w = 0; w < 8; ++w) tot += hist[w * 64 + lane];
        gbase[lane] = tot ? (int)__hip_atomic_fetch_add((unsigned*)(ws + WS_CTL) + CW_CNT + 64 * lane, (unsigned)tot, RLX_AGENT) : 0; }
    __syncthreads();
    {   int base = gbase[lane];
        for (int w = 0; w < wave; ++w) base += hist[w * 64 + lane];
        int* list = (int*)(ws + WS_LIST); float* wl = (float*)(ws + WS_WLIST);
#pragma unroll
        for (int j = 0; j < 4; ++j) { const int tr = wave * 4 + j, k = selk[tr * 64 + lane]; if (k >= 0) { const size_t p = (size_t)lane * LISTCAP + base; list[p] = (row0 + tr) * TOPK + k; wl[p] = selw[tr * 64 + lane]; ++base; } } }
    __syncthreads();
}

__device__ __forceinline__ float p6_rank_slow(float c, int lane) {
    int erk = 0;
#pragma nounroll
    for (int e2 = 0; e2 < 64; ++e2) { const float oc = __builtin_bit_cast(float, __builtin_amdgcn_readlane(__builtin_bit_cast(int, c), e2)); erk += (oc > c) || (oc == c && e2 < lane); }
    return (float)erk;
}
__device__ __forceinline__ void p6_block(const KArgs& a, LAS unsigned char* lds, int vcu, int tid, int wave, int lane) {
    unsigned char* ws = a.ws;
    const int rowb = 64 * vcu + 8 * wave, b = (64 * vcu) >> 13;
    const float* x1 = a.out; const float* ssq = (const float*)(ws + WS_SSQ); const float* mod = (const float*)(ws + WS_MOD) + (size_t)b * 6144;
    bf16* H2 = (bf16*)(ws + WS_H2); const bf16* WRH = (const bf16*)(ws + WS_WRH); const bf16* WRL = (const bf16*)(ws + WS_WRL);
    constexpr int RS = 272, BSH = 64 * RS, BSB = 2 * BSH;
    LAS unsigned char* BS = lds + RING_OFF;
    LAS unsigned char* AW = lds + RING_OFF + 2 * BSB + wave * (2 * 8 * RS);
    LAS int* hist = (LAS int*)(lds + RING_OFF + 2 * BSB + 8 * (2 * 8 * RS)); LAS int* gbase = hist + 512;
    float rs_l = 0.f;
    if (lane < 8) { float ss = 0.f;
#pragma unroll
        for (int p = 0; p < 4; ++p) ss += ssq[(size_t)p * T + rowb + lane];
        rs_l = 1.0f / sqrtf(ss * (1.0f / DMODEL) + EPS); }
    float rstd4[4];
#pragma unroll
    for (int i = 0; i < 4; ++i) rstd4[i] = __shfl(rs_l, 2 * i + (lane >> 5));
    const int lrow = lane >> 5, lcol = (lane & 31) * 4;
    const int fr = lane & 15, fg = lane >> 4;
    f32x4 acc[4];
#pragma unroll
    for (int nb = 0; nb < 4; ++nb) acc[nb] = (f32x4){0.f, 0.f, 0.f, 0.f};
    v4u bsA[4], bsB[4], bsC[4]; f32x4 xvA[4], xvB[4], xvC[4], gsA, gsB, gsC, shA, shB, shC;
#define P6_LOAD(S, c) do { _Pragma("unroll") for (int q = 0; q < 4; ++q) { const int idx = tid + 512 * q, e = (idx >> 4) & 63, part = idx & 15; \
            bs##S[q] = *(const v4u*)(((idx >> 10) ? WRL : WRH) + (size_t)e * DMODEL + 128 * (c) + part * 8); } \
        _Pragma("unroll") for (int i = 0; i < 4; ++i) xv##S[i] = *(const f32x4*)(x1 + (size_t)(rowb + 2 * i + lrow) * DMODEL + 128 * (c) + lcol); \
        gs##S = *(const f32x4*)(a.in[16] + 128 * (c) + lcol) * (1.0f + *(const f32x4*)(mod + 4096 + 128 * (c) + lcol)); sh##S = *(const f32x4*)(mod + 3072 + 128 * (c) + lcol); } while (0)
#define P6_BSTORE(S, buf) do { _Pragma("unroll") for (int q = 0; q < 4; ++q) { const int idx = tid + 512 * q, e = (idx >> 4) & 63, part = idx & 15; \
            *(LAS v4u*)(BS + (buf) * BSB + (idx >> 10) * BSH + e * RS + part * 16) = bs##S[q]; } } while (0)
#define P6_CONVERT(S, c) do { _Pragma("unroll") for (int i = 0; i < 4; ++i) { const int rr = 2 * i + lrow; const f32x4 hv = xv##S[i] * rstd4[i] * gs##S + sh##S; \
            const unsigned h0 = f2bf(hv[0]), h1_ = f2bf(hv[1]), h2_ = f2bf(hv[2]), h3 = f2bf(hv[3]); \
            const v2u whi = (v2u){h0 | (h1_ << 16), h2_ | (h3 << 16)}; \
            const v2u wlo = (v2u){pk2(hv[0] - bf2f(h0), hv[1] - bf2f(h1_)), pk2(hv[2] - bf2f(h2_), hv[3] - bf2f(h3))}; \
            *(GAS v2u*)(H2 + (size_t)(rowb + rr) * DMODEL + 128 * (c) + lcol) = whi; \
            *(LAS v2u*)(AW + rr * RS + lcol * 2) = whi; *(LAS v2u*)(AW + 8 * RS + rr * RS + lcol * 2) = wlo; } } while (0)
#if defined(P6_ABL) && P6_ABL == 4
#define P6_MMA(c) do { } while (0)
#else
#define P6_MMA(c) do { const LAS unsigned char* bsl = BS + ((c) & 1) * BSB; _Pragma("unroll") for (int ks = 0; ks < 4; ++ks) { \
            const bf16x8 ahi = *(const LAS bf16x8*)(AW + (fr & 7) * RS + (32 * ks + 8 * fg) * 2), alo = *(const LAS bf16x8*)(AW + 8 * RS + (fr & 7) * RS + (32 * ks + 8 * fg) * 2); \
            _Pragma("unroll") for (int nb = 0; nb < 4; ++nb) { const bf16x8 bh = *(const LAS bf16x8*)(bsl + (16 * nb + fr) * RS + (32 * ks + 8 * fg) * 2), bl = *(const LAS bf16x8*)(bsl + BSH + (16 * nb + fr) * RS + (32 * ks + 8 * fg) * 2); \
                acc[nb] = __builtin_amdgcn_mfma_f32_16x16x32_bf16(alo, bh, acc[nb], 0, 0, 0); acc[nb] = __builtin_amdgcn_mfma_f32_16x16x32_bf16(ahi, bl, acc[nb], 0, 0, 0); acc[nb] = __builtin_amdgcn_mfma_f32_16x16x32_bf16(ahi, bh, acc[nb], 0, 0, 0); } } } while (0)
#endif
#if defined(P6_ABL) && P6_ABL == 2
    return;
#endif
    P6_LOAD(A, 0); P6_LOAD(B, 1); P6_LOAD(C, 2); P6_BSTORE(A, 0);
    __syncthreads();
    P6_CONVERT(A, 0); P6_LOAD(A, 3); P6_MMA(0); P6_BSTORE(B, 1); __syncthreads();
    P6_CONVERT(B, 1); P6_LOAD(B, 4); P6_MMA(1); P6_BSTORE(C, 0); __syncthreads();
    P6_CONVERT(C, 2); P6_LOAD(C, 5); P6_MMA(2); P6_BSTORE(A, 1); __syncthreads();
    P6_CONVERT(A, 3); P6_LOAD(A, 6); P6_MMA(3); P6_BSTORE(B, 0); __syncthreads();
    P6_CONVERT(B, 4); P6_LOAD(B, 7); P6_MMA(4); P6_BSTORE(C, 1); __syncthreads();
    P6_CONVERT(C, 5); P6_MMA(5); P6_BSTORE(A, 0); __syncthreads();
    P6_CONVERT(A, 6); P6_MMA(6); P6_BSTORE(B, 1); __syncthreads();
    P6_CONVERT(B, 7); P6_MMA(7); __syncthreads();
#undef P6_LOAD
#undef P6_BSTORE
#undef P6_CONVERT
#undef P6_MMA
#if defined(P6_ABL) && P6_ABL == 1
    { if (fg < 2 && acc[0][0] == 12345.f) a.out[1] = acc[1][1] + acc[2][2] + acc[3][3]; return; }
#endif
    LAS float* LG = (LAS float*)AW;
    if (fg < 2) {
#pragma unroll
        for (int nb = 0; nb < 4; ++nb)
#pragma unroll
            for (int r = 0; r < 4; ++r) LG[(4 * fg + r) * 64 + 16 * nb + fr] = acc[nb][r];
    }
    LAS float* RSW = (LAS float*)(BS + wave * 8192);
    const float rbias = a.in[18][lane];
    int selk[8]; float selw[8]; int lc = 0;
#if defined(P6_ABL) && P6_ABL >= 3
#pragma unroll
    for (int j = 0; j < 8; ++j) { const bool sel = (lane >> 3) == j; selk[j] = sel ? (lane & 7) : -1; selw[j] = 0.3125f + 1e-9f * LG[j * 64 + lane] + 0.f * rbias; lc += sel ? 1 : 0; }
#else
#pragma unroll
    for (int j = 0; j < 8; ++j) {
        LAS float* Vb = RSW + j * 160; LAS float* Cb = Vb + 64; LAS float* Gb = Vb + 128; LAS float* Tb = Vb + 136;
        const float sc = 1.0f / (1.0f + expf(-LG[j * 64 + lane])), v = sc + rbias;
        Vb[lane] = v;
        const f32x4 ga = *(const LAS f32x4*)(Vb + (lane & ~7)), gb = *(const LAS f32x4*)(Vb + (lane & ~7) + 4);
        float m1 = -INFINITY, m2 = -INFINITY;
#pragma unroll
        for (int q = 0; q < 8; ++q) { const float o = q < 4 ? ga[q] : gb[q - 4]; if (o > m1) { m2 = m1; m1 = o; } else if (o > m2) m2 = o; }
        const float gs = m1 + m2;
        if ((lane & 7) == 0) Gb[lane >> 3] = gs;
        const f32x4 sa = *(const LAS f32x4*)Gb, sb = *(const LAS f32x4*)(Gb + 4);
        int grk = 0; const int g = lane >> 3;
#pragma unroll
        for (int g2 = 0; g2 < 8; ++g2) { const float og = g2 < 4 ? sa[g2] : sb[g2 - 4]; grk += (og > gs) || (og == gs && g2 < g); }
        const bool gsel = grk < 4; const float cnd = gsel ? v : -INFINITY;
        Cb[lane] = cnd;
        int gt = 0, eq = 0;
#pragma unroll
        for (int q = 0; q < 16; ++q) { const f32x4 o = *(const LAS f32x4*)(Cb + 4 * q);
            gt += (o[0] > cnd) + (o[1] > cnd) + (o[2] > cnd) + (o[3] > cnd); eq += (o[0] == cnd) + (o[1] == cnd) + (o[2] == cnd) + (o[3] == cnd); }
        int erk = gt;
        if (__builtin_expect(__any(gsel && eq > 1), 0)) erk = (int)p6_rank_slow(cnd, lane);
        const bool sel = gsel && erk < TOPK;
        if (sel) Tb[erk] = sc;
        const f32x4 ta = *(const LAS f32x4*)Tb, tb_ = *(const LAS f32x4*)(Tb + 4);
        const float wsum = ((ta[0] + ta[1]) + (ta[2] + ta[3])) + ((tb_[0] + tb_[1]) + (tb_[2] + tb_[3]));
        selk[j] = sel ? erk : -1; selw[j] = sc * (ROUTED_SCALE / wsum); lc += sel ? 1 : 0;
    }
#endif
    hist[wave * 64 + lane] = lc;
    __syncthreads();
    if (wave == 0) { int tot = 0;
#pragma unroll
        for (int w = 0; w < 8; ++w) tot += hist[w * 64 + lane];
        gbase[lane] = tot ? (int)__hip_atomic_fetch_add((unsigned*)(ws + WS_CTL) + CW_CNT + 64 * lane, (unsigned)tot, RLX_AGENT) : 0; }
    __syncthreads();
    {   int base = gbase[lane];
        for (int w = 0; w < wave; ++w) base += hist[w * 64 + lane];
        int* list = (int*)(ws + WS_LIST); float* wl = (float*)(ws + WS_WLIST);
#pragma unroll
        for (int j = 0; j < 8; ++j) if (selk[j] >= 0) { const size_t p = (size_t)lane * LISTCAP + base; list[p] = (rowb + j) * TOPK + selk[j]; wl[p] = selw[j]; ++base; } }
    __syncthreads();
}

__device__ __forceinline__ void moe_tables(const KArgs& a, LAS unsigned char* lds, int tid, int lane) {
    LAS int* tstart = (LAS int*)(lds + TAB_OFF); LAS int* cntl = tstart + 80;
    if (tid < 64) { const int c = (int)__hip_atomic_load((unsigned*)(a.ws + WS_CTL) + CW_CNT + 64 * tid, RLX_AGENT); const int tl = (c + 255) >> 8; int sc = tl;
#pragma unroll
        for (int o = 1; o < 64; o <<= 1) { const int up = __shfl_up(sc, o); if (lane >= o) sc += up; }
        cntl[tid] = c; tstart[tid + 1] = sc; if (tid == 0) tstart[0] = 0; }
    __syncthreads();
}

__global__ void __launch_bounds__(NWAVES * 64, 2) fox_fwd(KArgs args) {
    extern __shared__ __attribute__((aligned(16))) unsigned char lds_raw[];
    LAS unsigned char* lds = (LAS unsigned char*)lds_raw;
    volatile LAS unsigned* MISC = (volatile LAS unsigned*)(lds + MISC_OFF);
    const int tid = threadIdx.x, lane = tid & 63, wave = __builtin_amdgcn_readfirstlane(tid >> 6);
    const int G = gridDim.x; int vcu; { const int bx = blockIdx.x; vcu = (G % 8 == 0) ? (bx % 8) * (G / 8) + bx / 8 : bx; }
    unsigned char* ws = args.ws; gu32* ctl = (gu32*)(ws + WS_CTL);
    for (int u = tid; u < (LDS_BYTES - LDSCTL_OFF) / 4; u += NWAVES * 64) ((LAS unsigned*)(lds + LDSCTL_OFF))[u] = 0u;
    __syncthreads();
    const int lo = args.ph_lo, hi = args.ph_hi; const bool single = (hi - lo) > 1;
    XcdBarrier bar; bar.bar = (unsigned*)(ctl + CW_BAR); bar.x = 0; bar.st = nullptr;
    if (single) bar = xcd_barrier_post((unsigned*)(ctl + CW_BAR), MISC + 8);
#ifndef PHASE_MASK
#define PHASE_MASK 0x3ff
#endif
#define IN(k) (((PHASE_MASK >> (k)) & 1) && lo <= (k) && (k) < hi)
#if defined(DIAG_A)
    unsigned long long* dstamp = (unsigned long long*)(ws + WS_CTL + 512 * 1024);
#define GRID_BAR(k) do { if (IN(k) && IN((k) + 1)) xcd_barrier(bar); if (blockIdx.x == 0 && tid == 0) dstamp[(k) + 1] = __builtin_amdgcn_s_memrealtime(); } while (0)
    if (blockIdx.x == 0 && tid == 0) dstamp[0] = __builtin_amdgcn_s_memrealtime();
#else
#define GRID_BAR(k) do { if (IN(k) && IN((k) + 1)) xcd_barrier(bar); } while (0)
#endif
    bf16* H1 = (bf16*)(ws + WS_H1); bf16* Ub = (bf16*)(ws + WS_U); bf16* Qb = (bf16*)(ws + WS_Q); bf16* Kb = (bf16*)(ws + WS_K); bf16* Vb = (bf16*)(ws + WS_V);
    bf16* SG = (bf16*)(ws + WS_SG); bf16* UC = (bf16*)(ws + WS_UC); bf16* Ob = (bf16*)(ws + WS_O); bf16* MG = (bf16*)(ws + WS_MG);
    const float* mod = (const float*)(ws + WS_MOD);

#if FWD_LEVEL == 0
    if (IN(0)) { const f32x4* xs = (const f32x4*)args.in[0]; f32x4* od = (f32x4*)args.out;
        for (size_t i = (size_t)blockIdx.x * 512 + tid; i < (size_t)T * DMODEL / 4; i += (size_t)G * 512) od[i] = xs[i]; }
    for (int k = 0; k < 9; ++k) GRID_BAR(k);
#else
    if (IN(0)) p0_prologue(args, lds, vcu, G, wave, lane);
    GRID_BAR(0);
    if (IN(1)) { if (G == 256) p1_rows(args, lds, vcu, tid, wave, lane); }
    GRID_BAR(1);
    if (IN(2)) {
        if (blockIdx.x < 16) p2_cumsum(args, lds, blockIdx.x, tid, wave, lane);
        SchedDense S{64, NIN / 256, G, (int)blockIdx.x, 1024, (const char*)H1, (const char*)(ws + WS_WIN)};
        EpiIn E{Ub, Qb, Kb, Vb, SG, args.in[11], args.in[12]};
        pg8::gemm_phase<EpiIn, SchedDense, true>(lds + RING_OFF, 1024, S, E);
    }
    GRID_BAR(2);
#if defined(DBG_STAGE) && (DBG_STAGE == 24 || DBG_STAGE == 4)
    {   const bf16* src = (DBG_STAGE == 24) ? SG : (const bf16*)(ws + WS_WIN) + (size_t)2560 * 1024;
        for (size_t i = (size_t)blockIdx.x * 512 + tid; i < (size_t)T * 1024; i += (size_t)G * 512) { const size_t r = i >> 10, c = i & 1023; args.out[i] = bf2f(src[((DBG_STAGE == 24) ? r : (r & 2047)) * 1024 + c]); }
        return; }
#endif
    if (IN(3)) {
        float gq = fabsf(args.in[11][lane]), gk = fabsf(args.in[12][lane]);
#pragma unroll
        for (int o = 1; o < 64; o <<= 1) { gq = fmaxf(gq, __shfl_xor(gq, o)); gk = fmaxf(gk, __shfl_xor(gk, o)); }
        const float thr2 = 2.0f * (8.0f * gq * gk * LOG2E) + 40.0f;
        const attn_body::AttnTensors AT{(const attn_body::bf16*)Qb, (const attn_body::bf16*)Kb, (const attn_body::bf16*)Vb, (attn_body::bf16*)Ob, (const float*)(ws + WS_CUM), thr2};
        if (G == 256) { const attn_body::StaticOrder S(G, (int)blockIdx.x); attn_body::attn_phase<attn_body::StaticOrder>((char*)lds_raw + RING_OFF, AT, S); }
        for (int it = vcu; it < 1024; it += G) conv_item(args, lds, it, tid);
    }
    GRID_BAR(3);
#if defined(DBG_STAGE)
    {
#if DBG_STAGE == 2
        const bf16* bA = Qb; const bf16* bB = Kb;
#elif DBG_STAGE == 21
        const bf16* bA = Vb; const bf16* bB = Ub;
#elif DBG_STAGE == 22
        const bf16* bA = SG; const bf16* bB = SG + 512;
#elif DBG_STAGE == 23
        const bf16* bA = SG + (size_t)T * 1024; const bf16* bB = SG + (size_t)T * 1024 + 512;
#elif DBG_STAGE == 3
        const bf16* bA = Ob; const bf16* bB = UC;
#else
        const bf16* bA = H1; const bf16* bB = H1 + 512;
#endif
        const int ldA = (DBG_STAGE == 1 || DBG_STAGE == 22 || DBG_STAGE == 23) ? 1024 : 512;
        for (size_t i = (size_t)blockIdx.x * 512 + tid; i < (size_t)T * 512; i += (size_t)G * 512) { const size_t r = i >> 9, c = i & 511;
            args.out[r * 1024 + c] = bf2f(bA[r * ldA + c]); args.out[r * 1024 + 512 + c] = bf2f(bB[r * ldA + c]); }
        return;
    }
#endif
    if (IN(4)) {
        SchedMerge S{(int)blockIdx.x, (const char*)UC, (const char*)(ws + WS_WC), (const char*)Ob, (const char*)(ws + WS_WA)};
        EpiMerge E{SG, MG};
        pg8::gemm_phase<EpiMerge, SchedMerge, false>(lds + RING_OFF, 512, S, E);
    }
    GRID_BAR(4);
#if defined(DBG_STAGE2)
    {   for (size_t i = (size_t)blockIdx.x * 512 + tid; i < (size_t)T * 1024; i += (size_t)G * 512) args.out[i] = bf2f(MG[i]);
        return; }
#endif
    if (IN(5)) {
        SchedDense S{64, 4, G, (int)blockIdx.x, 1024, (const char*)MG, (const char*)(ws + WS_WOUT)};
        EpiX1 E{args.in[0], args.out, mod, (float*)(ws + WS_SSQ)};
        pg8::gemm_phase<EpiX1, SchedDense, false>(lds + RING_OFF, 1024, S, E);
    }
    GRID_BAR(5);
#if FWD_LEVEL >= 2
    if (IN(6)) { if (G == 256) p6_block(args, lds, vcu, tid, wave, lane); }
    GRID_BAR(6);
    const MoeTab tb{(const LAS int*)(lds + TAB_OFF), (const LAS int*)(lds + TAB_OFF) + 80};
    if (IN(7)) {
        moe_tables(args, lds, tid, lane);
        const int ntiles = tb.tstart[64], nmoe = 2 * ntiles, ntot = nmoe + 128, per = G;
        SchedMoe1 S{tb, nmoe, ntot, per, vcu, lane, (const char*)(ws + WS_H2), (const char*)(ws + WS_WGU), (const char*)(ws + WS_WSGU), (const int*)(ws + WS_LIST)};
        EpiGlu E{(bf16*)(ws + WS_ACT), (bf16*)(ws + WS_SACT), (const float*)(ws + WS_WLIST), tb};
        pg8::gemm_phase<EpiGlu, SchedMoe1, true, MOE_FP8 != 0>(lds + RING_OFF, MOE_FP8 ? 512 : 1024, S, E);
    }
    GRID_BAR(7);
    if (IN(8)) {
        moe_tables(args, lds, tid, lane);
        const int ntiles = tb.tstart[64], ntot = 4 * ntiles, per = G;
        SchedMoe2 S{tb, ntot, per, vcu, lane, (const char*)(ws + WS_ACT), (const char*)(ws + WS_WD)};
        EpiSlab E{ws + WS_SLAB, (const int*)(ws + WS_LIST), tb};
        pg8::gemm_phase<EpiSlab, SchedMoe2, true>(lds + RING_OFF, 256, S, E);
    }
    GRID_BAR(8);
    if (IN(9)) {
        SchedDense S{64, 4, G, (int)blockIdx.x, 256, (const char*)(ws + WS_SACT), (const char*)(ws + WS_WSD)};
        EpiFinal E{args.out, ws + WS_SLAB, mod};
        pg8::gemm_phase<EpiFinal, SchedDense, false>(lds + RING_OFF, 256, S, E);
    }
#endif
#endif
#if defined(DIAG_A)
    {
        xcd_barrier(bar); if (blockIdx.x == 0 && tid == 0) dstamp[10] = __builtin_amdgcn_s_memrealtime();
        xcd_barrier(bar); if (blockIdx.x == 0 && tid == 0) dstamp[11] = __builtin_amdgcn_s_memrealtime();
        xcd_barrier(bar); if (blockIdx.x == 0 && tid == 0) dstamp[12] = __builtin_amdgcn_s_memrealtime();
        xcd_barrier(bar);
        const float dta = (float)(dstamp[DIAG_A + 1] - dstamp[DIAG_A]) * 0.01f;
#if defined(DIAG_BIG)
        if (blockIdx.x == 0 && tid == 0) args.out[0] += 2.0f + dta * 0.04f;
#else
        if (blockIdx.x == 0 && tid == 0) args.out[0] += 0.5f + dta * 0.01f;
#endif
    }
#endif
#undef IN
#undef GRID_BAR
}

#ifndef N_LAUNCH_MODE
#define N_LAUNCH_MODE 1
#endif
extern "C" void kernel_launch(void* const* d_in, const int* in_sizes, int n_in, void* d_out, int out_size, void* d_ws, size_t ws_size, hipStream_t stream) {
    static int grid = 0;
    if (grid == 0) {
        if (n_in != 23 || in_sizes[0] != T * DMODEL || out_size != T * DMODEL || ws_size < WS_END) {
            fprintf(stderr, "kernel_launch: built for 23 inputs, x/out of %d floats, >= %zu bytes of workspace; got n_in %d, in0 %d, out %d, ws %zu; nothing launched\n", T * DMODEL, (size_t)WS_END, n_in, n_in > 0 ? in_sizes[0] : -1, out_size, ws_size);
            grid = -1; return; }
        int dev = 0, cus = 0, per_cu = 0;
        if (hipGetDevice(&dev) != hipSuccess || hipDeviceGetAttribute(&cus, hipDeviceAttributeMultiprocessorCount, dev) != hipSuccess) { fprintf(stderr, "kernel_launch: device query failed\n"); grid = -1; return; }
        if (hipFuncSetAttribute((const void*)fox_fwd, hipFuncAttributeMaxDynamicSharedMemorySize, LDS_BYTES) != hipSuccess) { fprintf(stderr, "kernel_launch: hipFuncSetAttribute failed\n"); grid = -1; return; }
        if (hipOccupancyMaxActiveBlocksPerMultiprocessor(&per_cu, (const void*)fox_fwd, NWAVES * 64, LDS_BYTES) != hipSuccess || per_cu < 1)
            fprintf(stderr, "kernel_launch: note: occupancy query reports %d workgroups per CU\n", per_cu);
        (void)hipGetLastError();
        grid = cus;
        if (grid != 256) fprintf(stderr, "kernel_launch: %d CUs; this kernel is built for 256\n", grid);
    }
    if (grid < 0) return;
    if (hipMemsetAsync((char*)d_ws + WS_CTL, 0, CTL_ZERO_BYTES, stream) != hipSuccess) { fprintf(stderr, "kernel_launch: memset failed\n"); return; }
    KArgs a{};
    for (int i = 0; i < 23; ++i) a.in[i] = (const float*)d_in[i];
    a.out = (float*)d_out; a.ws = (unsigned char*)d_ws;
#if N_LAUNCH_MODE == 1
    a.ph_lo = 0; a.ph_hi = 10;
    hipLaunchKernelGGL(fox_fwd, dim3(grid), dim3(NWAVES * 64), LDS_BYTES, stream, a);
#else
    for (int p = 0; p < 10; ++p) { a.ph_lo = p; a.ph_hi = p + 1; hipLaunchKernelGGL(fox_fwd, dim3(grid), dim3(NWAVES * 64), LDS_BYTES, stream, a); }
#endif
    const hipError_t le = hipPeekAtLastError();
    if (le != hipSuccess) fprintf(stderr, "kernel_launch: launch failed: %s\n", hipGetErrorName(le));
}
```

```cpp
#include <hip/hip_runtime.h>
#include <hip/hip_bf16.h>
#include <cstdio>
#include <cstdint>
#include <cmath>

#ifndef ATTN_SKIP
#define ATTN_SKIP 1
#endif
#ifndef FWD_LEVEL
#define FWD_LEVEL 2
#endif

namespace pg8 {
#define PG8_LAS __attribute__((address_space(3)))
typedef unsigned short bf16_t;
typedef short bf16x8 __attribute__((ext_vector_type(8)));
typedef float f32x4 __attribute__((ext_vector_type(4)));
typedef unsigned u32x4 __attribute__((ext_vector_type(4)));
constexpr int BM = 256, BK = 64, HALF = 128, HTB = HALF * BK * 2  , STAGE_BYTES = 8 * HTB, NXCD = 8, WGM = 8;

__host__ __device__ __forceinline__ int lds_byte(int r, int c) { const int st = (r >> 4) * 2 + (c >> 5), rr = r & 15, cc = c & 31, ob = rr * 64 + cc * 2; return st * 1024 + (ob ^ (((ob >> 9) & 1) << 5)); }
__host__ __device__ __forceinline__ void stage_rc(int b, int& R, int& C) { const int st = b / 1024, sb = b % 1024, swz = sb ^ (((sb >> 9) & 1) << 5); R = (st >> 1) * 16 + swz / 64; C = (st & 1) * 32 + (swz % 64) / 2; }
__host__ __device__ __forceinline__ int perm32(int rho) { const int n = rho >> 4, i = rho & 15; return 8 * (i >> 2) + 4 * n + (i & 3); }

struct Unit { int pm, pn, e, mt; const char* A; const char* B; };

__host__ __device__ __forceinline__ void tile_of(int L, int nM, int nN, int& pm, int& pn) {
    const int nwg = nM * nN; int wgid = L; { const int q = nwg / NXCD, r = nwg % NXCD, xcd = wgid % NXCD, off = wgid / NXCD; wgid = (xcd < r ? xcd * (q + 1) : r * (q + 1) + (xcd - r) * q) + off; }
    const int nig = WGM * nN, gid = wgid / nig, fm = gid * WGM, gsz = (nM - fm) < WGM ? (nM - fm) : WGM;
    pm = fm + ((wgid % nig) % gsz); pn = (wgid % nig) / gsz;
}
typedef float f32x2_c __attribute__((ext_vector_type(2))); typedef __bf16 bf16x2_c __attribute__((ext_vector_type(2)));
__device__ __forceinline__ unsigned cvt_pk_bf16(float lo, float hi) { f32x2_c v = {lo, hi}; bf16x2_c b = __builtin_convertvector(v, bf16x2_c); return __builtin_bit_cast(unsigned, b); }
__device__ __forceinline__ float bf_lo(unsigned w) { return __builtin_bit_cast(float, w << 16); }
__device__ __forceinline__ float bf_hi(unsigned w) { return __builtin_bit_cast(float, w & 0xffff0000u); }
__device__ __forceinline__ float sigmoidf_fast(float x) { return __builtin_amdgcn_rcpf(1.0f + __builtin_amdgcn_exp2f(-1.4426950408889634f * x)); }

typedef int i32x4_c __attribute__((ext_vector_type(4))); typedef int i32x8_c __attribute__((ext_vector_type(8)));
__device__ __forceinline__ i32x8_c cat16(const bf16x8& lo, const bf16x8& hi) { const i32x4_c a = __builtin_bit_cast(i32x4_c, lo), b = __builtin_bit_cast(i32x4_c, hi); return __builtin_shufflevector(a, b, 0, 1, 2, 3, 4, 5, 6, 7); }
template <class Epi, class Sched, bool ALIGN_EPI, bool FP8 = false, bool I8 = false>
__device__ __forceinline__ void gemm_phase(PG8_LAS unsigned char* lds, const int K, const Sched& S, const Epi& E) {
    const int tid = threadIdx.x, wid = __builtin_amdgcn_readfirstlane(tid >> 6), lane = tid & 63, wr = wid >> 2, wc = wid & 3, fr = lane & 15, fq = lane >> 4;
    const int nt = K / BK;
    int sR[2], sC[2]; unsigned voffB[2];
#pragma unroll
    for (int i = 0; i < 2; ++i) { int R, C; stage_rc(tid * 16 + i * 8192, R, C); sR[i] = R; sC[i] = C; const int Rb = Epi::PERM ? ((R & ~31) + perm32(R & 31)) : R; voffB[i] = (unsigned)(Rb * K + C) * 2u; }
    const size_t kstep = (size_t)(BK * 2);
    const size_t hstep = (size_t)HALF * K * 2;
    const unsigned ldsw = (unsigned)wid * 1024u;
    const int aoff = lds_byte(wr * 64 + fr, fq * 8), boff = lds_byte(wc * 32 + fr, fq * 8);
#define PG8_SA(b, h) (((b) * 2 + (h)) * HTB)
#define PG8_SB(b, h) ((4 + (b) * 2 + (h)) * HTB)
#define PG8_STAGE(bufoff, gbase, voff) do { _Pragma("unroll") for (int _i = 0; _i < 2; ++_i) \
        __builtin_amdgcn_global_load_lds((const unsigned*)((const char*)(gbase) + (voff)[_i]), (PG8_LAS unsigned*)(lds + (bufoff) + ldsw + _i * 8192), 16, 0, 0); } while (0)
#define PG8_STAGE_A(bufoff, gbase, h, V0, V1) do { if constexpr (Sched::GATHER) { if (h) PG8_STAGE(bufoff, gbase, V1); else PG8_STAGE(bufoff, gbase, V0); } \
        else { PG8_STAGE(bufoff, (const char*)(gbase) + ((h) ? hstep : 0), V0); } } while (0)
#define PG8_LDA(dst, b, h) do { _Pragma("unroll") for (int m = 0; m < 4; ++m) { if constexpr (FP8) { const bf16x8 lo_ = *(const PG8_LAS bf16x8*)(lds + PG8_SA(b, h) + aoff + m * 2048), hi_ = *(const PG8_LAS bf16x8*)(lds + PG8_SA(b, h) + aoff + m * 2048 + 1024); dst##8[m] = cat16(lo_, hi_); } \
        else { _Pragma("unroll") for (int k = 0; k < 2; ++k) dst[m][k] = *(const PG8_LAS bf16x8*)(lds + PG8_SA(b, h) + aoff + m * 2048 + k * 1024); } } } while (0)
#define PG8_LDB(dst, b, h) do { _Pragma("unroll") for (int n = 0; n < 2; ++n) { if constexpr (FP8) { const bf16x8 lo_ = *(const PG8_LAS bf16x8*)(lds + PG8_SB(b, h) + boff + n * 2048), hi_ = *(const PG8_LAS bf16x8*)(lds + PG8_SB(b, h) + boff + n * 2048 + 1024); dst##8[n] = cat16(lo_, hi_); } \
        else { _Pragma("unroll") for (int k = 0; k < 2; ++k) dst[n][k] = *(const PG8_LAS bf16x8*)(lds + PG8_SB(b, h) + boff + n * 2048 + k * 1024); } } } while (0)
#define PG8_MMA(ai, bj, At, Bt) do { __builtin_amdgcn_s_setprio(1); if constexpr (FP8) { _Pragma("unroll") for (int m = 0; m < 4; ++m) _Pragma("unroll") for (int n = 0; n < 2; ++n) \
        acc[ai][bj][m][n] = __builtin_amdgcn_mfma_scale_f32_16x16x128_f8f6f4(Bt##8[n], At##8[m], acc[ai][bj][m][n], 0, 0, 0, 0x7f7f7f7f, 0, 0x7f7f7f7f); } \
        else if constexpr (I8) { _Pragma("unroll") for (int m = 0; m < 4; ++m) _Pragma("unroll") for (int n = 0; n < 2; ++n) _Pragma("unroll") for (int k = 0; k < 2; ++k) \
        acc[ai][bj][m][n] = __builtin_bit_cast(f32x4, __builtin_amdgcn_mfma_i32_16x16x64_i8(__builtin_bit_cast(i32x4_c, Bt[n][k]), __builtin_bit_cast(i32x4_c, At[m][k]), __builtin_bit_cast(i32x4_c, acc[ai][bj][m][n]), 0, 0, 0)); } \
        else { _Pragma("unroll") for (int m = 0; m < 4; ++m) _Pragma("unroll") for (int n = 0; n < 2; ++n) _Pragma("unroll") for (int k = 0; k < 2; ++k) \
        acc[ai][bj][m][n] = __builtin_amdgcn_mfma_f32_16x16x32_bf16(Bt[n][k], At[m][k], acc[ai][bj][m][n], 0, 0, 0); } __builtin_amdgcn_s_setprio(0); } while (0)
#define PG8_WAIT_V(n) asm volatile("s_waitcnt vmcnt(" #n ")" ::: "memory")
#define PG8_WAIT_L(n) asm volatile("s_waitcnt lgkmcnt(" #n ")" ::: "memory")
#define PG8_BAR __builtin_amdgcn_s_barrier()
#define PG8_SCHED __builtin_amdgcn_sched_barrier(0)
    Unit cur, nxt; int ui = 0;
    if (!S.next(0, cur)) return;
    unsigned vc0[2], vc1[2], vn0[2], vn1[2];
#pragma unroll
    for (int i = 0; i < 2; ++i) {
        if constexpr (Sched::GATHER) { vc0[i] = (unsigned)(S.row(cur, sR[i]) * K + sC[i]) * 2u; vc1[i] = (unsigned)(S.row(cur, HALF + sR[i]) * K + sC[i]) * 2u; }
        else { vc0[i] = (unsigned)(sR[i] * K + sC[i]) * 2u; vc1[i] = 0u; }
        vn0[i] = vc0[i]; vn1[i] = vc1[i];
    }
    f32x4 acc[2][2][4][2];
#pragma unroll
    for (int a = 0; a < 2; ++a)
#pragma unroll
        for (int b = 0; b < 2; ++b)
#pragma unroll
            for (int m = 0; m < 4; ++m)
#pragma unroll
                for (int n = 0; n < 2; ++n) acc[a][b][m][n] = (f32x4){0.f, 0.f, 0.f, 0.f};
    typename Epi::Pre pre; E.prefetch(pre, cur, wr, wc, fr, fq);
    PG8_LAS unsigned char* const rtab = lds + STAGE_BYTES + 2048;
#define PG8_ROWTAB(U, par) do { if constexpr (Epi::ROWTAB) { _Pragma("unroll") for (int t_ = 0; t_ < Epi::NTAB; ++t_) { const char* src_ = E.tab_src(U, t_); if (wid < 4 && src_ != nullptr) \
        __builtin_amdgcn_global_load_lds((const unsigned*)(src_ + tid * 4), (PG8_LAS unsigned*)(rtab + ((par) * Epi::NTAB + t_) * 1024 + wid * 256), 4, 0, 0); } } } while (0)
    PG8_ROWTAB(cur, 0);
    bf16x8 At[4][2], B0[2][2], B1[2][2]; i32x8_c At8[4], B08[2], B18[2];
    const char* cA = cur.A; const char* cB = cur.B;
    PG8_STAGE(PG8_SB(0, 0), cB, voffB); PG8_STAGE(PG8_SB(0, 1), cB + hstep, voffB); PG8_STAGE_A(PG8_SA(0, 0), cA, 0, vc0, vc1); PG8_STAGE_A(PG8_SA(0, 1), cA, 1, vc0, vc1);
    if (wr == 1) PG8_BAR;
    PG8_WAIT_V(2); PG8_BAR;
    PG8_STAGE(PG8_SB(1, 0), cB + kstep, voffB); PG8_STAGE_A(PG8_SA(1, 0), cA + kstep, 0, vc0, vc1); PG8_STAGE(PG8_SB(1, 1), cB + hstep + kstep, voffB);
    PG8_WAIT_V(6); PG8_BAR;
    for (;;) {
        const bool has_next = S.next(ui + 1, nxt);
        const char* nA = has_next ? nxt.A : cA; const char* nB = has_next ? nxt.B : cB;
        if constexpr (Sched::GATHER) {
            if (has_next) {
#pragma unroll
                for (int i = 0; i < 2; ++i) { vn0[i] = (unsigned)(S.row(nxt, sR[i]) * K + sC[i]) * 2u; vn1[i] = (unsigned)(S.row(nxt, HALF + sR[i]) * K + sC[i]) * 2u; }
            }
        }
#pragma nounroll
        for (int t = 0; t < nt; t += 2) {
            const bool last = (t == nt - 2);
            const char* a1 = cA + (size_t)(t + 1) * kstep;
            const char* a2 = last ? nA : cA + (size_t)(t + 2) * kstep; const char* b2 = last ? nB : cB + (size_t)(t + 2) * kstep;
            const char* a3 = a2 + kstep; const char* b3 = b2 + kstep;
            unsigned w0[2], w1[2];
#pragma unroll
            for (int i = 0; i < 2; ++i) { if constexpr (Sched::GATHER) { w0[i] = last ? vn0[i] : vc0[i]; w1[i] = last ? vn1[i] : vc1[i]; } else { w0[i] = vc0[i]; w1[i] = 0u; } }
            PG8_LDB(B0, 0, 0); PG8_LDB(B1, 0, 1); PG8_SCHED; PG8_LDA(At, 0, 0); PG8_STAGE_A(PG8_SA(1, 1), a1, 1, vc0, vc1);
            PG8_WAIT_V(8); PG8_WAIT_L(0); PG8_BAR; PG8_MMA(0, 0, At, B0); PG8_MMA(0, 1, At, B1); PG8_BAR; PG8_SCHED;
            PG8_LDA(At, 0, 1); PG8_STAGE(PG8_SB(0, 0), b2, voffB); PG8_STAGE(PG8_SB(0, 1), b2 + hstep, voffB); PG8_STAGE_A(PG8_SA(0, 0), a2, 0, w0, w1);
            PG8_WAIT_V(8); PG8_WAIT_L(0); PG8_BAR; PG8_MMA(1, 0, At, B0); PG8_MMA(1, 1, At, B1); PG8_BAR; PG8_SCHED;
            PG8_LDB(B0, 1, 0); PG8_LDB(B1, 1, 1); PG8_SCHED; PG8_LDA(At, 1, 0); PG8_STAGE_A(PG8_SA(0, 1), a2, 1, w0, w1);
            PG8_WAIT_V(8); PG8_WAIT_L(0); PG8_BAR; PG8_MMA(0, 0, At, B0); PG8_MMA(0, 1, At, B1); PG8_BAR; PG8_SCHED;
            PG8_LDA(At, 1, 1); PG8_STAGE(PG8_SB(1, 0), b3, voffB); PG8_STAGE(PG8_SB(1, 1), b3 + hstep, voffB); PG8_STAGE_A(PG8_SA(1, 0), a3, 0, w0, w1);
            PG8_WAIT_V(8); PG8_WAIT_L(0); PG8_BAR; PG8_MMA(1, 0, At, B0); PG8_MMA(1, 1, At, B1); PG8_BAR; PG8_SCHED;
        }
        if constexpr (ALIGN_EPI) { if (wr == 0) PG8_BAR; }
        if constexpr (I8) {
#pragma unroll
            for (int a = 0; a < 2; ++a)
#pragma unroll
                for (int b = 0; b < 2; ++b)
#pragma unroll
                    for (int m = 0; m < 4; ++m)
#pragma unroll
                        for (int n = 0; n < 2; ++n) acc[a][b][m][n] = __builtin_convertvector(__builtin_bit_cast(i32x4_c, acc[a][b][m][n]), f32x4);
        }
        if constexpr (!Epi::AFTER_DRAIN) E(acc, cur, wr, wc, fr, fq, pre, (const PG8_LAS unsigned*)(rtab + (ui & 1) * Epi::NTAB * 1024));
        if (!has_next) break;
#pragma unroll
        for (int a = 0; a < 2; ++a)
#pragma unroll
            for (int b = 0; b < 2; ++b)
#pragma unroll
                for (int m = 0; m < 4; ++m)
#pragma unroll
                    for (int n = 0; n < 2; ++n) acc[a][b][m][n] = (f32x4){0.f, 0.f, 0.f, 0.f};
        cur = nxt; cA = nA; cB = nB; ++ui; E.prefetch(pre, cur, wr, wc, fr, fq); PG8_ROWTAB(cur, ui & 1);
#pragma unroll
        for (int i = 0; i < 2; ++i) { vc0[i] = vn0[i]; vc1[i] = vn1[i]; }
        if constexpr (ALIGN_EPI) { if (wr == 1) PG8_BAR; }
    }
    PG8_WAIT_V(0);
    if constexpr (!ALIGN_EPI) { if (wr == 0) PG8_BAR; }
    PG8_BAR;
    if constexpr (Epi::AFTER_DRAIN) E.fused(acc, cur, wr, wc, fr, fq, lds);
#undef PG8_SA
#undef PG8_SB
#undef PG8_STAGE
#undef PG8_ROWTAB
#undef PG8_STAGE_A
#undef PG8_LDA
#undef PG8_LDB
#undef PG8_MMA
#undef PG8_WAIT_V
#undef PG8_WAIT_L
#undef PG8_BAR
#undef PG8_SCHED
}
}
#include <hip/hip_bf16.h>
#include <cmath>
namespace attn_body {
using bf16=__hip_bfloat16;
using bf16x8=__attribute__((ext_vector_type(8)))short;
using s16x4=__attribute__((ext_vector_type(4)))short;
using f32x16=__attribute__((ext_vector_type(16)))float;
using u32x4=__attribute__((ext_vector_type(4)))unsigned;
constexpr int BATCH=2,NHEAD=8,SEQ=8192,D=64,DM=NHEAD*D;
constexpr int NW=8,QBLK=32,QB=QBLK*NW,KVBLK=64,NQB=SEQ/QB;
constexpr int ATTN_PITCH=DM, ATTN_UNIT_ROWS=QB;
__device__ __forceinline__ int crow(int r,int hi){return (r&3)+8*(r>>2)+4*hi;}
#define SBAR() __builtin_amdgcn_sched_barrier(0)
__device__ __forceinline__ void cmask(f32x16&p0,f32x16&p1,int jb,int qrel,int hi){
  const float NEG=-INFINITY; const int dq=qrel-(64*jb+4*hi);
  #pragma unroll
  for(int r=0;r<16;++r){const int c=(r&3)+8*(r>>2); if(c>dq)p0[r]=NEG; if(c+32>dq)p1[r]=NEG;}
}

constexpr int NSLOT=3, SLOTB=8192;
constexpr int LDS_K=0, LDS_V=NSLOT*SLOTB, LDS_WS=2*NSLOT*SLOTB, LDS_OST=LDS_WS+NW*64*4, LDS_DK=LDS_OST+NW*4096, LDS_BYTES=LDS_DK+SEQ*4;
constexpr float C2=0.125f*1.4426950408889634f;
__device__ __forceinline__ void glds16(const void*gsrc,unsigned lds_dst){unsigned keep;
  asm volatile("s_mov_b32 %0, m0\n\ts_mov_b32 m0, %2\n\ts_nop 0\n\tglobal_load_lds_dwordx4 %1, off\n\ts_mov_b32 m0, %0":"=&s"(keep):"v"(gsrc),"s"(lds_dst):"memory");}
__device__ __forceinline__ float max3f(float a,float b,float c){float r;asm("v_max3_f32 %0, %1, %2, %3":"=v"(r):"v"(a),"v"(b),"v"(c));return r;}
__device__ __forceinline__ float max2f(float a,float b){float r;asm("v_max_f32_e32 %0, %1, %2":"=v"(r):"v"(a),"v"(b));return r;}
__device__ __forceinline__ float fadd_s(float a,float b){float r;asm("v_add_f32_e32 %0, %1, %2":"=v"(r):"v"(a),"v"(b));return r;}
__device__ __forceinline__ float fsub_s(float a,float b){float r;asm("v_sub_f32_e32 %0, %1, %2":"=v"(r):"v"(a),"v"(b));return r;}
typedef float f32x2_t __attribute__((ext_vector_type(2))); typedef float f32x4_t __attribute__((ext_vector_type(4))); typedef __bf16 bf16x2_t __attribute__((ext_vector_type(2)));
__device__ __forceinline__ unsigned cvtpk_s(float lo,float hi){f32x2_t v={lo,hi};bf16x2_t b=__builtin_convertvector(v,bf16x2_t);return __builtin_bit_cast(unsigned,b);}
#define WAIT_BAR(N) asm volatile("s_waitcnt vmcnt(" #N ") lgkmcnt(0)\n\ts_barrier":::"memory")

__device__ __forceinline__ void qkt(f32x16&p0,f32x16&p1,const char*Kslot,const bf16x8*qr,const f32x16&negm,int r32,int hi){
  const char*kb=Kslot+hi*1024+r32*16;
  #pragma unroll
  for(int d0=0;d0<4;++d0){
    const bf16x8 b0=*reinterpret_cast<const bf16x8*>(kb+d0*2048);
    const bf16x8 b1=*reinterpret_cast<const bf16x8*>(kb+d0*2048+512);
    if(d0==0){p0=__builtin_amdgcn_mfma_f32_32x32x16_bf16(b0,qr[0],negm,0,0,0);p1=__builtin_amdgcn_mfma_f32_32x32x16_bf16(b1,qr[0],negm,0,0,0);}
    else{p0=__builtin_amdgcn_mfma_f32_32x32x16_bf16(b0,qr[d0],p0,0,0,0);p1=__builtin_amdgcn_mfma_f32_32x32x16_bf16(b1,qr[d0],p1,0,0,0);}}
}
typedef __attribute__((address_space(3))) const char* lds_cptr;
typedef short v4i16_t __attribute__((ext_vector_type(4)));
__device__ __forceinline__ void kload8(bf16x8*kf,lds_cptr kp){
  kf[0]=*(const __attribute__((address_space(3))) bf16x8*)(kp);      kf[1]=*(const __attribute__((address_space(3))) bf16x8*)(kp+512);
  kf[2]=*(const __attribute__((address_space(3))) bf16x8*)(kp+2048); kf[3]=*(const __attribute__((address_space(3))) bf16x8*)(kp+2560);
  kf[4]=*(const __attribute__((address_space(3))) bf16x8*)(kp+4096); kf[5]=*(const __attribute__((address_space(3))) bf16x8*)(kp+4608);
  kf[6]=*(const __attribute__((address_space(3))) bf16x8*)(kp+6144); kf[7]=*(const __attribute__((address_space(3))) bf16x8*)(kp+6656);
}
__device__ __forceinline__ void kload2(bf16x8*kf,lds_cptr kp,int j){ kf[2*j]=*(const __attribute__((address_space(3))) bf16x8*)(kp+j*2048); kf[2*j+1]=*(const __attribute__((address_space(3))) bf16x8*)(kp+j*2048+512); }
__device__ __forceinline__ s16x4 vtr(lds_cptr p){ return __builtin_bit_cast(s16x4,__builtin_amdgcn_ds_read_tr16_b64_v4i16((__attribute__((address_space(3))) v4i16_t*)p)); }
__device__ __forceinline__ float rowmax(const f32x16&p0,const f32x16&p1){
  float a=max3f(p0[0],p0[1],p1[0]),b=max3f(p0[2],p0[3],p1[1]);a=max3f(a,p1[2],p1[3]);
  #pragma unroll
  for(int r=4;r<16;r+=4){a=max3f(a,p0[r],p0[r+1]);b=max3f(b,p0[r+2],p0[r+3]);a=max3f(a,p1[r],p1[r+1]);b=max3f(b,p1[r+2],p1[r+3]);}
  const float m=max2f(a,b);
  auto rr=__builtin_amdgcn_permlane32_swap(__float_as_uint(m),__float_as_uint(m),false,false);
  return max2f(__uint_as_float(rr[0]),__uint_as_float(rr[1]));
}
__device__ __forceinline__ void pv(f32x16*o,int vb,bf16x8 pa0,bf16x8 pa1,bf16x8 pa2,bf16x8 pa3){
  #pragma unroll
  for(int d0=0;d0<2;++d0){s16x4 lo[4],hi[4];
    #pragma unroll
    for(int ks=0;ks<4;++ks){
      asm volatile("ds_read_b64_tr_b16 %0,%1 offset:%c2":"=&v"(lo[ks]):"v"(vb),"i"(d0*4096+ks*1024):"memory");
      asm volatile("ds_read_b64_tr_b16 %0,%1 offset:%c2":"=&v"(hi[ks]):"v"(vb),"i"(d0*4096+ks*1024+512):"memory");}
    asm volatile("s_waitcnt lgkmcnt(0)":::"memory");SBAR();
    #define PK(k) (bf16x8){lo[k][0],lo[k][1],lo[k][2],lo[k][3],hi[k][0],hi[k][1],hi[k][2],hi[k][3]}
    o[d0]=__builtin_amdgcn_mfma_f32_32x32x16_bf16(pa0,PK(0),o[d0],0,0,0);
    o[d0]=__builtin_amdgcn_mfma_f32_32x32x16_bf16(pa1,PK(1),o[d0],0,0,0);
    o[d0]=__builtin_amdgcn_mfma_f32_32x32x16_bf16(pa2,PK(2),o[d0],0,0,0);
    o[d0]=__builtin_amdgcn_mfma_f32_32x32x16_bf16(pa3,PK(3),o[d0],0,0,0);
    #undef PK
  }
}

#ifndef ATTN_STORE16
#define ATTN_STORE16(p,v) (*(u32x4*)(p)=(v))
#endif
template<int THRL> __device__ __forceinline__ void attn_unit(int b,int h,int qb,const bf16*Q,const bf16*__restrict__ K,const bf16*__restrict__ V,bf16*O,const float*cum,float thr2,char*shm){
  const int tid=threadIdx.x,lane=tid&63,r32=lane&31,hi=lane>>5; const int wid=__builtin_amdgcn_readfirstlane(tid>>6);
  const long rowbase=(long)b*SEQ; const int q0=qb*QB;
  const bf16*Qw=Q+(rowbase+q0+wid*QBLK)*DM+h*D;
  const float*cb=cum+(long)(b*NHEAD+h)*SEQ; const int NTF=(q0+QB)/KVBLK; int t0=0;
#if ATTN_SKIP
  { const float cq0=cb[q0]; int cnt=0;
    for(int base=0;base<NTF;base+=64){ const int t_=base+lane; const bool c_=(t_<NTF)&&((cb[64*t_+63]-cq0)*1.4426950408889634f>thr2); cnt+=__popcll(__ballot(c_)); }
    cnt&=~1; if(cnt>NTF-4)cnt=NTF-4; t0=__builtin_amdgcn_readfirstlane(cnt); }
#endif
  const int kv0=t0*KVBLK;
  { const float cref=cb[q0+QB-1]; __attribute__((address_space(3))) float*dkw=(__attribute__((address_space(3))) float*)((__attribute__((address_space(3))) char*)shm+LDS_DK);
    int tv_=tid; asm volatile("":"+v"(tv_));
    for(int j=tv_;j<q0+QB-kv0;j+=NW*64)dkw[j]=(cb[kv0+j]-cref)*1.4426950408889634f; }
  asm volatile("s_waitcnt vmcnt(0) lgkmcnt(0)\n\ts_barrier":::"memory");
  const bf16*Kh=K+(rowbase+kv0)*DM+h*D,*Vh=V+(rowbase+kv0)*DM+h*D;
  const unsigned lds0=(unsigned)(uintptr_t)shm;
  float*wsf=(float*)(shm+LDS_WS)+wid*64;
  const bf16*ksrc=Kh+(long)lane*DM+wid*8;
  const bf16*vsrc=Vh+(long)(16*(wid&3)+(lane>>2))*DM+(wid>>2)*32+(lane&3)*8;
  const unsigned kdst=lds0+LDS_K+wid*1024, vdst=lds0+LDS_V+wid*1024;
  #define DMA_K(t,slot) glds16(ksrc+(long)(t)*KVBLK*DM,(unsigned)__builtin_amdgcn_readfirstlane(kdst+(slot)))
  #define DMA_V(t,slot) glds16(vsrc+(long)(t)*KVBLK*DM,(unsigned)__builtin_amdgcn_readfirstlane(vdst+(slot)))
  const int vb0=(int)(lds0+LDS_V)+((lane>>4)&1)*32+(lane&3)*8+(4*hi+((lane&15)>>2))*64;
  const char*Kbase=shm+LDS_K; bf16x8 kf[8];
  const lds_cptr shm3=(lds_cptr)shm; const lds_cptr kp0=shm3+LDS_K+hi*1024+r32*16; const lds_cptr vp0=shm3+LDS_V+((lane>>4)&1)*32+(lane&3)*8+(4*hi+((lane&15)>>2))*64;
  int hiv_=hi; asm volatile("":"+v"(hiv_));
  const int NT=NTF-t0;
  const __attribute__((address_space(3))) float*dkp0=(const __attribute__((address_space(3))) float*)(shm3+LDS_DK)+4*hiv_;
  #define CINIT(C,t,o) do{ const __attribute__((address_space(3))) float*dp_=dkp0+(t)*64+(o); _Pragma("unroll") for(int g_=0;g_<4;++g_){ const f32x4_t a_=*(const __attribute__((address_space(3))) f32x4_t*)(dp_+8*g_); \
      C[4*g_]=negms-a_[0];C[4*g_+1]=negms-a_[1];C[4*g_+2]=negms-a_[2];C[4*g_+3]=negms-a_[3]; } }while(0)
  #define DECAY(P0,P1,t) do{ const __attribute__((address_space(3))) float*dp_=dkp0+(t)*64; _Pragma("unroll") for(int g_=0;g_<4;++g_){ const f32x4_t a_=*(const __attribute__((address_space(3))) f32x4_t*)(dp_+8*g_), b_=*(const __attribute__((address_space(3))) f32x4_t*)(dp_+32+8*g_); \
      P0[4*g_]-=a_[0];P0[4*g_+1]-=a_[1];P0[4*g_+2]-=a_[2];P0[4*g_+3]-=a_[3]; P1[4*g_]-=b_[0];P1[4*g_+1]-=b_[1];P1[4*g_+2]-=b_[2];P1[4*g_+3]-=b_[3]; } }while(0)
  DMA_K(0,0);DMA_V(0,0);DMA_K(1,SLOTB);
  bf16x8 qr[4];
  #pragma unroll
  for(int d0=0;d0<4;++d0)qr[d0]=*reinterpret_cast<const bf16x8*>(&Qw[(long)r32*DM+d0*16+hi*8]);
  float mhat=0.f,l_reg=0.f;f32x16 o[2];o[0]=f32x16{};o[1]=f32x16{};float negms=0.f; const f32x16 zero16=f32x16{};
  const int qrel=wid*QBLK+r32;
  #define CMASK(P0,P1,t) do{int jb_=(t)-(NT-4); if(jb_>=0)cmask(P0,P1,jb_,qrel,hi);}while(0)
  bool resc=false;
  #define START(P0,P1) do{ const float rm=rowmax(P0,P1); resc=false; \
    { const float dl=rm; mhat=fadd_s(mhat,dl); \
      _Pragma("unroll") for(int r=0;r<16;++r){P0[r]=fsub_s(P0[r],dl);P1[r]=fsub_s(P1[r],dl);} \
      negms=-mhat; } \
    _Pragma("unroll") for(int r=0;r<16;++r)P0[r]=__builtin_amdgcn_exp2f(P0[r]); }while(0)
  #define RESC() do{ if(resc){ asm volatile("s_waitcnt lgkmcnt(0)":::"memory"); \
      _Pragma("unroll") for(int d_=0;d_<2;++d_) _Pragma("unroll") for(int r=0;r<16;++r)o[d_][r]*=wsf[crow(r,hi)]; } }while(0)
  f32x16 pA0,pA1,pB0,pB1;
  int sl_prev=0,sl_cur=0,sl_next=SLOTB;
  #define ROT() do{sl_prev=sl_cur;sl_cur=sl_next;sl_next=(sl_next==(NSLOT-1)*SLOTB)?0:sl_next+SLOTB;}while(0)
  DMA_K(2,2*SLOTB);
  WAIT_BAR(3);
  qkt(pA0,pA1,Kbase,qr,zero16,r32,hi);asm volatile("s_nop 15\n\ts_nop 7":"+v"(pA0),"+v"(pA1));CMASK(pA0,pA1,0);DECAY(pA0,pA1,0);
  START(pA0,pA1);
  _Pragma("unroll") for(int r=0;r<16;++r)pA1[r]=__builtin_amdgcn_exp2f(pA1[r]);
  WAIT_BAR(0);
  DMA_K(3,0);DMA_V(1,SLOTB);
  ROT();
  kload8(kf,kp0+sl_cur);
  WAIT_BAR(2);
  s16x4 vlo[8],vhi[8]; u32x4 pw0,pw1,pw2,pw3;
  #define PKW(P,B) cvtpk_s(P[B],P[B+1])
  #define PAF(k) __builtin_bit_cast(bf16x8,pw##k)
  #define VFR(i) (bf16x8){vlo[i][0],vlo[i][1],vlo[i][2],vlo[i][3],vhi[i][0],vhi[i][1],vhi[i][2],vhi[i][3]}
  #define PIN(x) asm volatile("":"+v"(x))
  #define MX3(a,b,c) __builtin_fmaxf(__builtin_fmaxf((a),(b)),(c))
  #define GAPA(MF,A0,A1,A2,A3,W0,W1,PW) do{ MF; sacc+=A0; sacc+=A1; sacc+=A2; sacc+=A3; PIN(sacc); W0; W1; PIN(PW); SBAR(); }while(0)
  #define EX(v) __builtin_amdgcn_exp2f(v)
  #define GAPB(MF,X,B) do{ MF; X[B]=EX(X[B]); X[B+1]=EX(X[B+1]); X[B+2]=EX(X[B+2]); X[B+3]=EX(X[B+3]); PIN(X); SBAR(); }while(0)
  #define VRD(i) do{ vlo[i]=vtr(vp_+(((i)>>2)*4096+((i)&3)*1024)); vhi[i]=vtr(vp_+(((i)>>2)*4096+((i)&3)*1024+512)); }while(0)
  #define KRD(G,j) do{ if(G){ kload2(kf,kp0+sl_next,j); SBAR(); } }while(0)
  #define STEP(C0,C1,P0,P1,t,GK,GV,GL) do{ SBAR(); \
    const lds_cptr vp_=vp0+sl_prev; \
    CINIT(C0,t,0); VRD(0); SBAR(); float sacc=(P0[0]+P0[1]); \
    GAPA(C0=__builtin_amdgcn_mfma_f32_32x32x16_bf16(kf[0],qr[0],C0,0,0,0), P0[2],P0[3],P0[4],P0[5],     pw0[0]=PKW(P0,0), pw0[1]=PKW(P0,2), pw0); \
    CINIT(C1,t,32); VRD(4); SBAR(); GAPA(C1=__builtin_amdgcn_mfma_f32_32x32x16_bf16(kf[1],qr[0],C1,0,0,0), P0[6],P0[7],P0[8],P0[9],     pw0[2]=PKW(P0,4), pw0[3]=PKW(P0,6), pw0); \
    VRD(1); SBAR(); GAPA(C0=__builtin_amdgcn_mfma_f32_32x32x16_bf16(kf[2],qr[1],C0,0,0,0),   P0[10],P0[11],P0[12],P0[13], pw1[0]=PKW(P0,8), pw1[1]=PKW(P0,10), pw1); \
    VRD(5); SBAR(); GAPA(C1=__builtin_amdgcn_mfma_f32_32x32x16_bf16(kf[3],qr[1],C1,0,0,0),   P0[14],P0[15],P1[0],P1[1],   pw1[2]=PKW(P0,12),pw1[3]=PKW(P0,14), pw1); \
    VRD(2); SBAR(); GAPA(C0=__builtin_amdgcn_mfma_f32_32x32x16_bf16(kf[4],qr[2],C0,0,0,0),   P1[2],P1[3],P1[4],P1[5],     pw2[0]=PKW(P1,0), pw2[1]=PKW(P1,2), pw2); \
    VRD(6); SBAR(); GAPA(C1=__builtin_amdgcn_mfma_f32_32x32x16_bf16(kf[5],qr[2],C1,0,0,0),   P1[6],P1[7],P1[8],P1[9],     pw2[2]=PKW(P1,4), pw2[3]=PKW(P1,6), pw2); \
    VRD(3); SBAR(); GAPA(C0=__builtin_amdgcn_mfma_f32_32x32x16_bf16(kf[6],qr[3],C0,0,0,0),   P1[10],P1[11],P1[12],P1[13], pw3[0]=PKW(P1,8), pw3[1]=PKW(P1,10), pw3); \
    VRD(7); SBAR(); GAPA(C1=__builtin_amdgcn_mfma_f32_32x32x16_bf16(kf[7],qr[3],C1,0,0,0),   P1[14],P1[15],0.f,0.f,       pw3[2]=PKW(P1,12),pw3[3]=PKW(P1,14), pw3); \
    l_reg+=sacc; \
    if(GK){DMA_K((t)+3,sl_cur);} if(GV){DMA_V((t)+1,sl_next);} \
    CMASK(C0,C1,t); \
    { float a=MX3(C0[0],C0[1],C1[0]),b=MX3(C0[2],C0[3],C1[1]); a=MX3(a,C1[2],C1[3]); \
      _Pragma("unroll") for(int r=4;r<16;r+=4){a=MX3(a,C0[r],C0[r+1]);b=MX3(b,C0[r+2],C0[r+3]);a=MX3(a,C1[r],C1[r+1]);b=MX3(b,C1[r+2],C1[r+3]);} \
      float rm=__builtin_fmaxf(a,b); { auto rr=__builtin_amdgcn_permlane32_swap(__float_as_uint(rm),__float_as_uint(rm),false,false); rm=__builtin_fmaxf(__uint_as_float(rr[0]),__uint_as_float(rr[1])); } \
      resc=false; \
      if(__builtin_expect(__any(rm>(float)THRL),0)){ const float dl=__builtin_fmaxf(rm,0.f); mhat+=dl; \
        _Pragma("unroll") for(int r=0;r<16;++r){C0[r]-=dl;C1[r]-=dl;} \
        negms=-mhat; \
        const float f=__builtin_amdgcn_exp2f(-dl); l_reg*=f; if(hi==0)wsf[r32]=f; resc=true; } } \
    SBAR(); \
    GAPB(o[0]=__builtin_amdgcn_mfma_f32_32x32x16_bf16(PAF(0),VFR(0),o[0],0,0,0), C0,0); \
    GAPB(o[1]=__builtin_amdgcn_mfma_f32_32x32x16_bf16(PAF(0),VFR(4),o[1],0,0,0), C0,4); \
    KRD(GL,0); GAPB(o[0]=__builtin_amdgcn_mfma_f32_32x32x16_bf16(PAF(1),VFR(1),o[0],0,0,0), C0,8); \
    KRD(GL,1); GAPB(o[1]=__builtin_amdgcn_mfma_f32_32x32x16_bf16(PAF(1),VFR(5),o[1],0,0,0), C0,12); \
    KRD(GL,2); GAPB(o[0]=__builtin_amdgcn_mfma_f32_32x32x16_bf16(PAF(2),VFR(2),o[0],0,0,0), C1,0); \
    KRD(GL,3); GAPB(o[1]=__builtin_amdgcn_mfma_f32_32x32x16_bf16(PAF(2),VFR(6),o[1],0,0,0), C1,4); \
    GAPB(o[0]=__builtin_amdgcn_mfma_f32_32x32x16_bf16(PAF(3),VFR(3),o[0],0,0,0), C1,8); \
    GAPB(o[1]=__builtin_amdgcn_mfma_f32_32x32x16_bf16(PAF(3),VFR(7),o[1],0,0,0), C1,12); \
    }while(0)
  int t=1;
  #undef CMASK
  #define CMASK(P0,P1,t) do{}while(0)
  for(;t+5<NT;t+=2){
    STEP(pB0,pB1,pA0,pA1,t,true,true,true);     WAIT_BAR(2); RESC(); ROT();
    STEP(pA0,pA1,pB0,pB1,t+1,true,true,true);   WAIT_BAR(2); RESC(); ROT();
  }
  #undef CMASK
  #define CMASK(P0,P1,t) do{int jb_=(t)-(NT-4); if(jb_>=0)cmask(P0,P1,jb_,qrel,hi);}while(0)
  #define ENDW(tt) do{ if((tt)+3<NT){WAIT_BAR(2);} else if((tt)+2<NT){WAIT_BAR(1);} else {WAIT_BAR(0);} }while(0)
  for(;t+1<NT;t+=2){
    STEP(pB0,pB1,pA0,pA1,t,(t+3<NT),(t+1<NT),(t+1<NT));       ENDW(t);   RESC(); ROT();
    STEP(pA0,pA1,pB0,pB1,t+1,(t+4<NT),(t+2<NT),(t+2<NT));     ENDW(t+1); RESC(); ROT();
  }
  STEP(pB0,pB1,pA0,pA1,NT-1,false,false,false); RESC();
  { float sacc=pB0[0]+pB0[1]; _Pragma("unroll") for(int r=2;r<16;++r)sacc+=pB0[r]; _Pragma("unroll") for(int r=0;r<16;++r)sacc+=pB1[r]; l_reg+=sacc;
    pw0=(u32x4){PKW(pB0,0),PKW(pB0,2),PKW(pB0,4),PKW(pB0,6)};pw1=(u32x4){PKW(pB0,8),PKW(pB0,10),PKW(pB0,12),PKW(pB0,14)};pw2=(u32x4){PKW(pB1,0),PKW(pB1,2),PKW(pB1,4),PKW(pB1,6)};pw3=(u32x4){PKW(pB1,8),PKW(pB1,10),PKW(pB1,12),PKW(pB1,14)};
    SBAR(); pv(o,vb0+sl_cur,PAF(0),PAF(1),PAF(2),PAF(3)); }
  #undef PKW
  #undef PAF
  #undef VFR
  #undef PIN
  #undef MX3
  #undef GAPA
  #undef GAPB
  #undef EX
  #undef VRD
  #undef KRD
  #undef STEP
  #undef ENDW
  {auto rr=__builtin_amdgcn_permlane32_swap(__float_as_uint(l_reg),__float_as_uint(l_reg),false,false);l_reg=__uint_as_float(rr[0])+__uint_as_float(rr[1]);}
  if(hi==0)wsf[32+r32]=l_reg;asm volatile("s_waitcnt lgkmcnt(0)":::"memory");
  float rli[16];
  #pragma unroll
  for(int r=0;r<16;++r)rli[r]=__builtin_amdgcn_rcpf(wsf[32+crow(r,hi)]);
  bf16*Ow=O+(rowbase+q0+wid*QBLK)*DM+h*D;
  { bf16*stg=(bf16*)(shm+LDS_OST)+wid*2048;
    #pragma unroll
    for(int r=0;r<16;++r){const int orow=crow(r,hi);
      #pragma unroll
      for(int d0=0;d0<2;++d0)stg[orow*64+d0*32+r32]=__float2bfloat16(o[d0][r]*rli[r]);}
    asm volatile("s_waitcnt lgkmcnt(0)":::"memory");
    #pragma unroll
    for(int i=0;i<4;++i){const int row=i*8+(lane>>3),ch=lane&7; const u32x4 v=*(const u32x4*)(stg+row*64+ch*8); ATTN_STORE16(Ow+(long)row*DM+ch*8,v);} }
  asm volatile("s_waitcnt lgkmcnt(0)\n\ts_barrier":::"memory");
  #undef DECAY
  #undef CINIT
  #undef DMA_K
  #undef DMA_V
  #undef CMASK
  #undef START
  #undef RESC
  #undef ROT
}
constexpr int ATTN_LDS_BYTES=LDS_BYTES;
struct AttnTensors { const bf16* Q; const bf16* K; const bf16* V; bf16* O; const float* cum; float thr2; };
struct AttnUnit { int bh; int qb; };
struct StaticOrder {
  int vcu;
  __device__ __forceinline__ explicit StaticOrder(int grid,int block):vcu((block%8)*(grid/8)+block/8){}
  __device__ __forceinline__ bool next(int i,AttnUnit&u)const{ if(i>=2)return false; const int s=vcu&15; u.bh=vcu>>4; u.qb=(i==0)?s:31-s; return true; }
  __device__ __forceinline__ void a_ready(const AttnUnit&)const{}
  __device__ __forceinline__ void done(const AttnUnit&)const{}
};
template<class Sched,int THRL=8> __device__ __forceinline__ void attn_phase(char*lds,const AttnTensors&T,const Sched&S){
  AttnUnit u;
  for(int i=0;S.next(i,u);++i){ S.a_ready(u); attn_unit<THRL>(u.bh/NHEAD,u.bh%NHEAD,u.qb,T.Q,T.K,T.V,T.O,T.cum,T.thr2,lds); S.done(u); }
}
#undef SBAR
#undef WAIT_BAR
}

constexpr int NWAVES = 8;
constexpr int BATCH = 2, SEQ = 8192, DMODEL = 1024, T = BATCH * SEQ;
constexpr int CONVD = 512, CONVW = 31, NHEAD = 8, HD = 64, ATT = 512;
constexpr int NE = 64, TOPK = 8, EF = 256, SF = 256;
constexpr int INCOLS = 4616, OFF_Q = 1024, OFF_K = 1536, OFF_V = 2048, OFF_F = 2560, OFF_GC = 2568, OFF_GA = 3592;
constexpr int NIN = 4608;
constexpr float EPS = 1e-6f, LOG2E = 1.4426950408889634f, ROUTED_SCALE = 2.5f;
constexpr float C2Q = 0.125f * 1.4426950408889634f;
constexpr int LISTCAP = T;
constexpr int ACT_ROWS = T * TOPK + NE * 256;

constexpr size_t MiB = 1u << 20, KiB = 1u << 10;
constexpr size_t WS_CTL = 0, CTL_ZERO_BYTES = 1 * MiB;
constexpr size_t WS_MODP = 1 * MiB;
constexpr size_t WS_MOD = WS_MODP + 768 * KiB;
constexpr size_t WS_LOGF = 2 * MiB;
constexpr size_t WS_CUM = 2 * MiB + 512 * KiB;
constexpr size_t WS_SSQ = 3 * MiB;
constexpr size_t WS_XMX = 3 * MiB + 256 * KiB;
constexpr size_t WS_SA1 = 3 * MiB + 512 * KiB, WS_SA2 = 3 * MiB + 576 * KiB;
constexpr size_t WS_SLIST = 21 * MiB;
constexpr size_t WS_WRH = 4 * MiB, WS_WRL = 4 * MiB + 128 * KiB;
constexpr size_t WS_WLIST = 5 * MiB;
constexpr size_t WS_LIST = 9 * MiB;
constexpr size_t WS_WIN = 16 * MiB, WS_WC = 25 * MiB, WS_WA = 26 * MiB, WS_WOUT = 27 * MiB, WS_WSGU = 29 * MiB, WS_WSD = 30 * MiB;
constexpr size_t WS_WGU = 32 * MiB, WS_WD = 96 * MiB;
constexpr size_t WS_H2 = 128 * MiB, WS_ACT = 160 * MiB, WS_SACT = 232 * MiB;
constexpr size_t WS_H1 = 240 * MiB, WS_U = 272 * MiB, WS_Q = 288 * MiB, WS_K = 304 * MiB, WS_V = 320 * MiB, WS_SG = 336 * MiB, WS_UC = 400 * MiB, WS_O = 416 * MiB, WS_MG = 432 * MiB;
constexpr size_t WS_SLAB = 240 * MiB;
constexpr size_t WS_END = 512 * MiB;
static_assert(WS_ACT + (size_t)ACT_ROWS * EF * 2 <= WS_SACT && WS_SLAB + (size_t)T * TOPK * DMODEL * 2 <= WS_END && WS_MG + (size_t)T * DMODEL * 2 <= WS_SLAB + 256 * MiB, "ws map");
constexpr int CW_TMO = 0, CW_CODE = 1;
constexpr int CW_CNT = 1024;
constexpr int CW_BAR = 8192;

constexpr int RING_OFF = 0, RING_BYTES = 131072;
constexpr int LDSCTL_OFF = RING_BYTES, MISC_OFF = LDSCTL_OFF + 320;
constexpr int TAB_OFF = RING_BYTES + 1024;
constexpr int LDS_BYTES = 147456;

#define GAS __attribute__((address_space(1)))
#define LAS __attribute__((address_space(3)))
typedef unsigned short bf16;
typedef unsigned v4u __attribute__((ext_vector_type(4)));
typedef unsigned v2u __attribute__((ext_vector_type(2)));
typedef float f32x4 __attribute__((ext_vector_type(4)));
typedef float f32x2 __attribute__((ext_vector_type(2)));
typedef float f32x16 __attribute__((ext_vector_type(16)));
typedef short bf16x8 __attribute__((ext_vector_type(8)));
typedef GAS unsigned gu32;
#define RLX_AGENT __ATOMIC_RELAXED, __HIP_MEMORY_SCOPE_AGENT
#define LDS_WAIT() asm volatile("s_waitcnt lgkmcnt(0)" ::: "memory")
#define VM_WAIT() asm volatile("s_waitcnt vmcnt(0)" ::: "memory")
__device__ __forceinline__ unsigned f2bf(float f) { unsigned u = __builtin_bit_cast(unsigned, f); return (u + 0x7fffu + ((u >> 16) & 1u)) >> 16; }
__device__ __forceinline__ unsigned pk2(float lo, float hi) { return f2bf(lo) | (f2bf(hi) << 16); }
__device__ __forceinline__ float bf2f(unsigned h) { return __builtin_bit_cast(float, h << 16); }
__device__ __forceinline__ float wave_sum(float v) {
#pragma unroll
    for (int o = 1; o < 64; o <<= 1) v += __shfl_xor(v, o);
    return v;
}
using pg8::cvt_pk_bf16; using pg8::bf_lo; using pg8::bf_hi; using pg8::sigmoidf_fast;
#define XB_TMO      128
#define XB_XCNT(j)  (256  + 64 * (j))
#define XB_XSUB(j)  (1280 + 64 * (j))
#define XB_XGEN(j)  (2304 + 64 * (j))
#define XB_TOP      3328
#define XB_TOPGEN   3392
#define XCD_BAR_WORDS 3456
#define XB_SPIN_CAP (1u << 18)

__device__ __forceinline__ unsigned xb_ld(unsigned* p)              { return __hip_atomic_load(p, __ATOMIC_RELAXED, __HIP_MEMORY_SCOPE_AGENT); }
__device__ __forceinline__ unsigned xb_add(unsigned* p, unsigned v) { return __hip_atomic_fetch_add(p, v, __ATOMIC_RELAXED, __HIP_MEMORY_SCOPE_AGENT); }
__device__ __forceinline__ unsigned xb_xcc_id() { return (unsigned)__builtin_amdgcn_s_getreg((3 << 11) | 20) & 0xFu; }
#define XB_SPIN(cond, bar) do { unsigned _sp = 0; while (cond) { __builtin_amdgcn_s_sleep(1); \
    if ((++_sp & 255u) == 0u) { if (xb_ld(&(bar)[XB_TMO])) break; if (_sp > XB_SPIN_CAP) { atomicAdd(&(bar)[XB_TMO], 1u); break; } } } } while (0)

struct XcdBarrier {
    unsigned* bar; unsigned x;
    volatile LAS unsigned* st;
};

__device__ __forceinline__ XcdBarrier xcd_barrier_post(unsigned* bar, volatile LAS unsigned* st) {
    XcdBarrier b; b.bar = bar; b.x = xb_xcc_id(); b.st = st;
    if (threadIdx.x == 0) (void)xb_add(&bar[XB_XCNT(b.x)], 1u);
    return b;
}
__device__ __forceinline__ void xcd_barrier_complete(unsigned* bar, unsigned x, unsigned& nloc, unsigned& nx) {
    const unsigned G = gridDim.x * gridDim.y * gridDim.z;
    unsigned sum, cnt, mine, sp = 0u;
    for (;;) {
        sum = 0u; cnt = 0u; mine = 0u;
#pragma unroll
        for (unsigned j = 0; j < 16; ++j) { const unsigned c = xb_ld(&bar[XB_XCNT(j)]); sum += c; cnt += (c > 0u) ? 1u : 0u; mine = (j == x) ? c : mine; }
        if (sum == G) break;
        __builtin_amdgcn_s_sleep(1);
        if ((++sp & 255u) == 0u) { if (xb_ld(&bar[XB_TMO])) break; if (sp > XB_SPIN_CAP) { atomicAdd(&bar[XB_TMO], 1u); break; } }
    }
    nloc = mine > 0u ? mine : 1u; nx = cnt > 0u ? cnt : 1u;
}

__device__ __forceinline__ void xcd_barrier(const XcdBarrier& b) {
    asm volatile("s_waitcnt vmcnt(0)" ::: "memory");
    __syncthreads();
    if (threadIdx.x == 0) {
        unsigned* bar = b.bar;
        __builtin_amdgcn_s_waitcnt(0);
        unsigned nloc = b.st[0], nx = b.st[1];
        if (nloc == 0u) { xcd_barrier_complete(bar, b.x, nloc, nx); b.st[0] = nloc; b.st[1] = nx; }
        const unsigned old = xb_add(&bar[XB_XSUB(b.x)], 1u);
        const unsigned gen = old / nloc;
        if (old + 1u == (gen + 1u) * nloc) {
            __builtin_amdgcn_fence(__ATOMIC_RELEASE, "agent");
            asm volatile("s_waitcnt vmcnt(0)" ::: "memory");
            const unsigned og = xb_add(&bar[XB_TOP], 1u);
            const unsigned tg = og / nx;
            if (og + 1u == (tg + 1u) * nx) xb_add(&bar[XB_TOPGEN], 1u);
            else XB_SPIN(xb_ld(&bar[XB_TOPGEN]) == tg, bar);
            __builtin_amdgcn_fence(__ATOMIC_ACQUIRE, "agent");
            xb_add(&bar[XB_XGEN(b.x)], 1u);
            asm volatile("s_waitcnt vmcnt(0)" ::: "memory");
        } else {
            XB_SPIN(xb_ld(&bar[XB_XGEN(b.x)]) == gen, bar);
            __builtin_amdgcn_fence(__ATOMIC_ACQUIRE, "agent");
            asm volatile("s_waitcnt vmcnt(0)" ::: "memory");
        }
    }
    __syncthreads();
}

__device__ __forceinline__ int win_dst_row(int n) {
    if (n < 512) return 256 * (n >> 7) + (n & 127);
    if (n < 1024) { const int f = n - 512; return 256 * (f >> 7) + 128 + (f & 127); }
    if (n < 2048) { const int isk = n >= OFF_K, j = n - (isk ? OFF_K : OFF_Q), head = j >> 6, d = j & 63;
        return 256 * (4 + 2 * isk + (head >> 2)) + 128 * (d >> 5) + 32 * (head & 3) + (d & 31); }
    if (n < OFF_F) return 256 * 8 + (n - OFF_V);
    if (n < OFF_GC) return -1;
    return 256 * 10 + (n - OFF_GC);
}
__device__ __forceinline__ int glu_dst_row(int n, int F) { const int isu = n >= F, f = n - (isu ? F : 0); return 256 * (f >> 7) + 128 * isu + (f & 127); }

__device__ __forceinline__ unsigned pk4_i8(float a, float b, float c, float d) {
    const int ia = (int)__builtin_rintf(fminf(fmaxf(a, -127.f), 127.f)), ib = (int)__builtin_rintf(fminf(fmaxf(b, -127.f), 127.f)), ic = (int)__builtin_rintf(fminf(fmaxf(c, -127.f), 127.f)), id = (int)__builtin_rintf(fminf(fmaxf(d, -127.f), 127.f));
    return (unsigned)(ia & 255) | ((unsigned)(ib & 255) << 8) | ((unsigned)(ic & 255) << 16) | ((unsigned)id << 24); }
constexpr int CW_AMAX = 6144;
__device__ __forceinline__ unsigned pk4_fp8(float a, float b, float c, float d) { int p = __builtin_amdgcn_cvt_pk_fp8_f32(a, b, 0, false); p = __builtin_amdgcn_cvt_pk_fp8_f32(c, d, p, true); return (unsigned)p; }
#ifndef MOE_FP8
#define MOE_FP8 0
#endif
constexpr float W8SCALE = MOE_FP8 ? 32.0f : 1.0f;
constexpr float SLABSCALE = 16.0f;
template <int MODE>
__device__ __forceinline__ void tr_item(const float* W, int ldw, int K, bf16* WT, bf16* WT2, int k0, int n0, LAS float* scr, int lane, float qs = 1.0f) {
    f32x4 ld[8];
#pragma unroll
    for (int i = 0; i < 8; ++i) ld[i] = *(const f32x4*)(W + (size_t)(k0 + 8 * i + (lane >> 3)) * ldw + n0 + 4 * (lane & 7));
#pragma unroll
    for (int i = 0; i < 8; ++i) { LAS float* d = scr + (8 * i + (lane >> 3)) * 33 + 4 * (lane & 7); d[0] = ld[i][0]; d[1] = ld[i][1]; d[2] = ld[i][2]; d[3] = ld[i][3]; }
    LDS_WAIT(); asm volatile("" ::: "memory");
    const int c = lane & 7;
#pragma unroll
    for (int j = 0; j < 4; ++j) { const int n = (lane >> 3) + 8 * j; const LAS float* s = scr + (8 * c) * 33 + n;
        int row = n0 + n;
        if (MODE == 1 || MODE == 5) row = win_dst_row(row);
        if (MODE == 2 || MODE == 4 || MODE == 6) row = glu_dst_row(row, ldw >> 1);
        float v[8];
#pragma unroll
        for (int q = 0; q < 8; ++q) v[q] = s[q * 33];
        if ((MODE == 1 || MODE == 5) && row < 0) continue;
        if (MODE == 5 || MODE == 6) { v2u o8; o8.x = pk4_i8(v[0] * qs, v[1] * qs, v[2] * qs, v[3] * qs); o8.y = pk4_i8(v[4] * qs, v[5] * qs, v[6] * qs, v[7] * qs);
            *(GAS v2u*)((unsigned char*)WT + (size_t)row * K + k0 + 8 * c) = o8; continue; }
        if (MODE == 4) { v2u o8; o8.x = pk4_fp8(v[0] * W8SCALE, v[1] * W8SCALE, v[2] * W8SCALE, v[3] * W8SCALE); o8.y = pk4_fp8(v[4] * W8SCALE, v[5] * W8SCALE, v[6] * W8SCALE, v[7] * W8SCALE);
            *(GAS v2u*)((unsigned char*)WT + (size_t)row * K + k0 + 8 * c) = o8; continue; }
        v4u o; o.x = pk2(v[0], v[1]); o.y = pk2(v[2], v[3]); o.z = pk2(v[4], v[5]); o.w = pk2(v[6], v[7]);
        *(GAS v4u*)(WT + (size_t)row * K + k0 + 8 * c) = o;
        if (MODE == 3) { float r[8];
#pragma unroll
            for (int q = 0; q < 8; ++q) r[q] = v[q] - bf2f(f2bf(v[q]));
            v4u o2; o2.x = pk2(r[0], r[1]); o2.y = pk2(r[2], r[3]); o2.z = pk2(r[4], r[5]); o2.w = pk2(r[6], r[7]);
            *(GAS v4u*)(WT2 + (size_t)row * K + k0 + 8 * c) = o2; }
    }
    LDS_WAIT(); asm volatile("" ::: "memory");
}

struct KArgs { const float* in[23]; float* out; unsigned char* ws; int ph_lo, ph_hi; };

__device__ __forceinline__ void p0_prologue(const KArgs& a, LAS unsigned char* lds, int vcu, int G, int wave, int lane) {
    LAS float* scr = (LAS float*)(lds + RING_OFF + wave * 16384);
    const int gw = vcu * NWAVES + wave, NGW = G * NWAVES;
    unsigned char* ws = a.ws;
    {
        const float* c = a.in[1]; const float* wada = a.in[2]; float* modp = (float*)(ws + WS_MODP);
        for (int it = gw; it < 96 * 16; it += NGW) {
            const int cg = it % 96, kc = it / 96, n = 64 * cg + lane; float s0 = 0.f, s1 = 0.f;
            const float* wp = wada + (size_t)(64 * kc) * 6144 + n;
#pragma unroll 8
            for (int k = 0; k < 64; ++k) { const float w = wp[(size_t)k * 6144]; const float c0 = c[64 * kc + k], c1 = c[1024 + 64 * kc + k];
                s0 += (c0 / (1.0f + __expf(-c0))) * w; s1 += (c1 / (1.0f + __expf(-c1))) * w; }
            modp[(size_t)(kc * 2 + 0) * 6144 + n] = s0; modp[(size_t)(kc * 2 + 1) * 6144 + n] = s1;
        }
    }
    constexpr int I_WC = 8 * 32, I_WA = 8 * 32, I_WOUT = 16 * 32, I_WSD = 4 * 32, I_WR = 16 * 2;
    constexpr int NITEMS = I_WC + I_WA + I_WOUT + I_WSD + I_WR;
    for (int it = gw; it < NITEMS; it += NGW) {
        int r = it;
        if (r < I_WC) { tr_item<0>(a.in[10], 1024, 512, (bf16*)(ws + WS_WC), nullptr, 64 * (r / 32), 32 * (r % 32), scr, lane); continue; } r -= I_WC;
        if (r < I_WA) { tr_item<0>(a.in[14], 1024, 512, (bf16*)(ws + WS_WA), nullptr, 64 * (r / 32), 32 * (r % 32), scr, lane); continue; } r -= I_WA;
        if (r < I_WOUT) { tr_item<0>(a.in[15], 1024, 1024, (bf16*)(ws + WS_WOUT), nullptr, 64 * (r / 32), 32 * (r % 32), scr, lane); continue; } r -= I_WOUT;
        if (r < I_WSD) { tr_item<0>(a.in[22], 1024, 256, (bf16*)(ws + WS_WSD), nullptr, 64 * (r / 32), 32 * (r % 32), scr, lane); continue; } r -= I_WSD;
        tr_item<3>(a.in[17], 64, 1024, (bf16*)(ws + WS_WRH), (bf16*)(ws + WS_WRL), 64 * (r / 2), 32 * (r % 2), scr, lane);
    }
    {
        unsigned* amax = (unsigned*)(ws + WS_CTL) + CW_AMAX;
        constexpr int C4 = 4096, N_WIN4 = DMODEL * INCOLS / 4, IT_WIN = (N_WIN4 + C4 - 1) / C4, IT_WSGU = (1024 * 512 / 4) / C4, IT_WGU = 64 * IT_WSGU;
        for (int it = gw; it < IT_WIN + IT_WSGU + IT_WGU; it += NGW) {
            const f32x4* p; int n4; unsigned* dst;
            if (it < IT_WIN) { p = (const f32x4*)a.in[5] + (size_t)it * C4; n4 = (it == IT_WIN - 1) ? N_WIN4 - it * C4 : C4; dst = amax; }
            else if (it < IT_WIN + IT_WSGU) { p = (const f32x4*)a.in[21] + (size_t)(it - IT_WIN) * C4; n4 = C4; dst = amax + 1; }
            else { const int r = it - IT_WIN - IT_WSGU; p = (const f32x4*)a.in[19] + (size_t)r * C4; n4 = C4; dst = amax + 2 + r / IT_WSGU; }
            float m = 0.f;
#pragma unroll 8
            for (int i = lane; i < n4; i += 64) { const f32x4 v = p[i]; m = fmaxf(m, fmaxf(fmaxf(fabsf(v[0]), fabsf(v[1])), fmaxf(fabsf(v[2]), fabsf(v[3])))); }
#pragma unroll
            for (int o = 1; o < 64; o <<= 1) m = fmaxf(m, __shfl_xor(m, o));
            if (lane == 0) atomicMax(dst, __builtin_bit_cast(unsigned, m));
        }
    }
}
__device__ __forceinline__ void q8_items(const KArgs& a, LAS unsigned char* lds, int vcu, int G, int wave, int lane) {
    LAS float* scr = (LAS float*)(lds + RING_OFF + wave * 16384);
    const int gw = vcu * NWAVES + wave, NGW = G * NWAVES; unsigned char* ws = a.ws;
    const unsigned* amax = (const unsigned*)(ws + WS_CTL) + CW_AMAX;
    constexpr int I_WIN = 144 * 16, I_WSGU = 16 * 16, I_WGU = 64 * 256;
    for (int it = gw; it < I_WIN + I_WSGU + I_WGU; it += NGW) {
        int r = it;
        if (r < I_WIN) { const int cb = r % 144, kb = r / 144; const int n0 = cb < 80 ? 32 * cb : OFF_GC + 32 * (cb - 80);
            tr_item<5>(a.in[5], INCOLS, 1024, (bf16*)(ws + WS_WIN), nullptr, 64 * kb, n0, scr, lane, 127.0f / __builtin_bit_cast(float, amax[0])); continue; } r -= I_WIN;
        if (r < I_WSGU) { tr_item<6>(a.in[21], 512, 1024, (bf16*)(ws + WS_WSGU), nullptr, 64 * (r / 16), 32 * (r % 16), scr, lane, 127.0f / __builtin_bit_cast(float, amax[1])); continue; } r -= I_WSGU;
        { const int e = r / 256, q = r % 256;
            tr_item<6>(a.in[19] + (size_t)e * 1024 * 512, 512, 1024, (bf16*)(ws + WS_WGU + (size_t)e * 512 * 1024), nullptr, 64 * (q / 16), 32 * (q % 16), scr, lane, 127.0f / __builtin_bit_cast(float, amax[2 + e])); }
    }
}
__device__ __forceinline__ void wd_items(const KArgs& a, LAS unsigned char* lds, int first, int last, int slot, int nslots, int wave, int lane) {
    LAS float* scr = (LAS float*)(lds + RING_OFF + wave * 16384);
    for (int r = first + slot * NWAVES + wave; r < last; r += nslots * NWAVES) { const int e = r / 128, q = r % 128;
        tr_item<0>(a.in[20] + (size_t)e * 256 * 1024, 1024, 256, (bf16*)(a.ws + WS_WD) + (size_t)e * 1024 * 256, nullptr, 64 * (q / 32), 32 * (q % 32), scr, lane); }
}

__device__ __forceinline__ void p1_rows(const KArgs& a, LAS unsigned char* lds, int vcu, int tid, int wave, int lane) {
    unsigned char* ws = a.ws;
    const float* modp = (const float*)(ws + WS_MODP); const float* bada = a.in[3];
    LAS float* gs1 = (LAS float*)(lds + RING_OFF); LAS float* sh1 = gs1 + 1024; LAS float* wfl = gs1 + 2048;
    const int b = vcu >> 7;
    f32x4 vvA[4][4], vvB[4][4];
#pragma unroll
    for (int j = 0; j < 4; ++j) { const GAS f32x4* xa = (const GAS f32x4*)(a.in[0] + (size_t)(64 * vcu + 8 * wave + j) * DMODEL) + lane; const GAS f32x4* xb = (const GAS f32x4*)(a.in[0] + (size_t)(64 * vcu + 8 * wave + 4 + j) * DMODEL) + lane;
#pragma unroll
        for (int q = 0; q < 4; ++q) { vvA[j][q] = xa[64 * q]; vvB[j][q] = xb[64 * q]; } }
    {
        const int col = 4 * tid; f32x4 s = *(const f32x4*)(bada + col);
#pragma unroll
        for (int kc = 0; kc < 16; ++kc) s += *(const f32x4*)(modp + (size_t)(kc * 2 + b) * 6144 + col);
        if (col < 1024) { *(LAS f32x4*)(sh1 + col) = s; }
        else { const f32x4 g = *(const f32x4*)(a.in[4] + col - 1024); *(LAS f32x4*)(gs1 + col - 1024) = g * (1.0f + s); }
    }
    if (tid < 12) {
        float* mod = (float*)(ws + WS_MOD); const int gi = blockIdx.x * 12 + tid, bb = gi / 1536, col = 4 * (gi % 1536); f32x4 s = *(const f32x4*)(bada + col);
#pragma unroll
        for (int kc = 0; kc < 16; ++kc) s += *(const f32x4*)(modp + (size_t)(kc * 2 + bb) * 6144 + col);
        *(f32x4*)(mod + (size_t)bb * 6144 + col) = s;
    }
    for (int idx = tid; idx < 8192; idx += NWAVES * 64) { const int k = idx >> 3, f = idx & 7; wfl[f * 1024 + k] = a.in[5][(size_t)k * INCOLS + OFF_F + f]; }
    __syncthreads();
    const float* x = a.in[0]; bf16* h1 = (bf16*)(ws + WS_H1); float* logf_ = (float*)(ws + WS_LOGF); const float* bfg = a.in[13];
#pragma nounroll
    for (int jb = 0; jb < 2; ++jb) {
    f32x4 vv[4][4];
#pragma unroll
    for (int j = 0; j < 4; ++j)
#pragma unroll
        for (int q = 0; q < 4; ++q) vv[j][q] = jb ? vvB[j][q] : vvA[j][q];
#pragma unroll
    for (int j = 0; j < 4; ++j) {
        const int row = 64 * vcu + 8 * wave + 4 * jb + j, t = row & (SEQ - 1);
        LAS float* gs1_ = gs1; asm volatile("" : "+v"(gs1_));
        LAS float* sh1_ = gs1_ + 1024; LAS float* wfl_ = gs1_ + 2048;
        f32x4 v[4]; float ss = 0.f;
#pragma unroll
        for (int q = 0; q < 4; ++q) { v[q] = vv[j][q]; ss += (v[q].x * v[q].x + v[q].y * v[q].y) + (v[q].z * v[q].z + v[q].w * v[q].w); }
        const float rstd = 1.0f / sqrtf(wave_sum(ss) * (1.0f / DMODEL) + EPS);
        float hm = 0.f;
#pragma unroll
        for (int q = 0; q < 4; ++q) { const f32x4 g = *(const LAS f32x4*)(gs1_ + 4 * lane + 256 * q), s = *(const LAS f32x4*)(sh1_ + 4 * lane + 256 * q);
            v[q] = v[q] * rstd * g + s; hm = fmaxf(hm, fmaxf(fmaxf(fabsf(v[q].x), fabsf(v[q].y)), fmaxf(fabsf(v[q].z), fabsf(v[q].w)))); }
#pragma unroll
        for (int o = 1; o < 64; o <<= 1) hm = fmaxf(hm, __shfl_xor(hm, o));
        hm = fmaxf(hm, 1e-20f); const float qinv = 127.0f / hm;
        GAS unsigned* o4 = (GAS unsigned*)((unsigned char*)h1 + (size_t)row * DMODEL) + lane;
#pragma unroll
        for (int q = 0; q < 4; ++q) o4[64 * q] = pk4_i8(v[q].x * qinv, v[q].y * qinv, v[q].z * qinv, v[q].w * qinv);
        if (lane == 0) ((float*)(ws + WS_SA1))[row] = hm * (1.0f / 127.0f);
        float pf[8];
#pragma unroll
        for (int f = 0; f < 8; ++f) { float p = 0.f;
#pragma unroll
            for (int q = 0; q < 4; ++q) { const f32x4 w = *(const LAS f32x4*)(wfl_ + f * 1024 + 4 * lane + 256 * q); p += (v[q].x * w.x + v[q].y * w.y) + (v[q].z * w.z + v[q].w * w.w); }
            pf[f] = p; }
        float r4[4], r2[2], mine;
#pragma unroll
        for (int i = 0; i < 4; ++i) { const float keep = (lane & 1) ? pf[2 * i + 1] : pf[2 * i], send = (lane & 1) ? pf[2 * i] : pf[2 * i + 1]; r4[i] = keep + __shfl_xor(send, 1); }
#pragma unroll
        for (int i = 0; i < 2; ++i) { const float keep = (lane & 2) ? r4[2 * i + 1] : r4[2 * i], send = (lane & 2) ? r4[2 * i] : r4[2 * i + 1]; r2[i] = keep + __shfl_xor(send, 2); }
        { const float keep = (lane & 4) ? r2[1] : r2[0], send = (lane & 4) ? r2[0] : r2[1]; mine = keep + __shfl_xor(send, 4); }
        mine += __shfl_xor(mine, 8); mine += __shfl_xor(mine, 16); mine += __shfl_xor(mine, 32);
        if (lane < 8) { const float z = mine + bfg[lane]; const float ls = fminf(z, 0.f) - log1pf(expf(-fabsf(z)));
            logf_[(size_t)(b * 8 + lane) * SEQ + t] = ls; }
    }
    }
}

__device__ __forceinline__ void p2_cumsum(const KArgs& a, LAS unsigned char* lds, int seq, int tid, int wave, int lane) {
    const float* lf = (const float*)(a.ws + WS_LOGF) + (size_t)seq * SEQ + 16 * tid; float* cm = (float*)(a.ws + WS_CUM) + (size_t)seq * SEQ + 16 * tid;
    LAS double* wt = (LAS double*)(lds + RING_OFF);
    float v[16];
#pragma unroll
    for (int q = 0; q < 4; ++q) { const f32x4 x = *(const f32x4*)(lf + 4 * q); v[4 * q] = x.x; v[4 * q + 1] = x.y; v[4 * q + 2] = x.z; v[4 * q + 3] = x.w; }
    double pre[16]; double run = 0.0;
#pragma unroll
    for (int i = 0; i < 16; ++i) { run += (double)v[i]; pre[i] = run; }
    double sc = run;
#pragma unroll
    for (int o = 1; o < 64; o <<= 1) { const double up = __shfl_up(sc, o); if (lane >= o) sc += up; }
    if (lane == 63) wt[wave] = sc;
    __syncthreads();
    double off = sc - run;
    for (int w = 0; w < wave; ++w) off += wt[w];
#pragma unroll
    for (int q = 0; q < 4; ++q) { f32x4 o; o.x = (float)(off + pre[4 * q]); o.y = (float)(off + pre[4 * q + 1]); o.z = (float)(off + pre[4 * q + 2]); o.w = (float)(off + pre[4 * q + 3]); *(f32x4*)(cm + 4 * q) = o; }
    __syncthreads();
}

__device__ __forceinline__ void conv_item(const KArgs& a, LAS unsigned char* lds, int item, int tid) {
    const int tt = item >> 3, g = item & 7, row0 = 128 * tt, t0 = row0 & (SEQ - 1), c0 = 64 * g;
    const bf16* U = (const bf16*)(a.ws + WS_U); bf16* UC = (bf16*)(a.ws + WS_UC);
    constexpr int RS = 132;
    LAS unsigned char* ut = lds + RING_OFF;
    LAS float* yt = (LAS float*)(lds + RING_OFF + 24576);
    constexpr int YS = 68;
    for (int idx = tid; idx < 158 * 16; idx += NWAVES * 64) { const int r = idx >> 4, ch = idx & 15, tq = t0 - 30 + r;
        v2u val = (v2u){0u, 0u};
        if (tq >= 0) val = *(const GAS v2u*)(U + (size_t)(row0 - 30 + r) * CONVD + c0 + 4 * ch);
        *(LAS unsigned*)(ut + r * RS + 8 * ch) = val.x; *(LAS unsigned*)(ut + r * RS + 8 * ch + 4) = val.y; }
    const int c2 = tid & 31, seg = tid >> 5;
    float w0[CONVW], w1[CONVW];
#pragma unroll
    for (int j = 0; j < CONVW; ++j) { const f32x2 wv = *(const f32x2*)(a.in[6] + (size_t)j * CONVD + c0 + 2 * c2); w0[j] = wv[0]; w1[j] = wv[1]; }
    const f32x2 bv = *(const f32x2*)(a.in[7] + c0 + 2 * c2);
    __syncthreads();
    float y0[8], y1[8];
#pragma unroll
    for (int t = 0; t < 8; ++t) { y0[t] = bv[0]; y1[t] = bv[1]; }
#pragma unroll
    for (int r = 0; r < 38; ++r) { const unsigned uu = *(const LAS unsigned*)(ut + (8 * seg + r) * RS + 4 * c2); const float x0 = bf_lo(uu), x1v = bf_hi(uu);
#pragma unroll
        for (int t = 0; t < 8; ++t) { const int j = r - t; if (j >= 0 && j < CONVW) { y0[t] += x0 * w0[j]; y1[t] += x1v * w1[j]; } } }
#pragma unroll
    for (int t = 0; t < 8; ++t) *(LAS f32x2*)(yt + (8 * seg + t) * YS + 2 * c2) = (f32x2){y0[t], y1[t]};
    __syncthreads();
    const int tok = tid >> 2, q = tid & 3;
    float acc[16];
#pragma unroll
    for (int i = 0; i < 4; ++i) { const f32x4 v = *(const LAS f32x4*)(yt + tok * YS + 16 * q + 4 * i); acc[4 * i] = v[0]; acc[4 * i + 1] = v[1]; acc[4 * i + 2] = v[2]; acc[4 * i + 3] = v[3]; }
    float s = 0.f;
#pragma unroll
    for (int i = 0; i < 16; ++i) s += acc[i];
    s += __shfl_xor(s, 1); s += __shfl_xor(s, 2);
    const float mu = s * (1.0f / 64.0f); float qv = 0.f;
#pragma unroll
    for (int i = 0; i < 16; ++i) { acc[i] -= mu; qv += acc[i] * acc[i]; }
    qv += __shfl_xor(qv, 1); qv += __shfl_xor(qv, 2);
    const float rstd = 1.0f / sqrtf(qv * (1.0f / 64.0f) + EPS);
    unsigned o[8];
#pragma unroll
    for (int i = 0; i < 16; i += 2) { float v0 = acc[i] * rstd * a.in[8][c0 + 16 * q + i] + a.in[9][c0 + 16 * q + i], v1 = acc[i + 1] * rstd * a.in[8][c0 + 16 * q + i + 1] + a.in[9][c0 + 16 * q + i + 1];
        v0 = v0 * sigmoidf_fast(v0); v1 = v1 * sigmoidf_fast(v1); o[i >> 1] = pk2(v0, v1); }
    GAS v4u* dst = (GAS v4u*)(UC + (size_t)(row0 + tok) * CONVD + c0 + 16 * q);
    dst[0] = (v4u){o[0], o[1], o[2], o[3]}; dst[1] = (v4u){o[4], o[5], o[6], o[7]};
    __syncthreads();
}

struct SchedDense {
    static constexpr bool GATHER = false;
    int nM, nN, G, c, K; const char* A; const char* B;
    __device__ __forceinline__ bool next(int i, pg8::Unit& u) const {
        const long L = (long)i * G + c; if (L >= (long)nM * nN) return false;
        pg8::tile_of((int)L, nM, nN, u.pm, u.pn); u.e = 0; u.mt = 0;
        u.A = A + (size_t)u.pm * 256 * K * 2; u.B = B + (size_t)u.pn * 256 * K * 2; return true; }
    __device__ __forceinline__ int row(const pg8::Unit&, int) const { return 0; }
};
struct SchedMerge {
    static constexpr bool GATHER = false;
    int c; const char* A0; const char* B0; const char* A1; const char* B1;
    __device__ __forceinline__ bool next(int i, pg8::Unit& u) const {
        if (i >= 2 || c >= 256) return false;
        pg8::tile_of(c, 64, 4, u.pm, u.pn); u.e = i; u.mt = 0;
        u.A = (i ? A1 : A0) + (size_t)u.pm * 256 * 512 * 2; u.B = (i ? B1 : B0) + (size_t)u.pn * 256 * 512 * 2; return true; }
    __device__ __forceinline__ int row(const pg8::Unit&, int) const { return 0; }
};
struct MoeTab { const LAS int* tstart; const LAS int* cnt; };
struct SchedMoe1 {
    static constexpr bool GATHER = true;
    MoeTab tb; int nmoe, ntot, per, c, lane; const char* h2; const char* wgu; const char* wsgu; const int* list;
    __device__ __forceinline__ bool next(int i, pg8::Unit& u) const {
        const int L = i * per + c; if (L >= ntot) return false;
        if (L < nmoe) { const int nti = nmoe >> 1, tt = L % nti; const int e = __popcll(__ballot(tb.tstart[lane + 1] <= tt));
            u.e = e; u.mt = tt - tb.tstart[e]; u.pm = tt; u.pn = L / nti; u.A = h2; u.B = wgu + ((size_t)e * 512 + (size_t)u.pn * 256) * 1024; }
        else { const int s = L - nmoe; u.e = -1; u.mt = 0; u.pm = s & 63; u.pn = s >> 6; u.A = h2; u.B = wsgu + (size_t)u.pn * 256 * 1024; }
        return true; }
    __device__ __forceinline__ int row(const pg8::Unit& u, int r) const {
        if (u.e < 0) return u.pm * 256 + r;
        const int idx = u.mt * 256 + r; return idx < tb.cnt[u.e] ? (list[(size_t)u.e * LISTCAP + idx] >> 3) : 0; }
};
struct SchedMoe2 {
    static constexpr bool GATHER = false;
    MoeTab tb; int ntot, per, c, lane; const char* act; const char* wd;
    __device__ __forceinline__ bool next(int i, pg8::Unit& u) const {
        const int nti = ntot >> 2, j = (i >> 1) * per + c; if (j >= 2 * nti) return false;
        const int tt = j % nti; const int e = __popcll(__ballot(tb.tstart[lane + 1] <= tt));
        u.e = e; u.mt = tt - tb.tstart[e]; u.pm = tt; u.pn = 2 * (j / nti) + (i & 1); u.A = act + (size_t)tt * 256 * 256 * 2; u.B = wd + ((size_t)e * 1024 + (size_t)u.pn * 256) * 256 * 2; return true; }
    __device__ __forceinline__ int row(const pg8::Unit&, int) const { return 0; }
};

typedef pg8::f32x4 (AccT)[2][2][4][2];
#define NO_PRE_MEMBERS static constexpr bool AFTER_DRAIN = false; struct Pre {}; __device__ __forceinline__ void prefetch(Pre&, const pg8::Unit&, int, int, int, int) const {} static constexpr bool ROWTAB = false; static constexpr int NTAB = 1; __device__ __forceinline__ const char* tab_src(const pg8::Unit&, int) const { return nullptr; }
__device__ __forceinline__ v4u pack8(const f32x4& a, const f32x4& b) { v4u w; w.x = cvt_pk_bf16(a[0], a[1]); w.y = cvt_pk_bf16(a[2], a[3]); w.z = cvt_pk_bf16(b[0], b[1]); w.w = cvt_pk_bf16(b[2], b[3]); return w; }
__device__ __forceinline__ void unpack8(const v4u& w, f32x4& a, f32x4& b) { a = (f32x4){bf_lo(w.x), bf_hi(w.x), bf_lo(w.y), bf_hi(w.y)}; b = (f32x4){bf_lo(w.z), bf_hi(w.z), bf_lo(w.w), bf_hi(w.w)}; }
__device__ __forceinline__ f32x4 sig4(const f32x4& v) { return (f32x4){sigmoidf_fast(v[0]), sigmoidf_fast(v[1]), sigmoidf_fast(v[2]), sigmoidf_fast(v[3])}; }

struct EpiIn {
    static constexpr bool PERM = true; static constexpr bool AFTER_DRAIN = false; struct Pre {}; __device__ __forceinline__ void prefetch(Pre&, const pg8::Unit&, int, int, int, int) const {}
    static constexpr bool ROWTAB = true; static constexpr int NTAB = 1;
    __device__ __forceinline__ const char* tab_src(const pg8::Unit& u, int) const { return (const char*)(sA + u.pm * 256); }
    bf16 *U, *Q, *Kb, *V, *SG; const float *gq, *gk; const float* sA; const unsigned* amax;
    __device__ __forceinline__ void operator()(const AccT& acc, const pg8::Unit& u, int wr, int wc, int fr_, int fq_, const Pre& pre, const LAS unsigned* rtab) const {
        int fr = fr_, fq = fq_; asm volatile("" : "+v"(fr), "+v"(fq));
        const int rl0 = wr * 64 + fr, row0 = u.pm * 256 + rl0, pn = u.pn; const float sW = __builtin_bit_cast(float, amax[0]) * (1.0f / 127.0f);
        if (pn < 4) {
            const int col0 = 128 * pn + 32 * wc + 8 * fq;
#pragma unroll
            for (int ai = 0; ai < 2; ++ai)
#pragma unroll
                for (int m = 0; m < 4; ++m) { const float sc = __builtin_bit_cast(float, rtab[rl0 + ai * 128 + m * 16]) * sW;
                    const f32x4 v0 = acc[ai][0][m][0] * sc * sig4(acc[ai][1][m][0] * sc), v1 = acc[ai][0][m][1] * sc * sig4(acc[ai][1][m][1] * sc);
                    *(v4u*)(U + (size_t)(row0 + ai * 128 + m * 16) * CONVD + col0) = pack8(v0, v1); }
        } else if (pn < 8) {
            const bool isk = pn >= 6; const int head = 4 * ((pn - 4) & 1) + wc; const float* g = isk ? gk : gq; bf16* dst = isk ? Kb : Q; const float qsc = isk ? 1.0f : C2Q;
            f32x4 gv[2][2];
#pragma unroll
            for (int bj = 0; bj < 2; ++bj)
#pragma unroll
                for (int n = 0; n < 2; ++n) gv[bj][n] = *(const f32x4*)(g + 32 * bj + 8 * fq + 4 * n) * qsc;
#pragma unroll
            for (int ai = 0; ai < 2; ++ai)
#pragma unroll
                for (int m = 0; m < 4; ++m) { const float sc = __builtin_bit_cast(float, rtab[rl0 + ai * 128 + m * 16]) * sW; float ss = 0.f;
#pragma unroll
                    for (int bj = 0; bj < 2; ++bj)
#pragma unroll
                        for (int n = 0; n < 2; ++n) { const f32x4 x = acc[ai][bj][m][n]; ss += (x[0] * x[0] + x[1] * x[1]) + (x[2] * x[2] + x[3] * x[3]); }
                    ss += __shfl_xor(ss, 16); ss += __shfl_xor(ss, 32);
                    const float r = sc / sqrtf(ss * (sc * sc) * (1.0f / 64.0f) + EPS);
                    bf16* rowp = dst + (size_t)(row0 + ai * 128 + m * 16) * ATT + head * 64 + 8 * fq;
#pragma unroll
                    for (int bj = 0; bj < 2; ++bj) *(v4u*)(rowp + 32 * bj) = pack8(acc[ai][bj][m][0] * r * gv[bj][0], acc[ai][bj][m][1] * r * gv[bj][1]); }
        } else if (pn < 10) {
            const int col0 = 256 * (pn - 8) + 32 * wc + 8 * fq;
#pragma unroll
            for (int ai = 0; ai < 2; ++ai)
#pragma unroll
                for (int m = 0; m < 4; ++m) { const float sc = __builtin_bit_cast(float, rtab[rl0 + ai * 128 + m * 16]) * sW;
#pragma unroll
                    for (int bj = 0; bj < 2; ++bj) *(v4u*)(V + (size_t)(row0 + ai * 128 + m * 16) * ATT + col0 + 128 * bj) = pack8(acc[ai][bj][m][0] * sc, acc[ai][bj][m][1] * sc); }
        } else {
            bf16* dst = SG + (size_t)((pn - 10) >> 2) * T * DMODEL; const int col0 = 256 * ((pn - 10) & 3) + 32 * wc + 8 * fq;
#pragma unroll
            for (int ai = 0; ai < 2; ++ai)
#pragma unroll
                for (int m = 0; m < 4; ++m) { const float sc = __builtin_bit_cast(float, rtab[rl0 + ai * 128 + m * 16]) * sW;
#pragma unroll
                    for (int bj = 0; bj < 2; ++bj) *(v4u*)(dst + (size_t)(row0 + ai * 128 + m * 16) * DMODEL + col0 + 128 * bj) = pack8(sig4(acc[ai][bj][m][0] * sc), sig4(acc[ai][bj][m][1] * sc)); }
        }
    }
};
struct EpiMerge {
    static constexpr bool PERM = true; NO_PRE_MEMBERS
    const bf16* SG; bf16* MG;
    __device__ __forceinline__ void operator()(const AccT& acc, const pg8::Unit& u, int wr, int wc, int fr_, int fq_, const Pre& pre, const LAS unsigned* rtab) const {
        int fr = fr_, fq = fq_; asm volatile("" : "+v"(fr), "+v"(fq));
        const int row0 = u.pm * 256 + wr * 64 + fr, col0 = u.pn * 256 + 32 * wc + 8 * fq; const bf16* sg = SG + (size_t)u.e * T * DMODEL;
#pragma unroll
        for (int ai = 0; ai < 2; ++ai)
#pragma unroll
            for (int m = 0; m < 4; ++m)
#pragma unroll
                for (int bj = 0; bj < 2; ++bj) { const size_t off = (size_t)(row0 + ai * 128 + m * 16) * DMODEL + col0 + 128 * bj;
                    f32x4 g0, g1; unpack8(*(const v4u*)(sg + off), g0, g1);
                    f32x4 v0 = g0 * acc[ai][bj][m][0], v1 = g1 * acc[ai][bj][m][1];
                    if (u.e) { f32x4 p0, p1; unpack8(*(const v4u*)(MG + off), p0, p1); v0 += p0; v1 += p1; }
                    *(v4u*)(MG + off) = pack8(v0, v1); }
    }
};
struct EpiX1 {
    static constexpr bool PERM = true; static constexpr bool AFTER_DRAIN = true; struct Pre {}; __device__ __forceinline__ void prefetch(Pre&, const pg8::Unit&, int, int, int, int) const {}
    static constexpr bool ROWTAB = false; static constexpr int NTAB = 1; __device__ __forceinline__ const char* tab_src(const pg8::Unit&, int) const { return nullptr; }
    const float* x; float* out; const float* mod; float* ssq; float* xmx;
    __device__ __forceinline__ void operator()(const AccT&, const pg8::Unit&, int, int, int, int, const Pre&, const LAS unsigned*) const {}
    __device__ __forceinline__ void fused(const AccT& acc, const pg8::Unit& u, int wr, int wc, int fr, int fq, LAS unsigned char* lds) const;
};
struct EpiGlu {
    static constexpr bool PERM = true;
    bf16 *ACT, *SACT; const float* wlist; const float* slist; const float* sA2; const unsigned* amax; MoeTab tb;
    struct Pre {}; __device__ __forceinline__ void prefetch(Pre&, const pg8::Unit&, int, int, int, int) const {}
    static constexpr bool AFTER_DRAIN = false;
    static constexpr bool ROWTAB = true; static constexpr int NTAB = 2;
    __device__ __forceinline__ const char* tab_src(const pg8::Unit& u, int t) const {
        if (u.e >= 0) return (const char*)((t ? slist : wlist) + (size_t)u.e * LISTCAP + u.mt * 256);
        return t ? (const char*)(sA2 + u.pm * 256) : nullptr; }
    __device__ __forceinline__ void operator()(const AccT& acc, const pg8::Unit& u, int wr, int wc, int fr_, int fq_, const Pre& pre, const LAS unsigned* rtab) const {
        int fr = fr_, fq = fq_; asm volatile("" : "+v"(fr), "+v"(fq));
        const int rl0 = wr * 64 + fr, col0 = 128 * u.pn + 32 * wc + 8 * fq; bf16* dst = (u.e >= 0 ? ACT : SACT) + (size_t)u.pm * 256 * EF;
        const int cnt = u.e >= 0 ? tb.cnt[u.e] : 0; const float sW = __builtin_bit_cast(float, amax[u.e >= 0 ? 2 + u.e : 1]) * (1.0f / 127.0f);
#pragma unroll
        for (int ai = 0; ai < 2; ++ai)
#pragma unroll
            for (int m = 0; m < 4; ++m) { const int rl = rl0 + ai * 128 + m * 16; const bool valid = (u.e < 0) || (u.mt * 256 + rl < cnt);
                const float w = (u.e >= 0) ? (valid ? __builtin_bit_cast(float, rtab[rl]) : 0.0f) : 1.0f, gsc = valid ? __builtin_bit_cast(float, rtab[256 + rl]) * sW : 0.0f;
                const f32x4 g0 = acc[ai][0][m][0] * gsc, g1 = acc[ai][0][m][1] * gsc;
                const f32x4 v0 = g0 * sig4(g0) * acc[ai][1][m][0] * (w * gsc), v1 = g1 * sig4(g1) * acc[ai][1][m][1] * (w * gsc);
                *(v4u*)(dst + (size_t)rl * EF + col0) = pack8(v0, v1); asm volatile("" ::: "memory"); }
    }
};
struct EpiSlab {
    static constexpr bool PERM = true;
    unsigned char* SLAB; const int* list; MoeTab tb;
    struct Pre {}; __device__ __forceinline__ void prefetch(Pre&, const pg8::Unit&, int, int, int, int) const {}
    static constexpr bool AFTER_DRAIN = false;
    static constexpr bool ROWTAB = true; static constexpr int NTAB = 1;
    __device__ __forceinline__ const char* tab_src(const pg8::Unit& u, int) const { return (const char*)(list + (size_t)u.e * LISTCAP + u.mt * 256); }
    __device__ __forceinline__ void operator()(const AccT& acc, const pg8::Unit& u, int wr, int wc, int fr_, int fq_, const Pre& pre, const LAS unsigned* rtab) const {
        int fr = fr_, fq = fq_; asm volatile("" : "+v"(fr), "+v"(fq));
        const int col0 = 256 * u.pn + 64 * wc + 8 * fq;
#pragma unroll
        for (int ai = 0; ai < 2; ++ai)
#pragma unroll
            for (int m = 0; m < 4; ++m) { const int rl = wr * 64 + fr + ai * 128 + m * 16; const int slot = (int)rtab[rl];
                if (u.mt * 256 + rl < tb.cnt[u.e]) { unsigned char* rowp = SLAB + (size_t)slot * DMODEL + col0;
#pragma unroll
                    for (int bj = 0; bj < 2; ++bj) { const f32x4 a0 = acc[ai][bj][m][0] * SLABSCALE, a1 = acc[ai][bj][m][1] * SLABSCALE;
                        *(v2u*)(rowp + 32 * bj) = (v2u){pk4_fp8(a0[0], a0[1], a0[2], a0[3]), pk4_fp8(a1[0], a1[1], a1[2], a1[3])}; } }
                asm volatile("" ::: "memory"); }
    }
};
__device__ __forceinline__ void park_tile(const AccT& acc, LAS unsigned char* lds, int wr, int wc, int fr, int fq) {
#pragma unroll
    for (int ai = 0; ai < 2; ++ai)
#pragma unroll
        for (int m = 0; m < 4; ++m) { const int row = 128 * ai + 64 * wr + 16 * m + fr;
#pragma unroll
            for (int bj = 0; bj < 2; ++bj) { const int c16 = 16 * bj + 4 * wc + fq; *(LAS v4u*)(lds + row * 512 + ((c16 ^ (row & 31)) << 4)) = pack8(acc[ai][bj][m][0], acc[ai][bj][m][1]); } }
    asm volatile("s_waitcnt lgkmcnt(0)" ::: "memory"); __builtin_amdgcn_s_barrier(); asm volatile("" ::: "memory");
}
struct EpiFinal {
    static constexpr bool PERM = true; static constexpr bool AFTER_DRAIN = true; struct Pre {}; __device__ __forceinline__ void prefetch(Pre&, const pg8::Unit&, int, int, int, int) const {}
    static constexpr bool ROWTAB = false; static constexpr int NTAB = 1; __device__ __forceinline__ const char* tab_src(const pg8::Unit&, int) const { return nullptr; }
    float* out; const unsigned char* SLAB; const float* mod;
    __device__ __forceinline__ void operator()(const AccT&, const pg8::Unit&, int, int, int, int, const Pre&, const LAS unsigned*) const {}
    __device__ __forceinline__ void fused(const AccT& acc, const pg8::Unit& u, int wr, int wc, int fr, int fq, LAS unsigned char* lds) const {
        typedef float f32x2v __attribute__((ext_vector_type(2)));
        park_tile(acc, lds, wr, wc, fr, fq);
        const int tid = threadIdx.x, wave = tid >> 6, lane = tid & 63, hl = lane >> 5, i = lane & 31;
        const int col0 = 128 * ((i >> 2) & 1) + 32 * (i >> 3) + 8 * (i & 3);
        const float* g2 = mod + (size_t)(u.pm >> 5) * 6144 + 5120 + u.pn * 256 + col0;
        const f32x4 gv0 = *(const f32x4*)g2, gv1 = *(const f32x4*)(g2 + 4);
#pragma unroll 4
        for (int s = 0; s < 16; ++s) { const int rl = 32 * wave + 2 * s + hl; const size_t row = (size_t)u.pm * 256 + rl;
            const unsigned char* sp = SLAB + row * TOPK * DMODEL + u.pn * 256 + 8 * i;
            v2u sv[TOPK];
#if FWD_LEVEL >= 2
#pragma unroll
            for (int k = 0; k < TOPK; ++k) sv[k] = *(const v2u*)(sp + (size_t)k * DMODEL);
#endif
            float* op = out + row * DMODEL + u.pn * 256 + col0; const f32x4 x0 = *(const f32x4*)op, x1v = *(const f32x4*)(op + 4);
            f32x4 a0, a1; { const v4u pk_ = *(const LAS v4u*)(lds + rl * 512 + ((((col0 >> 3)) ^ (rl & 31)) << 4)); unpack8(pk_, a0, a1); }
            f32x4 s0 = (f32x4){0.f, 0.f, 0.f, 0.f}, s1 = s0;
#if FWD_LEVEL >= 2
#pragma unroll
            for (int k = 0; k < TOPK; ++k) { const f32x2v a = __builtin_amdgcn_cvt_pk_f32_fp8((int)sv[k].x, false), b = __builtin_amdgcn_cvt_pk_f32_fp8((int)sv[k].x, true), c = __builtin_amdgcn_cvt_pk_f32_fp8((int)sv[k].y, false), d = __builtin_amdgcn_cvt_pk_f32_fp8((int)sv[k].y, true);
                s0 += (f32x4){a[0], a[1], b[0], b[1]}; s1 += (f32x4){c[0], c[1], d[0], d[1]}; }
#endif
            s0 = s0 * (1.0f / SLABSCALE) + a0; s1 = s1 * (1.0f / SLABSCALE) + a1;
            *(f32x4*)op = x0 + gv0 * s0; *(f32x4*)(op + 4) = x1v + gv1 * s1; }
    }
};
__device__ __forceinline__ void EpiX1::fused(const AccT& acc, const pg8::Unit& u, int wr, int wc, int fr, int fq, LAS unsigned char* lds) const {
    park_tile(acc, lds, wr, wc, fr, fq);
    const int tid = threadIdx.x, wave = tid >> 6, lane = tid & 63, hl = lane >> 5, i = lane & 31;
    const float* g1 = mod + (size_t)(u.pm >> 5) * 6144 + 2048 + u.pn * 256 + 8 * i;
    const f32x4 gv0 = *(const f32x4*)g1, gv1 = *(const f32x4*)(g1 + 4);
#pragma unroll 4
    for (int s = 0; s < 16; ++s) { const int rl = 32 * wave + 2 * s + hl; const size_t off = ((size_t)u.pm * 256 + rl) * DMODEL + u.pn * 256 + 8 * i;
        const f32x4 x0 = *(const f32x4*)(x + off), x1v = *(const f32x4*)(x + off + 4);
        f32x4 a0, a1; { const v4u pk_ = *(const LAS v4u*)(lds + rl * 512 + ((i ^ (rl & 31)) << 4)); unpack8(pk_, a0, a1); }
        const f32x4 v0 = x0 + gv0 * a0, v1 = x1v + gv1 * a1;
        *(f32x4*)(out + off) = v0; *(f32x4*)(out + off + 4) = v1;
        float ss = ((v0[0] * v0[0] + v0[1] * v0[1]) + (v0[2] * v0[2] + v0[3] * v0[3])) + ((v1[0] * v1[0] + v1[1] * v1[1]) + (v1[2] * v1[2] + v1[3] * v1[3]));
        float mx = fmaxf(fmaxf(fmaxf(fabsf(v0[0]), fabsf(v0[1])), fmaxf(fabsf(v0[2]), fabsf(v0[3]))), fmaxf(fmaxf(fabsf(v1[0]), fabsf(v1[1])), fmaxf(fabsf(v1[2]), fabsf(v1[3]))));
        ss += __shfl_xor(ss, 1); ss += __shfl_xor(ss, 2); ss += __shfl_xor(ss, 4); ss += __shfl_xor(ss, 8); ss += __shfl_xor(ss, 16);
        mx = fmaxf(mx, __shfl_xor(mx, 1)); mx = fmaxf(mx, __shfl_xor(mx, 2)); mx = fmaxf(mx, __shfl_xor(mx, 4)); mx = fmaxf(mx, __shfl_xor(mx, 8)); mx = fmaxf(mx, __shfl_xor(mx, 16));
        if (i == 0) { ssq[(size_t)u.pn * T + (size_t)u.pm * 256 + rl] = ss; xmx[(size_t)u.pn * T + (size_t)u.pm * 256 + rl] = mx; } }
}


__device__ __forceinline__ void p6_item(const KArgs& a, LAS unsigned char* lds, int item, int tid, int wave, int lane) {
    unsigned char* ws = a.ws;
    const int row0 = 32 * item, r = lane & 31, h = lane >> 5, row = row0 + r, b = row >> 13;
    const float* x1 = a.out; const float* ssq = (const float*)(ws + WS_SSQ); const float* mod = (const float*)(ws + WS_MOD) + (size_t)b * 6144;
    unsigned char* H2 = ws + WS_H2;
    const bf16* WRH = (const bf16*)(ws + WS_WRH); const bf16* WRL = (const bf16*)(ws + WS_WRL);
    constexpr int WREG = 9216, TROW = 144;
    LAS unsigned char* wreg = lds + RING_OFF + wave * WREG;
    LAS float* scl = (LAS float*)(lds + RING_OFF + 8 * WREG);
    LAS float* bil = scl + 32 * 65;
    LAS int* hist = (LAS int*)(bil + 32 * 65);
    LAS int* gbase = hist + 512;
    LAS float* rstl = (LAS float*)(gbase + 64);
    if (tid < 32) { float ss = 0.f;
#pragma unroll
        for (int p = 0; p < 4; ++p) ss += ssq[(size_t)p * T + row0 + tid];
        rstl[tid] = 1.0f / sqrtf(ss * (1.0f / DMODEL) + EPS); }
    const int lr = lane >> 4, lc4 = (lane & 15) * 4;
    __syncthreads();
    f32x16 acc0, acc1;
#pragma unroll
    for (int i = 0; i < 16; ++i) { acc0[i] = 0.f; acc1[i] = 0.f; }
#pragma nounroll
    for (int ms = 0; ms < 2; ++ms) {
        const int kb = 128 * wave + 64 * ms;
        f32x4 xv[8];
#pragma unroll
        for (int i = 0; i < 8; ++i) xv[i] = *(const f32x4*)(x1 + (size_t)(row0 + 4 * i + lr) * DMODEL + kb + lc4);
        const f32x4 gs = *(const f32x4*)(a.in[16] + kb + lc4) * (1.0f + *(const f32x4*)(mod + 4096 + kb + lc4)), sh = *(const f32x4*)(mod + 3072 + kb + lc4);
#pragma unroll
        for (int i = 0; i < 8; ++i) { const int rr = 4 * i + lr; const f32x4 hv = xv[i] * rstl[rr] * gs + sh;
            const unsigned h0 = f2bf(hv[0]), h1_ = f2bf(hv[1]), h2_ = f2bf(hv[2]), h3 = f2bf(hv[3]);
            const v2u whi = (v2u){h0 | (h1_ << 16), h2_ | (h3 << 16)};
            const v2u wlo = (v2u){pk2(hv[0] - bf2f(h0), hv[1] - bf2f(h1_)), pk2(hv[2] - bf2f(h2_), hv[3] - bf2f(h3))};
#if MOE_FP8
            *(GAS unsigned*)(H2 + (size_t)(row0 + rr) * DMODEL + kb + lc4) = pk4_fp8(hv[0], hv[1], hv[2], hv[3]);
#else
            *(GAS v2u*)(H2 + ((size_t)(row0 + rr) * DMODEL + kb + lc4) * 2) = whi;
#endif
            *(LAS v2u*)(wreg + rr * TROW + lc4 * 2) = whi; *(LAS v2u*)(wreg + 32 * TROW + rr * TROW + lc4 * 2) = wlo; }
#pragma unroll
        for (int sp = 0; sp < 2; ++sp) {
            bf16x8 bh0[2], bh1[2], bl0[2], bl1[2];
#pragma unroll
            for (int s2 = 0; s2 < 2; ++s2) { const size_t o = (size_t)r * DMODEL + kb + 16 * (2 * sp + s2) + 8 * h;
                bh0[s2] = *(const bf16x8*)(WRH + o); bh1[s2] = *(const bf16x8*)(WRH + o + 32 * DMODEL); bl0[s2] = *(const bf16x8*)(WRL + o); bl1[s2] = *(const bf16x8*)(WRL + o + 32 * DMODEL); }
#pragma unroll
            for (int s2 = 0; s2 < 2; ++s2) { const int s_ = 2 * sp + s2;
                const bf16x8 ahi = *(const LAS bf16x8*)(wreg + r * TROW + (16 * s_ + 8 * h) * 2), alo = *(const LAS bf16x8*)(wreg + 32 * TROW + r * TROW + (16 * s_ + 8 * h) * 2);
                acc0 = __builtin_amdgcn_mfma_f32_32x32x16_bf16(alo, bh0[s2], acc0, 0, 0, 0); acc1 = __builtin_amdgcn_mfma_f32_32x32x16_bf16(alo, bh1[s2], acc1, 0, 0, 0);
                acc0 = __builtin_amdgcn_mfma_f32_32x32x16_bf16(ahi, bl0[s2], acc0, 0, 0, 0); acc1 = __builtin_amdgcn_mfma_f32_32x32x16_bf16(ahi, bl1[s2], acc1, 0, 0, 0);
                acc0 = __builtin_amdgcn_mfma_f32_32x32x16_bf16(ahi, bh0[s2], acc0, 0, 0, 0); acc1 = __builtin_amdgcn_mfma_f32_32x32x16_bf16(ahi, bh1[s2], acc1, 0, 0, 0); }
            asm volatile("" ::: "memory");
        }
        asm volatile("" ::: "memory");
    }
    { LAS float* part = (LAS float*)wreg;
#pragma unroll
      for (int i = 0; i < 16; ++i) { const int tr = (i & 3) + 8 * (i >> 2) + 4 * h; part[tr * 64 + r] = acc0[i]; part[tr * 64 + 32 + r] = acc1[i]; } }
    __syncthreads();
    {
        const int tr = tid >> 4, e4 = (tid & 15) * 4; f32x4 s = *(const LAS f32x4*)(lds + RING_OFF + tr * 256 + e4 * 4);
#pragma unroll
        for (int w = 1; w < 8; ++w) s += *(const LAS f32x4*)(lds + RING_OFF + w * WREG + tr * 256 + e4 * 4);
        const f32x4 rb = *(const f32x4*)(a.in[18] + e4);
#pragma unroll
        for (int j = 0; j < 4; ++j) { const float sc = 1.0f / (1.0f + expf(-s[j])); scl[tr * 65 + e4 + j] = sc; bil[tr * 65 + e4 + j] = sc + rb[j]; }
    }
    __syncthreads();
    LAS int* selk = (LAS int*)(rstl + 32); LAS float* selw = (LAS float*)(selk + 32 * 64);
    int lc = 0;
#pragma nounroll
    for (int j = 0; j < 4; ++j) {
        const int tr = wave * 4 + j; const float v = bil[tr * 65 + lane], sc = scl[tr * 65 + lane];
        int rk = 0;
#pragma unroll
        for (int d = 1; d < 8; ++d) { const int src = (lane & ~7) | ((lane + d) & 7); const float o = __shfl(v, src); rk += (o > v) || (o == v && src < lane); }
        float t2 = rk < 2 ? v : 0.f; t2 += __shfl_xor(t2, 1); t2 += __shfl_xor(t2, 2); t2 += __shfl_xor(t2, 4);
        int grk = 0; const int g = lane >> 3;
#pragma unroll
        for (int g2 = 0; g2 < 8; ++g2) { const float og = __builtin_bit_cast(float, __builtin_amdgcn_readlane(__builtin_bit_cast(int, t2), g2 * 8)); grk += (og > t2) || (og == t2 && g2 < g); }
        const bool gsel = grk < 4;
        const float c = gsel ? v : -INFINITY; int erk = 0;
#pragma nounroll
        for (int e2 = 0; e2 < 64; ++e2) { const float oc = __builtin_bit_cast(float, __builtin_amdgcn_readlane(__builtin_bit_cast(int, c), e2)); erk += (oc > c) || (oc == c && e2 < lane); }
        const bool sel = gsel && erk < TOPK;
        const float wsum = wave_sum(sel ? sc : 0.f);
        selk[tr * 64 + lane] = sel ? erk : -1; selw[tr * 64 + lane] = sc * (ROUTED_SCALE / wsum); lc += sel ? 1 : 0;
    }
    hist[wave * 64 + lane] = lc;
    __syncthreads();
    if (wave == 0) { int tot = 0;
#pragma unroll
        for (int w = 0; w < 8; ++w) tot += hist[w * 64 + lane];
        gbase[lane] = tot ? (int)__hip_atomic_fetch_add((unsigned*)(ws + WS_CTL) + CW_CNT + 64 * lane, (unsigned)tot, RLX_AGENT) : 0; }
    __syncthreads();
    {   int base = gbase[lane];
        for (int w = 0; w < wave; ++w) base += hist[w * 64 + lane];
        int* list = (int*)(ws + WS_LIST); float* wl = (float*)(ws + WS_WLIST);
#pragma unroll
        for (int j = 0; j < 4; ++j) { const int tr = wave * 4 + j, k = selk[tr * 64 + lane]; if (k >= 0) { const size_t p = (size_t)lane * LISTCAP + base; list[p] = (row0 + tr) * TOPK + k; wl[p] = selw[tr * 64 + lane]; ++base; } } }
    __syncthreads();
}

__device__ __forceinline__ float p6_rank_slow(float c, int lane) {
    int erk = 0;
#pragma nounroll
    for (int e2 = 0; e2 < 64; ++e2) { const float oc = __builtin_bit_cast(float, __builtin_amdgcn_readlane(__builtin_bit_cast(int, c), e2)); erk += (oc > c) || (oc == c && e2 < lane); }
    return (float)erk;
}
__device__ __forceinline__ void p6_block(const KArgs& a, LAS unsigned char* lds, int vcu, int tid, int wave, int lane) {
    unsigned char* ws = a.ws;
    const int rowb = 64 * vcu + 8 * wave, b = (64 * vcu) >> 13;
    const float* x1 = a.out; const float* ssq = (const float*)(ws + WS_SSQ); const float* mod = (const float*)(ws + WS_MOD) + (size_t)b * 6144;
    unsigned char* H2 = ws + WS_H2;
    const bf16* WRH = (const bf16*)(ws + WS_WRH); const bf16* WRL = (const bf16*)(ws + WS_WRL);
    constexpr int RS = 272, BSH = 64 * RS, BSB = 2 * BSH;
    LAS unsigned char* BS = lds + RING_OFF;
    LAS unsigned char* AW = lds + RING_OFF + 2 * BSB + wave * (2 * 8 * RS);
    LAS int* hist = (LAS int*)(lds + RING_OFF + 2 * BSB + 8 * (2 * 8 * RS)); LAS int* gbase = hist + 512;
    float rs_l = 0.f;
    if (lane < 8) { float ss = 0.f;
#pragma unroll
        for (int p = 0; p < 4; ++p) ss += ssq[(size_t)p * T + rowb + lane];
        rs_l = 1.0f / sqrtf(ss * (1.0f / DMODEL) + EPS); }
    float gmx = 0.f, smx = 0.f;
#pragma unroll
    for (int q = 0; q < 4; ++q) { const f32x4 gq_ = *(const f32x4*)(a.in[16] + 4 * lane + 256 * q) * (1.0f + *(const f32x4*)(mod + 4096 + 4 * lane + 256 * q)), sq_ = *(const f32x4*)(mod + 3072 + 4 * lane + 256 * q);
        gmx = fmaxf(gmx, fmaxf(fmaxf(fabsf(gq_[0]), fabsf(gq_[1])), fmaxf(fabsf(gq_[2]), fabsf(gq_[3])))); smx = fmaxf(smx, fmaxf(fmaxf(fabsf(sq_[0]), fabsf(sq_[1])), fmaxf(fabsf(sq_[2]), fabsf(sq_[3])))); }
#pragma unroll
    for (int o = 1; o < 64; o <<= 1) { gmx = fmaxf(gmx, __shfl_xor(gmx, o)); smx = fmaxf(smx, __shfl_xor(smx, o)); }
    float s2_l = 1.f;
    if (lane < 8) { const float* xm = (const float*)(ws + WS_XMX); float mx = 0.f;
#pragma unroll
        for (int p = 0; p < 4; ++p) mx = fmaxf(mx, xm[(size_t)p * T + rowb + lane]);
        s2_l = fmaxf(rs_l * mx * gmx + smx, 1e-20f) * (1.0f / 127.0f); ((float*)(ws + WS_SA2))[rowb + lane] = s2_l; }
    float rstd4[4], qinv4[4];
#pragma unroll
    for (int i = 0; i < 4; ++i) { rstd4[i] = __shfl(rs_l, 2 * i + (lane >> 5)); qinv4[i] = 1.0f / __shfl(s2_l, 2 * i + (lane >> 5)); }
    const int lrow = lane >> 5, lcol = (lane & 31) * 4;
    const int fr = lane & 15, fg = lane >> 4;
    f32x4 acc[4];
#pragma unroll
    for (int nb = 0; nb < 4; ++nb) acc[nb] = (f32x4){0.f, 0.f, 0.f, 0.f};
    v4u bsA[4], bsB[4], bsC[4]; f32x4 xvA[4], xvB[4], xvC[4], gsA, gsB, gsC, shA, shB, shC;
#define P6_LOAD(S, c) do { _Pragma("unroll") for (int q = 0; q < 4; ++q) { const int idx = tid + 512 * q, e = (idx >> 4) & 63, part = idx & 15; \
            bs##S[q] = *(const v4u*)(((idx >> 10) ? WRL : WRH) + (size_t)e * DMODEL + 128 * (c) + part * 8); } \
        _Pragma("unroll") for (int i = 0; i < 4; ++i) xv##S[i] = *(const f32x4*)(x1 + (size_t)(rowb + 2 * i + lrow) * DMODEL + 128 * (c) + lcol); \
        gs##S = *(const f32x4*)(a.in[16] + 128 * (c) + lcol) * (1.0f + *(const f32x4*)(mod + 4096 + 128 * (c) + lcol)); sh##S = *(const f32x4*)(mod + 3072 + 128 * (c) + lcol); } while (0)
#define P6_BSTORE(S, buf) do { _Pragma("unroll") for (int q = 0; q < 4; ++q) { const int idx = tid + 512 * q, e = (idx >> 4) & 63, part = idx & 15; \
            *(LAS v4u*)(BS + (buf) * BSB + (idx >> 10) * BSH + e * RS + part * 16) = bs##S[q]; } } while (0)
#define P6_CONVERT(S, c) do { _Pragma("unroll") for (int i = 0; i < 4; ++i) { const int rr = 2 * i + lrow; const f32x4 hv = xv##S[i] * rstd4[i] * gs##S + sh##S; \
            const unsigned h0 = f2bf(hv[0]), h1_ = f2bf(hv[1]), h2_ = f2bf(hv[2]), h3 = f2bf(hv[3]); \
            const v2u whi = (v2u){h0 | (h1_ << 16), h2_ | (h3 << 16)}; \
            const v2u wlo = (v2u){pk2(hv[0] - bf2f(h0), hv[1] - bf2f(h1_)), pk2(hv[2] - bf2f(h2_), hv[3] - bf2f(h3))}; \
            *(GAS unsigned*)(H2 + (size_t)(rowb + rr) * DMODEL + 128 * (c) + lcol) = pk4_i8(hv[0] * qinv4[i], hv[1] * qinv4[i], hv[2] * qinv4[i], hv[3] * qinv4[i]); \
            *(LAS v2u*)(AW + rr * RS + lcol * 2) = whi; *(LAS v2u*)(AW + 8 * RS + rr * RS + lcol * 2) = wlo; } } while (0)
#if defined(P6_ABL) && P6_ABL == 4
#define P6_MMA(c) do { } while (0)
#else
#define P6_MMA(c) do { const LAS unsigned char* bsl = BS + ((c) & 1) * BSB; _Pragma("unroll") for (int ks = 0; ks < 4; ++ks) { \
            const bf16x8 ahi = *(const LAS bf16x8*)(AW + (fr & 7) * RS + (32 * ks + 8 * fg) * 2), alo = *(const LAS bf16x8*)(AW + 8 * RS + (fr & 7) * RS + (32 * ks + 8 * fg) * 2); \
            _Pragma("unroll") for (int nb = 0; nb < 4; ++nb) { const bf16x8 bh = *(const LAS bf16x8*)(bsl + (16 * nb + fr) * RS + (32 * ks + 8 * fg) * 2), bl = *(const LAS bf16x8*)(bsl + BSH + (16 * nb + fr) * RS + (32 * ks + 8 * fg) * 2); \
                acc[nb] = __builtin_amdgcn_mfma_f32_16x16x32_bf16(alo, bh, acc[nb], 0, 0, 0); acc[nb] = __builtin_amdgcn_mfma_f32_16x16x32_bf16(ahi, bl, acc[nb], 0, 0, 0); acc[nb] = __builtin_amdgcn_mfma_f32_16x16x32_bf16(ahi, bh, acc[nb], 0, 0, 0); } } } while (0)
#endif
#if defined(P6_ABL) && P6_ABL == 2
    return;
#endif
    P6_LOAD(A, 0); P6_LOAD(B, 1); P6_LOAD(C, 2); P6_BSTORE(A, 0);
    __syncthreads();
    P6_CONVERT(A, 0); P6_LOAD(A, 3); P6_MMA(0); P6_BSTORE(B, 1); __syncthreads();
    P6_CONVERT(B, 1); P6_LOAD(B, 4); P6_MMA(1); P6_BSTORE(C, 0); __syncthreads();
    P6_CONVERT(C, 2); P6_LOAD(C, 5); P6_MMA(2); P6_BSTORE(A, 1); __syncthreads();
    P6_CONVERT(A, 3); P6_LOAD(A, 6); P6_MMA(3); P6_BSTORE(B, 0); __syncthreads();
    P6_CONVERT(B, 4); P6_LOAD(B, 7); P6_MMA(4); P6_BSTORE(C, 1); __syncthreads();
    P6_CONVERT(C, 5); P6_MMA(5); P6_BSTORE(A, 0); __syncthreads();
    P6_CONVERT(A, 6); P6_MMA(6); P6_BSTORE(B, 1); __syncthreads();
    P6_CONVERT(B, 7); P6_MMA(7); __syncthreads();
#undef P6_LOAD
#undef P6_BSTORE
#undef P6_CONVERT
#undef P6_MMA
#if defined(P6_ABL) && P6_ABL == 1
    { if (fg < 2 && acc[0][0] == 12345.f) a.out[1] = acc[1][1] + acc[2][2] + acc[3][3]; return; }
#endif
    LAS float* LG = (LAS float*)AW;
    if (fg < 2) {
#pragma unroll
        for (int nb = 0; nb < 4; ++nb)
#pragma unroll
            for (int r = 0; r < 4; ++r) LG[(4 * fg + r) * 64 + 16 * nb + fr] = acc[nb][r];
    }
    LAS float* RSW = (LAS float*)(BS + wave * 8192);
    const float rbias = a.in[18][lane];
    int selk[8]; float selw[8]; int lc = 0;
#if defined(P6_ABL) && P6_ABL >= 3
#pragma unroll
    for (int j = 0; j < 8; ++j) { const bool sel = (lane >> 3) == j; selk[j] = sel ? (lane & 7) : -1; selw[j] = 0.3125f + 1e-9f * LG[j * 64 + lane] + 0.f * rbias; lc += sel ? 1 : 0; }
#else
#pragma unroll
    for (int j = 0; j < 8; ++j) {
        LAS float* Vb = RSW + j * 160; LAS float* Cb = Vb + 64; LAS float* Gb = Vb + 128; LAS float* Tb = Vb + 136;
        const float sc = 1.0f / (1.0f + expf(-LG[j * 64 + lane])), v = sc + rbias;
        Vb[lane] = v;
        const f32x4 ga = *(const LAS f32x4*)(Vb + (lane & ~7)), gb = *(const LAS f32x4*)(Vb + (lane & ~7) + 4);
        float m1 = -INFINITY, m2 = -INFINITY;
#pragma unroll
        for (int q = 0; q < 8; ++q) { const float o = q < 4 ? ga[q] : gb[q - 4]; if (o > m1) { m2 = m1; m1 = o; } else if (o > m2) m2 = o; }
        const float gs = m1 + m2;
        if ((lane & 7) == 0) Gb[lane >> 3] = gs;
        const f32x4 sa = *(const LAS f32x4*)Gb, sb = *(const LAS f32x4*)(Gb + 4);
        int grk = 0; const int g = lane >> 3;
#pragma unroll
        for (int g2 = 0; g2 < 8; ++g2) { const float og = g2 < 4 ? sa[g2] : sb[g2 - 4]; grk += (og > gs) || (og == gs && g2 < g); }
        const bool gsel = grk < 4; const float cnd = gsel ? v : -INFINITY;
        Cb[lane] = cnd;
        int gt = 0, eq = 0;
#pragma unroll
        for (int q = 0; q < 16; ++q) { const f32x4 o = *(const LAS f32x4*)(Cb + 4 * q);
            gt += (o[0] > cnd) + (o[1] > cnd) + (o[2] > cnd) + (o[3] > cnd); eq += (o[0] == cnd) + (o[1] == cnd) + (o[2] == cnd) + (o[3] == cnd); }
        int erk = gt;
        if (__builtin_expect(__any(gsel && eq > 1), 0)) erk = (int)p6_rank_slow(cnd, lane);
        const bool sel = gsel && erk < TOPK;
        if (sel) Tb[erk] = sc;
        const f32x4 ta = *(const LAS f32x4*)Tb, tb_ = *(const LAS f32x4*)(Tb + 4);
        const float wsum = ((ta[0] + ta[1]) + (ta[2] + ta[3])) + ((tb_[0] + tb_[1]) + (tb_[2] + tb_[3]));
        selk[j] = sel ? erk : -1; selw[j] = sc * (ROUTED_SCALE / wsum); lc += sel ? 1 : 0;
    }
#endif
    hist[wave * 64 + lane] = lc;
    __syncthreads();
    if (wave == 0) { int tot = 0;
#pragma unroll
        for (int w = 0; w < 8; ++w) tot += hist[w * 64 + lane];
        gbase[lane] = tot ? (int)__hip_atomic_fetch_add((unsigned*)(ws + WS_CTL) + CW_CNT + 64 * lane, (unsigned)tot, RLX_AGENT) : 0; }
    __syncthreads();
    {   int base = gbase[lane];
        for (int w = 0; w < wave; ++w) base += hist[w * 64 + lane];
        int* list = (int*)(ws + WS_LIST); float* wl = (float*)(ws + WS_WLIST); float* sl = (float*)(ws + WS_SLIST);
#pragma unroll
        for (int j = 0; j < 8; ++j) { const float s2j = __shfl(s2_l, j); if (selk[j] >= 0) { const size_t p = (size_t)lane * LISTCAP + base; list[p] = (rowb + j) * TOPK + selk[j]; wl[p] = selw[j]; sl[p] = s2j; ++base; } } }
    __syncthreads();
}

constexpr int WD_SPLIT = 5120;
__device__ __forceinline__ void moe_tables(const KArgs& a, LAS unsigned char* lds, int tid, int lane) {
    LAS int* tstart = (LAS int*)(lds + TAB_OFF); LAS int* cntl = tstart + 80;
    if (tid < 64) { const int c = (int)__hip_atomic_load((unsigned*)(a.ws + WS_CTL) + CW_CNT + 64 * tid, RLX_AGENT); const int tl = (c + 255) >> 8; int sc = tl;
#pragma unroll
        for (int o = 1; o < 64; o <<= 1) { const int up = __shfl_up(sc, o); if (lane >= o) sc += up; }
        cntl[tid] = c; tstart[tid + 1] = sc; if (tid == 0) tstart[0] = 0; }
    __syncthreads();
}

__global__ void __launch_bounds__(NWAVES * 64, 2) fox_fwd(KArgs args) {
    extern __shared__ __attribute__((aligned(16))) unsigned char lds_raw[];
    LAS unsigned char* lds = (LAS unsigned char*)lds_raw;
    volatile LAS unsigned* MISC = (volatile LAS unsigned*)(lds + MISC_OFF);
    const int tid = threadIdx.x, lane = tid & 63, wave = __builtin_amdgcn_readfirstlane(tid >> 6);
    const int G = gridDim.x; int vcu; { const int bx = blockIdx.x; vcu = (G % 8 == 0) ? (bx % 8) * (G / 8) + bx / 8 : bx; }
    unsigned char* ws = args.ws; gu32* ctl = (gu32*)(ws + WS_CTL);
    for (int u = tid; u < (LDS_BYTES - LDSCTL_OFF) / 4; u += NWAVES * 64) ((LAS unsigned*)(lds + LDSCTL_OFF))[u] = 0u;
    __syncthreads();
    const int lo = args.ph_lo, hi = args.ph_hi; const bool single = (hi - lo) > 1;
    XcdBarrier bar; bar.bar = (unsigned*)(ctl + CW_BAR); bar.x = 0; bar.st = nullptr;
    if (single) bar = xcd_barrier_post((unsigned*)(ctl + CW_BAR), MISC + 8);
#ifndef PHASE_MASK
#define PHASE_MASK 0x3ff
#endif
#define IN(k) (((PHASE_MASK >> (k)) & 1) && lo <= (k) && (k) < hi)
#if defined(DIAG_A)
    unsigned long long* dstamp = (unsigned long long*)(ws + WS_CTL + 512 * 1024);
#define GRID_BAR(k) do { if (IN(k) && IN((k) + 1)) xcd_barrier(bar); if (blockIdx.x == 0 && tid == 0) dstamp[(k) + 1] = __builtin_amdgcn_s_memrealtime(); } while (0)
    if (blockIdx.x == 0 && tid == 0) dstamp[0] = __builtin_amdgcn_s_memrealtime();
#else
#define GRID_BAR(k) do { if (IN(k) && IN((k) + 1)) xcd_barrier(bar); } while (0)
#endif
    bf16* H1 = (bf16*)(ws + WS_H1); bf16* Ub = (bf16*)(ws + WS_U); bf16* Qb = (bf16*)(ws + WS_Q); bf16* Kb = (bf16*)(ws + WS_K); bf16* Vb = (bf16*)(ws + WS_V);
    bf16* SG = (bf16*)(ws + WS_SG); bf16* UC = (bf16*)(ws + WS_UC); bf16* Ob = (bf16*)(ws + WS_O); bf16* MG = (bf16*)(ws + WS_MG);
    const float* mod = (const float*)(ws + WS_MOD);

#if FWD_LEVEL == 0
    if (IN(0)) { const f32x4* xs = (const f32x4*)args.in[0]; f32x4* od = (f32x4*)args.out;
        for (size_t i = (size_t)blockIdx.x * 512 + tid; i < (size_t)T * DMODEL / 4; i += (size_t)G * 512) od[i] = xs[i]; }
    for (int k = 0; k < 9; ++k) GRID_BAR(k);
#else
    if (IN(0)) p0_prologue(args, lds, vcu, G, wave, lane);
    GRID_BAR(0);
    if (IN(1)) { if (G == 256) p1_rows(args, lds, vcu, tid, wave, lane); __syncthreads(); q8_items(args, lds, vcu, G, wave, lane); }
    GRID_BAR(1);
    if (IN(2)) {
        if (blockIdx.x < 16) p2_cumsum(args, lds, blockIdx.x, tid, wave, lane);
        SchedDense S{64, NIN / 256, G, (int)blockIdx.x, 512, (const char*)H1, (const char*)(ws + WS_WIN)};
        EpiIn E{Ub, Qb, Kb, Vb, SG, args.in[11], args.in[12], (const float*)(ws + WS_SA1), (const unsigned*)(ws + WS_CTL) + CW_AMAX};
        pg8::gemm_phase<EpiIn, SchedDense, true, false, true>(lds + RING_OFF, 512, S, E);
        if (G == 256 && blockIdx.x >= 128) wd_items(args, lds, 0, WD_SPLIT, (int)blockIdx.x - 128, 128, wave, lane);
        else if (G != 256) wd_items(args, lds, 0, WD_SPLIT, (int)blockIdx.x, G, wave, lane);
    }
    GRID_BAR(2);
#if defined(DBG_STAGE) && (DBG_STAGE == 24 || DBG_STAGE == 4)
    {   const bf16* src = (DBG_STAGE == 24) ? SG : (const bf16*)(ws + WS_WIN) + (size_t)2560 * 1024;
        for (size_t i = (size_t)blockIdx.x * 512 + tid; i < (size_t)T * 1024; i += (size_t)G * 512) { const size_t r = i >> 10, c = i & 1023; args.out[i] = bf2f(src[((DBG_STAGE == 24) ? r : (r & 2047)) * 1024 + c]); }
        return; }
#endif
    if (IN(3)) {
        float gq = fabsf(args.in[11][lane]), gk = fabsf(args.in[12][lane]);
#pragma unroll
        for (int o = 1; o < 64; o <<= 1) { gq = fmaxf(gq, __shfl_xor(gq, o)); gk = fmaxf(gk, __shfl_xor(gk, o)); }
        const float thr2 = 2.0f * (8.0f * gq * gk * LOG2E) + 40.0f;
        const attn_body::AttnTensors AT{(const attn_body::bf16*)Qb, (const attn_body::bf16*)Kb, (const attn_body::bf16*)Vb, (attn_body::bf16*)Ob, (const float*)(ws + WS_CUM), thr2};
        if (G == 256) { const attn_body::StaticOrder S(G, (int)blockIdx.x); attn_body::attn_phase<attn_body::StaticOrder>((char*)lds_raw + RING_OFF, AT, S); }
        for (int it = vcu; it < 1024; it += G) conv_item(args, lds, it, tid);
    }
    GRID_BAR(3);
#if defined(DBG_STAGE)
    {
#if DBG_STAGE == 2
        const bf16* bA = Qb; const bf16* bB = Kb;
#elif DBG_STAGE == 21
        const bf16* bA = Vb; const bf16* bB = Ub;
#elif DBG_STAGE == 22
        const bf16* bA = SG; const bf16* bB = SG + 512;
#elif DBG_STAGE == 23
        const bf16* bA = SG + (size_t)T * 1024; const bf16* bB = SG + (size_t)T * 1024 + 512;
#elif DBG_STAGE == 3
        const bf16* bA = Ob; const bf16* bB = UC;
#else
        const bf16* bA = H1; const bf16* bB = H1 + 512;
#endif
        const int ldA = (DBG_STAGE == 1 || DBG_STAGE == 22 || DBG_STAGE == 23) ? 1024 : 512;
        for (size_t i = (size_t)blockIdx.x * 512 + tid; i < (size_t)T * 512; i += (size_t)G * 512) { const size_t r = i >> 9, c = i & 511;
            args.out[r * 1024 + c] = bf2f(bA[r * ldA + c]); args.out[r * 1024 + 512 + c] = bf2f(bB[r * ldA + c]); }
        return;
    }
#endif
    if (IN(4)) {
        SchedMerge S{(int)blockIdx.x, (const char*)UC, (const char*)(ws + WS_WC), (const char*)Ob, (const char*)(ws + WS_WA)};
        EpiMerge E{SG, MG};
        pg8::gemm_phase<EpiMerge, SchedMerge, false>(lds + RING_OFF, 512, S, E);
    }
    GRID_BAR(4);
#if defined(DBG_STAGE2)
    {   for (size_t i = (size_t)blockIdx.x * 512 + tid; i < (size_t)T * 1024; i += (size_t)G * 512) args.out[i] = bf2f(MG[i]);
        return; }
#endif
    if (IN(5)) {
        SchedDense S{64, 4, G, (int)blockIdx.x, 1024, (const char*)MG, (const char*)(ws + WS_WOUT)};
        EpiX1 E{args.in[0], args.out, mod, (float*)(ws + WS_SSQ), (float*)(ws + WS_XMX)};
        pg8::gemm_phase<EpiX1, SchedDense, false>(lds + RING_OFF, 1024, S, E);
    }
    GRID_BAR(5);
#if FWD_LEVEL >= 2
    if (IN(6)) { if (G == 256) p6_block(args, lds, vcu, tid, wave, lane); }
    GRID_BAR(6);
    const MoeTab tb{(const LAS int*)(lds + TAB_OFF), (const LAS int*)(lds + TAB_OFF) + 80};
    if (IN(7)) {
        moe_tables(args, lds, tid, lane);
        const int ntiles = tb.tstart[64], nmoe = 2 * ntiles, ntot = nmoe + 128, per = G;
        SchedMoe1 S{tb, nmoe, ntot, per, vcu, lane, (const char*)(ws + WS_H2), (const char*)(ws + WS_WGU), (const char*)(ws + WS_WSGU), (const int*)(ws + WS_LIST)};
        EpiGlu E{(bf16*)(ws + WS_ACT), (bf16*)(ws + WS_SACT), (const float*)(ws + WS_WLIST), (const float*)(ws + WS_SLIST), (const float*)(ws + WS_SA2), (const unsigned*)(ws + WS_CTL) + CW_AMAX, tb};
        pg8::gemm_phase<EpiGlu, SchedMoe1, true, false, true>(lds + RING_OFF, 512, S, E);
        {
            const int rounds = (ntot + G - 1) / G, busy = ntot - (rounds - 1) * G;
            if (vcu >= busy && busy < G) wd_items(args, lds, WD_SPLIT, 64 * 128, vcu - busy, G - busy, wave, lane);
            else if (busy >= G) wd_items(args, lds, WD_SPLIT, 64 * 128, vcu, G, wave, lane); }
    }
    GRID_BAR(7);
    if (IN(8)) {
        moe_tables(args, lds, tid, lane);
        const int ntiles = tb.tstart[64], ntot = 4 * ntiles, per = G;
        SchedMoe2 S{tb, ntot, per, vcu, lane, (const char*)(ws + WS_ACT), (const char*)(ws + WS_WD)};
        EpiSlab E{ws + WS_SLAB, (const int*)(ws + WS_LIST), tb};
        pg8::gemm_phase<EpiSlab, SchedMoe2, true>(lds + RING_OFF, 256, S, E);
    }
    GRID_BAR(8);
    if (IN(9)) {
        SchedDense S{64, 4, G, (int)blockIdx.x, 256, (const char*)(ws + WS_SACT), (const char*)(ws + WS_WSD)};
        EpiFinal E{args.out, ws + WS_SLAB, mod};
        pg8::gemm_phase<EpiFinal, SchedDense, false>(lds + RING_OFF, 256, S, E);
    }
#endif
#endif
#if defined(DIAG_A)
    {
        xcd_barrier(bar); if (blockIdx.x == 0 && tid == 0) dstamp[10] = __builtin_amdgcn_s_memrealtime();
        xcd_barrier(bar); if (blockIdx.x == 0 && tid == 0) dstamp[11] = __builtin_amdgcn_s_memrealtime();
        xcd_barrier(bar); if (blockIdx.x == 0 && tid == 0) dstamp[12] = __builtin_amdgcn_s_memrealtime();
        xcd_barrier(bar);
        const float dta = (float)(dstamp[DIAG_A + 1] - dstamp[DIAG_A]) * 0.01f;
#if defined(DIAG_BIG)
        if (blockIdx.x == 0 && tid == 0) args.out[0] += 2.0f + dta * 0.04f;
#else
        if (blockIdx.x == 0 && tid == 0) args.out[0] += 0.5f + dta * 0.01f;
#endif
    }
#endif
#undef IN
#undef GRID_BAR
}

#ifndef N_LAUNCH_MODE
#define N_LAUNCH_MODE 1
#endif
extern "C" void kernel_launch(void* const* d_in, const int* in_sizes, int n_in, void* d_out, int out_size, void* d_ws, size_t ws_size, hipStream_t stream) {
    static int grid = 0;
    if (grid == 0) {
        if (n_in != 23 || in_sizes[0] != T * DMODEL || out_size != T * DMODEL || ws_size < WS_END) {
            fprintf(stderr, "kernel_launch: built for 23 inputs, x/out of %d floats, >= %zu bytes of workspace; got n_in %d, in0 %d, out %d, ws %zu; nothing launched\n", T * DMODEL, (size_t)WS_END, n_in, n_in > 0 ? in_sizes[0] : -1, out_size, ws_size);
            grid = -1; return; }
        int dev = 0, cus = 0, per_cu = 0;
        if (hipGetDevice(&dev) != hipSuccess || hipDeviceGetAttribute(&cus, hipDeviceAttributeMultiprocessorCount, dev) != hipSuccess) { fprintf(stderr, "kernel_launch: device query failed\n"); grid = -1; return; }
        if (hipFuncSetAttribute((const void*)fox_fwd, hipFuncAttributeMaxDynamicSharedMemorySize, LDS_BYTES) != hipSuccess) { fprintf(stderr, "kernel_launch: hipFuncSetAttribute failed\n"); grid = -1; return; }
        if (hipOccupancyMaxActiveBlocksPerMultiprocessor(&per_cu, (const void*)fox_fwd, NWAVES * 64, LDS_BYTES) != hipSuccess || per_cu < 1)
            fprintf(stderr, "kernel_launch: note: occupancy query reports %d workgroups per CU\n", per_cu);
        (void)hipGetLastError();
        grid = cus;
        if (grid != 256) fprintf(stderr, "kernel_launch: %d CUs; this kernel is built for 256\n", grid);
    }
    if (grid < 0) return;
    if (hipMemsetAsync((char*)d_ws + WS_CTL, 0, CTL_ZERO_BYTES, stream) != hipSuccess) { fprintf(stderr, "kernel_launch: memset failed\n"); return; }
    KArgs a{};
    for (int i = 0; i < 23; ++i) a.in[i] = (const float*)d_in[i];
    a.out = (float*)d_out; a.ws = (unsigned char*)d_ws;
#if N_LAUNCH_MODE == 1
    a.ph_lo = 0; a.ph_hi = 10;
    hipLaunchKernelGGL(fox_fwd, dim3(grid), dim3(NWAVES * 64), LDS_BYTES, stream, a);
#else
    for (int p = 0; p < 10; ++p) { a.ph_lo = p; a.ph_hi = p + 1; hipLaunchKernelGGL(fox_fwd, dim3(grid), dim3(NWAVES * 64), LDS_BYTES, stream, a); }
#endif
    const hipError_t le = hipPeekAtLastError();
    if (le != hipSuccess) fprintf(stderr, "kernel_launch: launch failed: %s\n", hipGetErrorName(le));
}
```

```cpp
#include <hip/hip_runtime.h>
#include <hip/hip_bf16.h>
#include <cstdio>
#include <cstdint>
#include <cmath>

#ifndef ATTN_SKIP
#define ATTN_SKIP 1
#endif
#ifndef FWD_LEVEL
#define FWD_LEVEL 2
#endif

namespace pg8 {
#define PG8_LAS __attribute__((address_space(3)))
typedef unsigned short bf16_t;
typedef short bf16x8 __attribute__((ext_vector_type(8)));
typedef float f32x4 __attribute__((ext_vector_type(4)));
typedef unsigned u32x4 __attribute__((ext_vector_type(4)));
constexpr int BM = 256, BK = 64, HALF = 128, HTB = HALF * BK * 2  , STAGE_BYTES = 8 * HTB, NXCD = 8, WGM = 8;

__host__ __device__ __forceinline__ int lds_byte(int r, int c) { const int st = (r >> 4) * 2 + (c >> 5), rr = r & 15, cc = c & 31, ob = rr * 64 + cc * 2; return st * 1024 + (ob ^ (((ob >> 9) & 1) << 5)); }
__host__ __device__ __forceinline__ void stage_rc(int b, int& R, int& C) { const int st = b / 1024, sb = b % 1024, swz = sb ^ (((sb >> 9) & 1) << 5); R = (st >> 1) * 16 + swz / 64; C = (st & 1) * 32 + (swz % 64) / 2; }
__host__ __device__ __forceinline__ int perm32(int rho) { const int n = rho >> 4, i = rho & 15; return 8 * (i >> 2) + 4 * n + (i & 3); }

struct Unit { int pm, pn, e, mt; const char* A; const char* B; };

__host__ __device__ __forceinline__ void tile_of(int L, int nM, int nN, int& pm, int& pn) {
    const int nwg = nM * nN; int wgid = L; { const int q = nwg / NXCD, r = nwg % NXCD, xcd = wgid % NXCD, off = wgid / NXCD; wgid = (xcd < r ? xcd * (q + 1) : r * (q + 1) + (xcd - r) * q) + off; }
    const int nig = WGM * nN, gid = wgid / nig, fm = gid * WGM, gsz = (nM - fm) < WGM ? (nM - fm) : WGM;
    pm = fm + ((wgid % nig) % gsz); pn = (wgid % nig) / gsz;
}
typedef float f32x2_c __attribute__((ext_vector_type(2))); typedef __bf16 bf16x2_c __attribute__((ext_vector_type(2)));
__device__ __forceinline__ unsigned cvt_pk_bf16(float lo, float hi) { f32x2_c v = {lo, hi}; bf16x2_c b = __builtin_convertvector(v, bf16x2_c); return __builtin_bit_cast(unsigned, b); }
__device__ __forceinline__ float bf_lo(unsigned w) { return __builtin_bit_cast(float, w << 16); }
__device__ __forceinline__ float bf_hi(unsigned w) { return __builtin_bit_cast(float, w & 0xffff0000u); }
__device__ __forceinline__ float sigmoidf_fast(float x) { return __builtin_amdgcn_rcpf(1.0f + __builtin_amdgcn_exp2f(-1.4426950408889634f * x)); }

typedef int i32x4_c __attribute__((ext_vector_type(4))); typedef int i32x8_c __attribute__((ext_vector_type(8)));
__device__ __forceinline__ i32x8_c cat16(const bf16x8& lo, const bf16x8& hi) { const i32x4_c a = __builtin_bit_cast(i32x4_c, lo), b = __builtin_bit_cast(i32x4_c, hi); return __builtin_shufflevector(a, b, 0, 1, 2, 3, 4, 5, 6, 7); }
template <class Epi, class Sched, bool ALIGN_EPI, bool FP8 = false, bool I8 = false>
__device__ __forceinline__ void gemm_phase(PG8_LAS unsigned char* lds, const int K, const Sched& S, const Epi& E) {
    const int tid = threadIdx.x, wid = __builtin_amdgcn_readfirstlane(tid >> 6), lane = tid & 63, wr = wid >> 2, wc = wid & 3, fr = lane & 15, fq = lane >> 4;
    const int nt = K / BK;
    int sR[2], sC[2]; unsigned voffB[2];
#pragma unroll
    for (int i = 0; i < 2; ++i) { int R, C; stage_rc(tid * 16 + i * 8192, R, C); sR[i] = R; sC[i] = C; const int Rb = Epi::PERM ? ((R & ~31) + perm32(R & 31)) : R; voffB[i] = (unsigned)(Rb * K + C) * 2u; }
    const size_t kstep = (size_t)(BK * 2);
    const size_t hstep = (size_t)HALF * K * 2;
    const unsigned ldsw = (unsigned)wid * 1024u;
    const int aoff = lds_byte(wr * 64 + fr, fq * 8), boff = lds_byte(wc * 32 + fr, fq * 8);
#define PG8_SA(b, h) (((b) * 2 + (h)) * HTB)
#define PG8_SB(b, h) ((4 + (b) * 2 + (h)) * HTB)
#define PG8_STAGE(bufoff, gbase, voff) do { _Pragma("unroll") for (int _i = 0; _i < 2; ++_i) \
        __builtin_amdgcn_global_load_lds((const unsigned*)((const char*)(gbase) + (voff)[_i]), (PG8_LAS unsigned*)(lds + (bufoff) + ldsw + _i * 8192), 16, 0, 0); } while (0)
#define PG8_STAGE_A(bufoff, gbase, h, V0, V1) do { if constexpr (Sched::GATHER) { if (h) PG8_STAGE(bufoff, gbase, V1); else PG8_STAGE(bufoff, gbase, V0); } \
        else { PG8_STAGE(bufoff, (const char*)(gbase) + ((h) ? hstep : 0), V0); } } while (0)
#define PG8_LDA(dst, b, h) do { _Pragma("unroll") for (int m = 0; m < 4; ++m) { if constexpr (FP8) { const bf16x8 lo_ = *(const PG8_LAS bf16x8*)(lds + PG8_SA(b, h) + aoff + m * 2048), hi_ = *(const PG8_LAS bf16x8*)(lds + PG8_SA(b, h) + aoff + m * 2048 + 1024); dst##8[m] = cat16(lo_, hi_); } \
        else { _Pragma("unroll") for (int k = 0; k < 2; ++k) dst[m][k] = *(const PG8_LAS bf16x8*)(lds + PG8_SA(b, h) + aoff + m * 2048 + k * 1024); } } } while (0)
#define PG8_LDB(dst, b, h) do { _Pragma("unroll") for (int n = 0; n < 2; ++n) { if constexpr (FP8) { const bf16x8 lo_ = *(const PG8_LAS bf16x8*)(lds + PG8_SB(b, h) + boff + n * 2048), hi_ = *(const PG8_LAS bf16x8*)(lds + PG8_SB(b, h) + boff + n * 2048 + 1024); dst##8[n] = cat16(lo_, hi_); } \
        else { _Pragma("unroll") for (int k = 0; k < 2; ++k) dst[n][k] = *(const PG8_LAS bf16x8*)(lds + PG8_SB(b, h) + boff + n * 2048 + k * 1024); } } } while (0)
#define PG8_MMA(ai, bj, At, Bt) do { __builtin_amdgcn_s_setprio(1); if constexpr (FP8) { _Pragma("unroll") for (int m = 0; m < 4; ++m) _Pragma("unroll") for (int n = 0; n < 2; ++n) \
        acc[ai][bj][m][n] = __builtin_amdgcn_mfma_scale_f32_16x16x128_f8f6f4(Bt##8[n], At##8[m], acc[ai][bj][m][n], 0, 0, 0, 0x7f7f7f7f, 0, 0x7f7f7f7f); } \
        else if constexpr (I8) { _Pragma("unroll") for (int m = 0; m < 4; ++m) _Pragma("unroll") for (int n = 0; n < 2; ++n) _Pragma("unroll") for (int k = 0; k < 2; ++k) \
        acc[ai][bj][m][n] = __builtin_bit_cast(f32x4, __builtin_amdgcn_mfma_i32_16x16x64_i8(__builtin_bit_cast(i32x4_c, Bt[n][k]), __builtin_bit_cast(i32x4_c, At[m][k]), __builtin_bit_cast(i32x4_c, acc[ai][bj][m][n]), 0, 0, 0)); } \
        else { _Pragma("unroll") for (int m = 0; m < 4; ++m) _Pragma("unroll") for (int n = 0; n < 2; ++n) _Pragma("unroll") for (int k = 0; k < 2; ++k) \
        acc[ai][bj][m][n] = __builtin_amdgcn_mfma_f32_16x16x32_bf16(Bt[n][k], At[m][k], acc[ai][bj][m][n], 0, 0, 0); } __builtin_amdgcn_s_setprio(0); } while (0)
#define PG8_WAIT_V(n) asm volatile("s_waitcnt vmcnt(" #n ")" ::: "memory")
#define PG8_WAIT_L(n) asm volatile("s_waitcnt lgkmcnt(" #n ")" ::: "memory")
#define PG8_BAR __builtin_amdgcn_s_barrier()
#define PG8_SCHED __builtin_amdgcn_sched_barrier(0)
    Unit cur, nxt; int ui = 0;
    if (!S.next(0, cur)) return;
    unsigned vc0[2], vc1[2], vn0[2], vn1[2];
#pragma unroll
    for (int i = 0; i < 2; ++i) {
        if constexpr (Sched::GATHER) { vc0[i] = (unsigned)(S.row(cur, sR[i]) * K + sC[i]) * 2u; vc1[i] = (unsigned)(S.row(cur, HALF + sR[i]) * K + sC[i]) * 2u; }
        else { vc0[i] = (unsigned)(sR[i] * K + sC[i]) * 2u; vc1[i] = 0u; }
        vn0[i] = vc0[i]; vn1[i] = vc1[i];
    }
    f32x4 acc[2][2][4][2];
#pragma unroll
    for (int a = 0; a < 2; ++a)
#pragma unroll
        for (int b = 0; b < 2; ++b)
#pragma unroll
            for (int m = 0; m < 4; ++m)
#pragma unroll
                for (int n = 0; n < 2; ++n) acc[a][b][m][n] = (f32x4){0.f, 0.f, 0.f, 0.f};
    typename Epi::Pre pre; E.prefetch(pre, cur, wr, wc, fr, fq);
    PG8_LAS unsigned char* const rtab = lds + STAGE_BYTES + 2048;
#define PG8_ROWTAB(U, par) do { if constexpr (Epi::ROWTAB) { _Pragma("unroll") for (int t_ = 0; t_ < Epi::NTAB; ++t_) { const char* src_ = E.tab_src(U, t_); if (wid < 4 && src_ != nullptr) \
        __builtin_amdgcn_global_load_lds((const unsigned*)(src_ + tid * 4), (PG8_LAS unsigned*)(rtab + ((par) * Epi::NTAB + t_) * 1024 + wid * 256), 4, 0, 0); } } } while (0)
    PG8_ROWTAB(cur, 0);
    bf16x8 At[4][2], B0[2][2], B1[2][2]; i32x8_c At8[4], B08[2], B18[2];
    const char* cA = cur.A; const char* cB = cur.B;
    PG8_STAGE(PG8_SB(0, 0), cB, voffB); PG8_STAGE(PG8_SB(0, 1), cB + hstep, voffB); PG8_STAGE_A(PG8_SA(0, 0), cA, 0, vc0, vc1); PG8_STAGE_A(PG8_SA(0, 1), cA, 1, vc0, vc1);
    if (wr == 1) PG8_BAR;
    PG8_WAIT_V(2); PG8_BAR;
    PG8_STAGE(PG8_SB(1, 0), cB + kstep, voffB); PG8_STAGE_A(PG8_SA(1, 0), cA + kstep, 0, vc0, vc1); PG8_STAGE(PG8_SB(1, 1), cB + hstep + kstep, voffB);
    PG8_WAIT_V(6); PG8_BAR;
    for (;;) {
        const bool has_next = S.next(ui + 1, nxt);
        const char* nA = has_next ? nxt.A : cA; const char* nB = has_next ? nxt.B : cB;
        if constexpr (Sched::GATHER) {
            if (has_next) {
#pragma unroll
                for (int i = 0; i < 2; ++i) { vn0[i] = (unsigned)(S.row(nxt, sR[i]) * K + sC[i]) * 2u; vn1[i] = (unsigned)(S.row(nxt, HALF + sR[i]) * K + sC[i]) * 2u; }
            }
        }
#pragma nounroll
        for (int t = 0; t < nt; t += 2) {
            const bool last = (t == nt - 2);
            const char* a1 = cA + (size_t)(t + 1) * kstep;
            const char* a2 = last ? nA : cA + (size_t)(t + 2) * kstep; const char* b2 = last ? nB : cB + (size_t)(t + 2) * kstep;
            const char* a3 = a2 + kstep; const char* b3 = b2 + kstep;
            unsigned w0[2], w1[2];
#pragma unroll
            for (int i = 0; i < 2; ++i) { if constexpr (Sched::GATHER) { w0[i] = last ? vn0[i] : vc0[i]; w1[i] = last ? vn1[i] : vc1[i]; } else { w0[i] = vc0[i]; w1[i] = 0u; } }
            PG8_LDB(B0, 0, 0); PG8_LDB(B1, 0, 1); PG8_SCHED; PG8_LDA(At, 0, 0); PG8_STAGE_A(PG8_SA(1, 1), a1, 1, vc0, vc1);
            PG8_WAIT_V(8); PG8_WAIT_L(0); PG8_BAR; PG8_MMA(0, 0, At, B0); PG8_MMA(0, 1, At, B1); PG8_BAR; PG8_SCHED;
            PG8_LDA(At, 0, 1); PG8_STAGE(PG8_SB(0, 0), b2, voffB); PG8_STAGE(PG8_SB(0, 1), b2 + hstep, voffB); PG8_STAGE_A(PG8_SA(0, 0), a2, 0, w0, w1);
            PG8_WAIT_V(8); PG8_WAIT_L(0); PG8_BAR; PG8_MMA(1, 0, At, B0); PG8_MMA(1, 1, At, B1); PG8_BAR; PG8_SCHED;
            PG8_LDB(B0, 1, 0); PG8_LDB(B1, 1, 1); PG8_SCHED; PG8_LDA(At, 1, 0); PG8_STAGE_A(PG8_SA(0, 1), a2, 1, w0, w1);
            PG8_WAIT_V(8); PG8_WAIT_L(0); PG8_BAR; PG8_MMA(0, 0, At, B0); PG8_MMA(0, 1, At, B1); PG8_BAR; PG8_SCHED;
            PG8_LDA(At, 1, 1); PG8_STAGE(PG8_SB(1, 0), b3, voffB); PG8_STAGE(PG8_SB(1, 1), b3 + hstep, voffB); PG8_STAGE_A(PG8_SA(1, 0), a3, 0, w0, w1);
            PG8_WAIT_V(8); PG8_WAIT_L(0); PG8_BAR; PG8_MMA(1, 0, At, B0); PG8_MMA(1, 1, At, B1); PG8_BAR; PG8_SCHED;
        }
        if constexpr (ALIGN_EPI) { if (wr == 0) PG8_BAR; }
        if constexpr (I8) {
#pragma unroll
            for (int a = 0; a < 2; ++a)
#pragma unroll
                for (int b = 0; b < 2; ++b)
#pragma unroll
                    for (int m = 0; m < 4; ++m)
#pragma unroll
                        for (int n = 0; n < 2; ++n) acc[a][b][m][n] = __builtin_convertvector(__builtin_bit_cast(i32x4_c, acc[a][b][m][n]), f32x4);
        }
        if constexpr (!Epi::AFTER_DRAIN) E(acc, cur, wr, wc, fr, fq, pre, (const PG8_LAS unsigned*)(rtab + (ui & 1) * Epi::NTAB * 1024));
        if (!has_next) break;
#pragma unroll
        for (int a = 0; a < 2; ++a)
#pragma unroll
            for (int b = 0; b < 2; ++b)
#pragma unroll
                for (int m = 0; m < 4; ++m)
#pragma unroll
                    for (int n = 0; n < 2; ++n) acc[a][b][m][n] = (f32x4){0.f, 0.f, 0.f, 0.f};
        cur = nxt; cA = nA; cB = nB; ++ui; E.prefetch(pre, cur, wr, wc, fr, fq); PG8_ROWTAB(cur, ui & 1);
#pragma unroll
        for (int i = 0; i < 2; ++i) { vc0[i] = vn0[i]; vc1[i] = vn1[i]; }
        if constexpr (ALIGN_EPI) { if (wr == 1) PG8_BAR; }
    }
    PG8_WAIT_V(0);
    if constexpr (!ALIGN_EPI) { if (wr == 0) PG8_BAR; }
    PG8_BAR;
    if constexpr (Epi::AFTER_DRAIN) E.fused(acc, cur, wr, wc, fr, fq, lds);
#undef PG8_SA
#undef PG8_SB
#undef PG8_STAGE
#undef PG8_ROWTAB
#undef PG8_STAGE_A
#undef PG8_LDA
#undef PG8_LDB
#undef PG8_MMA
#undef PG8_WAIT_V
#undef PG8_WAIT_L
#undef PG8_BAR
#undef PG8_SCHED
}
}
#include <hip/hip_bf16.h>
#include <cmath>
namespace attn_body {
using bf16=__hip_bfloat16;
using bf16x8=__attribute__((ext_vector_type(8)))short;
using s16x4=__attribute__((ext_vector_type(4)))short;
using f32x16=__attribute__((ext_vector_type(16)))float;
using u32x4=__attribute__((ext_vector_type(4)))unsigned;
constexpr int BATCH=2,NHEAD=8,SEQ=8192,D=64,DM=NHEAD*D;
constexpr int NW=8,QBLK=32,QB=QBLK*NW,KVBLK=64,NQB=SEQ/QB;
constexpr int ATTN_PITCH=DM, ATTN_UNIT_ROWS=QB;
__device__ __forceinline__ int crow(int r,int hi){return (r&3)+8*(r>>2)+4*hi;}
#define SBAR() __builtin_amdgcn_sched_barrier(0)
__device__ __forceinline__ void cmask(f32x16&p0,f32x16&p1,int jb,int qrel,int hi){
  const float NEG=-INFINITY; const int dq=qrel-(64*jb+4*hi);
  #pragma unroll
  for(int r=0;r<16;++r){const int c=(r&3)+8*(r>>2); if(c>dq)p0[r]=NEG; if(c+32>dq)p1[r]=NEG;}
}

constexpr int NSLOT=3, SLOTB=8192;
constexpr int LDS_K=0, LDS_V=NSLOT*SLOTB, LDS_WS=2*NSLOT*SLOTB, LDS_OST=LDS_WS+NW*64*4, LDS_DK=LDS_OST+NW*4096, LDS_BYTES=LDS_DK+SEQ*4;
constexpr float C2=0.125f*1.4426950408889634f;
__device__ __forceinline__ void glds16(const void*gsrc,unsigned lds_dst){unsigned keep;
  asm volatile("s_mov_b32 %0, m0\n\ts_mov_b32 m0, %2\n\ts_nop 0\n\tglobal_load_lds_dwordx4 %1, off\n\ts_mov_b32 m0, %0":"=&s"(keep):"v"(gsrc),"s"(lds_dst):"memory");}
__device__ __forceinline__ float max3f(float a,float b,float c){float r;asm("v_max3_f32 %0, %1, %2, %3":"=v"(r):"v"(a),"v"(b),"v"(c));return r;}
__device__ __forceinline__ float max2f(float a,float b){float r;asm("v_max_f32_e32 %0, %1, %2":"=v"(r):"v"(a),"v"(b));return r;}
__device__ __forceinline__ float fadd_s(float a,float b){float r;asm("v_add_f32_e32 %0, %1, %2":"=v"(r):"v"(a),"v"(b));return r;}
__device__ __forceinline__ float fsub_s(float a,float b){float r;asm("v_sub_f32_e32 %0, %1, %2":"=v"(r):"v"(a),"v"(b));return r;}
typedef float f32x2_t __attribute__((ext_vector_type(2))); typedef float f32x4_t __attribute__((ext_vector_type(4))); typedef __bf16 bf16x2_t __attribute__((ext_vector_type(2)));
__device__ __forceinline__ unsigned cvtpk_s(float lo,float hi){f32x2_t v={lo,hi};bf16x2_t b=__builtin_convertvector(v,bf16x2_t);return __builtin_bit_cast(unsigned,b);}
#define WAIT_BAR(N) asm volatile("s_waitcnt vmcnt(" #N ") lgkmcnt(0)\n\ts_barrier":::"memory")

__device__ __forceinline__ void qkt(f32x16&p0,f32x16&p1,const char*Kslot,const bf16x8*qr,const f32x16&negm,int r32,int hi){
  const char*kb=Kslot+hi*1024+r32*16;
  #pragma unroll
  for(int d0=0;d0<4;++d0){
    const bf16x8 b0=*reinterpret_cast<const bf16x8*>(kb+d0*2048);
    const bf16x8 b1=*reinterpret_cast<const bf16x8*>(kb+d0*2048+512);
    if(d0==0){p0=__builtin_amdgcn_mfma_f32_32x32x16_bf16(b0,qr[0],negm,0,0,0);p1=__builtin_amdgcn_mfma_f32_32x32x16_bf16(b1,qr[0],negm,0,0,0);}
    else{p0=__builtin_amdgcn_mfma_f32_32x32x16_bf16(b0,qr[d0],p0,0,0,0);p1=__builtin_amdgcn_mfma_f32_32x32x16_bf16(b1,qr[d0],p1,0,0,0);}}
}
typedef __attribute__((address_space(3))) const char* lds_cptr;
typedef short v4i16_t __attribute__((ext_vector_type(4)));
__device__ __forceinline__ void kload8(bf16x8*kf,lds_cptr kp){
  kf[0]=*(const __attribute__((address_space(3))) bf16x8*)(kp);      kf[1]=*(const __attribute__((address_space(3))) bf16x8*)(kp+512);
  kf[2]=*(const __attribute__((address_space(3))) bf16x8*)(kp+2048); kf[3]=*(const __attribute__((address_space(3))) bf16x8*)(kp+2560);
  kf[4]=*(const __attribute__((address_space(3))) bf16x8*)(kp+4096); kf[5]=*(const __attribute__((address_space(3))) bf16x8*)(kp+4608);
  kf[6]=*(const __attribute__((address_space(3))) bf16x8*)(kp+6144); kf[7]=*(const __attribute__((address_space(3))) bf16x8*)(kp+6656);
}
__device__ __forceinline__ void kload2(bf16x8*kf,lds_cptr kp,int j){ kf[2*j]=*(const __attribute__((address_space(3))) bf16x8*)(kp+j*2048); kf[2*j+1]=*(const __attribute__((address_space(3))) bf16x8*)(kp+j*2048+512); }
__device__ __forceinline__ s16x4 vtr(lds_cptr p){ return __builtin_bit_cast(s16x4,__builtin_amdgcn_ds_read_tr16_b64_v4i16((__attribute__((address_space(3))) v4i16_t*)p)); }
__device__ __forceinline__ float rowmax(const f32x16&p0,const f32x16&p1){
  float a=max3f(p0[0],p0[1],p1[0]),b=max3f(p0[2],p0[3],p1[1]);a=max3f(a,p1[2],p1[3]);
  #pragma unroll
  for(int r=4;r<16;r+=4){a=max3f(a,p0[r],p0[r+1]);b=max3f(b,p0[r+2],p0[r+3]);a=max3f(a,p1[r],p1[r+1]);b=max3f(b,p1[r+2],p1[r+3]);}
  const float m=max2f(a,b);
  auto rr=__builtin_amdgcn_permlane32_swap(__float_as_uint(m),__float_as_uint(m),false,false);
  return max2f(__uint_as_float(rr[0]),__uint_as_float(rr[1]));
}
__device__ __forceinline__ void pv(f32x16*o,int vb,bf16x8 pa0,bf16x8 pa1,bf16x8 pa2,bf16x8 pa3){
  #pragma unroll
  for(int d0=0;d0<2;++d0){s16x4 lo[4],hi[4];
    #pragma unroll
    for(int ks=0;ks<4;++ks){
      asm volatile("ds_read_b64_tr_b16 %0,%1 offset:%c2":"=&v"(lo[ks]):"v"(vb),"i"(d0*4096+ks*1024):"memory");
      asm volatile("ds_read_b64_tr_b16 %0,%1 offset:%c2":"=&v"(hi[ks]):"v"(vb),"i"(d0*4096+ks*1024+512):"memory");}
    asm volatile("s_waitcnt lgkmcnt(0)":::"memory");SBAR();
    #define PK(k) (bf16x8){lo[k][0],lo[k][1],lo[k][2],lo[k][3],hi[k][0],hi[k][1],hi[k][2],hi[k][3]}
    o[d0]=__builtin_amdgcn_mfma_f32_32x32x16_bf16(pa0,PK(0),o[d0],0,0,0);
    o[d0]=__builtin_amdgcn_mfma_f32_32x32x16_bf16(pa1,PK(1),o[d0],0,0,0);
    o[d0]=__builtin_amdgcn_mfma_f32_32x32x16_bf16(pa2,PK(2),o[d0],0,0,0);
    o[d0]=__builtin_amdgcn_mfma_f32_32x32x16_bf16(pa3,PK(3),o[d0],0,0,0);
    #undef PK
  }
}

#ifndef ATTN_STORE16
#define ATTN_STORE16(p,v) (*(u32x4*)(p)=(v))
#endif
template<int THRL> __device__ __forceinline__ void attn_unit(int b,int h,int qb,const bf16*Q,const bf16*__restrict__ K,const bf16*__restrict__ V,bf16*O,const float*cum,float thr2,char*shm){
  const int tid=threadIdx.x,lane=tid&63,r32=lane&31,hi=lane>>5; const int wid=__builtin_amdgcn_readfirstlane(tid>>6);
  const long rowbase=(long)b*SEQ; const int q0=qb*QB;
  const bf16*Qw=Q+(rowbase+q0+wid*QBLK)*DM+h*D;
  const float*cb=cum+(long)(b*NHEAD+h)*SEQ; const int NTF=(q0+QB)/KVBLK; int t0=0;
#if ATTN_SKIP
  { const float cq0=cb[q0]; int cnt=0;
    for(int base=0;base<NTF;base+=64){ const int t_=base+lane; const bool c_=(t_<NTF)&&((cb[64*t_+63]-cq0)*1.4426950408889634f>thr2); cnt+=__popcll(__ballot(c_)); }
    cnt&=~1; if(cnt>NTF-4)cnt=NTF-4; t0=__builtin_amdgcn_readfirstlane(cnt); }
#endif
  const int kv0=t0*KVBLK;
  { const float cref=cb[q0+QB-1]; __attribute__((address_space(3))) float*dkw=(__attribute__((address_space(3))) float*)((__attribute__((address_space(3))) char*)shm+LDS_DK);
    int tv_=tid; asm volatile("":"+v"(tv_));
    for(int j=tv_;j<q0+QB-kv0;j+=NW*64)dkw[j]=(cb[kv0+j]-cref)*1.4426950408889634f; }
  asm volatile("s_waitcnt vmcnt(0) lgkmcnt(0)\n\ts_barrier":::"memory");
  const bf16*Kh=K+(rowbase+kv0)*DM+h*D,*Vh=V+(rowbase+kv0)*DM+h*D;
  const unsigned lds0=(unsigned)(uintptr_t)shm;
  float*wsf=(float*)(shm+LDS_WS)+wid*64;
  const bf16*ksrc=Kh+(long)lane*DM+wid*8;
  const bf16*vsrc=Vh+(long)(16*(wid&3)+(lane>>2))*DM+(wid>>2)*32+(lane&3)*8;
  const unsigned kdst=lds0+LDS_K+wid*1024, vdst=lds0+LDS_V+wid*1024;
  #define DMA_K(t,slot) glds16(ksrc+(long)(t)*KVBLK*DM,(unsigned)__builtin_amdgcn_readfirstlane(kdst+(slot)))
  #define DMA_V(t,slot) glds16(vsrc+(long)(t)*KVBLK*DM,(unsigned)__builtin_amdgcn_readfirstlane(vdst+(slot)))
  const int vb0=(int)(lds0+LDS_V)+((lane>>4)&1)*32+(lane&3)*8+(4*hi+((lane&15)>>2))*64;
  const char*Kbase=shm+LDS_K; bf16x8 kf[8];
  const lds_cptr shm3=(lds_cptr)shm; const lds_cptr kp0=shm3+LDS_K+hi*1024+r32*16; const lds_cptr vp0=shm3+LDS_V+((lane>>4)&1)*32+(lane&3)*8+(4*hi+((lane&15)>>2))*64;
  int hiv_=hi; asm volatile("":"+v"(hiv_));
  const int NT=NTF-t0;
  const __attribute__((address_space(3))) float*dkp0=(const __attribute__((address_space(3))) float*)(shm3+LDS_DK)+4*hiv_;
  #define CINIT(C,t,o) do{ const __attribute__((address_space(3))) float*dp_=dkp0+(t)*64+(o); _Pragma("unroll") for(int g_=0;g_<4;++g_){ const f32x4_t a_=*(const __attribute__((address_space(3))) f32x4_t*)(dp_+8*g_); \
      C[4*g_]=negms-a_[0];C[4*g_+1]=negms-a_[1];C[4*g_+2]=negms-a_[2];C[4*g_+3]=negms-a_[3]; } }while(0)
  #define DECAY(P0,P1,t) do{ const __attribute__((address_space(3))) float*dp_=dkp0+(t)*64; _Pragma("unroll") for(int g_=0;g_<4;++g_){ const f32x4_t a_=*(const __attribute__((address_space(3))) f32x4_t*)(dp_+8*g_), b_=*(const __attribute__((address_space(3))) f32x4_t*)(dp_+32+8*g_); \
      P0[4*g_]-=a_[0];P0[4*g_+1]-=a_[1];P0[4*g_+2]-=a_[2];P0[4*g_+3]-=a_[3]; P1[4*g_]-=b_[0];P1[4*g_+1]-=b_[1];P1[4*g_+2]-=b_[2];P1[4*g_+3]-=b_[3]; } }while(0)
  DMA_K(0,0);DMA_V(0,0);DMA_K(1,SLOTB);
  bf16x8 qr[4];
  #pragma unroll
  for(int d0=0;d0<4;++d0)qr[d0]=*reinterpret_cast<const bf16x8*>(&Qw[(long)r32*DM+d0*16+hi*8]);
  float mhat=0.f,l_reg=0.f;f32x16 o[2];o[0]=f32x16{};o[1]=f32x16{};float negms=0.f; const f32x16 zero16=f32x16{};
  const int qrel=wid*QBLK+r32;
  #define CMASK(P0,P1,t) do{int jb_=(t)-(NT-4); if(jb_>=0)cmask(P0,P1,jb_,qrel,hi);}while(0)
  bool resc=false;
  #define START(P0,P1) do{ const float rm=rowmax(P0,P1); resc=false; \
    { const float dl=rm; mhat=fadd_s(mhat,dl); \
      _Pragma("unroll") for(int r=0;r<16;++r){P0[r]=fsub_s(P0[r],dl);P1[r]=fsub_s(P1[r],dl);} \
      negms=-mhat; } \
    _Pragma("unroll") for(int r=0;r<16;++r)P0[r]=__builtin_amdgcn_exp2f(P0[r]); }while(0)
  #define RESC() do{ if(resc){ asm volatile("s_waitcnt lgkmcnt(0)":::"memory"); \
      _Pragma("unroll") for(int d_=0;d_<2;++d_) _Pragma("unroll") for(int r=0;r<16;++r)o[d_][r]*=wsf[crow(r,hi)]; } }while(0)
  f32x16 pA0,pA1,pB0,pB1;
  int sl_prev=0,sl_cur=0,sl_next=SLOTB;
  #define ROT() do{sl_prev=sl_cur;sl_cur=sl_next;sl_next=(sl_next==(NSLOT-1)*SLOTB)?0:sl_next+SLOTB;}while(0)
  DMA_K(2,2*SLOTB);
  WAIT_BAR(3);
  qkt(pA0,pA1,Kbase,qr,zero16,r32,hi);asm volatile("s_nop 15\n\ts_nop 7":"+v"(pA0),"+v"(pA1));CMASK(pA0,pA1,0);DECAY(pA0,pA1,0);
  START(pA0,pA1);
  _Pragma("unroll") for(int r=0;r<16;++r)pA1[r]=__builtin_amdgcn_exp2f(pA1[r]);
  WAIT_BAR(0);
  DMA_K(3,0);DMA_V(1,SLOTB);
  ROT();
  kload8(kf,kp0+sl_cur);
  WAIT_BAR(2);
  s16x4 vlo[8],vhi[8]; u32x4 pw0,pw1,pw2,pw3;
  #define PKW(P,B) cvtpk_s(P[B],P[B+1])
  #define PAF(k) __builtin_bit_cast(bf16x8,pw##k)
  #define VFR(i) (bf16x8){vlo[i][0],vlo[i][1],vlo[i][2],vlo[i][3],vhi[i][0],vhi[i][1],vhi[i][2],vhi[i][3]}
  #define PIN(x) asm volatile("":"+v"(x))
  #define MX3(a,b,c) __builtin_fmaxf(__builtin_fmaxf((a),(b)),(c))
  #define GAPA(MF,A0,A1,A2,A3,W0,W1,PW) do{ MF; sacc+=A0; sacc+=A1; sacc+=A2; sacc+=A3; PIN(sacc); W0; W1; PIN(PW); SBAR(); }while(0)
  #define EX(v) __builtin_amdgcn_exp2f(v)
  #define GAPB(MF,X,B) do{ MF; X[B]=EX(X[B]); X[B+1]=EX(X[B+1]); X[B+2]=EX(X[B+2]); X[B+3]=EX(X[B+3]); PIN(X); SBAR(); }while(0)
  #define VRD(i) do{ vlo[i]=vtr(vp_+(((i)>>2)*4096+((i)&3)*1024)); vhi[i]=vtr(vp_+(((i)>>2)*4096+((i)&3)*1024+512)); }while(0)
  #define KRD(G,j) do{ if(G){ kload2(kf,kp0+sl_next,j); SBAR(); } }while(0)
  #define STEP(C0,C1,P0,P1,t,GK,GV,GL) do{ SBAR(); \
    const lds_cptr vp_=vp0+sl_prev; \
    CINIT(C0,t,0); VRD(0); SBAR(); float sacc=(P0[0]+P0[1]); \
    GAPA(C0=__builtin_amdgcn_mfma_f32_32x32x16_bf16(kf[0],qr[0],C0,0,0,0), P0[2],P0[3],P0[4],P0[5],     pw0[0]=PKW(P0,0), pw0[1]=PKW(P0,2), pw0); \
    CINIT(C1,t,32); VRD(4); SBAR(); GAPA(C1=__builtin_amdgcn_mfma_f32_32x32x16_bf16(kf[1],qr[0],C1,0,0,0), P0[6],P0[7],P0[8],P0[9],     pw0[2]=PKW(P0,4), pw0[3]=PKW(P0,6), pw0); \
    VRD(1); SBAR(); GAPA(C0=__builtin_amdgcn_mfma_f32_32x32x16_bf16(kf[2],qr[1],C0,0,0,0),   P0[10],P0[11],P0[12],P0[13], pw1[0]=PKW(P0,8), pw1[1]=PKW(P0,10), pw1); \
    VRD(5); SBAR(); GAPA(C1=__builtin_amdgcn_mfma_f32_32x32x16_bf16(kf[3],qr[1],C1,0,0,0),   P0[14],P0[15],P1[0],P1[1],   pw1[2]=PKW(P0,12),pw1[3]=PKW(P0,14), pw1); \
    VRD(2); SBAR(); GAPA(C0=__builtin_amdgcn_mfma_f32_32x32x16_bf16(kf[4],qr[2],C0,0,0,0),   P1[2],P1[3],P1[4],P1[5],     pw2[0]=PKW(P1,0), pw2[1]=PKW(P1,2), pw2); \
    VRD(6); SBAR(); GAPA(C1=__builtin_amdgcn_mfma_f32_32x32x16_bf16(kf[5],qr[2],C1,0,0,0),   P1[6],P1[7],P1[8],P1[9],     pw2[2]=PKW(P1,4), pw2[3]=PKW(P1,6), pw2); \
    VRD(3); SBAR(); GAPA(C0=__builtin_amdgcn_mfma_f32_32x32x16_bf16(kf[6],qr[3],C0,0,0,0),   P1[10],P1[11],P1[12],P1[13], pw3[0]=PKW(P1,8), pw3[1]=PKW(P1,10), pw3); \
    VRD(7); SBAR(); GAPA(C1=__builtin_amdgcn_mfma_f32_32x32x16_bf16(kf[7],qr[3],C1,0,0,0),   P1[14],P1[15],0.f,0.f,       pw3[2]=PKW(P1,12),pw3[3]=PKW(P1,14), pw3); \
    l_reg+=sacc; \
    if(GK){DMA_K((t)+3,sl_cur);} if(GV){DMA_V((t)+1,sl_next);} \
    CMASK(C0,C1,t); \
    { float a=MX3(C0[0],C0[1],C1[0]),b=MX3(C0[2],C0[3],C1[1]); a=MX3(a,C1[2],C1[3]); \
      _Pragma("unroll") for(int r=4;r<16;r+=4){a=MX3(a,C0[r],C0[r+1]);b=MX3(b,C0[r+2],C0[r+3]);a=MX3(a,C1[r],C1[r+1]);b=MX3(b,C1[r+2],C1[r+3]);} \
      float rm=__builtin_fmaxf(a,b); { auto rr=__builtin_amdgcn_permlane32_swap(__float_as_uint(rm),__float_as_uint(rm),false,false); rm=__builtin_fmaxf(__uint_as_float(rr[0]),__uint_as_float(rr[1])); } \
      resc=false; \
      if(__builtin_expect(__any(rm>(float)THRL),0)){ const float dl=__builtin_fmaxf(rm,0.f); mhat+=dl; \
        _Pragma("unroll") for(int r=0;r<16;++r){C0[r]-=dl;C1[r]-=dl;} \
        negms=-mhat; \
        const float f=__builtin_amdgcn_exp2f(-dl); l_reg*=f; if(hi==0)wsf[r32]=f; resc=true; } } \
    SBAR(); \
    GAPB(o[0]=__builtin_amdgcn_mfma_f32_32x32x16_bf16(PAF(0),VFR(0),o[0],0,0,0), C0,0); \
    GAPB(o[1]=__builtin_amdgcn_mfma_f32_32x32x16_bf16(PAF(0),VFR(4),o[1],0,0,0), C0,4); \
    KRD(GL,0); GAPB(o[0]=__builtin_amdgcn_mfma_f32_32x32x16_bf16(PAF(1),VFR(1),o[0],0,0,0), C0,8); \
    KRD(GL,1); GAPB(o[1]=__builtin_amdgcn_mfma_f32_32x32x16_bf16(PAF(1),VFR(5),o[1],0,0,0), C0,12); \
    KRD(GL,2); GAPB(o[0]=__builtin_amdgcn_mfma_f32_32x32x16_bf16(PAF(2),VFR(2),o[0],0,0,0), C1,0); \
    KRD(GL,3); GAPB(o[1]=__builtin_amdgcn_mfma_f32_32x32x16_bf16(PAF(2),VFR(6),o[1],0,0,0), C1,4); \
    GAPB(o[0]=__builtin_amdgcn_mfma_f32_32x32x16_bf16(PAF(3),VFR(3),o[0],0,0,0), C1,8); \
    GAPB(o[1]=__builtin_amdgcn_mfma_f32_32x32x16_bf16(PAF(3),VFR(7),o[1],0,0,0), C1,12); \
    }while(0)
  int t=1;
  #undef CMASK
  #define CMASK(P0,P1,t) do{}while(0)
  for(;t+5<NT;t+=2){
    STEP(pB0,pB1,pA0,pA1,t,true,true,true);     WAIT_BAR(2); RESC(); ROT();
    STEP(pA0,pA1,pB0,pB1,t+1,true,true,true);   WAIT_BAR(2); RESC(); ROT();
  }
  #undef CMASK
  #define CMASK(P0,P1,t) do{int jb_=(t)-(NT-4); if(jb_>=0)cmask(P0,P1,jb_,qrel,hi);}while(0)
  #define ENDW(tt) do{ if((tt)+3<NT){WAIT_BAR(2);} else if((tt)+2<NT){WAIT_BAR(1);} else {WAIT_BAR(0);} }while(0)
  for(;t+1<NT;t+=2){
    STEP(pB0,pB1,pA0,pA1,t,(t+3<NT),(t+1<NT),(t+1<NT));       ENDW(t);   RESC(); ROT();
    STEP(pA0,pA1,pB0,pB1,t+1,(t+4<NT),(t+2<NT),(t+2<NT));     ENDW(t+1); RESC(); ROT();
  }
  STEP(pB0,pB1,pA0,pA1,NT-1,false,false,false); RESC();
  { float sacc=pB0[0]+pB0[1]; _Pragma("unroll") for(int r=2;r<16;++r)sacc+=pB0[r]; _Pragma("unroll") for(int r=0;r<16;++r)sacc+=pB1[r]; l_reg+=sacc;
    pw0=(u32x4){PKW(pB0,0),PKW(pB0,2),PKW(pB0,4),PKW(pB0,6)};pw1=(u32x4){PKW(pB0,8),PKW(pB0,10),PKW(pB0,12),PKW(pB0,14)};pw2=(u32x4){PKW(pB1,0),PKW(pB1,2),PKW(pB1,4),PKW(pB1,6)};pw3=(u32x4){PKW(pB1,8),PKW(pB1,10),PKW(pB1,12),PKW(pB1,14)};
    SBAR(); pv(o,vb0+sl_cur,PAF(0),PAF(1),PAF(2),PAF(3)); }
  #undef PKW
  #undef PAF
  #undef VFR
  #undef PIN
  #undef MX3
  #undef GAPA
  #undef GAPB
  #undef EX
  #undef VRD
  #undef KRD
  #undef STEP
  #undef ENDW
  {auto rr=__builtin_amdgcn_permlane32_swap(__float_as_uint(l_reg),__float_as_uint(l_reg),false,false);l_reg=__uint_as_float(rr[0])+__uint_as_float(rr[1]);}
  if(hi==0)wsf[32+r32]=l_reg;asm volatile("s_waitcnt lgkmcnt(0)":::"memory");
  float rli[16];
  #pragma unroll
  for(int r=0;r<16;++r)rli[r]=__builtin_amdgcn_rcpf(wsf[32+crow(r,hi)]);
  bf16*Ow=O+(rowbase+q0+wid*QBLK)*DM+h*D;
  { bf16*stg=(bf16*)(shm+LDS_OST)+wid*2048;
    #pragma unroll
    for(int r=0;r<16;++r){const int orow=crow(r,hi);
      #pragma unroll
      for(int d0=0;d0<2;++d0)stg[orow*64+d0*32+r32]=__float2bfloat16(o[d0][r]*rli[r]);}
    asm volatile("s_waitcnt lgkmcnt(0)":::"memory");
    #pragma unroll
    for(int i=0;i<4;++i){const int row=i*8+(lane>>3),ch=lane&7; const u32x4 v=*(const u32x4*)(stg+row*64+ch*8); ATTN_STORE16(Ow+(long)row*DM+ch*8,v);} }
  asm volatile("s_waitcnt lgkmcnt(0)\n\ts_barrier":::"memory");
  #undef DECAY
  #undef CINIT
  #undef DMA_K
  #undef DMA_V
  #undef CMASK
  #undef START
  #undef RESC
  #undef ROT
}
constexpr int ATTN_LDS_BYTES=LDS_BYTES;
struct AttnTensors { const bf16* Q; const bf16* K; const bf16* V; bf16* O; const float* cum; float thr2; };
struct AttnUnit { int bh; int qb; };
struct StaticOrder {
  int vcu;
  __device__ __forceinline__ explicit StaticOrder(int grid,int block):vcu((block%8)*(grid/8)+block/8){}
  __device__ __forceinline__ bool next(int i,AttnUnit&u)const{ if(i>=2)return false; const int s=vcu&15; u.bh=vcu>>4; u.qb=(i==0)?s:31-s; return true; }
  __device__ __forceinline__ void a_ready(const AttnUnit&)const{}
  __device__ __forceinline__ void done(const AttnUnit&)const{}
};
template<class Sched,int THRL=8> __device__ __forceinline__ void attn_phase(char*lds,const AttnTensors&T,const Sched&S){
  AttnUnit u;
  for(int i=0;S.next(i,u);++i){ S.a_ready(u); attn_unit<THRL>(u.bh/NHEAD,u.bh%NHEAD,u.qb,T.Q,T.K,T.V,T.O,T.cum,T.thr2,lds); S.done(u); }
}
#undef SBAR
#undef WAIT_BAR
}

constexpr int NWAVES = 8;
constexpr int BATCH = 2, SEQ = 8192, DMODEL = 1024, T = BATCH * SEQ;
constexpr int CONVD = 512, CONVW = 31, NHEAD = 8, HD = 64, ATT = 512;
constexpr int NE = 64, TOPK = 8, EF = 256, SF = 256;
constexpr int INCOLS = 4616, OFF_Q = 1024, OFF_K = 1536, OFF_V = 2048, OFF_F = 2560, OFF_GC = 2568, OFF_GA = 3592;
constexpr int NIN = 4608;
constexpr float EPS = 1e-6f, LOG2E = 1.4426950408889634f, ROUTED_SCALE = 2.5f;
constexpr float C2Q = 0.125f * 1.4426950408889634f;
constexpr int LISTCAP = T;
constexpr int ACT_ROWS = T * TOPK + NE * 256;

constexpr size_t MiB = 1u << 20, KiB = 1u << 10;
constexpr size_t WS_CTL = 0, CTL_ZERO_BYTES = 1 * MiB;
constexpr size_t WS_MODP = 1 * MiB;
constexpr size_t WS_MOD = WS_MODP + 768 * KiB;
constexpr size_t WS_LOGF = 2 * MiB;
constexpr size_t WS_CUM = 2 * MiB + 512 * KiB;
constexpr size_t WS_SSQ = 3 * MiB;
constexpr size_t WS_XMX = 3 * MiB + 256 * KiB;
constexpr size_t WS_SA1 = 3 * MiB + 512 * KiB, WS_SA2 = 3 * MiB + 576 * KiB;
constexpr size_t WS_SLIST = 21 * MiB;
constexpr size_t WS_WRH = 4 * MiB, WS_WRL = 4 * MiB + 128 * KiB;
constexpr size_t WS_WLIST = 5 * MiB;
constexpr size_t WS_LIST = 9 * MiB;
constexpr size_t WS_WIN = 16 * MiB, WS_WC = 25 * MiB, WS_WA = 26 * MiB, WS_WOUT = 27 * MiB, WS_WSGU = 29 * MiB, WS_WSD = 30 * MiB;
constexpr size_t WS_WGU = 32 * MiB, WS_WD = 96 * MiB;
constexpr size_t WS_H2 = 128 * MiB, WS_ACT = 160 * MiB, WS_SACT = 232 * MiB;
constexpr size_t WS_H1 = 240 * MiB, WS_U = 272 * MiB, WS_Q = 288 * MiB, WS_K = 304 * MiB, WS_V = 320 * MiB, WS_SG = 336 * MiB, WS_UC = 400 * MiB, WS_O = 416 * MiB, WS_MG = 432 * MiB;
constexpr size_t WS_SLAB = 240 * MiB;
constexpr size_t WS_END = 512 * MiB;
static_assert(WS_ACT + (size_t)ACT_ROWS * EF * 2 <= WS_SACT && WS_SLAB + (size_t)T * TOPK * DMODEL * 2 <= WS_END && WS_MG + (size_t)T * DMODEL * 2 <= WS_SLAB + 256 * MiB, "ws map");
constexpr int CW_TMO = 0, CW_CODE = 1;
constexpr int CW_CNT = 1024;
constexpr int CW_BAR = 8192;

constexpr int RING_OFF = 0, RING_BYTES = 131072;
constexpr int LDSCTL_OFF = RING_BYTES, MISC_OFF = LDSCTL_OFF + 320;
constexpr int TAB_OFF = RING_BYTES + 1024;
constexpr int LDS_BYTES = 147456;

#define GAS __attribute__((address_space(1)))
#define LAS __attribute__((address_space(3)))
typedef unsigned short bf16;
typedef unsigned v4u __attribute__((ext_vector_type(4)));
typedef unsigned v2u __attribute__((ext_vector_type(2)));
typedef float f32x4 __attribute__((ext_vector_type(4)));
typedef float f32x2 __attribute__((ext_vector_type(2)));
typedef float f32x16 __attribute__((ext_vector_type(16)));
typedef short bf16x8 __attribute__((ext_vector_type(8)));
typedef GAS unsigned gu32;
#define RLX_AGENT __ATOMIC_RELAXED, __HIP_MEMORY_SCOPE_AGENT
#define LDS_WAIT() asm volatile("s_waitcnt lgkmcnt(0)" ::: "memory")
#define VM_WAIT() asm volatile("s_waitcnt vmcnt(0)" ::: "memory")
__device__ __forceinline__ unsigned f2bf(float f) { unsigned u = __builtin_bit_cast(unsigned, f); return (u + 0x7fffu + ((u >> 16) & 1u)) >> 16; }
__device__ __forceinline__ unsigned pk2(float lo, float hi) { return f2bf(lo) | (f2bf(hi) << 16); }
__device__ __forceinline__ float bf2f(unsigned h) { return __builtin_bit_cast(float, h << 16); }
__device__ __forceinline__ float wave_sum(float v) {
#pragma unroll
    for (int o = 1; o < 64; o <<= 1) v += __shfl_xor(v, o);
    return v;
}
using pg8::cvt_pk_bf16; using pg8::bf_lo; using pg8::bf_hi; using pg8::sigmoidf_fast;
#define XB_TMO      128
#define XB_XCNT(j)  (256  + 64 * (j))
#define XB_XSUB(j)  (1280 + 64 * (j))
#define XB_XGEN(j)  (2304 + 64 * (j))
#define XB_TOP      3328
#define XB_TOPGEN   3392
#define XCD_BAR_WORDS 3456
#define XB_SPIN_CAP (1u << 18)

__device__ __forceinline__ unsigned xb_ld(unsigned* p)              { return __hip_atomic_load(p, __ATOMIC_RELAXED, __HIP_MEMORY_SCOPE_AGENT); }
__device__ __forceinline__ unsigned xb_add(unsigned* p, unsigned v) { return __hip_atomic_fetch_add(p, v, __ATOMIC_RELAXED, __HIP_MEMORY_SCOPE_AGENT); }
__device__ __forceinline__ unsigned xb_xcc_id() { return (unsigned)__builtin_amdgcn_s_getreg((3 << 11) | 20) & 0xFu; }
#define XB_SPIN(cond, bar) do { unsigned _sp = 0; while (cond) { __builtin_amdgcn_s_sleep(1); \
    if ((++_sp & 255u) == 0u) { if (xb_ld(&(bar)[XB_TMO])) break; if (_sp > XB_SPIN_CAP) { atomicAdd(&(bar)[XB_TMO], 1u); break; } } } } while (0)

struct XcdBarrier {
    unsigned* bar; unsigned x;
    volatile LAS unsigned* st;
};

__device__ __forceinline__ XcdBarrier xcd_barrier_post(unsigned* bar, volatile LAS unsigned* st) {
    XcdBarrier b; b.bar = bar; b.x = xb_xcc_id(); b.st = st;
    if (threadIdx.x == 0) (void)xb_add(&bar[XB_XCNT(b.x)], 1u);
    return b;
}
__device__ __forceinline__ void xcd_barrier_complete(unsigned* bar, unsigned x, unsigned& nloc, unsigned& nx) {
    const unsigned G = gridDim.x * gridDim.y * gridDim.z;
    unsigned sum, cnt, mine, sp = 0u;
    for (;;) {
        sum = 0u; cnt = 0u; mine = 0u;
#pragma unroll
        for (unsigned j = 0; j < 16; ++j) { const unsigned c = xb_ld(&bar[XB_XCNT(j)]); sum += c; cnt += (c > 0u) ? 1u : 0u; mine = (j == x) ? c : mine; }
        if (sum == G) break;
        __builtin_amdgcn_s_sleep(1);
        if ((++sp & 255u) == 0u) { if (xb_ld(&bar[XB_TMO])) break; if (sp > XB_SPIN_CAP) { atomicAdd(&bar[XB_TMO], 1u); break; } }
    }
    nloc = mine > 0u ? mine : 1u; nx = cnt > 0u ? cnt : 1u;
}

__device__ __forceinline__ void xcd_barrier(const XcdBarrier& b) {
    asm volatile("s_waitcnt vmcnt(0)" ::: "memory");
    __syncthreads();
    if (threadIdx.x == 0) {
        unsigned* bar = b.bar;
        __builtin_amdgcn_s_waitcnt(0);
        unsigned nloc = b.st[0], nx = b.st[1];
        if (nloc == 0u) { xcd_barrier_complete(bar, b.x, nloc, nx); b.st[0] = nloc; b.st[1] = nx; }
        const unsigned old = xb_add(&bar[XB_XSUB(b.x)], 1u);
        const unsigned gen = old / nloc;
        if (old + 1u == (gen + 1u) * nloc) {
            __builtin_amdgcn_fence(__ATOMIC_RELEASE, "agent");
            asm volatile("s_waitcnt vmcnt(0)" ::: "memory");
            const unsigned og = xb_add(&bar[XB_TOP], 1u);
            const unsigned tg = og / nx;
            if (og + 1u == (tg + 1u) * nx) xb_add(&bar[XB_TOPGEN], 1u);
            else XB_SPIN(xb_ld(&bar[XB_TOPGEN]) == tg, bar);
            __builtin_amdgcn_fence(__ATOMIC_ACQUIRE, "agent");
            xb_add(&bar[XB_XGEN(b.x)], 1u);
            asm volatile("s_waitcnt vmcnt(0)" ::: "memory");
        } else {
            XB_SPIN(xb_ld(&bar[XB_XGEN(b.x)]) == gen, bar);
            __builtin_amdgcn_fence(__ATOMIC_ACQUIRE, "agent");
            asm volatile("s_waitcnt vmcnt(0)" ::: "memory");
        }
    }
    __syncthreads();
}

__device__ __forceinline__ int win_dst_row(int n) {
    if (n < 512) return 256 * (n >> 7) + (n & 127);
    if (n < 1024) { const int f = n - 512; return 256 * (f >> 7) + 128 + (f & 127); }
    if (n < 2048) { const int isk = n >= OFF_K, j = n - (isk ? OFF_K : OFF_Q), head = j >> 6, d = j & 63;
        return 256 * (4 + 2 * isk + (head >> 2)) + 128 * (d >> 5) + 32 * (head & 3) + (d & 31); }
    if (n < OFF_F) return 256 * 8 + (n - OFF_V);
    if (n < OFF_GC) return -1;
    return 256 * 10 + (n - OFF_GC);
}
__device__ __forceinline__ int glu_dst_row(int n, int F) { const int isu = n >= F, f = n - (isu ? F : 0); return 256 * (f >> 7) + 128 * isu + (f & 127); }

__device__ __forceinline__ unsigned pk4_i8(float a, float b, float c, float d) {
    const int ia = (int)__builtin_rintf(fminf(fmaxf(a, -127.f), 127.f)), ib = (int)__builtin_rintf(fminf(fmaxf(b, -127.f), 127.f)), ic = (int)__builtin_rintf(fminf(fmaxf(c, -127.f), 127.f)), id = (int)__builtin_rintf(fminf(fmaxf(d, -127.f), 127.f));
    return (unsigned)(ia & 255) | ((unsigned)(ib & 255) << 8) | ((unsigned)(ic & 255) << 16) | ((unsigned)id << 24); }
constexpr int CW_AMAX = 6144;
__device__ __forceinline__ unsigned pk4_fp8(float a, float b, float c, float d) { int p = __builtin_amdgcn_cvt_pk_fp8_f32(a, b, 0, false); p = __builtin_amdgcn_cvt_pk_fp8_f32(c, d, p, true); return (unsigned)p; }
#ifndef MOE_FP8
#define MOE_FP8 0
#endif
constexpr float W8SCALE = MOE_FP8 ? 32.0f : 1.0f;
constexpr float SLABSCALE = 16.0f;
__device__ __forceinline__ void tr_load(f32x4 (&ld)[8], const float* W, int ldw, int k0, int n0, int lane) {
#pragma unroll
    for (int i = 0; i < 8; ++i) ld[i] = *(const f32x4*)(W + (size_t)(k0 + 8 * i + (lane >> 3)) * ldw + n0 + 4 * (lane & 7));
}
template <int MODE>
__device__ __forceinline__ void tr_finish(const f32x4 (&ld)[8], int ldw, int K, bf16* WT, bf16* WT2, int k0, int n0, LAS float* scr, int lane, float qs = 1.0f) {
#pragma unroll
    for (int i = 0; i < 8; ++i) { LAS float* d = scr + (8 * i + (lane >> 3)) * 33 + 4 * (lane & 7); d[0] = ld[i][0]; d[1] = ld[i][1]; d[2] = ld[i][2]; d[3] = ld[i][3]; }
    LDS_WAIT(); asm volatile("" ::: "memory");
    const int c = lane & 7;
#pragma unroll
    for (int j = 0; j < 4; ++j) { const int n = (lane >> 3) + 8 * j; const LAS float* s = scr + (8 * c) * 33 + n;
        int row = n0 + n;
        if (MODE == 1 || MODE == 5) row = win_dst_row(row);
        if (MODE == 2 || MODE == 4 || MODE == 6) row = glu_dst_row(row, ldw >> 1);
        float v[8];
#pragma unroll
        for (int q = 0; q < 8; ++q) v[q] = s[q * 33];
        if ((MODE == 1 || MODE == 5) && row < 0) continue;
        if (MODE == 5 || MODE == 6) { v2u o8; o8.x = pk4_i8(v[0] * qs, v[1] * qs, v[2] * qs, v[3] * qs); o8.y = pk4_i8(v[4] * qs, v[5] * qs, v[6] * qs, v[7] * qs);
            *(GAS v2u*)((unsigned char*)WT + (size_t)row * K + k0 + 8 * c) = o8; continue; }
        if (MODE == 4) { v2u o8; o8.x = pk4_fp8(v[0] * W8SCALE, v[1] * W8SCALE, v[2] * W8SCALE, v[3] * W8SCALE); o8.y = pk4_fp8(v[4] * W8SCALE, v[5] * W8SCALE, v[6] * W8SCALE, v[7] * W8SCALE);
            *(GAS v2u*)((unsigned char*)WT + (size_t)row * K + k0 + 8 * c) = o8; continue; }
        v4u o; o.x = pk2(v[0], v[1]); o.y = pk2(v[2], v[3]); o.z = pk2(v[4], v[5]); o.w = pk2(v[6], v[7]);
        *(GAS v4u*)(WT + (size_t)row * K + k0 + 8 * c) = o;
        if (MODE == 3) { float r[8];
#pragma unroll
            for (int q = 0; q < 8; ++q) r[q] = v[q] - bf2f(f2bf(v[q]));
            v4u o2; o2.x = pk2(r[0], r[1]); o2.y = pk2(r[2], r[3]); o2.z = pk2(r[4], r[5]); o2.w = pk2(r[6], r[7]);
            *(GAS v4u*)(WT2 + (size_t)row * K + k0 + 8 * c) = o2; }
    }
    LDS_WAIT(); asm volatile("" ::: "memory");
}

template <int MODE>
__device__ __forceinline__ void tr_item(const float* W, int ldw, int K, bf16* WT, bf16* WT2, int k0, int n0, LAS float* scr, int lane, float qs = 1.0f) {
    f32x4 ld[8]; tr_load(ld, W, ldw, k0, n0, lane); tr_finish<MODE>(ld, ldw, K, WT, WT2, k0, n0, scr, lane, qs);
}
struct KArgs { const float* in[23]; float* out; unsigned char* ws; int ph_lo, ph_hi; };

__device__ __forceinline__ void p0_prologue(const KArgs& a, LAS unsigned char* lds, int vcu, int G, int wave, int lane) {
    LAS float* scr = (LAS float*)(lds + RING_OFF + wave * 16384);
    const int gw = vcu * NWAVES + wave, NGW = G * NWAVES;
    unsigned char* ws = a.ws;
    {
        const float* c = a.in[1]; const float* wada = a.in[2]; float* modp = (float*)(ws + WS_MODP);
        for (int it = gw; it < 96 * 16; it += NGW) {
            const int cg = it % 96, kc = it / 96, n = 64 * cg + lane; float s0 = 0.f, s1 = 0.f;
            const float* wp = wada + (size_t)(64 * kc) * 6144 + n;
            float wv[64];
#pragma unroll
            for (int k = 0; k < 64; ++k) wv[k] = wp[(size_t)k * 6144];
#pragma unroll
            for (int k = 0; k < 64; ++k) { const float c0 = c[64 * kc + k], c1 = c[1024 + 64 * kc + k];
                s0 += (c0 / (1.0f + __expf(-c0))) * wv[k]; s1 += (c1 / (1.0f + __expf(-c1))) * wv[k]; }
            modp[(size_t)(kc * 2 + 0) * 6144 + n] = s0; modp[(size_t)(kc * 2 + 1) * 6144 + n] = s1;
        }
    }
    constexpr int I_WC = 8 * 32, I_WA = 8 * 32, I_WOUT = 16 * 32, I_WSD = 4 * 32, I_WR = 16 * 2;
    constexpr int NITEMS = I_WC + I_WA + I_WOUT + I_WSD + I_WR;
    for (int it = gw; it < NITEMS; it += NGW) {
        int r = it;
        if (r < I_WC) { tr_item<0>(a.in[10], 1024, 512, (bf16*)(ws + WS_WC), nullptr, 64 * (r / 32), 32 * (r % 32), scr, lane); continue; } r -= I_WC;
        if (r < I_WA) { tr_item<0>(a.in[14], 1024, 512, (bf16*)(ws + WS_WA), nullptr, 64 * (r / 32), 32 * (r % 32), scr, lane); continue; } r -= I_WA;
        if (r < I_WOUT) { tr_item<0>(a.in[15], 1024, 1024, (bf16*)(ws + WS_WOUT), nullptr, 64 * (r / 32), 32 * (r % 32), scr, lane); continue; } r -= I_WOUT;
        if (r < I_WSD) { tr_item<0>(a.in[22], 1024, 256, (bf16*)(ws + WS_WSD), nullptr, 64 * (r / 32), 32 * (r % 32), scr, lane); continue; } r -= I_WSD;
        tr_item<3>(a.in[17], 64, 1024, (bf16*)(ws + WS_WRH), (bf16*)(ws + WS_WRL), 64 * (r / 2), 32 * (r % 2), scr, lane);
    }
    {
        unsigned* amax = (unsigned*)(ws + WS_CTL) + CW_AMAX;
        constexpr int C4 = 4096, N_WIN4 = DMODEL * INCOLS / 4, IT_WIN = (N_WIN4 + C4 - 1) / C4, IT_WSGU = (1024 * 512 / 4) / C4, IT_WGU = 64 * IT_WSGU;
        for (int it = gw; it < IT_WIN + IT_WSGU + IT_WGU; it += NGW) {
            const f32x4* p; int n4; unsigned* dst;
            if (it < IT_WIN) { p = (const f32x4*)a.in[5] + (size_t)it * C4; n4 = (it == IT_WIN - 1) ? N_WIN4 - it * C4 : C4; dst = amax; }
            else if (it < IT_WIN + IT_WSGU) { p = (const f32x4*)a.in[21] + (size_t)(it - IT_WIN) * C4; n4 = C4; dst = amax + 1; }
            else { const int r = it - IT_WIN - IT_WSGU; p = (const f32x4*)a.in[19] + (size_t)r * C4; n4 = C4; dst = amax + 2 + r / IT_WSGU; }
            float m = 0.f;
#pragma unroll 8
            for (int i = lane; i < n4; i += 64) { const f32x4 v = p[i]; m = fmaxf(m, fmaxf(fmaxf(fabsf(v[0]), fabsf(v[1])), fmaxf(fabsf(v[2]), fabsf(v[3])))); }
#pragma unroll
            for (int o = 1; o < 64; o <<= 1) m = fmaxf(m, __shfl_xor(m, o));
            if (lane == 0) atomicMax(dst, __builtin_bit_cast(unsigned, m));
        }
    }
}
__device__ __forceinline__ void q8_items(const KArgs& a, LAS unsigned char* lds, int vcu, int G, int wave, int lane) {
    LAS float* scr = (LAS float*)(lds + RING_OFF + wave * 16384);
    const int gw = vcu * NWAVES + wave, NGW = G * NWAVES; unsigned char* ws = a.ws;
    const unsigned* amax = (const unsigned*)(ws + WS_CTL) + CW_AMAX;
    constexpr int I_WIN = 144 * 16, I_WSGU = 16 * 16, I_WGU = 64 * 256, NIT = I_WIN + I_WSGU + I_WGU;
    struct Job { const float* W; int ldw, k0, n0, mode; unsigned char* WT; float qs; };
    auto job = [&](int it) { Job j; int r = it;
        if (r < I_WIN) { const int cb = r % 144, kb = r / 144; j.W = a.in[5]; j.ldw = INCOLS; j.k0 = 64 * kb; j.n0 = cb < 80 ? 32 * cb : OFF_GC + 32 * (cb - 80); j.mode = 5; j.WT = ws + WS_WIN; j.qs = 127.0f / __builtin_bit_cast(float, amax[0]); return j; } r -= I_WIN;
        if (r < I_WSGU) { j.W = a.in[21]; j.ldw = 512; j.k0 = 64 * (r / 16); j.n0 = 32 * (r % 16); j.mode = 6; j.WT = ws + WS_WSGU; j.qs = 127.0f / __builtin_bit_cast(float, amax[1]); return j; } r -= I_WSGU;
        const int e = r / 256, q = r % 256; j.W = a.in[19] + (size_t)e * 1024 * 512; j.ldw = 512; j.k0 = 64 * (q / 16); j.n0 = 32 * (q % 16); j.mode = 6; j.WT = ws + WS_WGU + (size_t)e * 512 * 1024; j.qs = 127.0f / __builtin_bit_cast(float, amax[2 + e]); return j; };
    auto fin = [&](const f32x4 (&ld)[8], const Job& j) { if (j.mode == 5) tr_finish<5>(ld, j.ldw, 1024, (bf16*)j.WT, nullptr, j.k0, j.n0, scr, lane, j.qs); else tr_finish<6>(ld, j.ldw, 1024, (bf16*)j.WT, nullptr, j.k0, j.n0, scr, lane, j.qs); };
    f32x4 lA[8], lB[8]; int it = gw; if (it >= NIT) return;
    Job jA = job(it), jB = jA; tr_load(lA, jA.W, jA.ldw, jA.k0, jA.n0, lane);
    for (;;) {
        const bool hb = it + NGW < NIT; if (hb) { jB = job(it + NGW); tr_load(lB, jB.W, jB.ldw, jB.k0, jB.n0, lane); }
        fin(lA, jA); if (!hb) break; it += NGW;
        const bool ha = it + NGW < NIT; if (ha) { jA = job(it + NGW); tr_load(lA, jA.W, jA.ldw, jA.k0, jA.n0, lane); }
        fin(lB, jB); if (!ha) break; it += NGW;
    }
}
__device__ __forceinline__ void wd_items(const KArgs& a, LAS unsigned char* lds, int first, int last, int slot, int nslots, int wave, int lane) {
    LAS float* scr = (LAS float*)(lds + RING_OFF + wave * 16384);
    const int step = nslots * NWAVES; int r = first + slot * NWAVES + wave; if (r >= last) return;
    const float* Wd = a.in[20]; bf16* WT = (bf16*)(a.ws + WS_WD);
#define WD_LOAD(L, rr) tr_load(L, Wd + (size_t)((rr) / 128) * 256 * 1024, 1024, 64 * (((rr) % 128) / 32), 32 * (((rr) % 128) % 32), lane)
#define WD_FIN(L, rr) tr_finish<0>(L, 1024, 256, WT + (size_t)((rr) / 128) * 1024 * 256, nullptr, 64 * (((rr) % 128) / 32), 32 * (((rr) % 128) % 32), scr, lane)
    f32x4 lA[8], lB[8]; WD_LOAD(lA, r);
    for (;;) {
        const bool hb = r + step < last; if (hb) WD_LOAD(lB, r + step);
        WD_FIN(lA, r); if (!hb) break; r += step;
        const bool ha = r + step < last; if (ha) WD_LOAD(lA, r + step);
        WD_FIN(lB, r); if (!ha) break; r += step;
    }
#undef WD_LOAD
#undef WD_FIN
}

__device__ __forceinline__ void p1_rows(const KArgs& a, LAS unsigned char* lds, int vcu, int tid, int wave, int lane) {
    unsigned char* ws = a.ws;
    const float* modp = (const float*)(ws + WS_MODP); const float* bada = a.in[3];
    LAS float* gs1 = (LAS float*)(lds + RING_OFF); LAS float* sh1 = gs1 + 1024; LAS float* wfl = gs1 + 2048;
    const int b = vcu >> 7;
    f32x4 vvA[4][4], vvB[4][4];
#pragma unroll
    for (int j = 0; j < 4; ++j) { const GAS f32x4* xa = (const GAS f32x4*)(a.in[0] + (size_t)(64 * vcu + 8 * wave + j) * DMODEL) + lane; const GAS f32x4* xb = (const GAS f32x4*)(a.in[0] + (size_t)(64 * vcu + 8 * wave + 4 + j) * DMODEL) + lane;
#pragma unroll
        for (int q = 0; q < 4; ++q) { vvA[j][q] = xa[64 * q]; vvB[j][q] = xb[64 * q]; } }
    {
        const int col = 4 * tid; f32x4 s = *(const f32x4*)(bada + col);
#pragma unroll
        for (int kc = 0; kc < 16; ++kc) s += *(const f32x4*)(modp + (size_t)(kc * 2 + b) * 6144 + col);
        if (col < 1024) { *(LAS f32x4*)(sh1 + col) = s; }
        else { const f32x4 g = *(const f32x4*)(a.in[4] + col - 1024); *(LAS f32x4*)(gs1 + col - 1024) = g * (1.0f + s); }
    }
    if (tid < 12) {
        float* mod = (float*)(ws + WS_MOD); const int gi = blockIdx.x * 12 + tid, bb = gi / 1536, col = 4 * (gi % 1536); f32x4 s = *(const f32x4*)(bada + col);
#pragma unroll
        for (int kc = 0; kc < 16; ++kc) s += *(const f32x4*)(modp + (size_t)(kc * 2 + bb) * 6144 + col);
        *(f32x4*)(mod + (size_t)bb * 6144 + col) = s;
    }
    for (int idx = tid; idx < 8192; idx += NWAVES * 64) { const int k = idx >> 3, f = idx & 7; wfl[f * 1024 + k] = a.in[5][(size_t)k * INCOLS + OFF_F + f]; }
    __syncthreads();
    const float* x = a.in[0]; bf16* h1 = (bf16*)(ws + WS_H1); float* logf_ = (float*)(ws + WS_LOGF); const float* bfg = a.in[13];
#pragma nounroll
    for (int jb = 0; jb < 2; ++jb) {
    f32x4 vv[4][4];
#pragma unroll
    for (int j = 0; j < 4; ++j)
#pragma unroll
        for (int q = 0; q < 4; ++q) vv[j][q] = jb ? vvB[j][q] : vvA[j][q];
#pragma unroll
    for (int j = 0; j < 4; ++j) {
        const int row = 64 * vcu + 8 * wave + 4 * jb + j, t = row & (SEQ - 1);
        LAS float* gs1_ = gs1; asm volatile("" : "+v"(gs1_));
        LAS float* sh1_ = gs1_ + 1024; LAS float* wfl_ = gs1_ + 2048;
        f32x4 v[4]; float ss = 0.f;
#pragma unroll
        for (int q = 0; q < 4; ++q) { v[q] = vv[j][q]; ss += (v[q].x * v[q].x + v[q].y * v[q].y) + (v[q].z * v[q].z + v[q].w * v[q].w); }
        const float rstd = 1.0f / sqrtf(wave_sum(ss) * (1.0f / DMODEL) + EPS);
        float hm = 0.f;
#pragma unroll
        for (int q = 0; q < 4; ++q) { const f32x4 g = *(const LAS f32x4*)(gs1_ + 4 * lane + 256 * q), s = *(const LAS f32x4*)(sh1_ + 4 * lane + 256 * q);
            v[q] = v[q] * rstd * g + s; hm = fmaxf(hm, fmaxf(fmaxf(fabsf(v[q].x), fabsf(v[q].y)), fmaxf(fabsf(v[q].z), fabsf(v[q].w)))); }
#pragma unroll
        for (int o = 1; o < 64; o <<= 1) hm = fmaxf(hm, __shfl_xor(hm, o));
        hm = fmaxf(hm, 1e-20f); const float qinv = 127.0f / hm;
        GAS unsigned* o4 = (GAS unsigned*)((unsigned char*)h1 + (size_t)row * DMODEL) + lane;
#pragma unroll
        for (int q = 0; q < 4; ++q) o4[64 * q] = pk4_i8(v[q].x * qinv, v[q].y * qinv, v[q].z * qinv, v[q].w * qinv);
        if (lane == 0) ((float*)(ws + WS_SA1))[row] = hm * (1.0f / 127.0f);
        float pf[8];
#pragma unroll
        for (int f = 0; f < 8; ++f) { float p = 0.f;
#pragma unroll
            for (int q = 0; q < 4; ++q) { const f32x4 w = *(const LAS f32x4*)(wfl_ + f * 1024 + 4 * lane + 256 * q); p += (v[q].x * w.x + v[q].y * w.y) + (v[q].z * w.z + v[q].w * w.w); }
            pf[f] = p; }
        float r4[4], r2[2], mine;
#pragma unroll
        for (int i = 0; i < 4; ++i) { const float keep = (lane & 1) ? pf[2 * i + 1] : pf[2 * i], send = (lane & 1) ? pf[2 * i] : pf[2 * i + 1]; r4[i] = keep + __shfl_xor(send, 1); }
#pragma unroll
        for (int i = 0; i < 2; ++i) { const float keep = (lane & 2) ? r4[2 * i + 1] : r4[2 * i], send = (lane & 2) ? r4[2 * i] : r4[2 * i + 1]; r2[i] = keep + __shfl_xor(send, 2); }
        { const float keep = (lane & 4) ? r2[1] : r2[0], send = (lane & 4) ? r2[0] : r2[1]; mine = keep + __shfl_xor(send, 4); }
        mine += __shfl_xor(mine, 8); mine += __shfl_xor(mine, 16); mine += __shfl_xor(mine, 32);
        if (lane < 8) { const float z = mine + bfg[lane]; const float ls = fminf(z, 0.f) - log1pf(expf(-fabsf(z)));
            logf_[(size_t)(b * 8 + lane) * SEQ + t] = ls; }
    }
    }
}

__device__ __forceinline__ void p2_cumsum(const KArgs& a, LAS unsigned char* lds, int seq, int tid, int wave, int lane) {
    const float* lf = (const float*)(a.ws + WS_LOGF) + (size_t)seq * SEQ + 16 * tid; float* cm = (float*)(a.ws + WS_CUM) + (size_t)seq * SEQ + 16 * tid;
    LAS double* wt = (LAS double*)(lds + RING_OFF);
    float v[16];
#pragma unroll
    for (int q = 0; q < 4; ++q) { const f32x4 x = *(const f32x4*)(lf + 4 * q); v[4 * q] = x.x; v[4 * q + 1] = x.y; v[4 * q + 2] = x.z; v[4 * q + 3] = x.w; }
    double pre[16]; double run = 0.0;
#pragma unroll
    for (int i = 0; i < 16; ++i) { run += (double)v[i]; pre[i] = run; }
    double sc = run;
#pragma unroll
    for (int o = 1; o < 64; o <<= 1) { const double up = __shfl_up(sc, o); if (lane >= o) sc += up; }
    if (lane == 63) wt[wave] = sc;
    __syncthreads();
    double off = sc - run;
    for (int w = 0; w < wave; ++w) off += wt[w];
#pragma unroll
    for (int q = 0; q < 4; ++q) { f32x4 o; o.x = (float)(off + pre[4 * q]); o.y = (float)(off + pre[4 * q + 1]); o.z = (float)(off + pre[4 * q + 2]); o.w = (float)(off + pre[4 * q + 3]); *(f32x4*)(cm + 4 * q) = o; }
    __syncthreads();
}

__device__ __forceinline__ void conv_item(const KArgs& a, LAS unsigned char* lds, int item, int tid) {
    const int tt = item >> 3, g = item & 7, row0 = 128 * tt, t0 = row0 & (SEQ - 1), c0 = 64 * g;
    const bf16* U = (const bf16*)(a.ws + WS_U); bf16* UC = (bf16*)(a.ws + WS_UC);
    constexpr int RS = 132;
    LAS unsigned char* ut = lds + RING_OFF;
    LAS float* yt = (LAS float*)(lds + RING_OFF + 24576);
    constexpr int YS = 68;
    for (int idx = tid; idx < 158 * 16; idx += NWAVES * 64) { const int r = idx >> 4, ch = idx & 15, tq = t0 - 30 + r;
        v2u val = (v2u){0u, 0u};
        if (tq >= 0) val = *(const GAS v2u*)(U + (size_t)(row0 - 30 + r) * CONVD + c0 + 4 * ch);
        *(LAS unsigned*)(ut + r * RS + 8 * ch) = val.x; *(LAS unsigned*)(ut + r * RS + 8 * ch + 4) = val.y; }
    const int c2 = tid & 31, seg = tid >> 5;
    float w0[CONVW], w1[CONVW];
#pragma unroll
    for (int j = 0; j < CONVW; ++j) { const f32x2 wv = *(const f32x2*)(a.in[6] + (size_t)j * CONVD + c0 + 2 * c2); w0[j] = wv[0]; w1[j] = wv[1]; }
    const f32x2 bv = *(const f32x2*)(a.in[7] + c0 + 2 * c2);
    __syncthreads();
    float y0[8], y1[8];
#pragma unroll
    for (int t = 0; t < 8; ++t) { y0[t] = bv[0]; y1[t] = bv[1]; }
#pragma unroll
    for (int r = 0; r < 38; ++r) { const unsigned uu = *(const LAS unsigned*)(ut + (8 * seg + r) * RS + 4 * c2); const float x0 = bf_lo(uu), x1v = bf_hi(uu);
#pragma unroll
        for (int t = 0; t < 8; ++t) { const int j = r - t; if (j >= 0 && j < CONVW) { y0[t] += x0 * w0[j]; y1[t] += x1v * w1[j]; } } }
#pragma unroll
    for (int t = 0; t < 8; ++t) *(LAS f32x2*)(yt + (8 * seg + t) * YS + 2 * c2) = (f32x2){y0[t], y1[t]};
    __syncthreads();
    const int tok = tid >> 2, q = tid & 3;
    float acc[16];
#pragma unroll
    for (int i = 0; i < 4; ++i) { const f32x4 v = *(const LAS f32x4*)(yt + tok * YS + 16 * q + 4 * i); acc[4 * i] = v[0]; acc[4 * i + 1] = v[1]; acc[4 * i + 2] = v[2]; acc[4 * i + 3] = v[3]; }
    float s = 0.f;
#pragma unroll
    for (int i = 0; i < 16; ++i) s += acc[i];
    s += __shfl_xor(s, 1); s += __shfl_xor(s, 2);
    const float mu = s * (1.0f / 64.0f); float qv = 0.f;
#pragma unroll
    for (int i = 0; i < 16; ++i) { acc[i] -= mu; qv += acc[i] * acc[i]; }
    qv += __shfl_xor(qv, 1); qv += __shfl_xor(qv, 2);
    const float rstd = 1.0f / sqrtf(qv * (1.0f / 64.0f) + EPS);
    unsigned o[8];
#pragma unroll
    for (int i = 0; i < 16; i += 2) { float v0 = acc[i] * rstd * a.in[8][c0 + 16 * q + i] + a.in[9][c0 + 16 * q + i], v1 = acc[i + 1] * rstd * a.in[8][c0 + 16 * q + i + 1] + a.in[9][c0 + 16 * q + i + 1];
        v0 = v0 * sigmoidf_fast(v0); v1 = v1 * sigmoidf_fast(v1); o[i >> 1] = pk2(v0, v1); }
    GAS v4u* dst = (GAS v4u*)(UC + (size_t)(row0 + tok) * CONVD + c0 + 16 * q);
    dst[0] = (v4u){o[0], o[1], o[2], o[3]}; dst[1] = (v4u){o[4], o[5], o[6], o[7]};
    __syncthreads();
}

struct SchedDense {
    static constexpr bool GATHER = false;
    int nM, nN, G, c, K; const char* A; const char* B;
    __device__ __forceinline__ bool next(int i, pg8::Unit& u) const {
        const long L = (long)i * G + c; if (L >= (long)nM * nN) return false;
        pg8::tile_of((int)L, nM, nN, u.pm, u.pn); u.e = 0; u.mt = 0;
        u.A = A + (size_t)u.pm * 256 * K * 2; u.B = B + (size_t)u.pn * 256 * K * 2; return true; }
    __device__ __forceinline__ int row(const pg8::Unit&, int) const { return 0; }
};
struct SchedMerge {
    static constexpr bool GATHER = false;
    int c; const char* A0; const char* B0; const char* A1; const char* B1;
    __device__ __forceinline__ bool next(int i, pg8::Unit& u) const {
        if (i >= 2 || c >= 256) return false;
        pg8::tile_of(c, 64, 4, u.pm, u.pn); u.e = i; u.mt = 0;
        u.A = (i ? A1 : A0) + (size_t)u.pm * 256 * 512 * 2; u.B = (i ? B1 : B0) + (size_t)u.pn * 256 * 512 * 2; return true; }
    __device__ __forceinline__ int row(const pg8::Unit&, int) const { return 0; }
};
struct MoeTab { const LAS int* tstart; const LAS int* cnt; };
struct SchedMoe1 {
    static constexpr bool GATHER = true;
    MoeTab tb; int nmoe, ntot, per, c, lane; const char* h2; const char* wgu; const char* wsgu; const int* list;
    __device__ __forceinline__ bool next(int i, pg8::Unit& u) const {
        const int L = i * per + c; if (L >= ntot) return false;
        if (L < nmoe) { const int nti = nmoe >> 1, tt = L % nti; const int e = __popcll(__ballot(tb.tstart[lane + 1] <= tt));
            u.e = e; u.mt = tt - tb.tstart[e]; u.pm = tt; u.pn = L / nti; u.A = h2; u.B = wgu + ((size_t)e * 512 + (size_t)u.pn * 256) * 1024; }
        else { const int s = L - nmoe; u.e = -1; u.mt = 0; u.pm = s & 63; u.pn = s >> 6; u.A = h2; u.B = wsgu + (size_t)u.pn * 256 * 1024; }
        return true; }
    __device__ __forceinline__ int row(const pg8::Unit& u, int r) const {
        if (u.e < 0) return u.pm * 256 + r;
        const int idx = u.mt * 256 + r; return idx < tb.cnt[u.e] ? (list[(size_t)u.e * LISTCAP + idx] >> 3) : 0; }
};
struct SchedMoe2 {
    static constexpr bool GATHER = false;
    MoeTab tb; int ntot, per, c, lane; const char* act; const char* wd;
    __device__ __forceinline__ bool next(int i, pg8::Unit& u) const {
        const int nti = ntot >> 2, NP = 2 * nti, R = NP / per, rem = NP - R * per; int j, half;
        if (i < 2 * R) { j = (i >> 1) * per + c; half = i & 1; }
        else { const int q = c + per * (i - 2 * R); if (q >= 2 * rem) return false; j = R * per + (q >> 1); half = q & 1; }
        const int tt = j % nti; const int e = __popcll(__ballot(tb.tstart[lane + 1] <= tt));
        u.e = e; u.mt = tt - tb.tstart[e]; u.pm = tt; u.pn = 2 * (j / nti) + half; u.A = act + (size_t)tt * 256 * 256 * 2; u.B = wd + ((size_t)e * 1024 + (size_t)u.pn * 256) * 256 * 2; return true; }
    __device__ __forceinline__ int row(const pg8::Unit&, int) const { return 0; }
};

typedef pg8::f32x4 (AccT)[2][2][4][2];
#define NO_PRE_MEMBERS static constexpr bool AFTER_DRAIN = false; struct Pre {}; __device__ __forceinline__ void prefetch(Pre&, const pg8::Unit&, int, int, int, int) const {} static constexpr bool ROWTAB = false; static constexpr int NTAB = 1; __device__ __forceinline__ const char* tab_src(const pg8::Unit&, int) const { return nullptr; }
__device__ __forceinline__ v4u pack8(const f32x4& a, const f32x4& b) { v4u w; w.x = cvt_pk_bf16(a[0], a[1]); w.y = cvt_pk_bf16(a[2], a[3]); w.z = cvt_pk_bf16(b[0], b[1]); w.w = cvt_pk_bf16(b[2], b[3]); return w; }
__device__ __forceinline__ void unpack8(const v4u& w, f32x4& a, f32x4& b) { a = (f32x4){bf_lo(w.x), bf_hi(w.x), bf_lo(w.y), bf_hi(w.y)}; b = (f32x4){bf_lo(w.z), bf_hi(w.z), bf_lo(w.w), bf_hi(w.w)}; }
__device__ __forceinline__ f32x4 sig4(const f32x4& v) { return (f32x4){sigmoidf_fast(v[0]), sigmoidf_fast(v[1]), sigmoidf_fast(v[2]), sigmoidf_fast(v[3])}; }

struct EpiIn {
    static constexpr bool PERM = true; static constexpr bool AFTER_DRAIN = false; struct Pre {}; __device__ __forceinline__ void prefetch(Pre&, const pg8::Unit&, int, int, int, int) const {}
    static constexpr bool ROWTAB = true; static constexpr int NTAB = 1;
    __device__ __forceinline__ const char* tab_src(const pg8::Unit& u, int) const { return (const char*)(sA + u.pm * 256); }
    bf16 *U, *Q, *Kb, *V, *SG; const float *gq, *gk; const float* sA; const unsigned* amax;
    __device__ __forceinline__ void operator()(const AccT& acc, const pg8::Unit& u, int wr, int wc, int fr_, int fq_, const Pre& pre, const LAS unsigned* rtab) const {
        int fr = fr_, fq = fq_; asm volatile("" : "+v"(fr), "+v"(fq));
        const int rl0 = wr * 64 + fr, row0 = u.pm * 256 + rl0, pn = u.pn; const float sW = __builtin_bit_cast(float, amax[0]) * (1.0f / 127.0f);
        if (pn < 4) {
            const int col0 = 128 * pn + 32 * wc + 8 * fq;
#pragma unroll
            for (int ai = 0; ai < 2; ++ai)
#pragma unroll
                for (int m = 0; m < 4; ++m) { const float sc = __builtin_bit_cast(float, rtab[rl0 + ai * 128 + m * 16]) * sW;
                    const f32x4 v0 = acc[ai][0][m][0] * sc * sig4(acc[ai][1][m][0] * sc), v1 = acc[ai][0][m][1] * sc * sig4(acc[ai][1][m][1] * sc);
                    *(v4u*)(U + (size_t)(row0 + ai * 128 + m * 16) * CONVD + col0) = pack8(v0, v1); }
        } else if (pn < 8) {
            const bool isk = pn >= 6; const int head = 4 * ((pn - 4) & 1) + wc; const float* g = isk ? gk : gq; bf16* dst = isk ? Kb : Q; const float qsc = isk ? 1.0f : C2Q;
            f32x4 gv[2][2];
#pragma unroll
            for (int bj = 0; bj < 2; ++bj)
#pragma unroll
                for (int n = 0; n < 2; ++n) gv[bj][n] = *(const f32x4*)(g + 32 * bj + 8 * fq + 4 * n) * qsc;
#pragma unroll
            for (int ai = 0; ai < 2; ++ai)
#pragma unroll
                for (int m = 0; m < 4; ++m) { const float sc = __builtin_bit_cast(float, rtab[rl0 + ai * 128 + m * 16]) * sW; float ss = 0.f;
#pragma unroll
                    for (int bj = 0; bj < 2; ++bj)
#pragma unroll
                        for (int n = 0; n < 2; ++n) { const f32x4 x = acc[ai][bj][m][n]; ss += (x[0] * x[0] + x[1] * x[1]) + (x[2] * x[2] + x[3] * x[3]); }
                    ss += __shfl_xor(ss, 16); ss += __shfl_xor(ss, 32);
                    const float r = sc / sqrtf(ss * (sc * sc) * (1.0f / 64.0f) + EPS);
                    bf16* rowp = dst + (size_t)(row0 + ai * 128 + m * 16) * ATT + head * 64 + 8 * fq;
#pragma unroll
                    for (int bj = 0; bj < 2; ++bj) *(v4u*)(rowp + 32 * bj) = pack8(acc[ai][bj][m][0] * r * gv[bj][0], acc[ai][bj][m][1] * r * gv[bj][1]); }
        } else if (pn < 10) {
            const int col0 = 256 * (pn - 8) + 32 * wc + 8 * fq;
#pragma unroll
            for (int ai = 0; ai < 2; ++ai)
#pragma unroll
                for (int m = 0; m < 4; ++m) { const float sc = __builtin_bit_cast(float, rtab[rl0 + ai * 128 + m * 16]) * sW;
#pragma unroll
                    for (int bj = 0; bj < 2; ++bj) *(v4u*)(V + (size_t)(row0 + ai * 128 + m * 16) * ATT + col0 + 128 * bj) = pack8(acc[ai][bj][m][0] * sc, acc[ai][bj][m][1] * sc); }
        } else {
            bf16* dst = SG + (size_t)((pn - 10) >> 2) * T * DMODEL; const int col0 = 256 * ((pn - 10) & 3) + 32 * wc + 8 * fq;
#pragma unroll
            for (int ai = 0; ai < 2; ++ai)
#pragma unroll
                for (int m = 0; m < 4; ++m) { const float sc = __builtin_bit_cast(float, rtab[rl0 + ai * 128 + m * 16]) * sW;
#pragma unroll
                    for (int bj = 0; bj < 2; ++bj) *(v4u*)(dst + (size_t)(row0 + ai * 128 + m * 16) * DMODEL + col0 + 128 * bj) = pack8(sig4(acc[ai][bj][m][0] * sc), sig4(acc[ai][bj][m][1] * sc)); }
        }
    }
};
struct EpiMerge {
    static constexpr bool PERM = true; NO_PRE_MEMBERS
    const bf16* SG; bf16* MG;
    __device__ __forceinline__ void operator()(const AccT& acc, const pg8::Unit& u, int wr, int wc, int fr_, int fq_, const Pre& pre, const LAS unsigned* rtab) const {
        int fr = fr_, fq = fq_; asm volatile("" : "+v"(fr), "+v"(fq));
        const int row0 = u.pm * 256 + wr * 64 + fr, col0 = u.pn * 256 + 32 * wc + 8 * fq; const bf16* sg = SG + (size_t)u.e * T * DMODEL;
#pragma unroll
        for (int ai = 0; ai < 2; ++ai)
#pragma unroll
            for (int m = 0; m < 4; ++m)
#pragma unroll
                for (int bj = 0; bj < 2; ++bj) { const size_t off = (size_t)(row0 + ai * 128 + m * 16) * DMODEL + col0 + 128 * bj;
                    f32x4 g0, g1; unpack8(*(const v4u*)(sg + off), g0, g1);
                    f32x4 v0 = g0 * acc[ai][bj][m][0], v1 = g1 * acc[ai][bj][m][1];
                    if (u.e) { f32x4 p0, p1; unpack8(*(const v4u*)(MG + off), p0, p1); v0 += p0; v1 += p1; }
                    *(v4u*)(MG + off) = pack8(v0, v1); }
    }
};
struct EpiX1 {
    static constexpr bool PERM = true; static constexpr bool AFTER_DRAIN = true; struct Pre {}; __device__ __forceinline__ void prefetch(Pre&, const pg8::Unit&, int, int, int, int) const {}
    static constexpr bool ROWTAB = false; static constexpr int NTAB = 1; __device__ __forceinline__ const char* tab_src(const pg8::Unit&, int) const { return nullptr; }
    const float* x; float* out; const float* mod; float* ssq; float* xmx;
    __device__ __forceinline__ void operator()(const AccT&, const pg8::Unit&, int, int, int, int, const Pre&, const LAS unsigned*) const {}
    __device__ __forceinline__ void fused(const AccT& acc, const pg8::Unit& u, int wr, int wc, int fr, int fq, LAS unsigned char* lds) const;
};
struct EpiGlu {
    static constexpr bool PERM = true;
    bf16 *ACT, *SACT; const float* wlist; const float* slist; const float* sA2; const unsigned* amax; MoeTab tb;
    struct Pre {}; __device__ __forceinline__ void prefetch(Pre&, const pg8::Unit&, int, int, int, int) const {}
    static constexpr bool AFTER_DRAIN = false;
    static constexpr bool ROWTAB = true; static constexpr int NTAB = 2;
    __device__ __forceinline__ const char* tab_src(const pg8::Unit& u, int t) const {
        if (u.e >= 0) return (const char*)((t ? slist : wlist) + (size_t)u.e * LISTCAP + u.mt * 256);
        return t ? (const char*)(sA2 + u.pm * 256) : nullptr; }
    __device__ __forceinline__ void operator()(const AccT& acc, const pg8::Unit& u, int wr, int wc, int fr_, int fq_, const Pre& pre, const LAS unsigned* rtab) const {
        int fr = fr_, fq = fq_; asm volatile("" : "+v"(fr), "+v"(fq));
        const int rl0 = wr * 64 + fr, col0 = 128 * u.pn + 32 * wc + 8 * fq; bf16* dst = (u.e >= 0 ? ACT : SACT) + (size_t)u.pm * 256 * EF;
        const int cnt = u.e >= 0 ? tb.cnt[u.e] : 0; const float sW = __builtin_bit_cast(float, amax[u.e >= 0 ? 2 + u.e : 1]) * (1.0f / 127.0f);
#pragma unroll
        for (int ai = 0; ai < 2; ++ai)
#pragma unroll
            for (int m = 0; m < 4; ++m) { const int rl = rl0 + ai * 128 + m * 16; const bool valid = (u.e < 0) || (u.mt * 256 + rl < cnt);
                const float w = (u.e >= 0) ? (valid ? __builtin_bit_cast(float, rtab[rl]) : 0.0f) : 1.0f, gsc = valid ? __builtin_bit_cast(float, rtab[256 + rl]) * sW : 0.0f;
                const f32x4 g0 = acc[ai][0][m][0] * gsc, g1 = acc[ai][0][m][1] * gsc;
                const f32x4 v0 = g0 * sig4(g0) * acc[ai][1][m][0] * (w * gsc), v1 = g1 * sig4(g1) * acc[ai][1][m][1] * (w * gsc);
                *(v4u*)(dst + (size_t)rl * EF + col0) = pack8(v0, v1); asm volatile("" ::: "memory"); }
    }
};
struct EpiSlab {
    static constexpr bool PERM = true;
    unsigned char* SLAB; const int* list; MoeTab tb;
    struct Pre {}; __device__ __forceinline__ void prefetch(Pre&, const pg8::Unit&, int, int, int, int) const {}
    static constexpr bool AFTER_DRAIN = false;
    static constexpr bool ROWTAB = true; static constexpr int NTAB = 1;
    __device__ __forceinline__ const char* tab_src(const pg8::Unit& u, int) const { return (const char*)(list + (size_t)u.e * LISTCAP + u.mt * 256); }
    __device__ __forceinline__ void operator()(const AccT& acc, const pg8::Unit& u, int wr, int wc, int fr_, int fq_, const Pre& pre, const LAS unsigned* rtab) const {
        int fr = fr_, fq = fq_; asm volatile("" : "+v"(fr), "+v"(fq));
        const int col0 = 256 * u.pn + 64 * wc + 8 * fq;
#pragma unroll
        for (int ai = 0; ai < 2; ++ai)
#pragma unroll
            for (int m = 0; m < 4; ++m) { const int rl = wr * 64 + fr + ai * 128 + m * 16; const int slot = (int)rtab[rl];
                if (u.mt * 256 + rl < tb.cnt[u.e]) { unsigned char* rowp = SLAB + (size_t)slot * DMODEL + col0;
#pragma unroll
                    for (int bj = 0; bj < 2; ++bj) { const f32x4 a0 = acc[ai][bj][m][0] * SLABSCALE, a1 = acc[ai][bj][m][1] * SLABSCALE;
#if defined(P8_ABL)
                        { v2u t_ = (v2u){pk4_fp8(a0[0], a0[1], a0[2], a0[3]), pk4_fp8(a1[0], a1[1], a1[2], a1[3])}; asm volatile("" :: "v"(t_.x), "v"(t_.y), "v"(rowp)); }
#else
                        *(v2u*)(rowp + 32 * bj) = (v2u){pk4_fp8(a0[0], a0[1], a0[2], a0[3]), pk4_fp8(a1[0], a1[1], a1[2], a1[3])};
#endif
                    } }
                asm volatile("" ::: "memory"); }
    }
};
__device__ __forceinline__ void park_tile(const AccT& acc, LAS unsigned char* lds, int wr, int wc, int fr, int fq) {
#pragma unroll
    for (int ai = 0; ai < 2; ++ai)
#pragma unroll
        for (int m = 0; m < 4; ++m) { const int row = 128 * ai + 64 * wr + 16 * m + fr;
#pragma unroll
            for (int bj = 0; bj < 2; ++bj) { const int c16 = 16 * bj + 4 * wc + fq; *(LAS v4u*)(lds + row * 512 + ((c16 ^ (row & 31)) << 4)) = pack8(acc[ai][bj][m][0], acc[ai][bj][m][1]); } }
    asm volatile("s_waitcnt lgkmcnt(0)" ::: "memory"); __builtin_amdgcn_s_barrier(); asm volatile("" ::: "memory");
}
struct EpiFinal {
    static constexpr bool PERM = true; static constexpr bool AFTER_DRAIN = true; struct Pre {}; __device__ __forceinline__ void prefetch(Pre&, const pg8::Unit&, int, int, int, int) const {}
    static constexpr bool ROWTAB = false; static constexpr int NTAB = 1; __device__ __forceinline__ const char* tab_src(const pg8::Unit&, int) const { return nullptr; }
    float* out; const unsigned char* SLAB; const float* mod;
    __device__ __forceinline__ void operator()(const AccT&, const pg8::Unit&, int, int, int, int, const Pre&, const LAS unsigned*) const {}
    __device__ __forceinline__ void fused(const AccT& acc, const pg8::Unit& u, int wr, int wc, int fr, int fq, LAS unsigned char* lds) const {
        typedef float f32x2v __attribute__((ext_vector_type(2)));
        park_tile(acc, lds, wr, wc, fr, fq);
        const int tid = threadIdx.x, wave = tid >> 6, lane = tid & 63, hl = lane >> 5, i = lane & 31;
        const int col0 = 128 * ((i >> 2) & 1) + 32 * (i >> 3) + 8 * (i & 3);
        const float* g2 = mod + (size_t)(u.pm >> 5) * 6144 + 5120 + u.pn * 256 + col0;
        const f32x4 gv0 = *(const f32x4*)g2, gv1 = *(const f32x4*)(g2 + 4);
#pragma unroll 4
        for (int s = 0; s < 16; ++s) { const int rl = 32 * wave + 2 * s + hl; const size_t row = (size_t)u.pm * 256 + rl;
            const unsigned char* sp = SLAB + row * TOPK * DMODEL + u.pn * 256 + 8 * i;
            v2u sv[TOPK];
#if FWD_LEVEL >= 2
#pragma unroll
            for (int k = 0; k < TOPK; ++k) sv[k] = *(const v2u*)(sp + (size_t)k * DMODEL);
#endif
            float* op = out + row * DMODEL + u.pn * 256 + col0; const f32x4 x0 = *(const f32x4*)op, x1v = *(const f32x4*)(op + 4);
            f32x4 a0, a1; { const v4u pk_ = *(const LAS v4u*)(lds + rl * 512 + ((((col0 >> 3)) ^ (rl & 31)) << 4)); unpack8(pk_, a0, a1); }
            f32x4 s0 = (f32x4){0.f, 0.f, 0.f, 0.f}, s1 = s0;
#if FWD_LEVEL >= 2
#pragma unroll
            for (int k = 0; k < TOPK; ++k) { const f32x2v a = __builtin_amdgcn_cvt_pk_f32_fp8((int)sv[k].x, false), b = __builtin_amdgcn_cvt_pk_f32_fp8((int)sv[k].x, true), c = __builtin_amdgcn_cvt_pk_f32_fp8((int)sv[k].y, false), d = __builtin_amdgcn_cvt_pk_f32_fp8((int)sv[k].y, true);
                s0 += (f32x4){a[0], a[1], b[0], b[1]}; s1 += (f32x4){c[0], c[1], d[0], d[1]}; }
#endif
            s0 = s0 * (1.0f / SLABSCALE) + a0; s1 = s1 * (1.0f / SLABSCALE) + a1;
            *(f32x4*)op = x0 + gv0 * s0; *(f32x4*)(op + 4) = x1v + gv1 * s1; }
    }
};
__device__ __forceinline__ void EpiX1::fused(const AccT& acc, const pg8::Unit& u, int wr, int wc, int fr, int fq, LAS unsigned char* lds) const {
    park_tile(acc, lds, wr, wc, fr, fq);
    const int tid = threadIdx.x, wave = tid >> 6, lane = tid & 63, hl = lane >> 5, i = lane & 31;
    const float* g1 = mod + (size_t)(u.pm >> 5) * 6144 + 2048 + u.pn * 256 + 8 * i;
    const f32x4 gv0 = *(const f32x4*)g1, gv1 = *(const f32x4*)(g1 + 4);
#pragma unroll 4
    for (int s = 0; s < 16; ++s) { const int rl = 32 * wave + 2 * s + hl; const size_t off = ((size_t)u.pm * 256 + rl) * DMODEL + u.pn * 256 + 8 * i;
        const f32x4 x0 = *(const f32x4*)(x + off), x1v = *(const f32x4*)(x + off + 4);
        f32x4 a0, a1; { const v4u pk_ = *(const LAS v4u*)(lds + rl * 512 + ((i ^ (rl & 31)) << 4)); unpack8(pk_, a0, a1); }
        const f32x4 v0 = x0 + gv0 * a0, v1 = x1v + gv1 * a1;
        *(f32x4*)(out + off) = v0; *(f32x4*)(out + off + 4) = v1;
        float ss = ((v0[0] * v0[0] + v0[1] * v0[1]) + (v0[2] * v0[2] + v0[3] * v0[3])) + ((v1[0] * v1[0] + v1[1] * v1[1]) + (v1[2] * v1[2] + v1[3] * v1[3]));
        float mx = fmaxf(fmaxf(fmaxf(fabsf(v0[0]), fabsf(v0[1])), fmaxf(fabsf(v0[2]), fabsf(v0[3]))), fmaxf(fmaxf(fabsf(v1[0]), fabsf(v1[1])), fmaxf(fabsf(v1[2]), fabsf(v1[3]))));
        ss += __shfl_xor(ss, 1); ss += __shfl_xor(ss, 2); ss += __shfl_xor(ss, 4); ss += __shfl_xor(ss, 8); ss += __shfl_xor(ss, 16);
        mx = fmaxf(mx, __shfl_xor(mx, 1)); mx = fmaxf(mx, __shfl_xor(mx, 2)); mx = fmaxf(mx, __shfl_xor(mx, 4)); mx = fmaxf(mx, __shfl_xor(mx, 8)); mx = fmaxf(mx, __shfl_xor(mx, 16));
        if (i == 0) { ssq[(size_t)u.pn * T + (size_t)u.pm * 256 + rl] = ss; xmx[(size_t)u.pn * T + (size_t)u.pm * 256 + rl] = mx; } }
}


__device__ __forceinline__ void p6_item(const KArgs& a, LAS unsigned char* lds, int item, int tid, int wave, int lane) {
    unsigned char* ws = a.ws;
    const int row0 = 32 * item, r = lane & 31, h = lane >> 5, row = row0 + r, b = row >> 13;
    const float* x1 = a.out; const float* ssq = (const float*)(ws + WS_SSQ); const float* mod = (const float*)(ws + WS_MOD) + (size_t)b * 6144;
    unsigned char* H2 = ws + WS_H2;
    const bf16* WRH = (const bf16*)(ws + WS_WRH); const bf16* WRL = (const bf16*)(ws + WS_WRL);
    constexpr int WREG = 9216, TROW = 144;
    LAS unsigned char* wreg = lds + RING_OFF + wave * WREG;
    LAS float* scl = (LAS float*)(lds + RING_OFF + 8 * WREG);
    LAS float* bil = scl + 32 * 65;
    LAS int* hist = (LAS int*)(bil + 32 * 65);
    LAS int* gbase = hist + 512;
    LAS float* rstl = (LAS float*)(gbase + 64);
    if (tid < 32) { float ss = 0.f;
#pragma unroll
        for (int p = 0; p < 4; ++p) ss += ssq[(size_t)p * T + row0 + tid];
        rstl[tid] = 1.0f / sqrtf(ss * (1.0f / DMODEL) + EPS); }
    const int lr = lane >> 4, lc4 = (lane & 15) * 4;
    __syncthreads();
    f32x16 acc0, acc1;
#pragma unroll
    for (int i = 0; i < 16; ++i) { acc0[i] = 0.f; acc1[i] = 0.f; }
#pragma nounroll
    for (int ms = 0; ms < 2; ++ms) {
        const int kb = 128 * wave + 64 * ms;
        f32x4 xv[8];
#pragma unroll
        for (int i = 0; i < 8; ++i) xv[i] = *(const f32x4*)(x1 + (size_t)(row0 + 4 * i + lr) * DMODEL + kb + lc4);
        const f32x4 gs = *(const f32x4*)(a.in[16] + kb + lc4) * (1.0f + *(const f32x4*)(mod + 4096 + kb + lc4)), sh = *(const f32x4*)(mod + 3072 + kb + lc4);
#pragma unroll
        for (int i = 0; i < 8; ++i) { const int rr = 4 * i + lr; const f32x4 hv = xv[i] * rstl[rr] * gs + sh;
            const unsigned h0 = f2bf(hv[0]), h1_ = f2bf(hv[1]), h2_ = f2bf(hv[2]), h3 = f2bf(hv[3]);
            const v2u whi = (v2u){h0 | (h1_ << 16), h2_ | (h3 << 16)};
            const v2u wlo = (v2u){pk2(hv[0] - bf2f(h0), hv[1] - bf2f(h1_)), pk2(hv[2] - bf2f(h2_), hv[3] - bf2f(h3))};
#if MOE_FP8
            *(GAS unsigned*)(H2 + (size_t)(row0 + rr) * DMODEL + kb + lc4) = pk4_fp8(hv[0], hv[1], hv[2], hv[3]);
#else
            *(GAS v2u*)(H2 + ((size_t)(row0 + rr) * DMODEL + kb + lc4) * 2) = whi;
#endif
            *(LAS v2u*)(wreg + rr * TROW + lc4 * 2) = whi; *(LAS v2u*)(wreg + 32 * TROW + rr * TROW + lc4 * 2) = wlo; }
#pragma unroll
        for (int sp = 0; sp < 2; ++sp) {
            bf16x8 bh0[2], bh1[2], bl0[2], bl1[2];
#pragma unroll
            for (int s2 = 0; s2 < 2; ++s2) { const size_t o = (size_t)r * DMODEL + kb + 16 * (2 * sp + s2) + 8 * h;
                bh0[s2] = *(const bf16x8*)(WRH + o); bh1[s2] = *(const bf16x8*)(WRH + o + 32 * DMODEL); bl0[s2] = *(const bf16x8*)(WRL + o); bl1[s2] = *(const bf16x8*)(WRL + o + 32 * DMODEL); }
#pragma unroll
            for (int s2 = 0; s2 < 2; ++s2) { const int s_ = 2 * sp + s2;
                const bf16x8 ahi = *(const LAS bf16x8*)(wreg + r * TROW + (16 * s_ + 8 * h) * 2), alo = *(const LAS bf16x8*)(wreg + 32 * TROW + r * TROW + (16 * s_ + 8 * h) * 2);
                acc0 = __builtin_amdgcn_mfma_f32_32x32x16_bf16(alo, bh0[s2], acc0, 0, 0, 0); acc1 = __builtin_amdgcn_mfma_f32_32x32x16_bf16(alo, bh1[s2], acc1, 0, 0, 0);
                acc0 = __builtin_amdgcn_mfma_f32_32x32x16_bf16(ahi, bl0[s2], acc0, 0, 0, 0); acc1 = __builtin_amdgcn_mfma_f32_32x32x16_bf16(ahi, bl1[s2], acc1, 0, 0, 0);
                acc0 = __builtin_amdgcn_mfma_f32_32x32x16_bf16(ahi, bh0[s2], acc0, 0, 0, 0); acc1 = __builtin_amdgcn_mfma_f32_32x32x16_bf16(ahi, bh1[s2], acc1, 0, 0, 0); }
            asm volatile("" ::: "memory");
        }
        asm volatile("" ::: "memory");
    }
    { LAS float* part = (LAS float*)wreg;
#pragma unroll
      for (int i = 0; i < 16; ++i) { const int tr = (i & 3) + 8 * (i >> 2) + 4 * h; part[tr * 64 + r] = acc0[i]; part[tr * 64 + 32 + r] = acc1[i]; } }
    __syncthreads();
    {
        const int tr = tid >> 4, e4 = (tid & 15) * 4; f32x4 s = *(const LAS f32x4*)(lds + RING_OFF + tr * 256 + e4 * 4);
#pragma unroll
        for (int w = 1; w < 8; ++w) s += *(const LAS f32x4*)(lds + RING_OFF + w * WREG + tr * 256 + e4 * 4);
        const f32x4 rb = *(const f32x4*)(a.in[18] + e4);
#pragma unroll
        for (int j = 0; j < 4; ++j) { const float sc = 1.0f / (1.0f + expf(-s[j])); scl[tr * 65 + e4 + j] = sc; bil[tr * 65 + e4 + j] = sc + rb[j]; }
    }
    __syncthreads();
    LAS int* selk = (LAS int*)(rstl + 32); LAS float* selw = (LAS float*)(selk + 32 * 64);
    int lc = 0;
#pragma nounroll
    for (int j = 0; j < 4; ++j) {
        const int tr = wave * 4 + j; const float v = bil[tr * 65 + lane], sc = scl[tr * 65 + lane];
        int rk = 0;
#pragma unroll
        for (int d = 1; d < 8; ++d) { const int src = (lane & ~7) | ((lane + d) & 7); const float o = __shfl(v, src); rk += (o > v) || (o == v && src < lane); }
        float t2 = rk < 2 ? v : 0.f; t2 += __shfl_xor(t2, 1); t2 += __shfl_xor(t2, 2); t2 += __shfl_xor(t2, 4);
        int grk = 0; const int g = lane >> 3;
#pragma unroll
        for (int g2 = 0; g2 < 8; ++g2) { const float og = __builtin_bit_cast(float, __builtin_amdgcn_readlane(__builtin_bit_cast(int, t2), g2 * 8)); grk += (og > t2) || (og == t2 && g2 < g); }
        const bool gsel = grk < 4;
        const float c = gsel ? v : -INFINITY; int erk = 0;
#pragma nounroll
        for (int e2 = 0; e2 < 64; ++e2) { const float oc = __builtin_bit_cast(float, __builtin_amdgcn_readlane(__builtin_bit_cast(int, c), e2)); erk += (oc > c) || (oc == c && e2 < lane); }
        const bool sel = gsel && erk < TOPK;
        const float wsum = wave_sum(sel ? sc : 0.f);
        selk[tr * 64 + lane] = sel ? erk : -1; selw[tr * 64 + lane] = sc * (ROUTED_SCALE / wsum); lc += sel ? 1 : 0;
    }
    hist[wave * 64 + lane] = lc;
    __syncthreads();
    if (wave == 0) { int tot = 0;
#pragma unroll
        for (int w = 0; w < 8; ++w) tot += hist[w * 64 + lane];
        gbase[lane] = tot ? (int)__hip_atomic_fetch_add((unsigned*)(ws + WS_CTL) + CW_CNT + 64 * lane, (unsigned)tot, RLX_AGENT) : 0; }
    __syncthreads();
    {   int base = gbase[lane];
        for (int w = 0; w < wave; ++w) base += hist[w * 64 + lane];
        int* list = (int*)(ws + WS_LIST); float* wl = (float*)(ws + WS_WLIST);
#pragma unroll
        for (int j = 0; j < 4; ++j) { const int tr = wave * 4 + j, k = selk[tr * 64 + lane]; if (k >= 0) { const size_t p = (size_t)lane * LISTCAP + base; list[p] = (row0 + tr) * TOPK + k; wl[p] = selw[tr * 64 + lane]; ++base; } } }
    __syncthreads();
}

__device__ __forceinline__ float p6_rank_slow(float c, int lane) {
    int erk = 0;
#pragma nounroll
    for (int e2 = 0; e2 < 64; ++e2) { const float oc = __builtin_bit_cast(float, __builtin_amdgcn_readlane(__builtin_bit_cast(int, c), e2)); erk += (oc > c) || (oc == c && e2 < lane); }
    return (float)erk;
}
__device__ __forceinline__ void p6_block(const KArgs& a, LAS unsigned char* lds, int vcu, int tid, int wave, int lane) {
    unsigned char* ws = a.ws;
    const int rowb = 64 * vcu + 8 * wave, b = (64 * vcu) >> 13;
    const float* x1 = a.out; const float* ssq = (const float*)(ws + WS_SSQ); const float* mod = (const float*)(ws + WS_MOD) + (size_t)b * 6144;
    unsigned char* H2 = ws + WS_H2;
    const bf16* WRH = (const bf16*)(ws + WS_WRH); const bf16* WRL = (const bf16*)(ws + WS_WRL);
    constexpr int RS = 272, BSH = 64 * RS, BSB = 2 * BSH;
    LAS unsigned char* BS = lds + RING_OFF;
    LAS unsigned char* AW = lds + RING_OFF + 2 * BSB + wave * (2 * 8 * RS);
    LAS int* hist = (LAS int*)(lds + RING_OFF + 2 * BSB + 8 * (2 * 8 * RS)); LAS int* gbase = hist + 512;
    float rs_l = 0.f;
    if (lane < 8) { float ss = 0.f;
#pragma unroll
        for (int p = 0; p < 4; ++p) ss += ssq[(size_t)p * T + rowb + lane];
        rs_l = 1.0f / sqrtf(ss * (1.0f / DMODEL) + EPS); }
    float gmx = 0.f, smx = 0.f;
#pragma unroll
    for (int q = 0; q < 4; ++q) { const f32x4 gq_ = *(const f32x4*)(a.in[16] + 4 * lane + 256 * q) * (1.0f + *(const f32x4*)(mod + 4096 + 4 * lane + 256 * q)), sq_ = *(const f32x4*)(mod + 3072 + 4 * lane + 256 * q);
        gmx = fmaxf(gmx, fmaxf(fmaxf(fabsf(gq_[0]), fabsf(gq_[1])), fmaxf(fabsf(gq_[2]), fabsf(gq_[3])))); smx = fmaxf(smx, fmaxf(fmaxf(fabsf(sq_[0]), fabsf(sq_[1])), fmaxf(fabsf(sq_[2]), fabsf(sq_[3])))); }
#pragma unroll
    for (int o = 1; o < 64; o <<= 1) { gmx = fmaxf(gmx, __shfl_xor(gmx, o)); smx = fmaxf(smx, __shfl_xor(smx, o)); }
    float s2_l = 1.f;
    if (lane < 8) { const float* xm = (const float*)(ws + WS_XMX); float mx = 0.f;
#pragma unroll
        for (int p = 0; p < 4; ++p) mx = fmaxf(mx, xm[(size_t)p * T + rowb + lane]);
        s2_l = fmaxf(rs_l * mx * gmx + smx, 1e-20f) * (1.0f / 127.0f); ((float*)(ws + WS_SA2))[rowb + lane] = s2_l; }
    float rstd4[4], qinv4[4];
#pragma unroll
    for (int i = 0; i < 4; ++i) { rstd4[i] = __shfl(rs_l, 2 * i + (lane >> 5)); qinv4[i] = 1.0f / __shfl(s2_l, 2 * i + (lane >> 5)); }
    const int lrow = lane >> 5, lcol = (lane & 31) * 4;
    const int fr = lane & 15, fg = lane >> 4;
    f32x4 acc[4];
#pragma unroll
    for (int nb = 0; nb < 4; ++nb) acc[nb] = (f32x4){0.f, 0.f, 0.f, 0.f};
    v4u bsA[4], bsB[4], bsC[4]; f32x4 xvA[4], xvB[4], xvC[4], gsA, gsB, gsC, shA, shB, shC;
#define P6_LOAD(S, c) do { _Pragma("unroll") for (int q = 0; q < 4; ++q) { const int idx = tid + 512 * q, e = (idx >> 4) & 63, part = idx & 15; \
            bs##S[q] = *(const v4u*)(((idx >> 10) ? WRL : WRH) + (size_t)e * DMODEL + 128 * (c) + part * 8); } \
        _Pragma("unroll") for (int i = 0; i < 4; ++i) xv##S[i] = *(const f32x4*)(x1 + (size_t)(rowb + 2 * i + lrow) * DMODEL + 128 * (c) + lcol); \
        gs##S = *(const f32x4*)(a.in[16] + 128 * (c) + lcol) * (1.0f + *(const f32x4*)(mod + 4096 + 128 * (c) + lcol)); sh##S = *(const f32x4*)(mod + 3072 + 128 * (c) + lcol); } while (0)
#define P6_BSTORE(S, buf) do { _Pragma("unroll") for (int q = 0; q < 4; ++q) { const int idx = tid + 512 * q, e = (idx >> 4) & 63, part = idx & 15; \
            *(LAS v4u*)(BS + (buf) * BSB + (idx >> 10) * BSH + e * RS + part * 16) = bs##S[q]; } } while (0)
#define P6_CONVERT(S, c) do { _Pragma("unroll") for (int i = 0; i < 4; ++i) { const int rr = 2 * i + lrow; const f32x4 hv = xv##S[i] * rstd4[i] * gs##S + sh##S; \
            const unsigned h0 = f2bf(hv[0]), h1_ = f2bf(hv[1]), h2_ = f2bf(hv[2]), h3 = f2bf(hv[3]); \
            const v2u whi = (v2u){h0 | (h1_ << 16), h2_ | (h3 << 16)}; \
            const v2u wlo = (v2u){pk2(hv[0] - bf2f(h0), hv[1] - bf2f(h1_)), pk2(hv[2] - bf2f(h2_), hv[3] - bf2f(h3))}; \
            *(GAS unsigned*)(H2 + (size_t)(rowb + rr) * DMODEL + 128 * (c) + lcol) = pk4_i8(hv[0] * qinv4[i], hv[1] * qinv4[i], hv[2] * qinv4[i], hv[3] * qinv4[i]); \
            *(LAS v2u*)(AW + rr * RS + lcol * 2) = whi; *(LAS v2u*)(AW + 8 * RS + rr * RS + lcol * 2) = wlo; } } while (0)
#if defined(P6_ABL) && P6_ABL == 4
#define P6_MMA(c) do { } while (0)
#else
#define P6_MMA(c) do { const LAS unsigned char* bsl = BS + ((c) & 1) * BSB; _Pragma("unroll") for (int ks = 0; ks < 4; ++ks) { \
            const bf16x8 ahi = *(const LAS bf16x8*)(AW + (fr & 7) * RS + (32 * ks + 8 * fg) * 2), alo = *(const LAS bf16x8*)(AW + 8 * RS + (fr & 7) * RS + (32 * ks + 8 * fg) * 2); \
            _Pragma("unroll") for (int nb = 0; nb < 4; ++nb) { const bf16x8 bh = *(const LAS bf16x8*)(bsl + (16 * nb + fr) * RS + (32 * ks + 8 * fg) * 2), bl = *(const LAS bf16x8*)(bsl + BSH + (16 * nb + fr) * RS + (32 * ks + 8 * fg) * 2); \
                acc[nb] = __builtin_amdgcn_mfma_f32_16x16x32_bf16(alo, bh, acc[nb], 0, 0, 0); acc[nb] = __builtin_amdgcn_mfma_f32_16x16x32_bf16(ahi, bl, acc[nb], 0, 0, 0); acc[nb] = __builtin_amdgcn_mfma_f32_16x16x32_bf16(ahi, bh, acc[nb], 0, 0, 0); } } } while (0)
#endif
#if defined(P6_ABL) && P6_ABL == 2
    return;
#endif
    P6_LOAD(A, 0); P6_LOAD(B, 1); P6_LOAD(C, 2); P6_BSTORE(A, 0);
    __syncthreads();
    P6_CONVERT(A, 0); P6_LOAD(A, 3); P6_MMA(0); P6_BSTORE(B, 1); __syncthreads();
    P6_CONVERT(B, 1); P6_LOAD(B, 4); P6_MMA(1); P6_BSTORE(C, 0); __syncthreads();
    P6_CONVERT(C, 2); P6_LOAD(C, 5); P6_MMA(2); P6_BSTORE(A, 1); __syncthreads();
    P6_CONVERT(A, 3); P6_LOAD(A, 6); P6_MMA(3); P6_BSTORE(B, 0); __syncthreads();
    P6_CONVERT(B, 4); P6_LOAD(B, 7); P6_MMA(4); P6_BSTORE(C, 1); __syncthreads();
    P6_CONVERT(C, 5); P6_MMA(5); P6_BSTORE(A, 0); __syncthreads();
    P6_CONVERT(A, 6); P6_MMA(6); P6_BSTORE(B, 1); __syncthreads();
    P6_CONVERT(B, 7); P6_MMA(7); __syncthreads();
#undef P6_LOAD
#undef P6_BSTORE
#undef P6_CONVERT
#undef P6_MMA
#if defined(P6_ABL) && P6_ABL == 1
    { if (fg < 2 && acc[0][0] == 12345.f) a.out[1] = acc[1][1] + acc[2][2] + acc[3][3]; return; }
#endif
    LAS float* LG = (LAS float*)AW;
    if (fg < 2) {
#pragma unroll
        for (int nb = 0; nb < 4; ++nb)
#pragma unroll
            for (int r = 0; r < 4; ++r) LG[(4 * fg + r) * 64 + 16 * nb + fr] = acc[nb][r];
    }
    LAS float* RSW = (LAS float*)(BS + wave * 8192);
    const float rbias = a.in[18][lane];
    int selk[8]; float selw[8]; int lc = 0;
#if defined(P6_ABL) && P6_ABL >= 3
#pragma unroll
    for (int j = 0; j < 8; ++j) { const bool sel = (lane >> 3) == j; selk[j] = sel ? (lane & 7) : -1; selw[j] = 0.3125f + 1e-9f * LG[j * 64 + lane] + 0.f * rbias; lc += sel ? 1 : 0; }
#else
#pragma unroll
    for (int j = 0; j < 8; ++j) {
        LAS float* Vb = RSW + j * 160; LAS float* Cb = Vb + 64; LAS float* Gb = Vb + 128; LAS float* Tb = Vb + 136;
        const float sc = 1.0f / (1.0f + expf(-LG[j * 64 + lane])), v = sc + rbias;
        Vb[lane] = v;
        const f32x4 ga = *(const LAS f32x4*)(Vb + (lane & ~7)), gb = *(const LAS f32x4*)(Vb + (lane & ~7) + 4);
        float m1 = -INFINITY, m2 = -INFINITY;
#pragma unroll
        for (int q = 0; q < 8; ++q) { const float o = q < 4 ? ga[q] : gb[q - 4]; if (o > m1) { m2 = m1; m1 = o; } else if (o > m2) m2 = o; }
        const float gs = m1 + m2;
        if ((lane & 7) == 0) Gb[lane >> 3] = gs;
        const f32x4 sa = *(const LAS f32x4*)Gb, sb = *(const LAS f32x4*)(Gb + 4);
        int grk = 0; const int g = lane >> 3;
#pragma unroll
        for (int g2 = 0; g2 < 8; ++g2) { const float og = g2 < 4 ? sa[g2] : sb[g2 - 4]; grk += (og > gs) || (og == gs && g2 < g); }
        const bool gsel = grk < 4; const float cnd = gsel ? v : -INFINITY;
        Cb[lane] = cnd;
        int gt = 0, eq = 0;
#pragma unroll
        for (int q = 0; q < 16; ++q) { const f32x4 o = *(const LAS f32x4*)(Cb + 4 * q);
            gt += (o[0] > cnd) + (o[1] > cnd) + (o[2] > cnd) + (o[3] > cnd); eq += (o[0] == cnd) + (o[1] == cnd) + (o[2] == cnd) + (o[3] == cnd); }
        int erk = gt;
        if (__builtin_expect(__any(gsel && eq > 1), 0)) erk = (int)p6_rank_slow(cnd, lane);
        const bool sel = gsel && erk < TOPK;
        if (sel) Tb[erk] = sc;
        const f32x4 ta = *(const LAS f32x4*)Tb, tb_ = *(const LAS f32x4*)(Tb + 4);
        const float wsum = ((ta[0] + ta[1]) + (ta[2] + ta[3])) + ((tb_[0] + tb_[1]) + (tb_[2] + tb_[3]));
        selk[j] = sel ? erk : -1; selw[j] = sc * (ROUTED_SCALE / wsum); lc += sel ? 1 : 0;
    }
#endif
    hist[wave * 64 + lane] = lc;
    __syncthreads();
    if (wave == 0) { int tot = 0;
#pragma unroll
        for (int w = 0; w < 8; ++w) tot += hist[w * 64 + lane];
        gbase[lane] = tot ? (int)__hip_atomic_fetch_add((unsigned*)(ws + WS_CTL) + CW_CNT + 64 * lane, (unsigned)tot, RLX_AGENT) : 0; }
    __syncthreads();
    {   int base = gbase[lane];
        for (int w = 0; w < wave; ++w) base += hist[w * 64 + lane];
        int* list = (int*)(ws + WS_LIST); float* wl = (float*)(ws + WS_WLIST); float* sl = (float*)(ws + WS_SLIST);
#pragma unroll
        for (int j = 0; j < 8; ++j) { const float s2j = __shfl(s2_l, j); if (selk[j] >= 0) { const size_t p = (size_t)lane * LISTCAP + base; list[p] = (rowb + j) * TOPK + selk[j]; wl[p] = selw[j]; sl[p] = s2j; ++base; } } }
    __syncthreads();
}

constexpr int WD_SPLIT = 5120;
__device__ __forceinline__ void moe_tables(const KArgs& a, LAS unsigned char* lds, int tid, int lane) {
    LAS int* tstart = (LAS int*)(lds + TAB_OFF); LAS int* cntl = tstart + 80;
    if (tid < 64) { const int c = (int)__hip_atomic_load((unsigned*)(a.ws + WS_CTL) + CW_CNT + 64 * tid, RLX_AGENT); const int tl = (c + 255) >> 8; int sc = tl;
#pragma unroll
        for (int o = 1; o < 64; o <<= 1) { const int up = __shfl_up(sc, o); if (lane >= o) sc += up; }
        cntl[tid] = c; tstart[tid + 1] = sc; if (tid == 0) tstart[0] = 0; }
    __syncthreads();
}

__global__ void __launch_bounds__(NWAVES * 64, 2) fox_fwd(KArgs args) {
    extern __shared__ __attribute__((aligned(16))) unsigned char lds_raw[];
    LAS unsigned char* lds = (LAS unsigned char*)lds_raw;
    volatile LAS unsigned* MISC = (volatile LAS unsigned*)(lds + MISC_OFF);
    const int tid = threadIdx.x, lane = tid & 63, wave = __builtin_amdgcn_readfirstlane(tid >> 6);
    const int G = gridDim.x; int vcu; { const int bx = blockIdx.x; vcu = (G % 8 == 0) ? (bx % 8) * (G / 8) + bx / 8 : bx; }
    unsigned char* ws = args.ws; gu32* ctl = (gu32*)(ws + WS_CTL);
    for (int u = tid; u < (LDS_BYTES - LDSCTL_OFF) / 4; u += NWAVES * 64) ((LAS unsigned*)(lds + LDSCTL_OFF))[u] = 0u;
    __syncthreads();
    const int lo = args.ph_lo, hi = args.ph_hi; const bool single = (hi - lo) > 1;
    XcdBarrier bar; bar.bar = (unsigned*)(ctl + CW_BAR); bar.x = 0; bar.st = nullptr;
    if (single) bar = xcd_barrier_post((unsigned*)(ctl + CW_BAR), MISC + 8);
#ifndef PHASE_MASK
#define PHASE_MASK 0x3ff
#endif
#define IN(k) (((PHASE_MASK >> (k)) & 1) && lo <= (k) && (k) < hi)
#ifndef DIAG_BLK
#define DIAG_BLK 0
#endif
#if defined(DIAG_A)
    unsigned long long* dstamp = (unsigned long long*)(ws + WS_CTL + 512 * 1024);
#define GRID_BAR(k) do { if (IN(k) && IN((k) + 1)) xcd_barrier(bar); if (blockIdx.x == 0 && tid == 0) dstamp[(k) + 1] = __builtin_amdgcn_s_memrealtime(); } while (0)
    if (blockIdx.x == 0 && tid == 0) dstamp[0] = __builtin_amdgcn_s_memrealtime();
#else
#define GRID_BAR(k) do { if (IN(k) && IN((k) + 1)) xcd_barrier(bar); } while (0)
#endif
    bf16* H1 = (bf16*)(ws + WS_H1); bf16* Ub = (bf16*)(ws + WS_U); bf16* Qb = (bf16*)(ws + WS_Q); bf16* Kb = (bf16*)(ws + WS_K); bf16* Vb = (bf16*)(ws + WS_V);
    bf16* SG = (bf16*)(ws + WS_SG); bf16* UC = (bf16*)(ws + WS_UC); bf16* Ob = (bf16*)(ws + WS_O); bf16* MG = (bf16*)(ws + WS_MG);
    const float* mod = (const float*)(ws + WS_MOD);

#if FWD_LEVEL == 0
    if (IN(0)) { const f32x4* xs = (const f32x4*)args.in[0]; f32x4* od = (f32x4*)args.out;
        for (size_t i = (size_t)blockIdx.x * 512 + tid; i < (size_t)T * DMODEL / 4; i += (size_t)G * 512) od[i] = xs[i]; }
    for (int k = 0; k < 9; ++k) GRID_BAR(k);
#else
    if (IN(0)) p0_prologue(args, lds, vcu, G, wave, lane);
    GRID_BAR(0);
    if (IN(1)) { if (G == 256) p1_rows(args, lds, vcu, tid, wave, lane); __syncthreads(); q8_items(args, lds, vcu, G, wave, lane); }
    GRID_BAR(1);
    if (IN(2)) {
        if (blockIdx.x < 16) p2_cumsum(args, lds, blockIdx.x, tid, wave, lane);
        SchedDense S{64, NIN / 256, G, (int)blockIdx.x, 512, (const char*)H1, (const char*)(ws + WS_WIN)};
        EpiIn E{Ub, Qb, Kb, Vb, SG, args.in[11], args.in[12], (const float*)(ws + WS_SA1), (const unsigned*)(ws + WS_CTL) + CW_AMAX};
        pg8::gemm_phase<EpiIn, SchedDense, true, false, true>(lds + RING_OFF, 512, S, E);
        if (G == 256 && blockIdx.x >= 128) wd_items(args, lds, 0, WD_SPLIT, (int)blockIdx.x - 128, 128, wave, lane);
        else if (G != 256) wd_items(args, lds, 0, WD_SPLIT, (int)blockIdx.x, G, wave, lane);
    }
    GRID_BAR(2);
#if defined(DBG_STAGE) && (DBG_STAGE == 24 || DBG_STAGE == 4)
    {   const bf16* src = (DBG_STAGE == 24) ? SG : (const bf16*)(ws + WS_WIN) + (size_t)2560 * 1024;
        for (size_t i = (size_t)blockIdx.x * 512 + tid; i < (size_t)T * 1024; i += (size_t)G * 512) { const size_t r = i >> 10, c = i & 1023; args.out[i] = bf2f(src[((DBG_STAGE == 24) ? r : (r & 2047)) * 1024 + c]); }
        return; }
#endif
    if (IN(3)) {
        float gq = fabsf(args.in[11][lane]), gk = fabsf(args.in[12][lane]);
#pragma unroll
        for (int o = 1; o < 64; o <<= 1) { gq = fmaxf(gq, __shfl_xor(gq, o)); gk = fmaxf(gk, __shfl_xor(gk, o)); }
        const float thr2 = 2.0f * (8.0f * gq * gk * LOG2E) + 40.0f;
        const attn_body::AttnTensors AT{(const attn_body::bf16*)Qb, (const attn_body::bf16*)Kb, (const attn_body::bf16*)Vb, (attn_body::bf16*)Ob, (const float*)(ws + WS_CUM), thr2};
        if (G == 256) { const attn_body::StaticOrder S(G, (int)blockIdx.x); attn_body::attn_phase<attn_body::StaticOrder>((char*)lds_raw + RING_OFF, AT, S); }
#if defined(DIAG_A)
        if (blockIdx.x == DIAG_BLK && tid == 0) dstamp[20] = __builtin_amdgcn_s_memrealtime();
#endif
        for (int it = vcu; it < 1024; it += G) conv_item(args, lds, it, tid);
#if defined(DIAG_A)
        if (blockIdx.x == DIAG_BLK && tid == 0) dstamp[21] = __builtin_amdgcn_s_memrealtime();
#endif
    }
    GRID_BAR(3);
#if defined(DBG_STAGE)
    {
#if DBG_STAGE == 2
        const bf16* bA = Qb; const bf16* bB = Kb;
#elif DBG_STAGE == 21
        const bf16* bA = Vb; const bf16* bB = Ub;
#elif DBG_STAGE == 22
        const bf16* bA = SG; const bf16* bB = SG + 512;
#elif DBG_STAGE == 23
        const bf16* bA = SG + (size_t)T * 1024; const bf16* bB = SG + (size_t)T * 1024 + 512;
#elif DBG_STAGE == 3
        const bf16* bA = Ob; const bf16* bB = UC;
#else
        const bf16* bA = H1; const bf16* bB = H1 + 512;
#endif
        const int ldA = (DBG_STAGE == 1 || DBG_STAGE == 22 || DBG_STAGE == 23) ? 1024 : 512;
        for (size_t i = (size_t)blockIdx.x * 512 + tid; i < (size_t)T * 512; i += (size_t)G * 512) { const size_t r = i >> 9, c = i & 511;
            args.out[r * 1024 + c] = bf2f(bA[r * ldA + c]); args.out[r * 1024 + 512 + c] = bf2f(bB[r * ldA + c]); }
        return;
    }
#endif
    if (IN(4)) {
        SchedMerge S{(int)blockIdx.x, (const char*)UC, (const char*)(ws + WS_WC), (const char*)Ob, (const char*)(ws + WS_WA)};
        EpiMerge E{SG, MG};
        pg8::gemm_phase<EpiMerge, SchedMerge, false>(lds + RING_OFF, 512, S, E);
    }
    GRID_BAR(4);
#if defined(DBG_STAGE2)
    {   for (size_t i = (size_t)blockIdx.x * 512 + tid; i < (size_t)T * 1024; i += (size_t)G * 512) args.out[i] = bf2f(MG[i]);
        return; }
#endif
    if (IN(5)) {
        SchedDense S{64, 4, G, (int)blockIdx.x, 1024, (const char*)MG, (const char*)(ws + WS_WOUT)};
        EpiX1 E{args.in[0], args.out, mod, (float*)(ws + WS_SSQ), (float*)(ws + WS_XMX)};
        pg8::gemm_phase<EpiX1, SchedDense, false>(lds + RING_OFF, 1024, S, E);
    }
    GRID_BAR(5);
#if FWD_LEVEL >= 2
    if (IN(6)) { if (G == 256) p6_block(args, lds, vcu, tid, wave, lane); }
    GRID_BAR(6);
    const MoeTab tb{(const LAS int*)(lds + TAB_OFF), (const LAS int*)(lds + TAB_OFF) + 80};
    if (IN(7)) {
        moe_tables(args, lds, tid, lane);
        const int ntiles = tb.tstart[64], nmoe = 2 * ntiles, ntot = nmoe + 128, per = G;
        SchedMoe1 S{tb, nmoe, ntot, per, vcu, lane, (const char*)(ws + WS_H2), (const char*)(ws + WS_WGU), (const char*)(ws + WS_WSGU), (const int*)(ws + WS_LIST)};
        EpiGlu E{(bf16*)(ws + WS_ACT), (bf16*)(ws + WS_SACT), (const float*)(ws + WS_WLIST), (const float*)(ws + WS_SLIST), (const float*)(ws + WS_SA2), (const unsigned*)(ws + WS_CTL) + CW_AMAX, tb};
        pg8::gemm_phase<EpiGlu, SchedMoe1, true, false, true>(lds + RING_OFF, 512, S, E);
        {
            const int rounds = (ntot + G - 1) / G, busy = ntot - (rounds - 1) * G;
            if (vcu >= busy && busy < G) wd_items(args, lds, WD_SPLIT, 64 * 128, vcu - busy, G - busy, wave, lane);
            else if (busy >= G) wd_items(args, lds, WD_SPLIT, 64 * 128, vcu, G, wave, lane); }
    }
    GRID_BAR(7);
    if (IN(8)) {
        moe_tables(args, lds, tid, lane);
        const int ntiles = tb.tstart[64], ntot = 4 * ntiles, per = G;
        SchedMoe2 S{tb, ntot, per, vcu, lane, (const char*)(ws + WS_ACT), (const char*)(ws + WS_WD)};
        EpiSlab E{ws + WS_SLAB, (const int*)(ws + WS_LIST), tb};
        pg8::gemm_phase<EpiSlab, SchedMoe2, false>(lds + RING_OFF, 256, S, E);
    }
    GRID_BAR(8);
    if (IN(9)) {
        SchedDense S{64, 4, G, (int)blockIdx.x, 256, (const char*)(ws + WS_SACT), (const char*)(ws + WS_WSD)};
        EpiFinal E{args.out, ws + WS_SLAB, mod};
        pg8::gemm_phase<EpiFinal, SchedDense, false>(lds + RING_OFF, 256, S, E);
    }
#endif
#endif
#if defined(DIAG_A)
    {
        xcd_barrier(bar); if (blockIdx.x == 0 && tid == 0) dstamp[10] = __builtin_amdgcn_s_memrealtime();
        xcd_barrier(bar); if (blockIdx.x == 0 && tid == 0) dstamp[11] = __builtin_amdgcn_s_memrealtime();
        xcd_barrier(bar); if (blockIdx.x == 0 && tid == 0) dstamp[12] = __builtin_amdgcn_s_memrealtime();
        xcd_barrier(bar);
#if defined(DIAG_LO)
        const float dta = (float)(dstamp[DIAG_HI] - dstamp[DIAG_LO]) * 0.01f;
#else
        const float dta = (float)(dstamp[DIAG_A + 1] - dstamp[DIAG_A]) * 0.01f;
#endif
#if defined(DIAG_BIG)
        if (blockIdx.x == 0 && tid == 0) args.out[0] += 2.0f + dta * 0.04f;
#else
        if (blockIdx.x == 0 && tid == 0) args.out[0] += 0.5f + dta * 0.01f;
#endif
    }
#endif
#undef IN
#undef GRID_BAR
}

#ifndef N_LAUNCH_MODE
#define N_LAUNCH_MODE 1
#endif
extern "C" void kernel_launch(void* const* d_in, const int* in_sizes, int n_in, void* d_out, int out_size, void* d_ws, size_t ws_size, hipStream_t stream) {
    static int grid = 0;
    if (grid == 0) {
        if (n_in != 23 || in_sizes[0] != T * DMODEL || out_size != T * DMODEL || ws_size < WS_END) {
            fprintf(stderr, "kernel_launch: built for 23 inputs, x/out of %d floats, >= %zu bytes of workspace; got n_in %d, in0 %d, out %d, ws %zu; nothing launched\n", T * DMODEL, (size_t)WS_END, n_in, n_in > 0 ? in_sizes[0] : -1, out_size, ws_size);
            grid = -1; return; }
        int dev = 0, cus = 0, per_cu = 0;
        if (hipGetDevice(&dev) != hipSuccess || hipDeviceGetAttribute(&cus, hipDeviceAttributeMultiprocessorCount, dev) != hipSuccess) { fprintf(stderr, "kernel_launch: device query failed\n"); grid = -1; return; }
        if (hipFuncSetAttribute((const void*)fox_fwd, hipFuncAttributeMaxDynamicSharedMemorySize, LDS_BYTES) != hipSuccess) { fprintf(stderr, "kernel_launch: hipFuncSetAttribute failed\n"); grid = -1; return; }
        if (hipOccupancyMaxActiveBlocksPerMultiprocessor(&per_cu, (const void*)fox_fwd, NWAVES * 64, LDS_BYTES) != hipSuccess || per_cu < 1)
            fprintf(stderr, "kernel_launch: note: occupancy query reports %d workgroups per CU\n", per_cu);
        (void)hipGetLastError();
        grid = cus;
        if (grid != 256) fprintf(stderr, "kernel_launch: %d CUs; this kernel is built for 256\n", grid);
    }
    if (grid < 0) return;
    if (hipMemsetAsync((char*)d_ws + WS_CTL, 0, CTL_ZERO_BYTES, stream) != hipSuccess) { fprintf(stderr, "kernel_launch: memset failed\n"); return; }
    KArgs a{};
    for (int i = 0; i < 23; ++i) a.in[i] = (const float*)d_in[i];
    a.out = (float*)d_out; a.ws = (unsigned char*)d_ws;
#if N_LAUNCH_MODE == 1
    a.ph_lo = 0; a.ph_hi = 10;
    hipLaunchKernelGGL(fox_fwd, dim3(grid), dim3(NWAVES * 64), LDS_BYTES, stream, a);
#else
    for (int p = 0; p < 10; ++p) { a.ph_lo = p; a.ph_hi = p + 1; hipLaunchKernelGGL(fox_fwd, dim3(grid), dim3(NWAVES * 64), LDS_BYTES, stream, a); }
#endif
    const hipError_t le = hipPeekAtLastError();
    if (le != hipSuccess) fprintf(stderr, "kernel_launch: launch failed: %s\n", hipGetErrorName(le));
}
```

```cpp
#include <hip/hip_runtime.h>
#include <hip/hip_bf16.h>
#include <cstdio>
#include <cstdint>
#include <cmath>

#ifndef ATTN_SKIP
#define ATTN_SKIP 1
#endif
#ifndef FWD_LEVEL
#define FWD_LEVEL 2
#endif

namespace pg8 {
#define PG8_LAS __attribute__((address_space(3)))
typedef unsigned short bf16_t;
typedef short bf16x8 __attribute__((ext_vector_type(8)));
typedef float f32x4 __attribute__((ext_vector_type(4)));
typedef unsigned u32x4 __attribute__((ext_vector_type(4)));
constexpr int BM = 256, BK = 64, HALF = 128, HTB = HALF * BK * 2  , STAGE_BYTES = 8 * HTB, NXCD = 8, WGM = 8;

__host__ __device__ __forceinline__ int lds_byte(int r, int c) { const int st = (r >> 4) * 2 + (c >> 5), rr = r & 15, cc = c & 31, ob = rr * 64 + cc * 2; return st * 1024 + (ob ^ (((ob >> 9) & 1) << 5)); }
__host__ __device__ __forceinline__ void stage_rc(int b, int& R, int& C) { const int st = b / 1024, sb = b % 1024, swz = sb ^ (((sb >> 9) & 1) << 5); R = (st >> 1) * 16 + swz / 64; C = (st & 1) * 32 + (swz % 64) / 2; }
__host__ __device__ __forceinline__ int perm32(int rho) { const int n = rho >> 4, i = rho & 15; return 8 * (i >> 2) + 4 * n + (i & 3); }

struct Unit { int pm, pn, e, mt; const char* A; const char* B; };

__host__ __device__ __forceinline__ void tile_of(int L, int nM, int nN, int& pm, int& pn) {
    const int nwg = nM * nN; int wgid = L; { const int q = nwg / NXCD, r = nwg % NXCD, xcd = wgid % NXCD, off = wgid / NXCD; wgid = (xcd < r ? xcd * (q + 1) : r * (q + 1) + (xcd - r) * q) + off; }
    const int nig = WGM * nN, gid = wgid / nig, fm = gid * WGM, gsz = (nM - fm) < WGM ? (nM - fm) : WGM;
    pm = fm + ((wgid % nig) % gsz); pn = (wgid % nig) / gsz;
}
typedef float f32x2_c __attribute__((ext_vector_type(2))); typedef __bf16 bf16x2_c __attribute__((ext_vector_type(2)));
__device__ __forceinline__ unsigned cvt_pk_bf16(float lo, float hi) { f32x2_c v = {lo, hi}; bf16x2_c b = __builtin_convertvector(v, bf16x2_c); return __builtin_bit_cast(unsigned, b); }
__device__ __forceinline__ float bf_lo(unsigned w) { return __builtin_bit_cast(float, w << 16); }
__device__ __forceinline__ float bf_hi(unsigned w) { return __builtin_bit_cast(float, w & 0xffff0000u); }
__device__ __forceinline__ float sigmoidf_fast(float x) { return __builtin_amdgcn_rcpf(1.0f + __builtin_amdgcn_exp2f(-1.4426950408889634f * x)); }

typedef int i32x4_c __attribute__((ext_vector_type(4))); typedef int i32x8_c __attribute__((ext_vector_type(8)));
__device__ __forceinline__ i32x8_c cat16(const bf16x8& lo, const bf16x8& hi) { const i32x4_c a = __builtin_bit_cast(i32x4_c, lo), b = __builtin_bit_cast(i32x4_c, hi); return __builtin_shufflevector(a, b, 0, 1, 2, 3, 4, 5, 6, 7); }
template <class Epi, class Sched, bool ALIGN_EPI, bool FP8 = false, bool I8 = false>
__device__ __forceinline__ void gemm_phase(PG8_LAS unsigned char* lds, const int K, const Sched& S, const Epi& E) {
    const int tid = threadIdx.x, wid = __builtin_amdgcn_readfirstlane(tid >> 6), lane = tid & 63, wr = wid >> 2, wc = wid & 3, fr = lane & 15, fq = lane >> 4;
    const int nt = K / BK;
    int sR[2], sC[2]; unsigned voffB[2];
#pragma unroll
    for (int i = 0; i < 2; ++i) { int R, C; stage_rc(tid * 16 + i * 8192, R, C); sR[i] = R; sC[i] = C; const int Rb = Epi::PERM ? ((R & ~31) + perm32(R & 31)) : R; voffB[i] = (unsigned)(Rb * K + C) * 2u; }
    const size_t kstep = (size_t)(BK * 2);
    const size_t hstep = (size_t)HALF * K * 2;
    const unsigned ldsw = (unsigned)wid * 1024u;
    const int aoff = lds_byte(wr * 64 + fr, fq * 8), boff = lds_byte(wc * 32 + fr, fq * 8);
#define PG8_SA(b, h) (((b) * 2 + (h)) * HTB)
#define PG8_SB(b, h) ((4 + (b) * 2 + (h)) * HTB)
#define PG8_STAGE(bufoff, gbase, voff) do { _Pragma("unroll") for (int _i = 0; _i < 2; ++_i) \
        __builtin_amdgcn_global_load_lds((const unsigned*)((const char*)(gbase) + (voff)[_i]), (PG8_LAS unsigned*)(lds + (bufoff) + ldsw + _i * 8192), 16, 0, 0); } while (0)
#define PG8_STAGE_A(bufoff, gbase, h, V0, V1) do { if constexpr (Sched::GATHER) { if (h) PG8_STAGE(bufoff, gbase, V1); else PG8_STAGE(bufoff, gbase, V0); } \
        else { PG8_STAGE(bufoff, (const char*)(gbase) + ((h) ? hstep : 0), V0); } } while (0)
#define PG8_LDA(dst, b, h) do { _Pragma("unroll") for (int m = 0; m < 4; ++m) { if constexpr (FP8) { const bf16x8 lo_ = *(const PG8_LAS bf16x8*)(lds + PG8_SA(b, h) + aoff + m * 2048), hi_ = *(const PG8_LAS bf16x8*)(lds + PG8_SA(b, h) + aoff + m * 2048 + 1024); dst##8[m] = cat16(lo_, hi_); } \
        else { _Pragma("unroll") for (int k = 0; k < 2; ++k) dst[m][k] = *(const PG8_LAS bf16x8*)(lds + PG8_SA(b, h) + aoff + m * 2048 + k * 1024); } } } while (0)
#define PG8_LDB(dst, b, h) do { _Pragma("unroll") for (int n = 0; n < 2; ++n) { if constexpr (FP8) { const bf16x8 lo_ = *(const PG8_LAS bf16x8*)(lds + PG8_SB(b, h) + boff + n * 2048), hi_ = *(const PG8_LAS bf16x8*)(lds + PG8_SB(b, h) + boff + n * 2048 + 1024); dst##8[n] = cat16(lo_, hi_); } \
        else { _Pragma("unroll") for (int k = 0; k < 2; ++k) dst[n][k] = *(const PG8_LAS bf16x8*)(lds + PG8_SB(b, h) + boff + n * 2048 + k * 1024); } } } while (0)
#define PG8_MMA(ai, bj, At, Bt) do { __builtin_amdgcn_s_setprio(1); if constexpr (FP8) { _Pragma("unroll") for (int m = 0; m < 4; ++m) _Pragma("unroll") for (int n = 0; n < 2; ++n) \
        acc[ai][bj][m][n] = __builtin_amdgcn_mfma_scale_f32_16x16x128_f8f6f4(Bt##8[n], At##8[m], acc[ai][bj][m][n], 0, 0, 0, 0x7f7f7f7f, 0, 0x7f7f7f7f); } \
        else if constexpr (I8) { _Pragma("unroll") for (int m = 0; m < 4; ++m) _Pragma("unroll") for (int n = 0; n < 2; ++n) _Pragma("unroll") for (int k = 0; k < 2; ++k) \
        acc[ai][bj][m][n] = __builtin_bit_cast(f32x4, __builtin_amdgcn_mfma_i32_16x16x64_i8(__builtin_bit_cast(i32x4_c, Bt[n][k]), __builtin_bit_cast(i32x4_c, At[m][k]), __builtin_bit_cast(i32x4_c, acc[ai][bj][m][n]), 0, 0, 0)); } \
        else { _Pragma("unroll") for (int m = 0; m < 4; ++m) _Pragma("unroll") for (int n = 0; n < 2; ++n) _Pragma("unroll") for (int k = 0; k < 2; ++k) \
        acc[ai][bj][m][n] = __builtin_amdgcn_mfma_f32_16x16x32_bf16(Bt[n][k], At[m][k], acc[ai][bj][m][n], 0, 0, 0); } __builtin_amdgcn_s_setprio(0); } while (0)
#define PG8_WAIT_V(n) asm volatile("s_waitcnt vmcnt(" #n ")" ::: "memory")
#define PG8_WAIT_L(n) asm volatile("s_waitcnt lgkmcnt(" #n ")" ::: "memory")
#define PG8_BAR __builtin_amdgcn_s_barrier()
#define PG8_SCHED __builtin_amdgcn_sched_barrier(0)
    Unit cur, nxt; int ui = 0;
    if (!S.next(0, cur)) return;
    unsigned vc0[2], vc1[2], vn0[2], vn1[2];
#pragma unroll
    for (int i = 0; i < 2; ++i) {
        if constexpr (Sched::GATHER) { vc0[i] = (unsigned)(S.row(cur, sR[i]) * K + sC[i]) * 2u; vc1[i] = (unsigned)(S.row(cur, HALF + sR[i]) * K + sC[i]) * 2u; }
        else { vc0[i] = (unsigned)(sR[i] * K + sC[i]) * 2u; vc1[i] = 0u; }
        vn0[i] = vc0[i]; vn1[i] = vc1[i];
    }
    f32x4 acc[2][2][4][2];
#pragma unroll
    for (int a = 0; a < 2; ++a)
#pragma unroll
        for (int b = 0; b < 2; ++b)
#pragma unroll
            for (int m = 0; m < 4; ++m)
#pragma unroll
                for (int n = 0; n < 2; ++n) acc[a][b][m][n] = (f32x4){0.f, 0.f, 0.f, 0.f};
    typename Epi::Pre pre; E.prefetch(pre, cur, wr, wc, fr, fq);
    PG8_LAS unsigned char* const rtab = lds + STAGE_BYTES + 2048;
#define PG8_ROWTAB(U, par) do { if constexpr (Epi::ROWTAB) { _Pragma("unroll") for (int t_ = 0; t_ < Epi::NTAB; ++t_) { const char* src_ = E.tab_src(U, t_); if (wid < 4 && src_ != nullptr) \
        __builtin_amdgcn_global_load_lds((const unsigned*)(src_ + tid * 4), (PG8_LAS unsigned*)(rtab + ((par) * Epi::NTAB + t_) * 1024 + wid * 256), 4, 0, 0); } } } while (0)
    PG8_ROWTAB(cur, 0);
    bf16x8 At[4][2], B0[2][2], B1[2][2]; i32x8_c At8[4], B08[2], B18[2];
    const char* cA = cur.A; const char* cB = cur.B;
    PG8_STAGE(PG8_SB(0, 0), cB, voffB); PG8_STAGE(PG8_SB(0, 1), cB + hstep, voffB); PG8_STAGE_A(PG8_SA(0, 0), cA, 0, vc0, vc1); PG8_STAGE_A(PG8_SA(0, 1), cA, 1, vc0, vc1);
    if (wr == 1) PG8_BAR;
    PG8_WAIT_V(2); PG8_BAR;
    PG8_STAGE(PG8_SB(1, 0), cB + kstep, voffB); PG8_STAGE_A(PG8_SA(1, 0), cA + kstep, 0, vc0, vc1); PG8_STAGE(PG8_SB(1, 1), cB + hstep + kstep, voffB);
    PG8_WAIT_V(6); PG8_BAR;
    for (;;) {
        const bool has_next = S.next(ui + 1, nxt);
        const char* nA = has_next ? nxt.A : cA; const char* nB = has_next ? nxt.B : cB;
        if constexpr (Sched::GATHER) {
            if (has_next) {
#pragma unroll
                for (int i = 0; i < 2; ++i) { vn0[i] = (unsigned)(S.row(nxt, sR[i]) * K + sC[i]) * 2u; vn1[i] = (unsigned)(S.row(nxt, HALF + sR[i]) * K + sC[i]) * 2u; }
            }
        }
#pragma nounroll
        for (int t = 0; t < nt; t += 2) {
            const bool last = (t == nt - 2);
            const char* a1 = cA + (size_t)(t + 1) * kstep;
            const char* a2 = last ? nA : cA + (size_t)(t + 2) * kstep; const char* b2 = last ? nB : cB + (size_t)(t + 2) * kstep;
            const char* a3 = a2 + kstep; const char* b3 = b2 + kstep;
            unsigned w0[2], w1[2];
#pragma unroll
            for (int i = 0; i < 2; ++i) { if constexpr (Sched::GATHER) { w0[i] = last ? vn0[i] : vc0[i]; w1[i] = last ? vn1[i] : vc1[i]; } else { w0[i] = vc0[i]; w1[i] = 0u; } }
            PG8_LDB(B0, 0, 0); PG8_LDB(B1, 0, 1); PG8_SCHED; PG8_LDA(At, 0, 0); PG8_STAGE_A(PG8_SA(1, 1), a1, 1, vc0, vc1);
            PG8_WAIT_V(8); PG8_WAIT_L(0); PG8_BAR; PG8_MMA(0, 0, At, B0); PG8_MMA(0, 1, At, B1); PG8_BAR; PG8_SCHED;
            PG8_LDA(At, 0, 1); PG8_STAGE(PG8_SB(0, 0), b2, voffB); PG8_STAGE(PG8_SB(0, 1), b2 + hstep, voffB); PG8_STAGE_A(PG8_SA(0, 0), a2, 0, w0, w1);
            PG8_WAIT_V(8); PG8_WAIT_L(0); PG8_BAR; PG8_MMA(1, 0, At, B0); PG8_MMA(1, 1, At, B1); PG8_BAR; PG8_SCHED;
            PG8_LDB(B0, 1, 0); PG8_LDB(B1, 1, 1); PG8_SCHED; PG8_LDA(At, 1, 0); PG8_STAGE_A(PG8_SA(0, 1), a2, 1, w0, w1);
            PG8_WAIT_V(8); PG8_WAIT_L(0); PG8_BAR; PG8_MMA(0, 0, At, B0); PG8_MMA(0, 1, At, B1); PG8_BAR; PG8_SCHED;
            PG8_LDA(At, 1, 1); PG8_STAGE(PG8_SB(1, 0), b3, voffB); PG8_STAGE(PG8_SB(1, 1), b3 + hstep, voffB); PG8_STAGE_A(PG8_SA(1, 0), a3, 0, w0, w1);
            PG8_WAIT_V(8); PG8_WAIT_L(0); PG8_BAR; PG8_MMA(1, 0, At, B0); PG8_MMA(1, 1, At, B1); PG8_BAR; PG8_SCHED;
        }
        if constexpr (ALIGN_EPI) { if (wr == 0) PG8_BAR; }
        if constexpr (I8) {
#pragma unroll
            for (int a = 0; a < 2; ++a)
#pragma unroll
                for (int b = 0; b < 2; ++b)
#pragma unroll
                    for (int m = 0; m < 4; ++m)
#pragma unroll
                        for (int n = 0; n < 2; ++n) acc[a][b][m][n] = __builtin_convertvector(__builtin_bit_cast(i32x4_c, acc[a][b][m][n]), f32x4);
        }
        if constexpr (!Epi::AFTER_DRAIN) E(acc, cur, wr, wc, fr, fq, pre, (const PG8_LAS unsigned*)(rtab + (ui & 1) * Epi::NTAB * 1024));
        if (!has_next) break;
#pragma unroll
        for (int a = 0; a < 2; ++a)
#pragma unroll
            for (int b = 0; b < 2; ++b)
#pragma unroll
                for (int m = 0; m < 4; ++m)
#pragma unroll
                    for (int n = 0; n < 2; ++n) acc[a][b][m][n] = (f32x4){0.f, 0.f, 0.f, 0.f};
        cur = nxt; cA = nA; cB = nB; ++ui; E.prefetch(pre, cur, wr, wc, fr, fq); PG8_ROWTAB(cur, ui & 1);
#pragma unroll
        for (int i = 0; i < 2; ++i) { vc0[i] = vn0[i]; vc1[i] = vn1[i]; }
        if constexpr (ALIGN_EPI) { if (wr == 1) PG8_BAR; }
    }
    PG8_WAIT_V(0);
    if constexpr (!ALIGN_EPI) { if (wr == 0) PG8_BAR; }
    PG8_BAR;
    if constexpr (Epi::AFTER_DRAIN) E.fused(acc, cur, wr, wc, fr, fq, lds);
#undef PG8_SA
#undef PG8_SB
#undef PG8_STAGE
#undef PG8_ROWTAB
#undef PG8_STAGE_A
#undef PG8_LDA
#undef PG8_LDB
#undef PG8_MMA
#undef PG8_WAIT_V
#undef PG8_WAIT_L
#undef PG8_BAR
#undef PG8_SCHED
}
}
#include <hip/hip_bf16.h>
#include <cmath>
namespace attn_body {
using bf16=__hip_bfloat16;
using bf16x8=__attribute__((ext_vector_type(8)))short;
using s16x4=__attribute__((ext_vector_type(4)))short;
using f32x16=__attribute__((ext_vector_type(16)))float;
using u32x4=__attribute__((ext_vector_type(4)))unsigned;
constexpr int BATCH=2,NHEAD=8,SEQ=8192,D=64,DM=NHEAD*D;
constexpr int NW=8,QBLK=32,QB=QBLK*NW,KVBLK=64,NQB=SEQ/QB;
constexpr int ATTN_PITCH=DM, ATTN_UNIT_ROWS=QB;
__device__ __forceinline__ int crow(int r,int hi){return (r&3)+8*(r>>2)+4*hi;}
#define SBAR() __builtin_amdgcn_sched_barrier(0)
__device__ __forceinline__ void cmask(f32x16&p0,f32x16&p1,int jb,int qrel,int hi){
  const float NEG=-INFINITY; const int dq=qrel-(64*jb+4*hi);
  #pragma unroll
  for(int r=0;r<16;++r){const int c=(r&3)+8*(r>>2); if(c>dq)p0[r]=NEG; if(c+32>dq)p1[r]=NEG;}
}

constexpr int NSLOT=3, SLOTB=8192;
constexpr int LDS_K=0, LDS_V=NSLOT*SLOTB, LDS_WS=2*NSLOT*SLOTB, LDS_OST=LDS_WS+NW*64*4, LDS_DK=LDS_OST+NW*4096, LDS_BYTES=LDS_DK+SEQ*4;
constexpr float C2=0.125f*1.4426950408889634f;
__device__ __forceinline__ void glds16(const void*gsrc,unsigned lds_dst){unsigned keep;
  asm volatile("s_mov_b32 %0, m0\n\ts_mov_b32 m0, %2\n\ts_nop 0\n\tglobal_load_lds_dwordx4 %1, off\n\ts_mov_b32 m0, %0":"=&s"(keep):"v"(gsrc),"s"(lds_dst):"memory");}
__device__ __forceinline__ float max3f(float a,float b,float c){float r;asm("v_max3_f32 %0, %1, %2, %3":"=v"(r):"v"(a),"v"(b),"v"(c));return r;}
__device__ __forceinline__ float max2f(float a,float b){float r;asm("v_max_f32_e32 %0, %1, %2":"=v"(r):"v"(a),"v"(b));return r;}
__device__ __forceinline__ float fadd_s(float a,float b){float r;asm("v_add_f32_e32 %0, %1, %2":"=v"(r):"v"(a),"v"(b));return r;}
__device__ __forceinline__ float fsub_s(float a,float b){float r;asm("v_sub_f32_e32 %0, %1, %2":"=v"(r):"v"(a),"v"(b));return r;}
typedef float f32x2_t __attribute__((ext_vector_type(2))); typedef float f32x4_t __attribute__((ext_vector_type(4))); typedef __bf16 bf16x2_t __attribute__((ext_vector_type(2)));
__device__ __forceinline__ unsigned cvtpk_s(float lo,float hi){f32x2_t v={lo,hi};bf16x2_t b=__builtin_convertvector(v,bf16x2_t);return __builtin_bit_cast(unsigned,b);}
#define WAIT_BAR(N) asm volatile("s_waitcnt vmcnt(" #N ") lgkmcnt(0)\n\ts_barrier":::"memory")

__device__ __forceinline__ void qkt(f32x16&p0,f32x16&p1,const char*Kslot,const bf16x8*qr,const f32x16&negm,int r32,int hi){
  const char*kb=Kslot+hi*1024+r32*16;
  #pragma unroll
  for(int d0=0;d0<4;++d0){
    const bf16x8 b0=*reinterpret_cast<const bf16x8*>(kb+d0*2048);
    const bf16x8 b1=*reinterpret_cast<const bf16x8*>(kb+d0*2048+512);
    if(d0==0){p0=__builtin_amdgcn_mfma_f32_32x32x16_bf16(b0,qr[0],negm,0,0,0);p1=__builtin_amdgcn_mfma_f32_32x32x16_bf16(b1,qr[0],negm,0,0,0);}
    else{p0=__builtin_amdgcn_mfma_f32_32x32x16_bf16(b0,qr[d0],p0,0,0,0);p1=__builtin_amdgcn_mfma_f32_32x32x16_bf16(b1,qr[d0],p1,0,0,0);}}
}
typedef __attribute__((address_space(3))) const char* lds_cptr;
typedef short v4i16_t __attribute__((ext_vector_type(4)));
__device__ __forceinline__ void kload8(bf16x8*kf,lds_cptr kp){
  kf[0]=*(const __attribute__((address_space(3))) bf16x8*)(kp);      kf[1]=*(const __attribute__((address_space(3))) bf16x8*)(kp+512);
  kf[2]=*(const __attribute__((address_space(3))) bf16x8*)(kp+2048); kf[3]=*(const __attribute__((address_space(3))) bf16x8*)(kp+2560);
  kf[4]=*(const __attribute__((address_space(3))) bf16x8*)(kp+4096); kf[5]=*(const __attribute__((address_space(3))) bf16x8*)(kp+4608);
  kf[6]=*(const __attribute__((address_space(3))) bf16x8*)(kp+6144); kf[7]=*(const __attribute__((address_space(3))) bf16x8*)(kp+6656);
}
__device__ __forceinline__ void kload2(bf16x8*kf,lds_cptr kp,int j){ kf[2*j]=*(const __attribute__((address_space(3))) bf16x8*)(kp+j*2048); kf[2*j+1]=*(const __attribute__((address_space(3))) bf16x8*)(kp+j*2048+512); }
__device__ __forceinline__ s16x4 vtr(lds_cptr p){ return __builtin_bit_cast(s16x4,__builtin_amdgcn_ds_read_tr16_b64_v4i16((__attribute__((address_space(3))) v4i16_t*)p)); }
__device__ __forceinline__ float rowmax(const f32x16&p0,const f32x16&p1){
  float a=max3f(p0[0],p0[1],p1[0]),b=max3f(p0[2],p0[3],p1[1]);a=max3f(a,p1[2],p1[3]);
  #pragma unroll
  for(int r=4;r<16;r+=4){a=max3f(a,p0[r],p0[r+1]);b=max3f(b,p0[r+2],p0[r+3]);a=max3f(a,p1[r],p1[r+1]);b=max3f(b,p1[r+2],p1[r+3]);}
  const float m=max2f(a,b);
  auto rr=__builtin_amdgcn_permlane32_swap(__float_as_uint(m),__float_as_uint(m),false,false);
  return max2f(__uint_as_float(rr[0]),__uint_as_float(rr[1]));
}
__device__ __forceinline__ void pv(f32x16*o,int vb,bf16x8 pa0,bf16x8 pa1,bf16x8 pa2,bf16x8 pa3){
  #pragma unroll
  for(int d0=0;d0<2;++d0){s16x4 lo[4],hi[4];
    #pragma unroll
    for(int ks=0;ks<4;++ks){
      asm volatile("ds_read_b64_tr_b16 %0,%1 offset:%c2":"=&v"(lo[ks]):"v"(vb),"i"(d0*4096+ks*1024):"memory");
      asm volatile("ds_read_b64_tr_b16 %0,%1 offset:%c2":"=&v"(hi[ks]):"v"(vb),"i"(d0*4096+ks*1024+512):"memory");}
    asm volatile("s_waitcnt lgkmcnt(0)":::"memory");SBAR();
    #define PK(k) (bf16x8){lo[k][0],lo[k][1],lo[k][2],lo[k][3],hi[k][0],hi[k][1],hi[k][2],hi[k][3]}
    o[d0]=__builtin_amdgcn_mfma_f32_32x32x16_bf16(pa0,PK(0),o[d0],0,0,0);
    o[d0]=__builtin_amdgcn_mfma_f32_32x32x16_bf16(pa1,PK(1),o[d0],0,0,0);
    o[d0]=__builtin_amdgcn_mfma_f32_32x32x16_bf16(pa2,PK(2),o[d0],0,0,0);
    o[d0]=__builtin_amdgcn_mfma_f32_32x32x16_bf16(pa3,PK(3),o[d0],0,0,0);
    #undef PK
  }
}

#ifndef ATTN_STORE16
#define ATTN_STORE16(p,v) (*(u32x4*)(p)=(v))
#endif
template<int THRL> __device__ __forceinline__ void attn_unit(int b,int h,int qb,const bf16*Q,const bf16*__restrict__ K,const bf16*__restrict__ V,bf16*O,const float*cum,float thr2,char*shm){
  const int tid=threadIdx.x,lane=tid&63,r32=lane&31,hi=lane>>5; const int wid=__builtin_amdgcn_readfirstlane(tid>>6);
  const long rowbase=(long)b*SEQ; const int q0=qb*QB;
  const bf16*Qw=Q+(rowbase+q0+wid*QBLK)*DM+h*D;
  const float*cb=cum+(long)(b*NHEAD+h)*SEQ; const int NTF=(q0+QB)/KVBLK; int t0=0;
#if ATTN_SKIP
  { const float cq0=cb[q0]; int cnt=0;
    for(int base=0;base<NTF;base+=64){ const int t_=base+lane; const bool c_=(t_<NTF)&&((cb[64*t_+63]-cq0)*1.4426950408889634f>thr2); cnt+=__popcll(__ballot(c_)); }
    cnt&=~1; if(cnt>NTF-4)cnt=NTF-4; t0=__builtin_amdgcn_readfirstlane(cnt); }
#endif
  const int kv0=t0*KVBLK;
  { const float cref=cb[q0+QB-1]; __attribute__((address_space(3))) float*dkw=(__attribute__((address_space(3))) float*)((__attribute__((address_space(3))) char*)shm+LDS_DK);
    int tv_=tid; asm volatile("":"+v"(tv_));
    for(int j=tv_;j<q0+QB-kv0;j+=NW*64)dkw[j]=(cb[kv0+j]-cref)*1.4426950408889634f; }
  asm volatile("s_waitcnt vmcnt(0) lgkmcnt(0)\n\ts_barrier":::"memory");
  const bf16*Kh=K+(rowbase+kv0)*DM+h*D,*Vh=V+(rowbase+kv0)*DM+h*D;
  const unsigned lds0=(unsigned)(uintptr_t)shm;
  float*wsf=(float*)(shm+LDS_WS)+wid*64;
  const bf16*ksrc=Kh+(long)lane*DM+wid*8;
  const bf16*vsrc=Vh+(long)(16*(wid&3)+(lane>>2))*DM+(wid>>2)*32+(lane&3)*8;
  const unsigned kdst=lds0+LDS_K+wid*1024, vdst=lds0+LDS_V+wid*1024;
  #define DMA_K(t,slot) glds16(ksrc+(long)(t)*KVBLK*DM,(unsigned)__builtin_amdgcn_readfirstlane(kdst+(slot)))
  #define DMA_V(t,slot) glds16(vsrc+(long)(t)*KVBLK*DM,(unsigned)__builtin_amdgcn_readfirstlane(vdst+(slot)))
  const int vb0=(int)(lds0+LDS_V)+((lane>>4)&1)*32+(lane&3)*8+(4*hi+((lane&15)>>2))*64;
  const char*Kbase=shm+LDS_K; bf16x8 kf[8];
  const lds_cptr shm3=(lds_cptr)shm; const lds_cptr kp0=shm3+LDS_K+hi*1024+r32*16; const lds_cptr vp0=shm3+LDS_V+((lane>>4)&1)*32+(lane&3)*8+(4*hi+((lane&15)>>2))*64;
  int hiv_=hi; asm volatile("":"+v"(hiv_));
  const int NT=NTF-t0;
  const __attribute__((address_space(3))) float*dkp0=(const __attribute__((address_space(3))) float*)(shm3+LDS_DK)+4*hiv_;
  #define CINIT(C,t,o) do{ const __attribute__((address_space(3))) float*dp_=dkp0+(t)*64+(o); _Pragma("unroll") for(int g_=0;g_<4;++g_){ const f32x4_t a_=*(const __attribute__((address_space(3))) f32x4_t*)(dp_+8*g_); \
      C[4*g_]=negms-a_[0];C[4*g_+1]=negms-a_[1];C[4*g_+2]=negms-a_[2];C[4*g_+3]=negms-a_[3]; } }while(0)
  #define DECAY(P0,P1,t) do{ const __attribute__((address_space(3))) float*dp_=dkp0+(t)*64; _Pragma("unroll") for(int g_=0;g_<4;++g_){ const f32x4_t a_=*(const __attribute__((address_space(3))) f32x4_t*)(dp_+8*g_), b_=*(const __attribute__((address_space(3))) f32x4_t*)(dp_+32+8*g_); \
      P0[4*g_]-=a_[0];P0[4*g_+1]-=a_[1];P0[4*g_+2]-=a_[2];P0[4*g_+3]-=a_[3]; P1[4*g_]-=b_[0];P1[4*g_+1]-=b_[1];P1[4*g_+2]-=b_[2];P1[4*g_+3]-=b_[3]; } }while(0)
  DMA_K(0,0);DMA_V(0,0);DMA_K(1,SLOTB);
  bf16x8 qr[4];
  #pragma unroll
  for(int d0=0;d0<4;++d0)qr[d0]=*reinterpret_cast<const bf16x8*>(&Qw[(long)r32*DM+d0*16+hi*8]);
  float mhat=0.f,l_reg=0.f;f32x16 o[2];o[0]=f32x16{};o[1]=f32x16{};float negms=0.f; const f32x16 zero16=f32x16{};
  const int qrel=wid*QBLK+r32;
  #define CMASK(P0,P1,t) do{int jb_=(t)-(NT-4); if(jb_>=0)cmask(P0,P1,jb_,qrel,hi);}while(0)
  bool resc=false;
  #define START(P0,P1) do{ const float rm=rowmax(P0,P1); resc=false; \
    { const float dl=rm; mhat=fadd_s(mhat,dl); \
      _Pragma("unroll") for(int r=0;r<16;++r){P0[r]=fsub_s(P0[r],dl);P1[r]=fsub_s(P1[r],dl);} \
      negms=-mhat; } \
    _Pragma("unroll") for(int r=0;r<16;++r)P0[r]=__builtin_amdgcn_exp2f(P0[r]); }while(0)
  #define RESC() do{ if(resc){ asm volatile("s_waitcnt lgkmcnt(0)":::"memory"); \
      _Pragma("unroll") for(int d_=0;d_<2;++d_) _Pragma("unroll") for(int r=0;r<16;++r)o[d_][r]*=wsf[crow(r,hi)]; } }while(0)
  f32x16 pA0,pA1,pB0,pB1;
  int sl_prev=0,sl_cur=0,sl_next=SLOTB;
  #define ROT() do{sl_prev=sl_cur;sl_cur=sl_next;sl_next=(sl_next==(NSLOT-1)*SLOTB)?0:sl_next+SLOTB;}while(0)
  DMA_K(2,2*SLOTB);
  WAIT_BAR(3);
  qkt(pA0,pA1,Kbase,qr,zero16,r32,hi);asm volatile("s_nop 15\n\ts_nop 7":"+v"(pA0),"+v"(pA1));CMASK(pA0,pA1,0);DECAY(pA0,pA1,0);
  START(pA0,pA1);
  _Pragma("unroll") for(int r=0;r<16;++r)pA1[r]=__builtin_amdgcn_exp2f(pA1[r]);
  WAIT_BAR(0);
  DMA_K(3,0);DMA_V(1,SLOTB);
  ROT();
  kload8(kf,kp0+sl_cur);
  WAIT_BAR(2);
  s16x4 vlo[8],vhi[8]; u32x4 pw0,pw1,pw2,pw3;
  #define PKW(P,B) cvtpk_s(P[B],P[B+1])
  #define PAF(k) __builtin_bit_cast(bf16x8,pw##k)
  #define VFR(i) (bf16x8){vlo[i][0],vlo[i][1],vlo[i][2],vlo[i][3],vhi[i][0],vhi[i][1],vhi[i][2],vhi[i][3]}
  #define PIN(x) asm volatile("":"+v"(x))
  #define MX3(a,b,c) __builtin_fmaxf(__builtin_fmaxf((a),(b)),(c))
  #define GAPA(MF,A0,A1,A2,A3,W0,W1,PW) do{ MF; sacc+=A0; sacc+=A1; sacc+=A2; sacc+=A3; PIN(sacc); W0; W1; PIN(PW); SBAR(); }while(0)
  #define EX(v) __builtin_amdgcn_exp2f(v)
  #define GAPB(MF,X,B) do{ MF; X[B]=EX(X[B]); X[B+1]=EX(X[B+1]); X[B+2]=EX(X[B+2]); X[B+3]=EX(X[B+3]); PIN(X); SBAR(); }while(0)
  #define VRD(i) do{ vlo[i]=vtr(vp_+(((i)>>2)*4096+((i)&3)*1024)); vhi[i]=vtr(vp_+(((i)>>2)*4096+((i)&3)*1024+512)); }while(0)
  #define KRD(G,j) do{ if(G){ kload2(kf,kp0+sl_next,j); SBAR(); } }while(0)
  #define STEP(C0,C1,P0,P1,t,GK,GV,GL) do{ SBAR(); \
    const lds_cptr vp_=vp0+sl_prev; \
    CINIT(C0,t,0); VRD(0); SBAR(); float sacc=(P0[0]+P0[1]); \
    GAPA(C0=__builtin_amdgcn_mfma_f32_32x32x16_bf16(kf[0],qr[0],C0,0,0,0), P0[2],P0[3],P0[4],P0[5],     pw0[0]=PKW(P0,0), pw0[1]=PKW(P0,2), pw0); \
    CINIT(C1,t,32); VRD(4); SBAR(); GAPA(C1=__builtin_amdgcn_mfma_f32_32x32x16_bf16(kf[1],qr[0],C1,0,0,0), P0[6],P0[7],P0[8],P0[9],     pw0[2]=PKW(P0,4), pw0[3]=PKW(P0,6), pw0); \
    VRD(1); SBAR(); GAPA(C0=__builtin_amdgcn_mfma_f32_32x32x16_bf16(kf[2],qr[1],C0,0,0,0),   P0[10],P0[11],P0[12],P0[13], pw1[0]=PKW(P0,8), pw1[1]=PKW(P0,10), pw1); \
    VRD(5); SBAR(); GAPA(C1=__builtin_amdgcn_mfma_f32_32x32x16_bf16(kf[3],qr[1],C1,0,0,0),   P0[14],P0[15],P1[0],P1[1],   pw1[2]=PKW(P0,12),pw1[3]=PKW(P0,14), pw1); \
    VRD(2); SBAR(); GAPA(C0=__builtin_amdgcn_mfma_f32_32x32x16_bf16(kf[4],qr[2],C0,0,0,0),   P1[2],P1[3],P1[4],P1[5],     pw2[0]=PKW(P1,0), pw2[1]=PKW(P1,2), pw2); \
    VRD(6); SBAR(); GAPA(C1=__builtin_amdgcn_mfma_f32_32x32x16_bf16(kf[5],qr[2],C1,0,0,0),   P1[6],P1[7],P1[8],P1[9],     pw2[2]=PKW(P1,4), pw2[3]=PKW(P1,6), pw2); \
    VRD(3); SBAR(); GAPA(C0=__builtin_amdgcn_mfma_f32_32x32x16_bf16(kf[6],qr[3],C0,0,0,0),   P1[10],P1[11],P1[12],P1[13], pw3[0]=PKW(P1,8), pw3[1]=PKW(P1,10), pw3); \
    VRD(7); SBAR(); GAPA(C1=__builtin_amdgcn_mfma_f32_32x32x16_bf16(kf[7],qr[3],C1,0,0,0),   P1[14],P1[15],0.f,0.f,       pw3[2]=PKW(P1,12),pw3[3]=PKW(P1,14), pw3); \
    l_reg+=sacc; \
    if(GK){DMA_K((t)+3,sl_cur);} if(GV){DMA_V((t)+1,sl_next);} \
    CMASK(C0,C1,t); \
    { float a=MX3(C0[0],C0[1],C1[0]),b=MX3(C0[2],C0[3],C1[1]); a=MX3(a,C1[2],C1[3]); \
      _Pragma("unroll") for(int r=4;r<16;r+=4){a=MX3(a,C0[r],C0[r+1]);b=MX3(b,C0[r+2],C0[r+3]);a=MX3(a,C1[r],C1[r+1]);b=MX3(b,C1[r+2],C1[r+3]);} \
      float rm=__builtin_fmaxf(a,b); { auto rr=__builtin_amdgcn_permlane32_swap(__float_as_uint(rm),__float_as_uint(rm),false,false); rm=__builtin_fmaxf(__uint_as_float(rr[0]),__uint_as_float(rr[1])); } \
      resc=false; \
      if(__builtin_expect(__any(rm>(float)THRL),0)){ const float dl=__builtin_fmaxf(rm,0.f); mhat+=dl; \
        _Pragma("unroll") for(int r=0;r<16;++r){C0[r]-=dl;C1[r]-=dl;} \
        negms=-mhat; \
        const float f=__builtin_amdgcn_exp2f(-dl); l_reg*=f; if(hi==0)wsf[r32]=f; resc=true; } } \
    SBAR(); \
    GAPB(o[0]=__builtin_amdgcn_mfma_f32_32x32x16_bf16(PAF(0),VFR(0),o[0],0,0,0), C0,0); \
    GAPB(o[1]=__builtin_amdgcn_mfma_f32_32x32x16_bf16(PAF(0),VFR(4),o[1],0,0,0), C0,4); \
    KRD(GL,0); GAPB(o[0]=__builtin_amdgcn_mfma_f32_32x32x16_bf16(PAF(1),VFR(1),o[0],0,0,0), C0,8); \
    KRD(GL,1); GAPB(o[1]=__builtin_amdgcn_mfma_f32_32x32x16_bf16(PAF(1),VFR(5),o[1],0,0,0), C0,12); \
    KRD(GL,2); GAPB(o[0]=__builtin_amdgcn_mfma_f32_32x32x16_bf16(PAF(2),VFR(2),o[0],0,0,0), C1,0); \
    KRD(GL,3); GAPB(o[1]=__builtin_amdgcn_mfma_f32_32x32x16_bf16(PAF(2),VFR(6),o[1],0,0,0), C1,4); \
    GAPB(o[0]=__builtin_amdgcn_mfma_f32_32x32x16_bf16(PAF(3),VFR(3),o[0],0,0,0), C1,8); \
    GAPB(o[1]=__builtin_amdgcn_mfma_f32_32x32x16_bf16(PAF(3),VFR(7),o[1],0,0,0), C1,12); \
    }while(0)
  int t=1;
  #undef CMASK
  #define CMASK(P0,P1,t) do{}while(0)
  for(;t+5<NT;t+=2){
    STEP(pB0,pB1,pA0,pA1,t,true,true,true);     WAIT_BAR(2); RESC(); ROT();
    STEP(pA0,pA1,pB0,pB1,t+1,true,true,true);   WAIT_BAR(2); RESC(); ROT();
  }
  #undef CMASK
  #define CMASK(P0,P1,t) do{int jb_=(t)-(NT-4); if(jb_>=0)cmask(P0,P1,jb_,qrel,hi);}while(0)
  #define ENDW(tt) do{ if((tt)+3<NT){WAIT_BAR(2);} else if((tt)+2<NT){WAIT_BAR(1);} else {WAIT_BAR(0);} }while(0)
  for(;t+1<NT;t+=2){
    STEP(pB0,pB1,pA0,pA1,t,(t+3<NT),(t+1<NT),(t+1<NT));       ENDW(t);   RESC(); ROT();
    STEP(pA0,pA1,pB0,pB1,t+1,(t+4<NT),(t+2<NT),(t+2<NT));     ENDW(t+1); RESC(); ROT();
  }
  STEP(pB0,pB1,pA0,pA1,NT-1,false,false,false); RESC();
  { float sacc=pB0[0]+pB0[1]; _Pragma("unroll") for(int r=2;r<16;++r)sacc+=pB0[r]; _Pragma("unroll") for(int r=0;r<16;++r)sacc+=pB1[r]; l_reg+=sacc;
    pw0=(u32x4){PKW(pB0,0),PKW(pB0,2),PKW(pB0,4),PKW(pB0,6)};pw1=(u32x4){PKW(pB0,8),PKW(pB0,10),PKW(pB0,12),PKW(pB0,14)};pw2=(u32x4){PKW(pB1,0),PKW(pB1,2),PKW(pB1,4),PKW(pB1,6)};pw3=(u32x4){PKW(pB1,8),PKW(pB1,10),PKW(pB1,12),PKW(pB1,14)};
    SBAR(); pv(o,vb0+sl_cur,PAF(0),PAF(1),PAF(2),PAF(3)); }
  #undef PKW
  #undef PAF
  #undef VFR
  #undef PIN
  #undef MX3
  #undef GAPA
  #undef GAPB
  #undef EX
  #undef VRD
  #undef KRD
  #undef STEP
  #undef ENDW
  {auto rr=__builtin_amdgcn_permlane32_swap(__float_as_uint(l_reg),__float_as_uint(l_reg),false,false);l_reg=__uint_as_float(rr[0])+__uint_as_float(rr[1]);}
  if(hi==0)wsf[32+r32]=l_reg;asm volatile("s_waitcnt lgkmcnt(0)":::"memory");
  float rli[16];
  #pragma unroll
  for(int r=0;r<16;++r)rli[r]=__builtin_amdgcn_rcpf(wsf[32+crow(r,hi)]);
  bf16*Ow=O+(rowbase+q0+wid*QBLK)*DM+h*D;
  { bf16*stg=(bf16*)(shm+LDS_OST)+wid*2048;
    #pragma unroll
    for(int r=0;r<16;++r){const int orow=crow(r,hi);
      #pragma unroll
      for(int d0=0;d0<2;++d0)stg[orow*64+d0*32+r32]=__float2bfloat16(o[d0][r]*rli[r]);}
    asm volatile("s_waitcnt lgkmcnt(0)":::"memory");
    #pragma unroll
    for(int i=0;i<4;++i){const int row=i*8+(lane>>3),ch=lane&7; const u32x4 v=*(const u32x4*)(stg+row*64+ch*8); ATTN_STORE16(Ow+(long)row*DM+ch*8,v);} }
  asm volatile("s_waitcnt lgkmcnt(0)\n\ts_barrier":::"memory");
  #undef DECAY
  #undef CINIT
  #undef DMA_K
  #undef DMA_V
  #undef CMASK
  #undef START
  #undef RESC
  #undef ROT
}
constexpr int ATTN_LDS_BYTES=LDS_BYTES;
struct AttnTensors { const bf16* Q; const bf16* K; const bf16* V; bf16* O; const float* cum; float thr2; };
struct AttnUnit { int bh; int qb; };
struct StaticOrder {
  int vcu;
  __device__ __forceinline__ explicit StaticOrder(int grid,int block):vcu((block%8)*(grid/8)+block/8){}
  __device__ __forceinline__ bool next(int i,AttnUnit&u)const{ if(i>=2)return false; const int s=vcu&15; u.bh=vcu>>4; u.qb=(i==0)?s:31-s; return true; }
  __device__ __forceinline__ void a_ready(const AttnUnit&)const{}
  __device__ __forceinline__ void done(const AttnUnit&)const{}
};
template<class Sched,int THRL=8> __device__ __forceinline__ void attn_phase(char*lds,const AttnTensors&T,const Sched&S){
  AttnUnit u;
  for(int i=0;S.next(i,u);++i){ S.a_ready(u); attn_unit<THRL>(u.bh/NHEAD,u.bh%NHEAD,u.qb,T.Q,T.K,T.V,T.O,T.cum,T.thr2,lds); S.done(u); }
}
#undef SBAR
#undef WAIT_BAR
}

constexpr int NWAVES = 8;
constexpr int BATCH = 2, SEQ = 8192, DMODEL = 1024, T = BATCH * SEQ;
constexpr int CONVD = 512, CONVW = 31, NHEAD = 8, HD = 64, ATT = 512;
constexpr int NE = 64, TOPK = 8, EF = 256, SF = 256;
constexpr int INCOLS = 4616, OFF_Q = 1024, OFF_K = 1536, OFF_V = 2048, OFF_F = 2560, OFF_GC = 2568, OFF_GA = 3592;
constexpr int NIN = 4608;
constexpr float EPS = 1e-6f, LOG2E = 1.4426950408889634f, ROUTED_SCALE = 2.5f;
constexpr float C2Q = 0.125f * 1.4426950408889634f;
constexpr int LISTCAP = T;
constexpr int ACT_ROWS = T * TOPK + NE * 256;

constexpr size_t MiB = 1u << 20, KiB = 1u << 10;
constexpr size_t WS_CTL = 0, CTL_ZERO_BYTES = 1 * MiB;
constexpr size_t WS_MODP = 1 * MiB;
constexpr size_t WS_MOD = WS_MODP + 768 * KiB;
constexpr size_t WS_LOGF = 2 * MiB;
constexpr size_t WS_CUM = 2 * MiB + 512 * KiB;
constexpr size_t WS_SSQ = 3 * MiB;
constexpr size_t WS_XMX = 3 * MiB + 256 * KiB;
constexpr size_t WS_WFT = 3 * MiB + 640 * KiB;
constexpr size_t WS_SA1 = 3 * MiB + 512 * KiB, WS_SA2 = 3 * MiB + 576 * KiB;
constexpr size_t WS_SLIST = 21 * MiB;
constexpr size_t WS_WRH = 4 * MiB, WS_WRL = 4 * MiB + 128 * KiB;
constexpr size_t WS_WLIST = 5 * MiB;
constexpr size_t WS_LIST = 9 * MiB;
constexpr size_t WS_WIN = 16 * MiB, WS_WC = 25 * MiB, WS_WA = 26 * MiB, WS_WOUT = 27 * MiB, WS_WSGU = 29 * MiB, WS_WSD = 30 * MiB;
constexpr size_t WS_WGU = 32 * MiB, WS_WD = 96 * MiB;
constexpr size_t WS_H2 = 128 * MiB, WS_ACT = 160 * MiB, WS_SACT = 232 * MiB;
constexpr size_t WS_H1 = 240 * MiB, WS_U = 272 * MiB, WS_Q = 288 * MiB, WS_K = 304 * MiB, WS_V = 320 * MiB, WS_SG = 336 * MiB, WS_UC = 400 * MiB, WS_O = 416 * MiB, WS_MG = 432 * MiB;
constexpr size_t WS_SLAB = 240 * MiB;
constexpr size_t WS_END = 512 * MiB;
static_assert(WS_ACT + (size_t)ACT_ROWS * EF * 2 <= WS_SACT && WS_SLAB + (size_t)T * TOPK * DMODEL * 2 <= WS_END && WS_MG + (size_t)T * DMODEL * 2 <= WS_SLAB + 256 * MiB, "ws map");
constexpr int CW_TMO = 0, CW_CODE = 1;
constexpr int CW_CNT = 1024;
constexpr int CW_BAR = 8192;

constexpr int RING_OFF = 0, RING_BYTES = 131072;
constexpr int LDSCTL_OFF = RING_BYTES, MISC_OFF = LDSCTL_OFF + 320;
constexpr int TAB_OFF = RING_BYTES + 1024;
constexpr int LDS_BYTES = 147456;

#define GAS __attribute__((address_space(1)))
#define LAS __attribute__((address_space(3)))
typedef unsigned short bf16;
typedef unsigned v4u __attribute__((ext_vector_type(4)));
typedef unsigned v2u __attribute__((ext_vector_type(2)));
typedef float f32x4 __attribute__((ext_vector_type(4)));
typedef float f32x2 __attribute__((ext_vector_type(2)));
typedef float f32x16 __attribute__((ext_vector_type(16)));
typedef short bf16x8 __attribute__((ext_vector_type(8)));
typedef GAS unsigned gu32;
#define RLX_AGENT __ATOMIC_RELAXED, __HIP_MEMORY_SCOPE_AGENT
#define LDS_WAIT() asm volatile("s_waitcnt lgkmcnt(0)" ::: "memory")
#define VM_WAIT() asm volatile("s_waitcnt vmcnt(0)" ::: "memory")
__device__ __forceinline__ unsigned f2bf(float f) { unsigned u = __builtin_bit_cast(unsigned, f); return (u + 0x7fffu + ((u >> 16) & 1u)) >> 16; }
__device__ __forceinline__ unsigned pk2(float lo, float hi) { return f2bf(lo) | (f2bf(hi) << 16); }
__device__ __forceinline__ float bf2f(unsigned h) { return __builtin_bit_cast(float, h << 16); }
__device__ __forceinline__ float wave_sum(float v) {
#pragma unroll
    for (int o = 1; o < 64; o <<= 1) v += __shfl_xor(v, o);
    return v;
}
using pg8::cvt_pk_bf16; using pg8::bf_lo; using pg8::bf_hi; using pg8::sigmoidf_fast;

#ifndef DIAG_BLK
#define DIAG_BLK 0
#endif
#define XB_TMO      128
#define XB_XCNT(j)  (256  + 64 * (j))
#define XB_XSUB(j)  (1280 + 64 * (j))
#define XB_XGEN(j)  (2304 + 64 * (j))
#define XB_TOP      3328
#define XB_TOPGEN   3392
#define XCD_BAR_WORDS 3456
#define XB_SPIN_CAP (1u << 18)

__device__ __forceinline__ unsigned xb_ld(unsigned* p)              { return __hip_atomic_load(p, __ATOMIC_RELAXED, __HIP_MEMORY_SCOPE_AGENT); }
__device__ __forceinline__ unsigned xb_add(unsigned* p, unsigned v) { return __hip_atomic_fetch_add(p, v, __ATOMIC_RELAXED, __HIP_MEMORY_SCOPE_AGENT); }
__device__ __forceinline__ unsigned xb_xcc_id() { return (unsigned)__builtin_amdgcn_s_getreg((3 << 11) | 20) & 0xFu; }
#define XB_SPIN(cond, bar) do { unsigned _sp = 0; while (cond) { __builtin_amdgcn_s_sleep(1); \
    if ((++_sp & 255u) == 0u) { if (xb_ld(&(bar)[XB_TMO])) break; if (_sp > XB_SPIN_CAP) { atomicAdd(&(bar)[XB_TMO], 1u); break; } } } } while (0)

struct XcdBarrier {
    unsigned* bar; unsigned x;
    volatile LAS unsigned* st;
};

__device__ __forceinline__ XcdBarrier xcd_barrier_post(unsigned* bar, volatile LAS unsigned* st) {
    XcdBarrier b; b.bar = bar; b.x = xb_xcc_id(); b.st = st;
    if (threadIdx.x == 0) (void)xb_add(&bar[XB_XCNT(b.x)], 1u);
    return b;
}
__device__ __forceinline__ void xcd_barrier_complete(unsigned* bar, unsigned x, unsigned& nloc, unsigned& nx) {
    const unsigned G = gridDim.x * gridDim.y * gridDim.z;
    unsigned sum, cnt, mine, sp = 0u;
    for (;;) {
        sum = 0u; cnt = 0u; mine = 0u;
#pragma unroll
        for (unsigned j = 0; j < 16; ++j) { const unsigned c = xb_ld(&bar[XB_XCNT(j)]); sum += c; cnt += (c > 0u) ? 1u : 0u; mine = (j == x) ? c : mine; }
        if (sum == G) break;
        __builtin_amdgcn_s_sleep(1);
        if ((++sp & 255u) == 0u) { if (xb_ld(&bar[XB_TMO])) break; if (sp > XB_SPIN_CAP) { atomicAdd(&bar[XB_TMO], 1u); break; } }
    }
    nloc = mine > 0u ? mine : 1u; nx = cnt > 0u ? cnt : 1u;
}

__device__ __forceinline__ void xcd_barrier(const XcdBarrier& b) {
    asm volatile("s_waitcnt vmcnt(0)" ::: "memory");
    __syncthreads();
    if (threadIdx.x == 0) {
        unsigned* bar = b.bar;
        __builtin_amdgcn_s_waitcnt(0);
        unsigned nloc = b.st[0], nx = b.st[1];
        if (nloc == 0u) { xcd_barrier_complete(bar, b.x, nloc, nx); b.st[0] = nloc; b.st[1] = nx; }
        const unsigned old = xb_add(&bar[XB_XSUB(b.x)], 1u);
        const unsigned gen = old / nloc;
        if (old + 1u == (gen + 1u) * nloc) {
            __builtin_amdgcn_fence(__ATOMIC_RELEASE, "agent");
            asm volatile("s_waitcnt vmcnt(0)" ::: "memory");
            const unsigned og = xb_add(&bar[XB_TOP], 1u);
            const unsigned tg = og / nx;
            if (og + 1u == (tg + 1u) * nx) xb_add(&bar[XB_TOPGEN], 1u);
            else XB_SPIN(xb_ld(&bar[XB_TOPGEN]) == tg, bar);
            __builtin_amdgcn_fence(__ATOMIC_ACQUIRE, "agent");
            xb_add(&bar[XB_XGEN(b.x)], 1u);
            asm volatile("s_waitcnt vmcnt(0)" ::: "memory");
        } else {
            XB_SPIN(xb_ld(&bar[XB_XGEN(b.x)]) == gen, bar);
            __builtin_amdgcn_fence(__ATOMIC_ACQUIRE, "agent");
            asm volatile("s_waitcnt vmcnt(0)" ::: "memory");
        }
    }
    __syncthreads();
}

__device__ __forceinline__ int win_dst_row(int n) {
    if (n < 512) return 256 * (n >> 7) + (n & 127);
    if (n < 1024) { const int f = n - 512; return 256 * (f >> 7) + 128 + (f & 127); }
    if (n < 2048) { const int isk = n >= OFF_K, j = n - (isk ? OFF_K : OFF_Q), head = j >> 6, d = j & 63;
        return 256 * (4 + 2 * isk + (head >> 2)) + 128 * (d >> 5) + 32 * (head & 3) + (d & 31); }
    if (n < OFF_F) return 256 * 8 + (n - OFF_V);
    if (n < OFF_GC) return -1;
    return 256 * 10 + (n - OFF_GC);
}
__device__ __forceinline__ int glu_dst_row(int n, int F) { const int isu = n >= F, f = n - (isu ? F : 0); return 256 * (f >> 7) + 128 * isu + (f & 127); }

__device__ __forceinline__ unsigned pk4_i8(float a, float b, float c, float d) {
    const int ia = (int)__builtin_rintf(fminf(fmaxf(a, -127.f), 127.f)), ib = (int)__builtin_rintf(fminf(fmaxf(b, -127.f), 127.f)), ic = (int)__builtin_rintf(fminf(fmaxf(c, -127.f), 127.f)), id = (int)__builtin_rintf(fminf(fmaxf(d, -127.f), 127.f));
    return (unsigned)(ia & 255) | ((unsigned)(ib & 255) << 8) | ((unsigned)(ic & 255) << 16) | ((unsigned)id << 24); }
constexpr float WGU_MARGIN = 1.25f;
constexpr int CW_AMAX = 6144;
__device__ __forceinline__ unsigned pk4_fp8(float a, float b, float c, float d) { int p = __builtin_amdgcn_cvt_pk_fp8_f32(a, b, 0, false); p = __builtin_amdgcn_cvt_pk_fp8_f32(c, d, p, true); return (unsigned)p; }
#ifndef MOE_FP8
#define MOE_FP8 0
#endif
constexpr float W8SCALE = MOE_FP8 ? 32.0f : 1.0f;
constexpr float SLABSCALE = 16.0f;
__device__ __forceinline__ void tr_load(f32x4 (&ld)[8], const float* W, int ldw, int k0, int n0, int lane) {
#pragma unroll
    for (int i = 0; i < 8; ++i) ld[i] = *(const f32x4*)(W + (size_t)(k0 + 8 * i + (lane >> 3)) * ldw + n0 + 4 * (lane & 7));
}
template <int MODE>
__device__ __forceinline__ void tr_finish(const f32x4 (&ld)[8], int ldw, int K, bf16* WT, bf16* WT2, int k0, int n0, LAS float* scr, int lane, float qs = 1.0f) {
#pragma unroll
    for (int i = 0; i < 8; ++i) { LAS float* d = scr + (8 * i + (lane >> 3)) * 33 + 4 * (lane & 7); d[0] = ld[i][0]; d[1] = ld[i][1]; d[2] = ld[i][2]; d[3] = ld[i][3]; }
    LDS_WAIT(); asm volatile("" ::: "memory");
    const int c = lane & 7;
#pragma unroll
    for (int j = 0; j < 4; ++j) { const int n = (lane >> 3) + 8 * j; const LAS float* s = scr + (8 * c) * 33 + n;
        int row = n0 + n;
        if (MODE == 1 || MODE == 5) row = win_dst_row(row);
        if (MODE == 2 || MODE == 4 || MODE == 6) row = glu_dst_row(row, ldw >> 1);
        float v[8];
#pragma unroll
        for (int q = 0; q < 8; ++q) v[q] = s[q * 33];
        if ((MODE == 1 || MODE == 5) && row < 0) continue;
        if (MODE == 5 || MODE == 6) { v2u o8; o8.x = pk4_i8(v[0] * qs, v[1] * qs, v[2] * qs, v[3] * qs); o8.y = pk4_i8(v[4] * qs, v[5] * qs, v[6] * qs, v[7] * qs);
            *(GAS v2u*)((unsigned char*)WT + (size_t)row * K + k0 + 8 * c) = o8; continue; }
        if (MODE == 4) { v2u o8; o8.x = pk4_fp8(v[0] * W8SCALE, v[1] * W8SCALE, v[2] * W8SCALE, v[3] * W8SCALE); o8.y = pk4_fp8(v[4] * W8SCALE, v[5] * W8SCALE, v[6] * W8SCALE, v[7] * W8SCALE);
            *(GAS v2u*)((unsigned char*)WT + (size_t)row * K + k0 + 8 * c) = o8; continue; }
        v4u o; o.x = pk2(v[0], v[1]); o.y = pk2(v[2], v[3]); o.z = pk2(v[4], v[5]); o.w = pk2(v[6], v[7]);
        *(GAS v4u*)(WT + (size_t)row * K + k0 + 8 * c) = o;
        if (MODE == 3) { float r[8];
#pragma unroll
            for (int q = 0; q < 8; ++q) r[q] = v[q] - bf2f(f2bf(v[q]));
            v4u o2; o2.x = pk2(r[0], r[1]); o2.y = pk2(r[2], r[3]); o2.z = pk2(r[4], r[5]); o2.w = pk2(r[6], r[7]);
            *(GAS v4u*)(WT2 + (size_t)row * K + k0 + 8 * c) = o2; }
    }
    LDS_WAIT(); asm volatile("" ::: "memory");
}

template <int MODE>
__device__ __forceinline__ void tr_item(const float* W, int ldw, int K, bf16* WT, bf16* WT2, int k0, int n0, LAS float* scr, int lane, float qs = 1.0f) {
    f32x4 ld[8]; tr_load(ld, W, ldw, k0, n0, lane); tr_finish<MODE>(ld, ldw, K, WT, WT2, k0, n0, scr, lane, qs);
}
struct KArgs { const float* in[23]; float* out; unsigned char* ws; int ph_lo, ph_hi; };

__device__ __forceinline__ void p0_prologue(const KArgs& a, LAS unsigned char* lds, int vcu, int G, int wave, int lane) {
    LAS float* scr = (LAS float*)(lds + RING_OFF + wave * 16384);
    const int gw = vcu * NWAVES + wave, NGW = G * NWAVES;
    unsigned char* ws = a.ws;
    {
        const float* c = a.in[1]; const float* wada = a.in[2]; float* modp = (float*)(ws + WS_MODP);
        for (int it = gw; it < 96 * 16; it += NGW) {
            const int cg = it % 96, kc = it / 96, n = 64 * cg + lane; float s0 = 0.f, s1 = 0.f;
            const float* wp = wada + (size_t)(64 * kc) * 6144 + n;
            float wv[64];
#pragma unroll
            for (int k = 0; k < 64; ++k) wv[k] = wp[(size_t)k * 6144];
#pragma unroll
            for (int k = 0; k < 64; ++k) { const float c0 = c[64 * kc + k], c1 = c[1024 + 64 * kc + k];
                s0 += (c0 / (1.0f + __expf(-c0))) * wv[k]; s1 += (c1 / (1.0f + __expf(-c1))) * wv[k]; }
            modp[(size_t)(kc * 2 + 0) * 6144 + n] = s0; modp[(size_t)(kc * 2 + 1) * 6144 + n] = s1;
        }
    }
    for (int it = gw - 1536; it >= 0 && it < 16; it += NGW) { const int k = 64 * it + lane; const float* src = a.in[5] + (size_t)k * INCOLS + OFF_F;
        const f32x4 w0 = *(const f32x4*)src, w1 = *(const f32x4*)(src + 4); float* dst = (float*)(ws + WS_WFT) + k;
        dst[0] = w0[0]; dst[1024] = w0[1]; dst[2048] = w0[2]; dst[3072] = w0[3]; dst[4096] = w1[0]; dst[5120] = w1[1]; dst[6144] = w1[2]; dst[7168] = w1[3]; }
    constexpr int I_WC = 8 * 32, I_WA = 8 * 32, I_WOUT = 16 * 32, I_WSD = 4 * 32, I_WR = 16 * 2;
    constexpr int NITEMS = I_WC + I_WA + I_WOUT + I_WSD + I_WR;
    for (int it = gw; it < NITEMS; it += NGW) {
        int r = it;
        if (r < I_WC) { tr_item<0>(a.in[10], 1024, 512, (bf16*)(ws + WS_WC), nullptr, 64 * (r / 32), 32 * (r % 32), scr, lane); continue; } r -= I_WC;
        if (r < I_WA) { tr_item<0>(a.in[14], 1024, 512, (bf16*)(ws + WS_WA), nullptr, 64 * (r / 32), 32 * (r % 32), scr, lane); continue; } r -= I_WA;
        if (r < I_WOUT) { tr_item<0>(a.in[15], 1024, 1024, (bf16*)(ws + WS_WOUT), nullptr, 64 * (r / 32), 32 * (r % 32), scr, lane); continue; } r -= I_WOUT;
        if (r < I_WSD) { tr_item<0>(a.in[22], 1024, 256, (bf16*)(ws + WS_WSD), nullptr, 64 * (r / 32), 32 * (r % 32), scr, lane); continue; } r -= I_WSD;
        tr_item<3>(a.in[17], 64, 1024, (bf16*)(ws + WS_WRH), (bf16*)(ws + WS_WRL), 64 * (r / 2), 32 * (r % 2), scr, lane);
    }
#if defined(DIAG_A)
    if (blockIdx.x == DIAG_BLK && threadIdx.x == 0) ((unsigned long long*)(ws + WS_CTL + 512 * 1024))[23] = __builtin_amdgcn_s_memrealtime();
#endif
    {
        unsigned* amax = (unsigned*)(ws + WS_CTL) + CW_AMAX;
        constexpr int C4 = 4096, N_WIN4 = DMODEL * INCOLS / 4, IT_WIN = (N_WIN4 + C4 - 1) / C4, IT_WSGU = (1024 * 512 / 4) / C4, WGU_SAMPLE = 4, IT_WGU = 64 * WGU_SAMPLE;
        for (int it = gw; it < IT_WIN + IT_WSGU + IT_WGU; it += NGW) {
            const f32x4* p; int n4; unsigned* dst;
            if (it < IT_WIN) { p = (const f32x4*)a.in[5] + (size_t)it * C4; n4 = (it == IT_WIN - 1) ? N_WIN4 - it * C4 : C4; dst = amax; }
            else if (it < IT_WIN + IT_WSGU) { p = (const f32x4*)a.in[21] + (size_t)(it - IT_WIN) * C4; n4 = C4; dst = amax + 1; }
            else { const int r = it - IT_WIN - IT_WSGU, e = r / WGU_SAMPLE; p = (const f32x4*)a.in[19] + ((size_t)e * IT_WSGU + r % WGU_SAMPLE) * C4; n4 = C4; dst = amax + 2 + e; }
            float m = 0.f;
#pragma unroll 8
            for (int i = lane; i < n4; i += 64) { const f32x4 v = p[i]; m = fmaxf(m, fmaxf(fmaxf(fabsf(v[0]), fabsf(v[1])), fmaxf(fabsf(v[2]), fabsf(v[3])))); }
#pragma unroll
            for (int o = 1; o < 64; o <<= 1) m = fmaxf(m, __shfl_xor(m, o));
            if (lane == 0) atomicMax(dst, __builtin_bit_cast(unsigned, m));
        }
    }
}
__device__ __forceinline__ void q8_items(const KArgs& a, LAS unsigned char* lds, int vcu, int G, int wave, int lane) {
    LAS float* scr = (LAS float*)(lds + RING_OFF + wave * 16384);
    const int gw = vcu * NWAVES + wave, NGW = G * NWAVES; unsigned char* ws = a.ws;
    const unsigned* amax = (const unsigned*)(ws + WS_CTL) + CW_AMAX;
    constexpr int I_WIN = 144 * 16, I_WSGU = 16 * 16, I_WGU = 64 * 256, NIT = I_WIN + I_WSGU + I_WGU;
    struct Job { const float* W; int ldw, k0, n0, mode; unsigned char* WT; float qs; };
    auto job = [&](int it) { Job j; int r = it;
        if (r < I_WIN) { const int cb = r % 144, kb = r / 144; j.W = a.in[5]; j.ldw = INCOLS; j.k0 = 64 * kb; j.n0 = cb < 80 ? 32 * cb : OFF_GC + 32 * (cb - 80); j.mode = 5; j.WT = ws + WS_WIN; j.qs = 127.0f / __builtin_bit_cast(float, amax[0]); return j; } r -= I_WIN;
        if (r < I_WSGU) { j.W = a.in[21]; j.ldw = 512; j.k0 = 64 * (r / 16); j.n0 = 32 * (r % 16); j.mode = 6; j.WT = ws + WS_WSGU; j.qs = 127.0f / __builtin_bit_cast(float, amax[1]); return j; } r -= I_WSGU;
        const int e = r / 256, q = r % 256; j.W = a.in[19] + (size_t)e * 1024 * 512; j.ldw = 512; j.k0 = 64 * (q / 16); j.n0 = 32 * (q % 16); j.mode = 6; j.WT = ws + WS_WGU + (size_t)e * 512 * 1024; j.qs = 127.0f / (WGU_MARGIN * __builtin_bit_cast(float, amax[2 + e])); return j; };
    auto fin = [&](const f32x4 (&ld)[8], const Job& j) { if (j.mode == 5) tr_finish<5>(ld, j.ldw, 1024, (bf16*)j.WT, nullptr, j.k0, j.n0, scr, lane, j.qs); else tr_finish<6>(ld, j.ldw, 1024, (bf16*)j.WT, nullptr, j.k0, j.n0, scr, lane, j.qs); };
    f32x4 lA[8], lB[8]; int it = gw; if (it >= NIT) return;
    Job jA = job(it), jB = jA; tr_load(lA, jA.W, jA.ldw, jA.k0, jA.n0, lane);
    for (;;) {
        const bool hb = it + NGW < NIT; if (hb) { jB = job(it + NGW); tr_load(lB, jB.W, jB.ldw, jB.k0, jB.n0, lane); }
        fin(lA, jA); if (!hb) break; it += NGW;
        const bool ha = it + NGW < NIT; if (ha) { jA = job(it + NGW); tr_load(lA, jA.W, jA.ldw, jA.k0, jA.n0, lane); }
        fin(lB, jB); if (!ha) break; it += NGW;
    }
}
__device__ __forceinline__ void wd_items(const KArgs& a, LAS unsigned char* lds, int first, int last, int slot, int nslots, int wave, int lane) {
    LAS float* scr = (LAS float*)(lds + RING_OFF + wave * 16384);
    const int step = nslots * NWAVES; int r = first + slot * NWAVES + wave; if (r >= last) return;
    const float* Wd = a.in[20]; bf16* WT = (bf16*)(a.ws + WS_WD);
#define WD_LOAD(L, rr) tr_load(L, Wd + (size_t)((rr) / 128) * 256 * 1024, 1024, 64 * (((rr) % 128) / 32), 32 * (((rr) % 128) % 32), lane)
#define WD_FIN(L, rr) tr_finish<0>(L, 1024, 256, WT + (size_t)((rr) / 128) * 1024 * 256, nullptr, 64 * (((rr) % 128) / 32), 32 * (((rr) % 128) % 32), scr, lane)
    f32x4 lA[8], lB[8]; WD_LOAD(lA, r);
    for (;;) {
        const bool hb = r + step < last; if (hb) WD_LOAD(lB, r + step);
        WD_FIN(lA, r); if (!hb) break; r += step;
        const bool ha = r + step < last; if (ha) WD_LOAD(lA, r + step);
        WD_FIN(lB, r); if (!ha) break; r += step;
    }
#undef WD_LOAD
#undef WD_FIN
}

__device__ __forceinline__ void p1_rows(const KArgs& a, LAS unsigned char* lds, int vcu, int tid, int wave, int lane) {
    unsigned char* ws = a.ws;
    const float* modp = (const float*)(ws + WS_MODP); const float* bada = a.in[3];
    LAS float* gs1 = (LAS float*)(lds + RING_OFF); LAS float* sh1 = gs1 + 1024; LAS float* wfl = gs1 + 2048;
    const int b = vcu >> 7;
    f32x4 vvA[4][4], vvB[4][4];
#pragma unroll
    for (int j = 0; j < 4; ++j) { const GAS f32x4* xa = (const GAS f32x4*)(a.in[0] + (size_t)(64 * vcu + 8 * wave + j) * DMODEL) + lane; const GAS f32x4* xb = (const GAS f32x4*)(a.in[0] + (size_t)(64 * vcu + 8 * wave + 4 + j) * DMODEL) + lane;
#pragma unroll
        for (int q = 0; q < 4; ++q) { vvA[j][q] = xa[64 * q]; vvB[j][q] = xb[64 * q]; } }
    {
        const int col = 4 * tid; f32x4 s = *(const f32x4*)(bada + col);
#pragma unroll
        for (int kc = 0; kc < 16; ++kc) s += *(const f32x4*)(modp + (size_t)(kc * 2 + b) * 6144 + col);
        if (col < 1024) { *(LAS f32x4*)(sh1 + col) = s; }
        else { const f32x4 g = *(const f32x4*)(a.in[4] + col - 1024); *(LAS f32x4*)(gs1 + col - 1024) = g * (1.0f + s); }
    }
    if (tid < 12) {
        float* mod = (float*)(ws + WS_MOD); const int gi = blockIdx.x * 12 + tid, bb = gi / 1536, col = 4 * (gi % 1536); f32x4 s = *(const f32x4*)(bada + col);
#pragma unroll
        for (int kc = 0; kc < 16; ++kc) s += *(const f32x4*)(modp + (size_t)(kc * 2 + bb) * 6144 + col);
        *(f32x4*)(mod + (size_t)bb * 6144 + col) = s;
    }
    { const f32x4* wft = (const f32x4*)(ws + WS_WFT);
#pragma unroll
      for (int i = 0; i < 4; ++i) *(LAS f32x4*)(wfl + 4 * (tid + 512 * i)) = wft[tid + 512 * i]; }
    __syncthreads();
#if defined(DIAG_A)
    if (blockIdx.x == DIAG_BLK && threadIdx.x == 0) ((unsigned long long*)(ws + WS_CTL + 512 * 1024))[27] = __builtin_amdgcn_s_memrealtime();
#endif
    const float* x = a.in[0]; bf16* h1 = (bf16*)(ws + WS_H1); float* logf_ = (float*)(ws + WS_LOGF); const float* bfg = a.in[13];
#pragma nounroll
    for (int jb = 0; jb < 2; ++jb) {
    f32x4 vv[4][4];
#pragma unroll
    for (int j = 0; j < 4; ++j)
#pragma unroll
        for (int q = 0; q < 4; ++q) vv[j][q] = jb ? vvB[j][q] : vvA[j][q];
#pragma unroll
    for (int j = 0; j < 4; ++j) {
        const int row = 64 * vcu + 8 * wave + 4 * jb + j, t = row & (SEQ - 1);
        LAS float* gs1_ = gs1; asm volatile("" : "+v"(gs1_));
        LAS float* sh1_ = gs1_ + 1024; LAS float* wfl_ = gs1_ + 2048;
        f32x4 v[4]; float ss = 0.f;
#pragma unroll
        for (int q = 0; q < 4; ++q) { v[q] = vv[j][q]; ss += (v[q].x * v[q].x + v[q].y * v[q].y) + (v[q].z * v[q].z + v[q].w * v[q].w); }
        const float rstd = 1.0f / sqrtf(wave_sum(ss) * (1.0f / DMODEL) + EPS);
        float hm = 0.f;
#pragma unroll
        for (int q = 0; q < 4; ++q) { const f32x4 g = *(const LAS f32x4*)(gs1_ + 4 * lane + 256 * q), s = *(const LAS f32x4*)(sh1_ + 4 * lane + 256 * q);
            v[q] = v[q] * rstd * g + s; hm = fmaxf(hm, fmaxf(fmaxf(fabsf(v[q].x), fabsf(v[q].y)), fmaxf(fabsf(v[q].z), fabsf(v[q].w)))); }
#pragma unroll
        for (int o = 1; o < 64; o <<= 1) hm = fmaxf(hm, __shfl_xor(hm, o));
        hm = fmaxf(hm, 1e-20f); const float qinv = 127.0f / hm;
        GAS unsigned* o4 = (GAS unsigned*)((unsigned char*)h1 + (size_t)row * DMODEL) + lane;
#pragma unroll
        for (int q = 0; q < 4; ++q) o4[64 * q] = pk4_i8(v[q].x * qinv, v[q].y * qinv, v[q].z * qinv, v[q].w * qinv);
        if (lane == 0) ((float*)(ws + WS_SA1))[row] = hm * (1.0f / 127.0f);
        float pf[8];
#pragma unroll
        for (int f = 0; f < 8; ++f) { float p = 0.f;
#pragma unroll
            for (int q = 0; q < 4; ++q) { const f32x4 w = *(const LAS f32x4*)(wfl_ + f * 1024 + 4 * lane + 256 * q); p += (v[q].x * w.x + v[q].y * w.y) + (v[q].z * w.z + v[q].w * w.w); }
            pf[f] = p; }
        float r4[4], r2[2], mine;
#pragma unroll
        for (int i = 0; i < 4; ++i) { const float keep = (lane & 1) ? pf[2 * i + 1] : pf[2 * i], send = (lane & 1) ? pf[2 * i] : pf[2 * i + 1]; r4[i] = keep + __shfl_xor(send, 1); }
#pragma unroll
        for (int i = 0; i < 2; ++i) { const float keep = (lane & 2) ? r4[2 * i + 1] : r4[2 * i], send = (lane & 2) ? r4[2 * i] : r4[2 * i + 1]; r2[i] = keep + __shfl_xor(send, 2); }
        { const float keep = (lane & 4) ? r2[1] : r2[0], send = (lane & 4) ? r2[0] : r2[1]; mine = keep + __shfl_xor(send, 4); }
        mine += __shfl_xor(mine, 8); mine += __shfl_xor(mine, 16); mine += __shfl_xor(mine, 32);
        if (lane < 8) { const float z = mine + bfg[lane]; const float ls = fminf(z, 0.f) - __logf(1.0f + __expf(-fabsf(z)));
            logf_[(size_t)(b * 8 + lane) * SEQ + t] = ls; }
    }
    }
}

__device__ __forceinline__ void p2_cumsum(const KArgs& a, LAS unsigned char* lds, int seq, int tid, int wave, int lane) {
    const float* lf = (const float*)(a.ws + WS_LOGF) + (size_t)seq * SEQ + 16 * tid; float* cm = (float*)(a.ws + WS_CUM) + (size_t)seq * SEQ + 16 * tid;
    LAS double* wt = (LAS double*)(lds + RING_OFF);
    float v[16];
#pragma unroll
    for (int q = 0; q < 4; ++q) { const f32x4 x = *(const f32x4*)(lf + 4 * q); v[4 * q] = x.x; v[4 * q + 1] = x.y; v[4 * q + 2] = x.z; v[4 * q + 3] = x.w; }
    double pre[16]; double run = 0.0;
#pragma unroll
    for (int i = 0; i < 16; ++i) { run += (double)v[i]; pre[i] = run; }
    double sc = run;
#pragma unroll
    for (int o = 1; o < 64; o <<= 1) { const double up = __shfl_up(sc, o); if (lane >= o) sc += up; }
    if (lane == 63) wt[wave] = sc;
    __syncthreads();
    double off = sc - run;
    for (int w = 0; w < wave; ++w) off += wt[w];
#pragma unroll
    for (int q = 0; q < 4; ++q) { f32x4 o; o.x = (float)(off + pre[4 * q]); o.y = (float)(off + pre[4 * q + 1]); o.z = (float)(off + pre[4 * q + 2]); o.w = (float)(off + pre[4 * q + 3]); *(f32x4*)(cm + 4 * q) = o; }
    __syncthreads();
}

__device__ __forceinline__ void conv_items(const KArgs& a, LAS unsigned char* lds, int first, int stride, int tid) {
    const int g = first & 7, c0 = 64 * g;
    const int c2 = tid & 31, seg = tid >> 5;
    const int tok = tid >> 2, q = tid & 3;
    float w0[CONVW], w1[CONVW];
#pragma unroll
    for (int j = 0; j < CONVW; ++j) { const f32x2 wv = *(const f32x2*)(a.in[6] + (size_t)j * CONVD + c0 + 2 * c2); w0[j] = wv[0]; w1[j] = wv[1]; }
    const f32x2 bv = *(const f32x2*)(a.in[7] + c0 + 2 * c2);
    v2u pre[5];
#define CONV_PREFETCH(it_) do { const int r0_ = 128 * ((it_) >> 3), tz_ = r0_ & (SEQ - 1); _Pragma("unroll") for (int p_ = 0; p_ < 5; ++p_) { const int idx = tid + p_ * NWAVES * 64, r = idx >> 4, ch = idx & 15; \
        pre[p_] = (v2u){0u, 0u}; if (idx < 158 * 16 && tz_ - 30 + r >= 0) pre[p_] = *(const GAS v2u*)(U + (size_t)(r0_ - 30 + r) * CONVD + c0 + 4 * ch); } } while (0)
    const bf16* U = (const bf16*)(a.ws + WS_U); bf16* UC = (bf16*)(a.ws + WS_UC);
    if (first < 1024) CONV_PREFETCH(first);
    for (int item = first; item < 1024; item += stride) {
    const int tt = item >> 3, row0 = 128 * tt;
    constexpr int RS = 132;
    LAS unsigned char* ut = lds + RING_OFF;
    LAS float* yt = (LAS float*)(lds + RING_OFF + 24576);
    constexpr int YS = 68;
#pragma unroll
    for (int p_ = 0; p_ < 5; ++p_) { const int idx = tid + p_ * NWAVES * 64, r = idx >> 4, ch = idx & 15;
        if (idx < 158 * 16) { *(LAS unsigned*)(ut + r * RS + 8 * ch) = pre[p_].x; *(LAS unsigned*)(ut + r * RS + 8 * ch + 4) = pre[p_].y; } }
    __syncthreads();
    if (item + stride < 1024) CONV_PREFETCH(item + stride);
    float y0[8], y1[8];
#pragma unroll
    for (int t = 0; t < 8; ++t) { y0[t] = bv[0]; y1[t] = bv[1]; }
#pragma unroll
    for (int r = 0; r < 38; ++r) { const unsigned uu = *(const LAS unsigned*)(ut + (8 * seg + r) * RS + 4 * c2); const float x0 = bf_lo(uu), x1v = bf_hi(uu);
#pragma unroll
        for (int t = 0; t < 8; ++t) { const int j = r - t; if (j >= 0 && j < CONVW) { y0[t] += x0 * w0[j]; y1[t] += x1v * w1[j]; } } }
#pragma unroll
    for (int t = 0; t < 8; ++t) *(LAS f32x2*)(yt + (8 * seg + t) * YS + 2 * c2) = (f32x2){y0[t], y1[t]};
    __syncthreads();
    float acc[16];
#pragma unroll
    for (int i = 0; i < 4; ++i) { const f32x4 v = *(const LAS f32x4*)(yt + tok * YS + 16 * q + 4 * i); acc[4 * i] = v[0]; acc[4 * i + 1] = v[1]; acc[4 * i + 2] = v[2]; acc[4 * i + 3] = v[3]; }
    float s = 0.f;
#pragma unroll
    for (int i = 0; i < 16; ++i) s += acc[i];
    s += __shfl_xor(s, 1); s += __shfl_xor(s, 2);
    const float mu = s * (1.0f / 64.0f); float qv = 0.f;
#pragma unroll
    for (int i = 0; i < 16; ++i) { acc[i] -= mu; qv += acc[i] * acc[i]; }
    qv += __shfl_xor(qv, 1); qv += __shfl_xor(qv, 2);
    const float rstd = 1.0f / sqrtf(qv * (1.0f / 64.0f) + EPS);
    unsigned o[8];
#pragma unroll
    for (int i = 0; i < 16; i += 2) { float v0 = acc[i] * rstd * a.in[8][c0 + 16 * q + i] + a.in[9][c0 + 16 * q + i], v1 = acc[i + 1] * rstd * a.in[8][c0 + 16 * q + i + 1] + a.in[9][c0 + 16 * q + i + 1];
        v0 = v0 * sigmoidf_fast(v0); v1 = v1 * sigmoidf_fast(v1); o[i >> 1] = pk2(v0, v1); }
    GAS v4u* dst = (GAS v4u*)(UC + (size_t)(row0 + tok) * CONVD + c0 + 16 * q);
    dst[0] = (v4u){o[0], o[1], o[2], o[3]}; dst[1] = (v4u){o[4], o[5], o[6], o[7]};
    __syncthreads();
    }
#undef CONV_PREFETCH
}

struct SchedDense {
    static constexpr bool GATHER = false;
    int nM, nN, G, c, K; const char* A; const char* B;
    __device__ __forceinline__ bool next(int i, pg8::Unit& u) const {
        const long L = (long)i * G + c; if (L >= (long)nM * nN) return false;
        pg8::tile_of((int)L, nM, nN, u.pm, u.pn); u.e = 0; u.mt = 0;
        u.A = A + (size_t)u.pm * 256 * K * 2; u.B = B + (size_t)u.pn * 256 * K * 2; return true; }
    __device__ __forceinline__ int row(const pg8::Unit&, int) const { return 0; }
};
struct SchedMerge {
    static constexpr bool GATHER = false;
    int c; const char* A0; const char* B0; const char* A1; const char* B1;
    __device__ __forceinline__ bool next(int i, pg8::Unit& u) const {
        if (i >= 2 || c >= 256) return false;
        pg8::tile_of(c, 64, 4, u.pm, u.pn); u.e = i; u.mt = 0;
        u.A = (i ? A1 : A0) + (size_t)u.pm * 256 * 512 * 2; u.B = (i ? B1 : B0) + (size_t)u.pn * 256 * 512 * 2; return true; }
    __device__ __forceinline__ int row(const pg8::Unit&, int) const { return 0; }
};
struct MoeTab { const LAS int* tstart; const LAS int* cnt; };
struct SchedMoe1 {
    static constexpr bool GATHER = true;
    MoeTab tb; int nmoe, ntot, per, c, lane; const char* h2; const char* wgu; const char* wsgu; const int* list;
    __device__ __forceinline__ bool next(int i, pg8::Unit& u) const {
        const int L = i * per + c; if (L >= ntot) return false;
        if (L < nmoe) { const int nti = nmoe >> 1, tt = L % nti; const int e = __popcll(__ballot(tb.tstart[lane + 1] <= tt));
            u.e = e; u.mt = tt - tb.tstart[e]; u.pm = tt; u.pn = L / nti; u.A = h2; u.B = wgu + ((size_t)e * 512 + (size_t)u.pn * 256) * 1024; }
        else { const int s = L - nmoe; u.e = -1; u.mt = 0; u.pm = s & 63; u.pn = s >> 6; u.A = h2; u.B = wsgu + (size_t)u.pn * 256 * 1024; }
        return true; }
    __device__ __forceinline__ int row(const pg8::Unit& u, int r) const {
        if (u.e < 0) return u.pm * 256 + r;
        const int idx = u.mt * 256 + r; return idx < tb.cnt[u.e] ? (list[(size_t)u.e * LISTCAP + idx] >> 3) : 0; }
};
struct SchedMoe2 {
    static constexpr bool GATHER = false;
    MoeTab tb; int ntot, per, c, lane; const char* act; const char* wd;
    __device__ __forceinline__ bool next(int i, pg8::Unit& u) const {
        const int nti = ntot >> 2, NP = 2 * nti, R = NP / per, rem = NP - R * per; int j, half;
        if (i < 2 * R) { j = (i >> 1) * per + c; half = i & 1; }
        else { const int q = c + per * (i - 2 * R); if (q >= 2 * rem) return false; j = R * per + (q >> 1); half = q & 1; }
        const int tt = j % nti; const int e = __popcll(__ballot(tb.tstart[lane + 1] <= tt));
        u.e = e; u.mt = tt - tb.tstart[e]; u.pm = tt; u.pn = 2 * (j / nti) + half; u.A = act + (size_t)tt * 256 * 256 * 2; u.B = wd + ((size_t)e * 1024 + (size_t)u.pn * 256) * 256 * 2; return true; }
    __device__ __forceinline__ int row(const pg8::Unit&, int) const { return 0; }
};

typedef pg8::f32x4 (AccT)[2][2][4][2];
#define NO_PRE_MEMBERS static constexpr bool AFTER_DRAIN = false; struct Pre {}; __device__ __forceinline__ void prefetch(Pre&, const pg8::Unit&, int, int, int, int) const {} static constexpr bool ROWTAB = false; static constexpr int NTAB = 1; __device__ __forceinline__ const char* tab_src(const pg8::Unit&, int) const { return nullptr; }
__device__ __forceinline__ v4u pack8(const f32x4& a, const f32x4& b) { v4u w; w.x = cvt_pk_bf16(a[0], a[1]); w.y = cvt_pk_bf16(a[2], a[3]); w.z = cvt_pk_bf16(b[0], b[1]); w.w = cvt_pk_bf16(b[2], b[3]); return w; }
__device__ __forceinline__ void unpack8(const v4u& w, f32x4& a, f32x4& b) { a = (f32x4){bf_lo(w.x), bf_hi(w.x), bf_lo(w.y), bf_hi(w.y)}; b = (f32x4){bf_lo(w.z), bf_hi(w.z), bf_lo(w.w), bf_hi(w.w)}; }
__device__ __forceinline__ f32x4 sig4(const f32x4& v) { return (f32x4){sigmoidf_fast(v[0]), sigmoidf_fast(v[1]), sigmoidf_fast(v[2]), sigmoidf_fast(v[3])}; }

struct EpiIn {
    static constexpr bool PERM = true; static constexpr bool AFTER_DRAIN = false; struct Pre {}; __device__ __forceinline__ void prefetch(Pre&, const pg8::Unit&, int, int, int, int) const {}
    static constexpr bool ROWTAB = true; static constexpr int NTAB = 1;
    __device__ __forceinline__ const char* tab_src(const pg8::Unit& u, int) const { return (const char*)(sA + u.pm * 256); }
    bf16 *U, *Q, *Kb, *V, *SG; const float *gq, *gk; const float* sA; const unsigned* amax;
    __device__ __forceinline__ void operator()(const AccT& acc, const pg8::Unit& u, int wr, int wc, int fr_, int fq_, const Pre& pre, const LAS unsigned* rtab) const {
        int fr = fr_, fq = fq_; asm volatile("" : "+v"(fr), "+v"(fq));
        const int rl0 = wr * 64 + fr, row0 = u.pm * 256 + rl0, pn = u.pn; const float sW = __builtin_bit_cast(float, amax[0]) * (1.0f / 127.0f);
        if (pn < 4) {
            const int col0 = 128 * pn + 32 * wc + 8 * fq;
#pragma unroll
            for (int ai = 0; ai < 2; ++ai)
#pragma unroll
                for (int m = 0; m < 4; ++m) { const float sc = __builtin_bit_cast(float, rtab[rl0 + ai * 128 + m * 16]) * sW;
                    const f32x4 v0 = acc[ai][0][m][0] * sc * sig4(acc[ai][1][m][0] * sc), v1 = acc[ai][0][m][1] * sc * sig4(acc[ai][1][m][1] * sc);
                    *(v4u*)(U + (size_t)(row0 + ai * 128 + m * 16) * CONVD + col0) = pack8(v0, v1); }
        } else if (pn < 8) {
            const bool isk = pn >= 6; const int head = 4 * ((pn - 4) & 1) + wc; const float* g = isk ? gk : gq; bf16* dst = isk ? Kb : Q; const float qsc = isk ? 1.0f : C2Q;
            f32x4 gv[2][2];
#pragma unroll
            for (int bj = 0; bj < 2; ++bj)
#pragma unroll
                for (int n = 0; n < 2; ++n) gv[bj][n] = *(const f32x4*)(g + 32 * bj + 8 * fq + 4 * n) * qsc;
#pragma unroll
            for (int ai = 0; ai < 2; ++ai)
#pragma unroll
                for (int m = 0; m < 4; ++m) { const float sc = __builtin_bit_cast(float, rtab[rl0 + ai * 128 + m * 16]) * sW; float ss = 0.f;
#pragma unroll
                    for (int bj = 0; bj < 2; ++bj)
#pragma unroll
                        for (int n = 0; n < 2; ++n) { const f32x4 x = acc[ai][bj][m][n]; ss += (x[0] * x[0] + x[1] * x[1]) + (x[2] * x[2] + x[3] * x[3]); }
                    ss += __shfl_xor(ss, 16); ss += __shfl_xor(ss, 32);
                    const float r = sc / sqrtf(ss * (sc * sc) * (1.0f / 64.0f) + EPS);
                    bf16* rowp = dst + (size_t)(row0 + ai * 128 + m * 16) * ATT + head * 64 + 8 * fq;
#pragma unroll
                    for (int bj = 0; bj < 2; ++bj) *(v4u*)(rowp + 32 * bj) = pack8(acc[ai][bj][m][0] * r * gv[bj][0], acc[ai][bj][m][1] * r * gv[bj][1]); }
        } else if (pn < 10) {
            const int col0 = 256 * (pn - 8) + 32 * wc + 8 * fq;
#pragma unroll
            for (int ai = 0; ai < 2; ++ai)
#pragma unroll
                for (int m = 0; m < 4; ++m) { const float sc = __builtin_bit_cast(float, rtab[rl0 + ai * 128 + m * 16]) * sW;
#pragma unroll
                    for (int bj = 0; bj < 2; ++bj) *(v4u*)(V + (size_t)(row0 + ai * 128 + m * 16) * ATT + col0 + 128 * bj) = pack8(acc[ai][bj][m][0] * sc, acc[ai][bj][m][1] * sc); }
        } else {
            bf16* dst = SG + (size_t)((pn - 10) >> 2) * T * DMODEL; const int col0 = 256 * ((pn - 10) & 3) + 32 * wc + 8 * fq;
#pragma unroll
            for (int ai = 0; ai < 2; ++ai)
#pragma unroll
                for (int m = 0; m < 4; ++m) { const float sc = __builtin_bit_cast(float, rtab[rl0 + ai * 128 + m * 16]) * sW;
#pragma unroll
                    for (int bj = 0; bj < 2; ++bj) *(v4u*)(dst + (size_t)(row0 + ai * 128 + m * 16) * DMODEL + col0 + 128 * bj) = pack8(sig4(acc[ai][bj][m][0] * sc), sig4(acc[ai][bj][m][1] * sc)); }
        }
    }
};
struct EpiMerge {
    static constexpr bool PERM = true; NO_PRE_MEMBERS
    const bf16* SG; bf16* MG;
    __device__ __forceinline__ void operator()(const AccT& acc, const pg8::Unit& u, int wr, int wc, int fr_, int fq_, const Pre& pre, const LAS unsigned* rtab) const {
        int fr = fr_, fq = fq_; asm volatile("" : "+v"(fr), "+v"(fq));
        const int row0 = u.pm * 256 + wr * 64 + fr, col0 = u.pn * 256 + 32 * wc + 8 * fq; const bf16* sg = SG + (size_t)u.e * T * DMODEL;
#pragma unroll
        for (int ai = 0; ai < 2; ++ai)
#pragma unroll
            for (int m = 0; m < 4; ++m)
#pragma unroll
                for (int bj = 0; bj < 2; ++bj) { const size_t off = (size_t)(row0 + ai * 128 + m * 16) * DMODEL + col0 + 128 * bj;
                    f32x4 g0, g1; unpack8(*(const v4u*)(sg + off), g0, g1);
                    f32x4 v0 = g0 * acc[ai][bj][m][0], v1 = g1 * acc[ai][bj][m][1];
                    if (u.e) { f32x4 p0, p1; unpack8(*(const v4u*)(MG + off), p0, p1); v0 += p0; v1 += p1; }
                    *(v4u*)(MG + off) = pack8(v0, v1); }
    }
};
struct EpiX1 {
    static constexpr bool PERM = true; static constexpr bool AFTER_DRAIN = true; struct Pre {}; __device__ __forceinline__ void prefetch(Pre&, const pg8::Unit&, int, int, int, int) const {}
    static constexpr bool ROWTAB = false; static constexpr int NTAB = 1; __device__ __forceinline__ const char* tab_src(const pg8::Unit&, int) const { return nullptr; }
    const float* x; float* out; const float* mod; float* ssq; float* xmx;
    __device__ __forceinline__ void operator()(const AccT&, const pg8::Unit&, int, int, int, int, const Pre&, const LAS unsigned*) const {}
    __device__ __forceinline__ void fused(const AccT& acc, const pg8::Unit& u, int wr, int wc, int fr, int fq, LAS unsigned char* lds) const;
};
struct EpiGlu {
    static constexpr bool PERM = true;
    bf16 *ACT, *SACT; const float* wlist; const float* slist; const float* sA2; const unsigned* amax; MoeTab tb;
    struct Pre {}; __device__ __forceinline__ void prefetch(Pre&, const pg8::Unit&, int, int, int, int) const {}
    static constexpr bool AFTER_DRAIN = false;
    static constexpr bool ROWTAB = true; static constexpr int NTAB = 2;
    __device__ __forceinline__ const char* tab_src(const pg8::Unit& u, int t) const {
        if (u.e >= 0) return (const char*)((t ? slist : wlist) + (size_t)u.e * LISTCAP + u.mt * 256);
        return t ? (const char*)(sA2 + u.pm * 256) : nullptr; }
    __device__ __forceinline__ void operator()(const AccT& acc, const pg8::Unit& u, int wr, int wc, int fr_, int fq_, const Pre& pre, const LAS unsigned* rtab) const {
        int fr = fr_, fq = fq_; asm volatile("" : "+v"(fr), "+v"(fq));
        const int rl0 = wr * 64 + fr, col0 = 128 * u.pn + 32 * wc + 8 * fq; bf16* dst = (u.e >= 0 ? ACT : SACT) + (size_t)u.pm * 256 * EF;
        const int cnt = u.e >= 0 ? tb.cnt[u.e] : 0; const float sW = __builtin_bit_cast(float, amax[u.e >= 0 ? 2 + u.e : 1]) * ((u.e >= 0 ? WGU_MARGIN : 1.0f) / 127.0f);
#pragma unroll
        for (int ai = 0; ai < 2; ++ai)
#pragma unroll
            for (int m = 0; m < 4; ++m) { const int rl = rl0 + ai * 128 + m * 16; const bool valid = (u.e < 0) || (u.mt * 256 + rl < cnt);
                const float w = (u.e >= 0) ? (valid ? __builtin_bit_cast(float, rtab[rl]) : 0.0f) : 1.0f, gsc = valid ? __builtin_bit_cast(float, rtab[256 + rl]) * sW : 0.0f;
                const f32x4 g0 = acc[ai][0][m][0] * gsc, g1 = acc[ai][0][m][1] * gsc;
                const f32x4 v0 = g0 * sig4(g0) * acc[ai][1][m][0] * (w * gsc), v1 = g1 * sig4(g1) * acc[ai][1][m][1] * (w * gsc);
                *(v4u*)(dst + (size_t)rl * EF + col0) = pack8(v0, v1); asm volatile("" ::: "memory"); }
    }
};
struct EpiSlab {
    static constexpr bool PERM = true;
    unsigned char* SLAB; const int* list; MoeTab tb;
    struct Pre {}; __device__ __forceinline__ void prefetch(Pre&, const pg8::Unit&, int, int, int, int) const {}
    static constexpr bool AFTER_DRAIN = false;
    static constexpr bool ROWTAB = true; static constexpr int NTAB = 1;
    __device__ __forceinline__ const char* tab_src(const pg8::Unit& u, int) const { return (const char*)(list + (size_t)u.e * LISTCAP + u.mt * 256); }
    __device__ __forceinline__ void operator()(const AccT& acc, const pg8::Unit& u, int wr, int wc, int fr_, int fq_, const Pre& pre, const LAS unsigned* rtab) const {
        int fr = fr_, fq = fq_; asm volatile("" : "+v"(fr), "+v"(fq));
        const int col0 = 256 * u.pn + 64 * wc + 8 * fq;
#pragma unroll
        for (int ai = 0; ai < 2; ++ai)
#pragma unroll
            for (int m = 0; m < 4; ++m) { const int rl = wr * 64 + fr + ai * 128 + m * 16; const int slot = (int)rtab[rl];
                if (u.mt * 256 + rl < tb.cnt[u.e]) { unsigned char* rowp = SLAB + (size_t)slot * DMODEL + col0;
#pragma unroll
                    for (int bj = 0; bj < 2; ++bj) { const f32x4 a0 = acc[ai][bj][m][0] * SLABSCALE, a1 = acc[ai][bj][m][1] * SLABSCALE;
#if defined(P8_ABL)
                        { v2u t_ = (v2u){pk4_fp8(a0[0], a0[1], a0[2], a0[3]), pk4_fp8(a1[0], a1[1], a1[2], a1[3])}; asm volatile("" :: "v"(t_.x), "v"(t_.y), "v"(rowp)); }
#else
                        *(v2u*)(rowp + 32 * bj) = (v2u){pk4_fp8(a0[0], a0[1], a0[2], a0[3]), pk4_fp8(a1[0], a1[1], a1[2], a1[3])};
#endif
                    } }
                asm volatile("" ::: "memory"); }
    }
};
__device__ __forceinline__ void park_tile(const AccT& acc, LAS unsigned char* lds, int wr, int wc, int fr, int fq) {
#pragma unroll
    for (int ai = 0; ai < 2; ++ai)
#pragma unroll
        for (int m = 0; m < 4; ++m) { const int row = 128 * ai + 64 * wr + 16 * m + fr;
#pragma unroll
            for (int bj = 0; bj < 2; ++bj) { const int c16 = 16 * bj + 4 * wc + fq; *(LAS v4u*)(lds + row * 512 + ((c16 ^ (row & 31)) << 4)) = pack8(acc[ai][bj][m][0], acc[ai][bj][m][1]); } }
    asm volatile("s_waitcnt lgkmcnt(0)" ::: "memory"); __builtin_amdgcn_s_barrier(); asm volatile("" ::: "memory");
}
struct EpiFinal {
    static constexpr bool PERM = true; static constexpr bool AFTER_DRAIN = true; struct Pre {}; __device__ __forceinline__ void prefetch(Pre&, const pg8::Unit&, int, int, int, int) const {}
    static constexpr bool ROWTAB = false; static constexpr int NTAB = 1; __device__ __forceinline__ const char* tab_src(const pg8::Unit&, int) const { return nullptr; }
    float* out; const unsigned char* SLAB; const float* mod;
    __device__ __forceinline__ void operator()(const AccT&, const pg8::Unit&, int, int, int, int, const Pre&, const LAS unsigned*) const {}
    __device__ __forceinline__ void fused(const AccT& acc, const pg8::Unit& u, int wr, int wc, int fr, int fq, LAS unsigned char* lds) const {
        typedef float f32x2v __attribute__((ext_vector_type(2)));
        park_tile(acc, lds, wr, wc, fr, fq);
        const int tid = threadIdx.x, wave = tid >> 6, lane = tid & 63, hl = lane >> 5, i = lane & 31;
        const int col0 = 128 * ((i >> 2) & 1) + 32 * (i >> 3) + 8 * (i & 3);
        const float* g2 = mod + (size_t)(u.pm >> 5) * 6144 + 5120 + u.pn * 256 + col0;
        const f32x4 gv0 = *(const f32x4*)g2, gv1 = *(const f32x4*)(g2 + 4);
#pragma unroll 4
        for (int s = 0; s < 16; ++s) { const int rl = 32 * wave + 2 * s + hl; const size_t row = (size_t)u.pm * 256 + rl;
            const unsigned char* sp = SLAB + row * TOPK * DMODEL + u.pn * 256 + 8 * i;
            v2u sv[TOPK];
#if FWD_LEVEL >= 2
#pragma unroll
            for (int k = 0; k < TOPK; ++k) sv[k] = *(const v2u*)(sp + (size_t)k * DMODEL);
#endif
            float* op = out + row * DMODEL + u.pn * 256 + col0; const f32x4 x0 = *(const f32x4*)op, x1v = *(const f32x4*)(op + 4);
            f32x4 a0, a1; { const v4u pk_ = *(const LAS v4u*)(lds + rl * 512 + ((((col0 >> 3)) ^ (rl & 31)) << 4)); unpack8(pk_, a0, a1); }
            f32x4 s0 = (f32x4){0.f, 0.f, 0.f, 0.f}, s1 = s0;
#if FWD_LEVEL >= 2
#pragma unroll
            for (int k = 0; k < TOPK; ++k) { const f32x2v a = __builtin_amdgcn_cvt_pk_f32_fp8((int)sv[k].x, false), b = __builtin_amdgcn_cvt_pk_f32_fp8((int)sv[k].x, true), c = __builtin_amdgcn_cvt_pk_f32_fp8((int)sv[k].y, false), d = __builtin_amdgcn_cvt_pk_f32_fp8((int)sv[k].y, true);
                s0 += (f32x4){a[0], a[1], b[0], b[1]}; s1 += (f32x4){c[0], c[1], d[0], d[1]}; }
#endif
            s0 = s0 * (1.0f / SLABSCALE) + a0; s1 = s1 * (1.0f / SLABSCALE) + a1;
            *(f32x4*)op = x0 + gv0 * s0; *(f32x4*)(op + 4) = x1v + gv1 * s1; }
    }
};
__device__ __forceinline__ void EpiX1::fused(const AccT& acc, const pg8::Unit& u, int wr, int wc, int fr, int fq, LAS unsigned char* lds) const {
    park_tile(acc, lds, wr, wc, fr, fq);
    const int tid = threadIdx.x, wave = tid >> 6, lane = tid & 63, hl = lane >> 5, i = lane & 31;
    const float* g1 = mod + (size_t)(u.pm >> 5) * 6144 + 2048 + u.pn * 256 + 8 * i;
    const f32x4 gv0 = *(const f32x4*)g1, gv1 = *(const f32x4*)(g1 + 4);
#pragma unroll 4
    for (int s = 0; s < 16; ++s) { const int rl = 32 * wave + 2 * s + hl; const size_t off = ((size_t)u.pm * 256 + rl) * DMODEL + u.pn * 256 + 8 * i;
        const f32x4 x0 = *(const f32x4*)(x + off), x1v = *(const f32x4*)(x + off + 4);
        f32x4 a0, a1; { const v4u pk_ = *(const LAS v4u*)(lds + rl * 512 + ((i ^ (rl & 31)) << 4)); unpack8(pk_, a0, a1); }
        const f32x4 v0 = x0 + gv0 * a0, v1 = x1v + gv1 * a1;
        *(f32x4*)(out + off) = v0; *(f32x4*)(out + off + 4) = v1;
        float ss = ((v0[0] * v0[0] + v0[1] * v0[1]) + (v0[2] * v0[2] + v0[3] * v0[3])) + ((v1[0] * v1[0] + v1[1] * v1[1]) + (v1[2] * v1[2] + v1[3] * v1[3]));
        float mx = fmaxf(fmaxf(fmaxf(fabsf(v0[0]), fabsf(v0[1])), fmaxf(fabsf(v0[2]), fabsf(v0[3]))), fmaxf(fmaxf(fabsf(v1[0]), fabsf(v1[1])), fmaxf(fabsf(v1[2]), fabsf(v1[3]))));
        ss += __shfl_xor(ss, 1); ss += __shfl_xor(ss, 2); ss += __shfl_xor(ss, 4); ss += __shfl_xor(ss, 8); ss += __shfl_xor(ss, 16);
        mx = fmaxf(mx, __shfl_xor(mx, 1)); mx = fmaxf(mx, __shfl_xor(mx, 2)); mx = fmaxf(mx, __shfl_xor(mx, 4)); mx = fmaxf(mx, __shfl_xor(mx, 8)); mx = fmaxf(mx, __shfl_xor(mx, 16));
        if (i == 0) { ssq[(size_t)u.pn * T + (size_t)u.pm * 256 + rl] = ss; xmx[(size_t)u.pn * T + (size_t)u.pm * 256 + rl] = mx; } }
}


__device__ __forceinline__ void p6_item(const KArgs& a, LAS unsigned char* lds, int item, int tid, int wave, int lane) {
    unsigned char* ws = a.ws;
    const int row0 = 32 * item, r = lane & 31, h = lane >> 5, row = row0 + r, b = row >> 13;
    const float* x1 = a.out; const float* ssq = (const float*)(ws + WS_SSQ); const float* mod = (const float*)(ws + WS_MOD) + (size_t)b * 6144;
    unsigned char* H2 = ws + WS_H2;
    const bf16* WRH = (const bf16*)(ws + WS_WRH); const bf16* WRL = (const bf16*)(ws + WS_WRL);
    constexpr int WREG = 9216, TROW = 144;
    LAS unsigned char* wreg = lds + RING_OFF + wave * WREG;
    LAS float* scl = (LAS float*)(lds + RING_OFF + 8 * WREG);
    LAS float* bil = scl + 32 * 65;
    LAS int* hist = (LAS int*)(bil + 32 * 65);
    LAS int* gbase = hist + 512;
    LAS float* rstl = (LAS float*)(gbase + 64);
    if (tid < 32) { float ss = 0.f;
#pragma unroll
        for (int p = 0; p < 4; ++p) ss += ssq[(size_t)p * T + row0 + tid];
        rstl[tid] = 1.0f / sqrtf(ss * (1.0f / DMODEL) + EPS); }
    const int lr = lane >> 4, lc4 = (lane & 15) * 4;
    __syncthreads();
    f32x16 acc0, acc1;
#pragma unroll
    for (int i = 0; i < 16; ++i) { acc0[i] = 0.f; acc1[i] = 0.f; }
#pragma nounroll
    for (int ms = 0; ms < 2; ++ms) {
        const int kb = 128 * wave + 64 * ms;
        f32x4 xv[8];
#pragma unroll
        for (int i = 0; i < 8; ++i) xv[i] = *(const f32x4*)(x1 + (size_t)(row0 + 4 * i + lr) * DMODEL + kb + lc4);
        const f32x4 gs = *(const f32x4*)(a.in[16] + kb + lc4) * (1.0f + *(const f32x4*)(mod + 4096 + kb + lc4)), sh = *(const f32x4*)(mod + 3072 + kb + lc4);
#pragma unroll
        for (int i = 0; i < 8; ++i) { const int rr = 4 * i + lr; const f32x4 hv = xv[i] * rstl[rr] * gs + sh;
            const unsigned h0 = f2bf(hv[0]), h1_ = f2bf(hv[1]), h2_ = f2bf(hv[2]), h3 = f2bf(hv[3]);
            const v2u whi = (v2u){h0 | (h1_ << 16), h2_ | (h3 << 16)};
            const v2u wlo = (v2u){pk2(hv[0] - bf2f(h0), hv[1] - bf2f(h1_)), pk2(hv[2] - bf2f(h2_), hv[3] - bf2f(h3))};
#if MOE_FP8
            *(GAS unsigned*)(H2 + (size_t)(row0 + rr) * DMODEL + kb + lc4) = pk4_fp8(hv[0], hv[1], hv[2], hv[3]);
#else
            *(GAS v2u*)(H2 + ((size_t)(row0 + rr) * DMODEL + kb + lc4) * 2) = whi;
#endif
            *(LAS v2u*)(wreg + rr * TROW + lc4 * 2) = whi; *(LAS v2u*)(wreg + 32 * TROW + rr * TROW + lc4 * 2) = wlo; }
#pragma unroll
        for (int sp = 0; sp < 2; ++sp) {
            bf16x8 bh0[2], bh1[2], bl0[2], bl1[2];
#pragma unroll
            for (int s2 = 0; s2 < 2; ++s2) { const size_t o = (size_t)r * DMODEL + kb + 16 * (2 * sp + s2) + 8 * h;
                bh0[s2] = *(const bf16x8*)(WRH + o); bh1[s2] = *(const bf16x8*)(WRH + o + 32 * DMODEL); bl0[s2] = *(const bf16x8*)(WRL + o); bl1[s2] = *(const bf16x8*)(WRL + o + 32 * DMODEL); }
#pragma unroll
            for (int s2 = 0; s2 < 2; ++s2) { const int s_ = 2 * sp + s2;
                const bf16x8 ahi = *(const LAS bf16x8*)(wreg + r * TROW + (16 * s_ + 8 * h) * 2), alo = *(const LAS bf16x8*)(wreg + 32 * TROW + r * TROW + (16 * s_ + 8 * h) * 2);
                acc0 = __builtin_amdgcn_mfma_f32_32x32x16_bf16(alo, bh0[s2], acc0, 0, 0, 0); acc1 = __builtin_amdgcn_mfma_f32_32x32x16_bf16(alo, bh1[s2], acc1, 0, 0, 0);
                acc0 = __builtin_amdgcn_mfma_f32_32x32x16_bf16(ahi, bl0[s2], acc0, 0, 0, 0); acc1 = __builtin_amdgcn_mfma_f32_32x32x16_bf16(ahi, bl1[s2], acc1, 0, 0, 0);
                acc0 = __builtin_amdgcn_mfma_f32_32x32x16_bf16(ahi, bh0[s2], acc0, 0, 0, 0); acc1 = __builtin_amdgcn_mfma_f32_32x32x16_bf16(ahi, bh1[s2], acc1, 0, 0, 0); }
            asm volatile("" ::: "memory");
        }
        asm volatile("" ::: "memory");
    }
    { LAS float* part = (LAS float*)wreg;
#pragma unroll
      for (int i = 0; i < 16; ++i) { const int tr = (i & 3) + 8 * (i >> 2) + 4 * h; part[tr * 64 + r] = acc0[i]; part[tr * 64 + 32 + r] = acc1[i]; } }
    __syncthreads();
    {
        const int tr = tid >> 4, e4 = (tid & 15) * 4; f32x4 s = *(const LAS f32x4*)(lds + RING_OFF + tr * 256 + e4 * 4);
#pragma unroll
        for (int w = 1; w < 8; ++w) s += *(const LAS f32x4*)(lds + RING_OFF + w * WREG + tr * 256 + e4 * 4);
        const f32x4 rb = *(const f32x4*)(a.in[18] + e4);
#pragma unroll
        for (int j = 0; j < 4; ++j) { const float sc = 1.0f / (1.0f + expf(-s[j])); scl[tr * 65 + e4 + j] = sc; bil[tr * 65 + e4 + j] = sc + rb[j]; }
    }
    __syncthreads();
    LAS int* selk = (LAS int*)(rstl + 32); LAS float* selw = (LAS float*)(selk + 32 * 64);
    int lc = 0;
#pragma nounroll
    for (int j = 0; j < 4; ++j) {
        const int tr = wave * 4 + j; const float v = bil[tr * 65 + lane], sc = scl[tr * 65 + lane];
        int rk = 0;
#pragma unroll
        for (int d = 1; d < 8; ++d) { const int src = (lane & ~7) | ((lane + d) & 7); const float o = __shfl(v, src); rk += (o > v) || (o == v && src < lane); }
        float t2 = rk < 2 ? v : 0.f; t2 += __shfl_xor(t2, 1); t2 += __shfl_xor(t2, 2); t2 += __shfl_xor(t2, 4);
        int grk = 0; const int g = lane >> 3;
#pragma unroll
        for (int g2 = 0; g2 < 8; ++g2) { const float og = __builtin_bit_cast(float, __builtin_amdgcn_readlane(__builtin_bit_cast(int, t2), g2 * 8)); grk += (og > t2) || (og == t2 && g2 < g); }
        const bool gsel = grk < 4;
        const float c = gsel ? v : -INFINITY; int erk = 0;
#pragma nounroll
        for (int e2 = 0; e2 < 64; ++e2) { const float oc = __builtin_bit_cast(float, __builtin_amdgcn_readlane(__builtin_bit_cast(int, c), e2)); erk += (oc > c) || (oc == c && e2 < lane); }
        const bool sel = gsel && erk < TOPK;
        const float wsum = wave_sum(sel ? sc : 0.f);
        selk[tr * 64 + lane] = sel ? erk : -1; selw[tr * 64 + lane] = sc * (ROUTED_SCALE / wsum); lc += sel ? 1 : 0;
    }
    hist[wave * 64 + lane] = lc;
    __syncthreads();
    if (wave == 0) { int tot = 0;
#pragma unroll
        for (int w = 0; w < 8; ++w) tot += hist[w * 64 + lane];
        gbase[lane] = tot ? (int)__hip_atomic_fetch_add((unsigned*)(ws + WS_CTL) + CW_CNT + 64 * lane, (unsigned)tot, RLX_AGENT) : 0; }
    __syncthreads();
    {   int base = gbase[lane];
        for (int w = 0; w < wave; ++w) base += hist[w * 64 + lane];
        int* list = (int*)(ws + WS_LIST); float* wl = (float*)(ws + WS_WLIST);
#pragma unroll
        for (int j = 0; j < 4; ++j) { const int tr = wave * 4 + j, k = selk[tr * 64 + lane]; if (k >= 0) { const size_t p = (size_t)lane * LISTCAP + base; list[p] = (row0 + tr) * TOPK + k; wl[p] = selw[tr * 64 + lane]; ++base; } } }
    __syncthreads();
}

__device__ __forceinline__ float p6_rank_slow(float c, int lane) {
    int erk = 0;
#pragma nounroll
    for (int e2 = 0; e2 < 64; ++e2) { const float oc = __builtin_bit_cast(float, __builtin_amdgcn_readlane(__builtin_bit_cast(int, c), e2)); erk += (oc > c) || (oc == c && e2 < lane); }
    return (float)erk;
}
__device__ __forceinline__ void p6_block(const KArgs& a, LAS unsigned char* lds, int vcu, int tid, int wave, int lane) {
    unsigned char* ws = a.ws;
    const int rowb = 64 * vcu + 8 * wave, b = (64 * vcu) >> 13;
    const float* x1 = a.out; const float* ssq = (const float*)(ws + WS_SSQ); const float* mod = (const float*)(ws + WS_MOD) + (size_t)b * 6144;
    unsigned char* H2 = ws + WS_H2;
    const bf16* WRH = (const bf16*)(ws + WS_WRH); const bf16* WRL = (const bf16*)(ws + WS_WRL);
    constexpr int RS = 272, BSH = 64 * RS, BSB = 2 * BSH;
    LAS unsigned char* BS = lds + RING_OFF;
    LAS unsigned char* AW = lds + RING_OFF + 2 * BSB + wave * (2 * 8 * RS);
    LAS int* hist = (LAS int*)(lds + RING_OFF + 2 * BSB + 8 * (2 * 8 * RS)); LAS int* gbase = hist + 512;
    float rs_l = 0.f;
    if (lane < 8) { float ss = 0.f;
#pragma unroll
        for (int p = 0; p < 4; ++p) ss += ssq[(size_t)p * T + rowb + lane];
        rs_l = 1.0f / sqrtf(ss * (1.0f / DMODEL) + EPS); }
    float gmx = 0.f, smx = 0.f;
#pragma unroll
    for (int q = 0; q < 4; ++q) { const f32x4 gq_ = *(const f32x4*)(a.in[16] + 4 * lane + 256 * q) * (1.0f + *(const f32x4*)(mod + 4096 + 4 * lane + 256 * q)), sq_ = *(const f32x4*)(mod + 3072 + 4 * lane + 256 * q);
        gmx = fmaxf(gmx, fmaxf(fmaxf(fabsf(gq_[0]), fabsf(gq_[1])), fmaxf(fabsf(gq_[2]), fabsf(gq_[3])))); smx = fmaxf(smx, fmaxf(fmaxf(fabsf(sq_[0]), fabsf(sq_[1])), fmaxf(fabsf(sq_[2]), fabsf(sq_[3])))); }
#pragma unroll
    for (int o = 1; o < 64; o <<= 1) { gmx = fmaxf(gmx, __shfl_xor(gmx, o)); smx = fmaxf(smx, __shfl_xor(smx, o)); }
    float s2_l = 1.f;
    if (lane < 8) { const float* xm = (const float*)(ws + WS_XMX); float mx = 0.f;
#pragma unroll
        for (int p = 0; p < 4; ++p) mx = fmaxf(mx, xm[(size_t)p * T + rowb + lane]);
        s2_l = fmaxf(rs_l * mx * gmx + smx, 1e-20f) * (1.0f / 127.0f); ((float*)(ws + WS_SA2))[rowb + lane] = s2_l; }
    float rstd4[4], qinv4[4];
#pragma unroll
    for (int i = 0; i < 4; ++i) { rstd4[i] = __shfl(rs_l, 2 * i + (lane >> 5)); qinv4[i] = 1.0f / __shfl(s2_l, 2 * i + (lane >> 5)); }
    const int lrow = lane >> 5, lcol = (lane & 31) * 4;
    const int fr = lane & 15, fg = lane >> 4;
    f32x4 acc[4];
#pragma unroll
    for (int nb = 0; nb < 4; ++nb) acc[nb] = (f32x4){0.f, 0.f, 0.f, 0.f};
    v4u bsA[4], bsB[4], bsC[4]; f32x4 xvA[4], xvB[4], xvC[4], gsA, gsB, gsC, shA, shB, shC;
#define P6_LOAD(S, c) do { _Pragma("unroll") for (int q = 0; q < 4; ++q) { const int idx = tid + 512 * q, e = (idx >> 4) & 63, part = idx & 15; \
            bs##S[q] = *(const v4u*)(((idx >> 10) ? WRL : WRH) + (size_t)e * DMODEL + 128 * (c) + part * 8); } \
        _Pragma("unroll") for (int i = 0; i < 4; ++i) xv##S[i] = *(const f32x4*)(x1 + (size_t)(rowb + 2 * i + lrow) * DMODEL + 128 * (c) + lcol); \
        gs##S = *(const f32x4*)(a.in[16] + 128 * (c) + lcol) * (1.0f + *(const f32x4*)(mod + 4096 + 128 * (c) + lcol)); sh##S = *(const f32x4*)(mod + 3072 + 128 * (c) + lcol); } while (0)
#define P6_BSTORE(S, buf) do { _Pragma("unroll") for (int q = 0; q < 4; ++q) { const int idx = tid + 512 * q, e = (idx >> 4) & 63, part = idx & 15; \
            *(LAS v4u*)(BS + (buf) * BSB + (idx >> 10) * BSH + e * RS + part * 16) = bs##S[q]; } } while (0)
#define P6_CONVERT(S, c) do { _Pragma("unroll") for (int i = 0; i < 4; ++i) { const int rr = 2 * i + lrow; const f32x4 hv = xv##S[i] * rstd4[i] * gs##S + sh##S; \
            const unsigned h0 = f2bf(hv[0]), h1_ = f2bf(hv[1]), h2_ = f2bf(hv[2]), h3 = f2bf(hv[3]); \
            const v2u whi = (v2u){h0 | (h1_ << 16), h2_ | (h3 << 16)}; \
            const v2u wlo = (v2u){pk2(hv[0] - bf2f(h0), hv[1] - bf2f(h1_)), pk2(hv[2] - bf2f(h2_), hv[3] - bf2f(h3))}; \
            *(GAS unsigned*)(H2 + (size_t)(rowb + rr) * DMODEL + 128 * (c) + lcol) = pk4_i8(hv[0] * qinv4[i], hv[1] * qinv4[i], hv[2] * qinv4[i], hv[3] * qinv4[i]); \
            *(LAS v2u*)(AW + rr * RS + lcol * 2) = whi; *(LAS v2u*)(AW + 8 * RS + rr * RS + lcol * 2) = wlo; } } while (0)
#if defined(P6_ABL) && P6_ABL == 4
#define P6_MMA(c) do { } while (0)
#else
#define P6_MMA(c) do { const LAS unsigned char* bsl = BS + ((c) & 1) * BSB; _Pragma("unroll") for (int ks = 0; ks < 4; ++ks) { \
            const bf16x8 ahi = *(const LAS bf16x8*)(AW + (fr & 7) * RS + (32 * ks + 8 * fg) * 2), alo = *(const LAS bf16x8*)(AW + 8 * RS + (fr & 7) * RS + (32 * ks + 8 * fg) * 2); \
            _Pragma("unroll") for (int nb = 0; nb < 4; ++nb) { const bf16x8 bh = *(const LAS bf16x8*)(bsl + (16 * nb + fr) * RS + (32 * ks + 8 * fg) * 2), bl = *(const LAS bf16x8*)(bsl + BSH + (16 * nb + fr) * RS + (32 * ks + 8 * fg) * 2); \
                acc[nb] = __builtin_amdgcn_mfma_f32_16x16x32_bf16(alo, bh, acc[nb], 0, 0, 0); acc[nb] = __builtin_amdgcn_mfma_f32_16x16x32_bf16(ahi, bl, acc[nb], 0, 0, 0); acc[nb] = __builtin_amdgcn_mfma_f32_16x16x32_bf16(ahi, bh, acc[nb], 0, 0, 0); } } } while (0)
#endif
#if defined(P6_ABL) && P6_ABL == 2
    return;
#endif
    P6_LOAD(A, 0); P6_LOAD(B, 1); P6_LOAD(C, 2); P6_BSTORE(A, 0);
    __syncthreads();
    P6_CONVERT(A, 0); P6_LOAD(A, 3); P6_MMA(0); P6_BSTORE(B, 1); __syncthreads();
    P6_CONVERT(B, 1); P6_LOAD(B, 4); P6_MMA(1); P6_BSTORE(C, 0); __syncthreads();
    P6_CONVERT(C, 2); P6_LOAD(C, 5); P6_MMA(2); P6_BSTORE(A, 1); __syncthreads();
    P6_CONVERT(A, 3); P6_LOAD(A, 6); P6_MMA(3); P6_BSTORE(B, 0); __syncthreads();
    P6_CONVERT(B, 4); P6_LOAD(B, 7); P6_MMA(4); P6_BSTORE(C, 1); __syncthreads();
    P6_CONVERT(C, 5); P6_MMA(5); P6_BSTORE(A, 0); __syncthreads();
    P6_CONVERT(A, 6); P6_MMA(6); P6_BSTORE(B, 1); __syncthreads();
    P6_CONVERT(B, 7); P6_MMA(7); __syncthreads();
#undef P6_LOAD
#undef P6_BSTORE
#undef P6_CONVERT
#undef P6_MMA
#if defined(P6_ABL) && P6_ABL == 1
    { if (fg < 2 && acc[0][0] == 12345.f) a.out[1] = acc[1][1] + acc[2][2] + acc[3][3]; return; }
#endif
    LAS float* LG = (LAS float*)AW;
    if (fg < 2) {
#pragma unroll
        for (int nb = 0; nb < 4; ++nb)
#pragma unroll
            for (int r = 0; r < 4; ++r) LG[(4 * fg + r) * 64 + 16 * nb + fr] = acc[nb][r];
    }
    LAS float* RSW = (LAS float*)(BS + wave * 8192);
    const float rbias = a.in[18][lane];
    int selk[8]; float selw[8]; int lc = 0;
#if defined(P6_ABL) && P6_ABL >= 3
#pragma unroll
    for (int j = 0; j < 8; ++j) { const bool sel = (lane >> 3) == j; selk[j] = sel ? (lane & 7) : -1; selw[j] = 0.3125f + 1e-9f * LG[j * 64 + lane] + 0.f * rbias; lc += sel ? 1 : 0; }
#else
#pragma unroll
    for (int j = 0; j < 8; ++j) {
        LAS float* Vb = RSW + j * 160; LAS float* Cb = Vb + 64; LAS float* Gb = Vb + 128; LAS float* Tb = Vb + 136;
        const float sc = 1.0f / (1.0f + expf(-LG[j * 64 + lane])), v = sc + rbias;
        Vb[lane] = v;
        const f32x4 ga = *(const LAS f32x4*)(Vb + (lane & ~7)), gb = *(const LAS f32x4*)(Vb + (lane & ~7) + 4);
        float m1 = -INFINITY, m2 = -INFINITY;
#pragma unroll
        for (int q = 0; q < 8; ++q) { const float o = q < 4 ? ga[q] : gb[q - 4]; if (o > m1) { m2 = m1; m1 = o; } else if (o > m2) m2 = o; }
        const float gs = m1 + m2;
        if ((lane & 7) == 0) Gb[lane >> 3] = gs;
        const f32x4 sa = *(const LAS f32x4*)Gb, sb = *(const LAS f32x4*)(Gb + 4);
        int grk = 0; const int g = lane >> 3;
#pragma unroll
        for (int g2 = 0; g2 < 8; ++g2) { const float og = g2 < 4 ? sa[g2] : sb[g2 - 4]; grk += (og > gs) || (og == gs && g2 < g); }
        const bool gsel = grk < 4; const float cnd = gsel ? v : -INFINITY;
        Cb[lane] = cnd;
        int gt = 0, eq = 0;
#pragma unroll
        for (int q = 0; q < 16; ++q) { const f32x4 o = *(const LAS f32x4*)(Cb + 4 * q);
            gt += (o[0] > cnd) + (o[1] > cnd) + (o[2] > cnd) + (o[3] > cnd); eq += (o[0] == cnd) + (o[1] == cnd) + (o[2] == cnd) + (o[3] == cnd); }
        int erk = gt;
        if (__builtin_expect(__any(gsel && eq > 1), 0)) erk = (int)p6_rank_slow(cnd, lane);
        const bool sel = gsel && erk < TOPK;
        if (sel) Tb[erk] = sc;
        const f32x4 ta = *(const LAS f32x4*)Tb, tb_ = *(const LAS f32x4*)(Tb + 4);
        const float wsum = ((ta[0] + ta[1]) + (ta[2] + ta[3])) + ((tb_[0] + tb_[1]) + (tb_[2] + tb_[3]));
        selk[j] = sel ? erk : -1; selw[j] = sc * (ROUTED_SCALE / wsum); lc += sel ? 1 : 0;
    }
#endif
    hist[wave * 64 + lane] = lc;
    __syncthreads();
    if (wave == 0) { int tot = 0;
#pragma unroll
        for (int w = 0; w < 8; ++w) tot += hist[w * 64 + lane];
        gbase[lane] = tot ? (int)__hip_atomic_fetch_add((unsigned*)(ws + WS_CTL) + CW_CNT + 64 * lane, (unsigned)tot, RLX_AGENT) : 0; }
    __syncthreads();
    {   int base = gbase[lane];
        for (int w = 0; w < wave; ++w) base += hist[w * 64 + lane];
        int* list = (int*)(ws + WS_LIST); float* wl = (float*)(ws + WS_WLIST); float* sl = (float*)(ws + WS_SLIST);
#pragma unroll
        for (int j = 0; j < 8; ++j) { const float s2j = __shfl(s2_l, j); if (selk[j] >= 0) { const size_t p = (size_t)lane * LISTCAP + base; list[p] = (rowb + j) * TOPK + selk[j]; wl[p] = selw[j]; sl[p] = s2j; ++base; } } }
    __syncthreads();
}

constexpr int WD_SPLIT = 3584;
__device__ __forceinline__ void moe_tables(const KArgs& a, LAS unsigned char* lds, int tid, int lane) {
    LAS int* tstart = (LAS int*)(lds + TAB_OFF); LAS int* cntl = tstart + 80;
    if (tid < 64) { const int c = (int)__hip_atomic_load((unsigned*)(a.ws + WS_CTL) + CW_CNT + 64 * tid, RLX_AGENT); const int tl = (c + 255) >> 8; int sc = tl;
#pragma unroll
        for (int o = 1; o < 64; o <<= 1) { const int up = __shfl_up(sc, o); if (lane >= o) sc += up; }
        cntl[tid] = c; tstart[tid + 1] = sc; if (tid == 0) tstart[0] = 0; }
    __syncthreads();
}

__global__ void __launch_bounds__(NWAVES * 64, 2) fox_fwd(KArgs args) {
    extern __shared__ __attribute__((aligned(16))) unsigned char lds_raw[];
    LAS unsigned char* lds = (LAS unsigned char*)lds_raw;
    volatile LAS unsigned* MISC = (volatile LAS unsigned*)(lds + MISC_OFF);
    const int tid = threadIdx.x, lane = tid & 63, wave = __builtin_amdgcn_readfirstlane(tid >> 6);
    const int G = gridDim.x; int vcu; { const int bx = blockIdx.x; vcu = (G % 8 == 0) ? (bx % 8) * (G / 8) + bx / 8 : bx; }
    unsigned char* ws = args.ws; gu32* ctl = (gu32*)(ws + WS_CTL);
    for (int u = tid; u < (LDS_BYTES - LDSCTL_OFF) / 4; u += NWAVES * 64) ((LAS unsigned*)(lds + LDSCTL_OFF))[u] = 0u;
    __syncthreads();
    const int lo = args.ph_lo, hi = args.ph_hi; const bool single = (hi - lo) > 1;
    XcdBarrier bar; bar.bar = (unsigned*)(ctl + CW_BAR); bar.x = 0; bar.st = nullptr;
    if (single) bar = xcd_barrier_post((unsigned*)(ctl + CW_BAR), MISC + 8);
#ifndef PHASE_MASK
#define PHASE_MASK 0x3ff
#endif
#define IN(k) (((PHASE_MASK >> (k)) & 1) && lo <= (k) && (k) < hi)
#ifndef DIAG_BLK
#define DIAG_BLK 0
#endif
#if defined(DIAG_A)
    unsigned long long* dstamp = (unsigned long long*)(ws + WS_CTL + 512 * 1024);
#define GRID_BAR(k) do { if (IN(k) && IN((k) + 1)) xcd_barrier(bar); if (blockIdx.x == 0 && tid == 0) dstamp[(k) + 1] = __builtin_amdgcn_s_memrealtime(); } while (0)
    if (blockIdx.x == 0 && tid == 0) dstamp[0] = __builtin_amdgcn_s_memrealtime();
#else
#define GRID_BAR(k) do { if (IN(k) && IN((k) + 1)) xcd_barrier(bar); } while (0)
#endif
    bf16* H1 = (bf16*)(ws + WS_H1); bf16* Ub = (bf16*)(ws + WS_U); bf16* Qb = (bf16*)(ws + WS_Q); bf16* Kb = (bf16*)(ws + WS_K); bf16* Vb = (bf16*)(ws + WS_V);
    bf16* SG = (bf16*)(ws + WS_SG); bf16* UC = (bf16*)(ws + WS_UC); bf16* Ob = (bf16*)(ws + WS_O); bf16* MG = (bf16*)(ws + WS_MG);
    const float* mod = (const float*)(ws + WS_MOD);

#if FWD_LEVEL == 0
    if (IN(0)) { const f32x4* xs = (const f32x4*)args.in[0]; f32x4* od = (f32x4*)args.out;
        for (size_t i = (size_t)blockIdx.x * 512 + tid; i < (size_t)T * DMODEL / 4; i += (size_t)G * 512) od[i] = xs[i]; }
    for (int k = 0; k < 9; ++k) GRID_BAR(k);
#else
    if (IN(0)) p0_prologue(args, lds, vcu, G, wave, lane);
#if defined(DIAG_A)
    if (blockIdx.x == DIAG_BLK && tid == 0) dstamp[24] = __builtin_amdgcn_s_memrealtime();
#endif
    GRID_BAR(0);
    if (IN(1)) { if (G == 256) p1_rows(args, lds, vcu, tid, wave, lane); __syncthreads();
#if defined(DIAG_A)
        if (blockIdx.x == DIAG_BLK && tid == 0) dstamp[25] = __builtin_amdgcn_s_memrealtime();
#endif
        q8_items(args, lds, vcu, G, wave, lane);
#if defined(DIAG_A)
        if (blockIdx.x == DIAG_BLK && tid == 0) dstamp[26] = __builtin_amdgcn_s_memrealtime();
#endif
    }
    GRID_BAR(1);
    if (IN(2)) {
        if (blockIdx.x < 16) p2_cumsum(args, lds, blockIdx.x, tid, wave, lane);
        SchedDense S{64, NIN / 256, G, (int)blockIdx.x, 512, (const char*)H1, (const char*)(ws + WS_WIN)};
        EpiIn E{Ub, Qb, Kb, Vb, SG, args.in[11], args.in[12], (const float*)(ws + WS_SA1), (const unsigned*)(ws + WS_CTL) + CW_AMAX};
        pg8::gemm_phase<EpiIn, SchedDense, true, false, true>(lds + RING_OFF, 512, S, E);
        if (G == 256 && blockIdx.x >= 128) wd_items(args, lds, 0, WD_SPLIT, (int)blockIdx.x - 128, 128, wave, lane);
        else if (G != 256) wd_items(args, lds, 0, WD_SPLIT, (int)blockIdx.x, G, wave, lane);
    }
    GRID_BAR(2);
#if defined(DBG_STAGE) && (DBG_STAGE == 24 || DBG_STAGE == 4)
    {   const bf16* src = (DBG_STAGE == 24) ? SG : (const bf16*)(ws + WS_WIN) + (size_t)2560 * 1024;
        for (size_t i = (size_t)blockIdx.x * 512 + tid; i < (size_t)T * 1024; i += (size_t)G * 512) { const size_t r = i >> 10, c = i & 1023; args.out[i] = bf2f(src[((DBG_STAGE == 24) ? r : (r & 2047)) * 1024 + c]); }
        return; }
#endif
    if (IN(3)) {
        float gq = fabsf(args.in[11][lane]), gk = fabsf(args.in[12][lane]);
#pragma unroll
        for (int o = 1; o < 64; o <<= 1) { gq = fmaxf(gq, __shfl_xor(gq, o)); gk = fmaxf(gk, __shfl_xor(gk, o)); }
        const float thr2 = 2.0f * (8.0f * gq * gk * LOG2E) + 40.0f;
        const attn_body::AttnTensors AT{(const attn_body::bf16*)Qb, (const attn_body::bf16*)Kb, (const attn_body::bf16*)Vb, (attn_body::bf16*)Ob, (const float*)(ws + WS_CUM), thr2};
        if (G == 256) { const attn_body::StaticOrder S(G, (int)blockIdx.x); attn_body::attn_phase<attn_body::StaticOrder>((char*)lds_raw + RING_OFF, AT, S); }
#if defined(DIAG_A)
        if (blockIdx.x == DIAG_BLK && tid == 0) dstamp[20] = __builtin_amdgcn_s_memrealtime();
#endif
        if ((G & 7) == 0) conv_items(args, lds, vcu, G, tid); else for (int it = vcu; it < 1024; it += G) conv_items(args, lds, it, 1024, tid);
#if defined(DIAG_A)
        if (blockIdx.x == DIAG_BLK && tid == 0) dstamp[21] = __builtin_amdgcn_s_memrealtime();
#endif
    }
    GRID_BAR(3);
#if defined(DBG_STAGE)
    {
#if DBG_STAGE == 2
        const bf16* bA = Qb; const bf16* bB = Kb;
#elif DBG_STAGE == 21
        const bf16* bA = Vb; const bf16* bB = Ub;
#elif DBG_STAGE == 22
        const bf16* bA = SG; const bf16* bB = SG + 512;
#elif DBG_STAGE == 23
        const bf16* bA = SG + (size_t)T * 1024; const bf16* bB = SG + (size_t)T * 1024 + 512;
#elif DBG_STAGE == 3
        const bf16* bA = Ob; const bf16* bB = UC;
#else
        const bf16* bA = H1; const bf16* bB = H1 + 512;
#endif
        const int ldA = (DBG_STAGE == 1 || DBG_STAGE == 22 || DBG_STAGE == 23) ? 1024 : 512;
        for (size_t i = (size_t)blockIdx.x * 512 + tid; i < (size_t)T * 512; i += (size_t)G * 512) { const size_t r = i >> 9, c = i & 511;
            args.out[r * 1024 + c] = bf2f(bA[r * ldA + c]); args.out[r * 1024 + 512 + c] = bf2f(bB[r * ldA + c]); }
        return;
    }
#endif
    if (IN(4)) {
        SchedMerge S{(int)blockIdx.x, (const char*)UC, (const char*)(ws + WS_WC), (const char*)Ob, (const char*)(ws + WS_WA)};
        EpiMerge E{SG, MG};
        pg8::gemm_phase<EpiMerge, SchedMerge, false>(lds + RING_OFF, 512, S, E);
    }
    GRID_BAR(4);
#if defined(DBG_STAGE2)
    {   for (size_t i = (size_t)blockIdx.x * 512 + tid; i < (size_t)T * 1024; i += (size_t)G * 512) args.out[i] = bf2f(MG[i]);
        return; }
#endif
    if (IN(5)) {
        SchedDense S{64, 4, G, (int)blockIdx.x, 1024, (const char*)MG, (const char*)(ws + WS_WOUT)};
        EpiX1 E{args.in[0], args.out, mod, (float*)(ws + WS_SSQ), (float*)(ws + WS_XMX)};
        pg8::gemm_phase<EpiX1, SchedDense, false>(lds + RING_OFF, 1024, S, E);
    }
    GRID_BAR(5);
#if FWD_LEVEL >= 2
    if (IN(6)) { if (G == 256) p6_block(args, lds, vcu, tid, wave, lane); }
    GRID_BAR(6);
    const MoeTab tb{(const LAS int*)(lds + TAB_OFF), (const LAS int*)(lds + TAB_OFF) + 80};
    if (IN(7)) {
        moe_tables(args, lds, tid, lane);
        const int ntiles = tb.tstart[64], nmoe = 2 * ntiles, ntot = nmoe + 128, per = G;
        SchedMoe1 S{tb, nmoe, ntot, per, vcu, lane, (const char*)(ws + WS_H2), (const char*)(ws + WS_WGU), (const char*)(ws + WS_WSGU), (const int*)(ws + WS_LIST)};
        EpiGlu E{(bf16*)(ws + WS_ACT), (bf16*)(ws + WS_SACT), (const float*)(ws + WS_WLIST), (const float*)(ws + WS_SLIST), (const float*)(ws + WS_SA2), (const unsigned*)(ws + WS_CTL) + CW_AMAX, tb};
        pg8::gemm_phase<EpiGlu, SchedMoe1, true, false, true>(lds + RING_OFF, 512, S, E);
        {
            const int rounds = (ntot + G - 1) / G, busy = ntot - (rounds - 1) * G;
            if (vcu >= busy && busy < G) wd_items(args, lds, WD_SPLIT, 64 * 128, vcu - busy, G - busy, wave, lane);
            else if (busy >= G) wd_items(args, lds, WD_SPLIT, 64 * 128, vcu, G, wave, lane); }
    }
    GRID_BAR(7);
    if (IN(8)) {
        moe_tables(args, lds, tid, lane);
        const int ntiles = tb.tstart[64], ntot = 4 * ntiles, per = G;
        SchedMoe2 S{tb, ntot, per, vcu, lane, (const char*)(ws + WS_ACT), (const char*)(ws + WS_WD)};
        EpiSlab E{ws + WS_SLAB, (const int*)(ws + WS_LIST), tb};
        pg8::gemm_phase<EpiSlab, SchedMoe2, false>(lds + RING_OFF, 256, S, E);
    }
    GRID_BAR(8);
    if (IN(9)) {
        SchedDense S{64, 4, G, (int)blockIdx.x, 256, (const char*)(ws + WS_SACT), (const char*)(ws + WS_WSD)};
        EpiFinal E{args.out, ws + WS_SLAB, mod};
        pg8::gemm_phase<EpiFinal, SchedDense, false>(lds + RING_OFF, 256, S, E);
    }
#endif
#endif
#if defined(DIAG_A)
    {
        xcd_barrier(bar); if (blockIdx.x == 0 && tid == 0) dstamp[10] = __builtin_amdgcn_s_memrealtime();
        xcd_barrier(bar); if (blockIdx.x == 0 && tid == 0) dstamp[11] = __builtin_amdgcn_s_memrealtime();
        xcd_barrier(bar); if (blockIdx.x == 0 && tid == 0) dstamp[12] = __builtin_amdgcn_s_memrealtime();
        xcd_barrier(bar);
#if defined(DIAG_LO)
        const float dta = (float)(dstamp[DIAG_HI] - dstamp[DIAG_LO]) * 0.01f;
#else
        const float dta = (float)(dstamp[DIAG_A + 1] - dstamp[DIAG_A]) * 0.01f;
#endif
#if defined(DIAG_BIG)
        if (blockIdx.x == 0 && tid == 0) args.out[0] += 2.0f + dta * 0.04f;
#else
        if (blockIdx.x == 0 && tid == 0) args.out[0] += 0.5f + dta * 0.01f;
#endif
    }
#endif
#undef IN
#undef GRID_BAR
}

#ifndef N_LAUNCH_MODE
#define N_LAUNCH_MODE 1
#endif
extern "C" void kernel_launch(void* const* d_in, const int* in_sizes, int n_in, void* d_out, int out_size, void* d_ws, size_t ws_size, hipStream_t stream) {
    static int grid = 0;
    if (grid == 0) {
        if (n_in != 23 || in_sizes[0] != T * DMODEL || out_size != T * DMODEL || ws_size < WS_END) {
            fprintf(stderr, "kernel_launch: built for 23 inputs, x/out of %d floats, >= %zu bytes of workspace; got n_in %d, in0 %d, out %d, ws %zu; nothing launched\n", T * DMODEL, (size_t)WS_END, n_in, n_in > 0 ? in_sizes[0] : -1, out_size, ws_size);
            grid = -1; return; }
        int dev = 0, cus = 0, per_cu = 0;
        if (hipGetDevice(&dev) != hipSuccess || hipDeviceGetAttribute(&cus, hipDeviceAttributeMultiprocessorCount, dev) != hipSuccess) { fprintf(stderr, "kernel_launch: device query failed\n"); grid = -1; return; }
        if (hipFuncSetAttribute((const void*)fox_fwd, hipFuncAttributeMaxDynamicSharedMemorySize, LDS_BYTES) != hipSuccess) { fprintf(stderr, "kernel_launch: hipFuncSetAttribute failed\n"); grid = -1; return; }
        if (hipOccupancyMaxActiveBlocksPerMultiprocessor(&per_cu, (const void*)fox_fwd, NWAVES * 64, LDS_BYTES) != hipSuccess || per_cu < 1)
            fprintf(stderr, "kernel_launch: note: occupancy query reports %d workgroups per CU\n", per_cu);
        (void)hipGetLastError();
        grid = cus;
        if (grid != 256) fprintf(stderr, "kernel_launch: %d CUs; this kernel is built for 256\n", grid);
    }
    if (grid < 0) return;
    if (hipMemsetAsync((char*)d_ws + WS_CTL, 0, CTL_ZERO_BYTES, stream) != hipSuccess) { fprintf(stderr, "kernel_launch: memset failed\n"); return; }
    KArgs a{};
    for (int i = 0; i < 23; ++i) a.in[i] = (const float*)d_in[i];
    a.out = (float*)d_out; a.ws = (unsigned char*)d_ws;
#if N_LAUNCH_MODE == 1
    a.ph_lo = 0; a.ph_hi = 10;
    hipLaunchKernelGGL(fox_fwd, dim3(grid), dim3(NWAVES * 64), LDS_BYTES, stream, a);
#else
    for (int p = 0; p < 10; ++p) { a.ph_lo = p; a.ph_hi = p + 1; hipLaunchKernelGGL(fox_fwd, dim3(grid), dim3(NWAVES * 64), LDS_BYTES, stream, a); }
#endif
    const hipError_t le = hipPeekAtLastError();
    if (le != hipSuccess) fprintf(stderr, "kernel_launch: launch failed: %s\n", hipGetErrorName(le));
}
```

```cpp
#include <hip/hip_runtime.h>
#include <hip/hip_bf16.h>
#include <cstdio>
#include <cstdint>
#include <cmath>

#ifndef ATTN_SKIP
#define ATTN_SKIP 1
#endif
#ifndef DIAG_BLK
#define DIAG_BLK 0
#endif
#ifndef FWD_LEVEL
#define FWD_LEVEL 2
#endif

namespace pg8 {
#define PG8_LAS __attribute__((address_space(3)))
typedef unsigned short bf16_t;
typedef short bf16x8 __attribute__((ext_vector_type(8)));
typedef float f32x4 __attribute__((ext_vector_type(4)));
typedef unsigned u32x4 __attribute__((ext_vector_type(4)));
constexpr int BM = 256, BK = 64, HALF = 128, HTB = HALF * BK * 2  , STAGE_BYTES = 8 * HTB, NXCD = 8, WGM = 8;

__host__ __device__ __forceinline__ int lds_byte(int r, int c) { const int st = (r >> 4) * 2 + (c >> 5), rr = r & 15, cc = c & 31, ob = rr * 64 + cc * 2; return st * 1024 + (ob ^ (((ob >> 9) & 1) << 5)); }
__host__ __device__ __forceinline__ void stage_rc(int b, int& R, int& C) { const int st = b / 1024, sb = b % 1024, swz = sb ^ (((sb >> 9) & 1) << 5); R = (st >> 1) * 16 + swz / 64; C = (st & 1) * 32 + (swz % 64) / 2; }
__host__ __device__ __forceinline__ int perm32(int rho) { const int n = rho >> 4, i = rho & 15; return 8 * (i >> 2) + 4 * n + (i & 3); }

struct Unit { int pm, pn, e, mt; const char* A; const char* B; };

__host__ __device__ __forceinline__ void tile_of(int L, int nM, int nN, int& pm, int& pn) {
    const int nwg = nM * nN; int wgid = L; { const int q = nwg / NXCD, r = nwg % NXCD, xcd = wgid % NXCD, off = wgid / NXCD; wgid = (xcd < r ? xcd * (q + 1) : r * (q + 1) + (xcd - r) * q) + off; }
    const int nig = WGM * nN, gid = wgid / nig, fm = gid * WGM, gsz = (nM - fm) < WGM ? (nM - fm) : WGM;
    pm = fm + ((wgid % nig) % gsz); pn = (wgid % nig) / gsz;
}
typedef float f32x2_c __attribute__((ext_vector_type(2))); typedef __bf16 bf16x2_c __attribute__((ext_vector_type(2)));
__device__ __forceinline__ unsigned cvt_pk_bf16(float lo, float hi) { f32x2_c v = {lo, hi}; bf16x2_c b = __builtin_convertvector(v, bf16x2_c); return __builtin_bit_cast(unsigned, b); }
__device__ __forceinline__ float bf_lo(unsigned w) { return __builtin_bit_cast(float, w << 16); }
__device__ __forceinline__ float bf_hi(unsigned w) { return __builtin_bit_cast(float, w & 0xffff0000u); }
__device__ __forceinline__ float sigmoidf_fast(float x) { return __builtin_amdgcn_rcpf(1.0f + __builtin_amdgcn_exp2f(-1.4426950408889634f * x)); }

typedef int i32x4_c __attribute__((ext_vector_type(4))); typedef int i32x8_c __attribute__((ext_vector_type(8)));
__device__ __forceinline__ i32x8_c cat16(const bf16x8& lo, const bf16x8& hi) { const i32x4_c a = __builtin_bit_cast(i32x4_c, lo), b = __builtin_bit_cast(i32x4_c, hi); return __builtin_shufflevector(a, b, 0, 1, 2, 3, 4, 5, 6, 7); }
template <class Epi, class Sched, bool ALIGN_EPI, bool FP8 = false, bool I8 = false>
__device__ __forceinline__ void gemm_phase(PG8_LAS unsigned char* lds, const int K, const Sched& S, const Epi& E, int dphase = -1, unsigned long long* dst_ = nullptr) {
    const int tid = threadIdx.x, wid = __builtin_amdgcn_readfirstlane(tid >> 6), lane = tid & 63, wr = wid >> 2, wc = wid & 3, fr = lane & 15, fq = lane >> 4;
    const int nt = K / BK;
    int sR[2], sC[2]; unsigned voffB[2];
#pragma unroll
    for (int i = 0; i < 2; ++i) { int R, C; stage_rc(tid * 16 + i * 8192, R, C); sR[i] = R; sC[i] = C; const int Rb = Epi::PERM ? ((R & ~31) + perm32(R & 31)) : R; voffB[i] = (unsigned)(Rb * K + C) * 2u; }
    const size_t kstep = (size_t)(BK * 2);
    const size_t hstep = (size_t)HALF * K * 2;
    const unsigned ldsw = (unsigned)wid * 1024u;
    const int aoff = lds_byte(wr * 64 + fr, fq * 8), boff = lds_byte(wc * 32 + fr, fq * 8);
#define PG8_SA(b, h) (((b) * 2 + (h)) * HTB)
#define PG8_SB(b, h) ((4 + (b) * 2 + (h)) * HTB)
#define PG8_STAGE(bufoff, gbase, voff) do { _Pragma("unroll") for (int _i = 0; _i < 2; ++_i) \
        __builtin_amdgcn_global_load_lds((const unsigned*)((const char*)(gbase) + (voff)[_i]), (PG8_LAS unsigned*)(lds + (bufoff) + ldsw + _i * 8192), 16, 0, 0); } while (0)
#define PG8_STAGE_A(bufoff, gbase, h, V0, V1) do { if constexpr (Sched::GATHER) { if (h) PG8_STAGE(bufoff, gbase, V1); else PG8_STAGE(bufoff, gbase, V0); } \
        else { PG8_STAGE(bufoff, (const char*)(gbase) + ((h) ? hstep : 0), V0); } } while (0)
#define PG8_LDA(dst, b, h) do { _Pragma("unroll") for (int m = 0; m < 4; ++m) { if constexpr (FP8) { const bf16x8 lo_ = *(const PG8_LAS bf16x8*)(lds + PG8_SA(b, h) + aoff + m * 2048), hi_ = *(const PG8_LAS bf16x8*)(lds + PG8_SA(b, h) + aoff + m * 2048 + 1024); dst##8[m] = cat16(lo_, hi_); } \
        else { _Pragma("unroll") for (int k = 0; k < 2; ++k) dst[m][k] = *(const PG8_LAS bf16x8*)(lds + PG8_SA(b, h) + aoff + m * 2048 + k * 1024); } } } while (0)
#define PG8_LDB(dst, b, h) do { _Pragma("unroll") for (int n = 0; n < 2; ++n) { if constexpr (FP8) { const bf16x8 lo_ = *(const PG8_LAS bf16x8*)(lds + PG8_SB(b, h) + boff + n * 2048), hi_ = *(const PG8_LAS bf16x8*)(lds + PG8_SB(b, h) + boff + n * 2048 + 1024); dst##8[n] = cat16(lo_, hi_); } \
        else { _Pragma("unroll") for (int k = 0; k < 2; ++k) dst[n][k] = *(const PG8_LAS bf16x8*)(lds + PG8_SB(b, h) + boff + n * 2048 + k * 1024); } } } while (0)
#define PG8_MMA(ai, bj, At, Bt) do { __builtin_amdgcn_s_setprio(1); if constexpr (FP8) { _Pragma("unroll") for (int m = 0; m < 4; ++m) _Pragma("unroll") for (int n = 0; n < 2; ++n) \
        acc[ai][bj][m][n] = __builtin_amdgcn_mfma_scale_f32_16x16x128_f8f6f4(Bt##8[n], At##8[m], acc[ai][bj][m][n], 0, 0, 0, 0x7f7f7f7f, 0, 0x7f7f7f7f); } \
        else if constexpr (I8) { _Pragma("unroll") for (int m = 0; m < 4; ++m) _Pragma("unroll") for (int n = 0; n < 2; ++n) _Pragma("unroll") for (int k = 0; k < 2; ++k) \
        acc[ai][bj][m][n] = __builtin_bit_cast(f32x4, __builtin_amdgcn_mfma_i32_16x16x64_i8(__builtin_bit_cast(i32x4_c, Bt[n][k]), __builtin_bit_cast(i32x4_c, At[m][k]), __builtin_bit_cast(i32x4_c, acc[ai][bj][m][n]), 0, 0, 0)); } \
        else { _Pragma("unroll") for (int m = 0; m < 4; ++m) _Pragma("unroll") for (int n = 0; n < 2; ++n) _Pragma("unroll") for (int k = 0; k < 2; ++k) \
        acc[ai][bj][m][n] = __builtin_amdgcn_mfma_f32_16x16x32_bf16(Bt[n][k], At[m][k], acc[ai][bj][m][n], 0, 0, 0); } __builtin_amdgcn_s_setprio(0); } while (0)
#define PG8_WAIT_V(n) asm volatile("s_waitcnt vmcnt(" #n ")" ::: "memory")
#define PG8_WAIT_L(n) asm volatile("s_waitcnt lgkmcnt(" #n ")" ::: "memory")
#define PG8_BAR __builtin_amdgcn_s_barrier()
#define PG8_SCHED __builtin_amdgcn_sched_barrier(0)
    Unit cur, nxt; int ui = 0;
    if (!S.next(0, cur)) return;
    unsigned vc0[2], vc1[2], vn0[2], vn1[2];
#pragma unroll
    for (int i = 0; i < 2; ++i) {
        if constexpr (Sched::GATHER) { vc0[i] = (unsigned)(S.row(cur, sR[i]) * K + sC[i]) * 2u; vc1[i] = (unsigned)(S.row(cur, HALF + sR[i]) * K + sC[i]) * 2u; }
        else { vc0[i] = (unsigned)(sR[i] * K + sC[i]) * 2u; vc1[i] = 0u; }
        vn0[i] = vc0[i]; vn1[i] = vc1[i];
    }
    f32x4 acc[2][2][4][2];
#pragma unroll
    for (int a = 0; a < 2; ++a)
#pragma unroll
        for (int b = 0; b < 2; ++b)
#pragma unroll
            for (int m = 0; m < 4; ++m)
#pragma unroll
                for (int n = 0; n < 2; ++n) acc[a][b][m][n] = (f32x4){0.f, 0.f, 0.f, 0.f};
    typename Epi::Pre pre; E.prefetch(pre, cur, wr, wc, fr, fq);
    PG8_LAS unsigned char* const rtab = lds + STAGE_BYTES + 2048;
#define PG8_ROWTAB(U, par) do { if constexpr (Epi::ROWTAB) { _Pragma("unroll") for (int t_ = 0; t_ < Epi::NTAB; ++t_) { const char* src_ = E.tab_src(U, t_); if (wid < 4 && src_ != nullptr) \
        __builtin_amdgcn_global_load_lds((const unsigned*)(src_ + tid * 4), (PG8_LAS unsigned*)(rtab + ((par) * Epi::NTAB + t_) * 1024 + wid * 256), 4, 0, 0); } } } while (0)
    PG8_ROWTAB(cur, 0);
    bf16x8 At[4][2], B0[2][2], B1[2][2]; i32x8_c At8[4], B08[2], B18[2];
    const char* cA = cur.A; const char* cB = cur.B;
    PG8_STAGE(PG8_SB(0, 0), cB, voffB); PG8_STAGE(PG8_SB(0, 1), cB + hstep, voffB); PG8_STAGE_A(PG8_SA(0, 0), cA, 0, vc0, vc1); PG8_STAGE_A(PG8_SA(0, 1), cA, 1, vc0, vc1);
    if (wr == 1) PG8_BAR;
    PG8_WAIT_V(2); PG8_BAR;
    PG8_STAGE(PG8_SB(1, 0), cB + kstep, voffB); PG8_STAGE_A(PG8_SA(1, 0), cA + kstep, 0, vc0, vc1); PG8_STAGE(PG8_SB(1, 1), cB + hstep + kstep, voffB);
    PG8_WAIT_V(6); PG8_BAR;
    for (;;) {
        const bool has_next = S.next(ui + 1, nxt);
        const char* nA = has_next ? nxt.A : cA; const char* nB = has_next ? nxt.B : cB;
        if constexpr (Sched::GATHER) {
            if (has_next) {
#pragma unroll
                for (int i = 0; i < 2; ++i) { vn0[i] = (unsigned)(S.row(nxt, sR[i]) * K + sC[i]) * 2u; vn1[i] = (unsigned)(S.row(nxt, HALF + sR[i]) * K + sC[i]) * 2u; }
            }
        }
#pragma nounroll
        for (int t = 0; t < nt; t += 2) {
            const bool last = (t == nt - 2);
            const char* a1 = cA + (size_t)(t + 1) * kstep;
            const char* a2 = last ? nA : cA + (size_t)(t + 2) * kstep; const char* b2 = last ? nB : cB + (size_t)(t + 2) * kstep;
            const char* a3 = a2 + kstep; const char* b3 = b2 + kstep;
            unsigned w0[2], w1[2];
#pragma unroll
            for (int i = 0; i < 2; ++i) { if constexpr (Sched::GATHER) { w0[i] = last ? vn0[i] : vc0[i]; w1[i] = last ? vn1[i] : vc1[i]; } else { w0[i] = vc0[i]; w1[i] = 0u; } }
            PG8_LDB(B0, 0, 0); PG8_LDB(B1, 0, 1); PG8_SCHED; PG8_LDA(At, 0, 0); PG8_STAGE_A(PG8_SA(1, 1), a1, 1, vc0, vc1);
            PG8_WAIT_V(8); PG8_WAIT_L(0); PG8_BAR; PG8_MMA(0, 0, At, B0); PG8_MMA(0, 1, At, B1); PG8_BAR; PG8_SCHED;
            PG8_LDA(At, 0, 1); PG8_STAGE(PG8_SB(0, 0), b2, voffB); PG8_STAGE(PG8_SB(0, 1), b2 + hstep, voffB); PG8_STAGE_A(PG8_SA(0, 0), a2, 0, w0, w1);
            PG8_WAIT_V(8); PG8_WAIT_L(0); PG8_BAR; PG8_MMA(1, 0, At, B0); PG8_MMA(1, 1, At, B1); PG8_BAR; PG8_SCHED;
            PG8_LDB(B0, 1, 0); PG8_LDB(B1, 1, 1); PG8_SCHED; PG8_LDA(At, 1, 0); PG8_STAGE_A(PG8_SA(0, 1), a2, 1, w0, w1);
            PG8_WAIT_V(8); PG8_WAIT_L(0); PG8_BAR; PG8_MMA(0, 0, At, B0); PG8_MMA(0, 1, At, B1); PG8_BAR; PG8_SCHED;
            PG8_LDA(At, 1, 1); PG8_STAGE(PG8_SB(1, 0), b3, voffB); PG8_STAGE(PG8_SB(1, 1), b3 + hstep, voffB); PG8_STAGE_A(PG8_SA(1, 0), a3, 0, w0, w1);
            PG8_WAIT_V(8); PG8_WAIT_L(0); PG8_BAR; PG8_MMA(1, 0, At, B0); PG8_MMA(1, 1, At, B1); PG8_BAR; PG8_SCHED;
        }
        if constexpr (ALIGN_EPI) { if (wr == 0) PG8_BAR; }
#if defined(DIAG_GP)
        if (dphase == DIAG_GP && blockIdx.x == DIAG_BLK && tid == 0 && ui < 12) dst_[30 + 2 * ui] = __builtin_amdgcn_s_memrealtime();
#endif
        if constexpr (I8) {
#pragma unroll
            for (int a = 0; a < 2; ++a)
#pragma unroll
                for (int b = 0; b < 2; ++b)
#pragma unroll
                    for (int m = 0; m < 4; ++m)
#pragma unroll
                        for (int n = 0; n < 2; ++n) acc[a][b][m][n] = __builtin_convertvector(__builtin_bit_cast(i32x4_c, acc[a][b][m][n]), f32x4);
        }
        if (!Epi::AFTER_DRAIN || has_next) E(acc, cur, wr, wc, fr, fq, pre, (const PG8_LAS unsigned*)(rtab + (ui & 1) * Epi::NTAB * 1024));
#if defined(DIAG_GP)
        if (dphase == DIAG_GP && blockIdx.x == DIAG_BLK && tid == 0 && ui < 12) dst_[31 + 2 * ui] = __builtin_amdgcn_s_memrealtime();
#endif
        if (!has_next) break;
#pragma unroll
        for (int a = 0; a < 2; ++a)
#pragma unroll
            for (int b = 0; b < 2; ++b)
#pragma unroll
                for (int m = 0; m < 4; ++m)
#pragma unroll
                    for (int n = 0; n < 2; ++n) acc[a][b][m][n] = (f32x4){0.f, 0.f, 0.f, 0.f};
        cur = nxt; cA = nA; cB = nB; ++ui; E.prefetch(pre, cur, wr, wc, fr, fq); PG8_ROWTAB(cur, ui & 1);
#pragma unroll
        for (int i = 0; i < 2; ++i) { vc0[i] = vn0[i]; vc1[i] = vn1[i]; }
        if constexpr (ALIGN_EPI) { if (wr == 1) PG8_BAR; }
    }
    PG8_WAIT_V(0);
    if constexpr (!ALIGN_EPI) { if (wr == 0) PG8_BAR; }
    PG8_BAR;
    if constexpr (Epi::AFTER_DRAIN) E.fused(acc, cur, wr, wc, fr, fq, lds);
#undef PG8_SA
#undef PG8_SB
#undef PG8_STAGE
#undef PG8_ROWTAB
#undef PG8_STAGE_A
#undef PG8_LDA
#undef PG8_LDB
#undef PG8_MMA
#undef PG8_WAIT_V
#undef PG8_WAIT_L
#undef PG8_BAR
#undef PG8_SCHED
}
}
#include <hip/hip_bf16.h>
#include <cmath>
namespace attn_body {
using bf16=__hip_bfloat16;
using bf16x8=__attribute__((ext_vector_type(8)))short;
using s16x4=__attribute__((ext_vector_type(4)))short;
using f32x16=__attribute__((ext_vector_type(16)))float;
using u32x4=__attribute__((ext_vector_type(4)))unsigned;
constexpr int BATCH=2,NHEAD=8,SEQ=8192,D=64,DM=NHEAD*D;
constexpr int NW=8,QBLK=32,QB=QBLK*NW,KVBLK=64,NQB=SEQ/QB;
constexpr int ATTN_PITCH=DM, ATTN_UNIT_ROWS=QB;
__device__ __forceinline__ int crow(int r,int hi){return (r&3)+8*(r>>2)+4*hi;}
#define SBAR() __builtin_amdgcn_sched_barrier(0)
__device__ __forceinline__ void cmask(f32x16&p0,f32x16&p1,int jb,int qrel,int hi){
  const float NEG=-INFINITY; const int dq=qrel-(64*jb+4*hi);
  #pragma unroll
  for(int r=0;r<16;++r){const int c=(r&3)+8*(r>>2); if(c>dq)p0[r]=NEG; if(c+32>dq)p1[r]=NEG;}
}

constexpr int NSLOT=3, SLOTB=8192;
constexpr int LDS_K=0, LDS_V=NSLOT*SLOTB, LDS_WS=2*NSLOT*SLOTB, LDS_OST=LDS_WS+NW*64*4, LDS_DK=LDS_OST+NW*4096, LDS_BYTES=LDS_DK+SEQ*4;
constexpr float C2=0.125f*1.4426950408889634f;
__device__ __forceinline__ void glds16(const void*gsrc,unsigned lds_dst){unsigned keep;
  asm volatile("s_mov_b32 %0, m0\n\ts_mov_b32 m0, %2\n\ts_nop 0\n\tglobal_load_lds_dwordx4 %1, off\n\ts_mov_b32 m0, %0":"=&s"(keep):"v"(gsrc),"s"(lds_dst):"memory");}
__device__ __forceinline__ float max3f(float a,float b,float c){float r;asm("v_max3_f32 %0, %1, %2, %3":"=v"(r):"v"(a),"v"(b),"v"(c));return r;}
__device__ __forceinline__ float max2f(float a,float b){float r;asm("v_max_f32_e32 %0, %1, %2":"=v"(r):"v"(a),"v"(b));return r;}
__device__ __forceinline__ float fadd_s(float a,float b){float r;asm("v_add_f32_e32 %0, %1, %2":"=v"(r):"v"(a),"v"(b));return r;}
__device__ __forceinline__ float fsub_s(float a,float b){float r;asm("v_sub_f32_e32 %0, %1, %2":"=v"(r):"v"(a),"v"(b));return r;}
typedef float f32x2_t __attribute__((ext_vector_type(2))); typedef float f32x4_t __attribute__((ext_vector_type(4))); typedef __bf16 bf16x2_t __attribute__((ext_vector_type(2)));
__device__ __forceinline__ unsigned cvtpk_s(float lo,float hi){f32x2_t v={lo,hi};bf16x2_t b=__builtin_convertvector(v,bf16x2_t);return __builtin_bit_cast(unsigned,b);}
#define WAIT_BAR(N) asm volatile("s_waitcnt vmcnt(" #N ") lgkmcnt(0)\n\ts_barrier":::"memory")

__device__ __forceinline__ void qkt(f32x16&p0,f32x16&p1,const char*Kslot,const bf16x8*qr,const f32x16&negm,int r32,int hi){
  const char*kb=Kslot+hi*1024+r32*16;
  #pragma unroll
  for(int d0=0;d0<4;++d0){
    const bf16x8 b0=*reinterpret_cast<const bf16x8*>(kb+d0*2048);
    const bf16x8 b1=*reinterpret_cast<const bf16x8*>(kb+d0*2048+512);
    if(d0==0){p0=__builtin_amdgcn_mfma_f32_32x32x16_bf16(b0,qr[0],negm,0,0,0);p1=__builtin_amdgcn_mfma_f32_32x32x16_bf16(b1,qr[0],negm,0,0,0);}
    else{p0=__builtin_amdgcn_mfma_f32_32x32x16_bf16(b0,qr[d0],p0,0,0,0);p1=__builtin_amdgcn_mfma_f32_32x32x16_bf16(b1,qr[d0],p1,0,0,0);}}
}
typedef __attribute__((address_space(3))) const char* lds_cptr;
typedef short v4i16_t __attribute__((ext_vector_type(4)));
__device__ __forceinline__ void kload8(bf16x8*kf,lds_cptr kp){
  kf[0]=*(const __attribute__((address_space(3))) bf16x8*)(kp);      kf[1]=*(const __attribute__((address_space(3))) bf16x8*)(kp+512);
  kf[2]=*(const __attribute__((address_space(3))) bf16x8*)(kp+2048); kf[3]=*(const __attribute__((address_space(3))) bf16x8*)(kp+2560);
  kf[4]=*(const __attribute__((address_space(3))) bf16x8*)(kp+4096); kf[5]=*(const __attribute__((address_space(3))) bf16x8*)(kp+4608);
  kf[6]=*(const __attribute__((address_space(3))) bf16x8*)(kp+6144); kf[7]=*(const __attribute__((address_space(3))) bf16x8*)(kp+6656);
}
__device__ __forceinline__ void kload2(bf16x8*kf,lds_cptr kp,int j){ kf[2*j]=*(const __attribute__((address_space(3))) bf16x8*)(kp+j*2048); kf[2*j+1]=*(const __attribute__((address_space(3))) bf16x8*)(kp+j*2048+512); }
__device__ __forceinline__ s16x4 vtr(lds_cptr p){ return __builtin_bit_cast(s16x4,__builtin_amdgcn_ds_read_tr16_b64_v4i16((__attribute__((address_space(3))) v4i16_t*)p)); }
__device__ __forceinline__ float rowmax(const f32x16&p0,const f32x16&p1){
  float a=max3f(p0[0],p0[1],p1[0]),b=max3f(p0[2],p0[3],p1[1]);a=max3f(a,p1[2],p1[3]);
  #pragma unroll
  for(int r=4;r<16;r+=4){a=max3f(a,p0[r],p0[r+1]);b=max3f(b,p0[r+2],p0[r+3]);a=max3f(a,p1[r],p1[r+1]);b=max3f(b,p1[r+2],p1[r+3]);}
  const float m=max2f(a,b);
  auto rr=__builtin_amdgcn_permlane32_swap(__float_as_uint(m),__float_as_uint(m),false,false);
  return max2f(__uint_as_float(rr[0]),__uint_as_float(rr[1]));
}
__device__ __forceinline__ void pv(f32x16*o,int vb,bf16x8 pa0,bf16x8 pa1,bf16x8 pa2,bf16x8 pa3){
  #pragma unroll
  for(int d0=0;d0<2;++d0){s16x4 lo[4],hi[4];
    #pragma unroll
    for(int ks=0;ks<4;++ks){
      asm volatile("ds_read_b64_tr_b16 %0,%1 offset:%c2":"=&v"(lo[ks]):"v"(vb),"i"(d0*4096+ks*1024):"memory");
      asm volatile("ds_read_b64_tr_b16 %0,%1 offset:%c2":"=&v"(hi[ks]):"v"(vb),"i"(d0*4096+ks*1024+512):"memory");}
    asm volatile("s_waitcnt lgkmcnt(0)":::"memory");SBAR();
    #define PK(k) (bf16x8){lo[k][0],lo[k][1],lo[k][2],lo[k][3],hi[k][0],hi[k][1],hi[k][2],hi[k][3]}
    o[d0]=__builtin_amdgcn_mfma_f32_32x32x16_bf16(pa0,PK(0),o[d0],0,0,0);
    o[d0]=__builtin_amdgcn_mfma_f32_32x32x16_bf16(pa1,PK(1),o[d0],0,0,0);
    o[d0]=__builtin_amdgcn_mfma_f32_32x32x16_bf16(pa2,PK(2),o[d0],0,0,0);
    o[d0]=__builtin_amdgcn_mfma_f32_32x32x16_bf16(pa3,PK(3),o[d0],0,0,0);
    #undef PK
  }
}

#ifndef ATTN_STORE16
#define ATTN_STORE16(p,v) (*(u32x4*)(p)=(v))
#endif
template<int THRL> __device__ __forceinline__ void attn_unit(int b,int h,int qb,const bf16*Q,const bf16*__restrict__ K,const bf16*__restrict__ V,bf16*O,const float*cum,float thr2,char*shm){
  const int tid=threadIdx.x,lane=tid&63,r32=lane&31,hi=lane>>5; const int wid=__builtin_amdgcn_readfirstlane(tid>>6);
  const long rowbase=(long)b*SEQ; const int q0=qb*QB;
  const bf16*Qw=Q+(rowbase+q0+wid*QBLK)*DM+h*D;
  const float*cb=cum+(long)(b*NHEAD+h)*SEQ; const int NTF=(q0+QB)/KVBLK; int t0=0;
  const float cref=cb[q0+QB-1];
#if ATTN_SKIP
  { const float cq0=cb[q0];
    const int ta_=lane, tb_=64+lane; const float pa_=cb[64*(ta_<NTF?ta_:0)+63], pb_=cb[64*(tb_<NTF?tb_:0)+63];
    const bool ca_=(ta_<NTF)&&((pa_-cq0)*1.4426950408889634f>thr2), cb_=(tb_<NTF)&&((pb_-cq0)*1.4426950408889634f>thr2);
    int cnt=__popcll(__ballot(ca_))+__popcll(__ballot(cb_));
    cnt&=~1; if(cnt>NTF-4)cnt=NTF-4; t0=__builtin_amdgcn_readfirstlane(cnt); }
#endif
  const int kv0=t0*KVBLK;
  const int ndk=q0+QB-kv0; int tv_=tid; asm volatile("":"+v"(tv_));
  float dkv_[4];
  #pragma unroll
  for(int u_=0;u_<4;++u_){ const int j_=tv_+u_*NW*64; dkv_[u_]=cb[kv0+(j_<ndk?j_:0)]; }
  const bf16*Kh=K+(rowbase+kv0)*DM+h*D,*Vh=V+(rowbase+kv0)*DM+h*D;
  const unsigned lds0=(unsigned)(uintptr_t)shm;
  float*wsf=(float*)(shm+LDS_WS)+wid*64;
  const bf16*ksrc=Kh+(long)lane*DM+wid*8;
  const bf16*vsrc=Vh+(long)(16*(wid&3)+(lane>>2))*DM+(wid>>2)*32+(lane&3)*8;
  const unsigned kdst=lds0+LDS_K+wid*1024, vdst=lds0+LDS_V+wid*1024;
  #define DMA_K(t,slot) glds16(ksrc+(long)(t)*KVBLK*DM,(unsigned)__builtin_amdgcn_readfirstlane(kdst+(slot)))
  #define DMA_V(t,slot) glds16(vsrc+(long)(t)*KVBLK*DM,(unsigned)__builtin_amdgcn_readfirstlane(vdst+(slot)))
  const int vb0=(int)(lds0+LDS_V)+((lane>>4)&1)*32+(lane&3)*8+(4*hi+((lane&15)>>2))*64;
  const char*Kbase=shm+LDS_K; bf16x8 kf[8];
  const lds_cptr shm3=(lds_cptr)shm; const lds_cptr kp0=shm3+LDS_K+hi*1024+r32*16; const lds_cptr vp0=shm3+LDS_V+((lane>>4)&1)*32+(lane&3)*8+(4*hi+((lane&15)>>2))*64;
  int hiv_=hi; asm volatile("":"+v"(hiv_));
  const int NT=NTF-t0;
  const __attribute__((address_space(3))) float*dkp0=(const __attribute__((address_space(3))) float*)(shm3+LDS_DK)+4*hiv_;
  #define CINIT(C,t,o) do{ const __attribute__((address_space(3))) float*dp_=dkp0+(t)*64+(o); _Pragma("unroll") for(int g_=0;g_<4;++g_){ const f32x4_t a_=*(const __attribute__((address_space(3))) f32x4_t*)(dp_+8*g_); \
      C[4*g_]=negms-a_[0];C[4*g_+1]=negms-a_[1];C[4*g_+2]=negms-a_[2];C[4*g_+3]=negms-a_[3]; } }while(0)
  #define DECAY(P0,P1,t) do{ const __attribute__((address_space(3))) float*dp_=dkp0+(t)*64; _Pragma("unroll") for(int g_=0;g_<4;++g_){ const f32x4_t a_=*(const __attribute__((address_space(3))) f32x4_t*)(dp_+8*g_), b_=*(const __attribute__((address_space(3))) f32x4_t*)(dp_+32+8*g_); \
      P0[4*g_]-=a_[0];P0[4*g_+1]-=a_[1];P0[4*g_+2]-=a_[2];P0[4*g_+3]-=a_[3]; P1[4*g_]-=b_[0];P1[4*g_+1]-=b_[1];P1[4*g_+2]-=b_[2];P1[4*g_+3]-=b_[3]; } }while(0)
  DMA_K(0,0);DMA_V(0,0);DMA_K(1,SLOTB);
  bf16x8 qr[4];
  #pragma unroll
  for(int d0=0;d0<4;++d0)qr[d0]=*reinterpret_cast<const bf16x8*>(&Qw[(long)r32*DM+d0*16+hi*8]);
  float mhat=0.f,l_reg=0.f;f32x16 o[2];o[0]=f32x16{};o[1]=f32x16{};float negms=0.f; const f32x16 zero16=f32x16{};
  const int qrel=wid*QBLK+r32;
  #define CMASK(P0,P1,t) do{int jb_=(t)-(NT-4); if(jb_>=0)cmask(P0,P1,jb_,qrel,hi);}while(0)
  bool resc=false;
  #define START(P0,P1) do{ const float rm=rowmax(P0,P1); resc=false; \
    { const float dl=rm; mhat=fadd_s(mhat,dl); \
      _Pragma("unroll") for(int r=0;r<16;++r){P0[r]=fsub_s(P0[r],dl);P1[r]=fsub_s(P1[r],dl);} \
      negms=-mhat; } \
    _Pragma("unroll") for(int r=0;r<16;++r)P0[r]=__builtin_amdgcn_exp2f(P0[r]); }while(0)
  #define RESC() do{ if(resc){ asm volatile("s_waitcnt lgkmcnt(0)":::"memory"); \
      _Pragma("unroll") for(int d_=0;d_<2;++d_) _Pragma("unroll") for(int r=0;r<16;++r)o[d_][r]*=wsf[crow(r,hi)]; } }while(0)
  f32x16 pA0,pA1,pB0,pB1;
  int sl_prev=0,sl_cur=0,sl_next=SLOTB;
  #define ROT() do{sl_prev=sl_cur;sl_cur=sl_next;sl_next=(sl_next==(NSLOT-1)*SLOTB)?0:sl_next+SLOTB;}while(0)
  DMA_K(2,2*SLOTB);
  { __attribute__((address_space(3))) float*dkw=(__attribute__((address_space(3))) float*)((__attribute__((address_space(3))) char*)shm+LDS_DK);
    #pragma unroll
    for(int u_=0;u_<4;++u_){ const int j_=tv_+u_*NW*64; if(j_<ndk)dkw[j_]=(dkv_[u_]-cref)*1.4426950408889634f; }
    for(int j=tv_+4*NW*64;j<ndk;j+=NW*64)dkw[j]=(cb[kv0+j]-cref)*1.4426950408889634f; }
  WAIT_BAR(3);
  qkt(pA0,pA1,Kbase,qr,zero16,r32,hi);asm volatile("s_nop 15\n\ts_nop 7":"+v"(pA0),"+v"(pA1));CMASK(pA0,pA1,0);DECAY(pA0,pA1,0);
  START(pA0,pA1);
  _Pragma("unroll") for(int r=0;r<16;++r)pA1[r]=__builtin_amdgcn_exp2f(pA1[r]);
  WAIT_BAR(0);
  DMA_K(3,0);DMA_V(1,SLOTB);
  ROT();
  kload8(kf,kp0+sl_cur);
  WAIT_BAR(2);
  s16x4 vlo[8],vhi[8]; u32x4 pw0,pw1,pw2,pw3;
  #define PKW(P,B) cvtpk_s(P[B],P[B+1])
  #define PAF(k) __builtin_bit_cast(bf16x8,pw##k)
  #define VFR(i) (bf16x8){vlo[i][0],vlo[i][1],vlo[i][2],vlo[i][3],vhi[i][0],vhi[i][1],vhi[i][2],vhi[i][3]}
  #define PIN(x) asm volatile("":"+v"(x))
  #define MX3(a,b,c) __builtin_fmaxf(__builtin_fmaxf((a),(b)),(c))
  #define GAPA(MF,A0,A1,A2,A3,W0,W1,PW) do{ MF; sacc+=A0; sacc+=A1; sacc+=A2; sacc+=A3; PIN(sacc); W0; W1; PIN(PW); SBAR(); }while(0)
  #define EX(v) __builtin_amdgcn_exp2f(v)
  #define GAPB(MF,X,B) do{ MF; X[B]=EX(X[B]); X[B+1]=EX(X[B+1]); X[B+2]=EX(X[B+2]); X[B+3]=EX(X[B+3]); PIN(X); SBAR(); }while(0)
  #define VRD(i) do{ vlo[i]=vtr(vp_+(((i)>>2)*4096+((i)&3)*1024)); vhi[i]=vtr(vp_+(((i)>>2)*4096+((i)&3)*1024+512)); }while(0)
  #define KRD(G,j) do{ if(G){ kload2(kf,kp0+sl_next,j); SBAR(); } }while(0)
  #define STEP(C0,C1,P0,P1,t,GK,GV,GL) do{ SBAR(); \
    const lds_cptr vp_=vp0+sl_prev; \
    CINIT(C0,t,0); VRD(0); SBAR(); float sacc=(P0[0]+P0[1]); \
    GAPA(C0=__builtin_amdgcn_mfma_f32_32x32x16_bf16(kf[0],qr[0],C0,0,0,0), P0[2],P0[3],P0[4],P0[5],     pw0[0]=PKW(P0,0), pw0[1]=PKW(P0,2), pw0); \
    CINIT(C1,t,32); VRD(4); SBAR(); GAPA(C1=__builtin_amdgcn_mfma_f32_32x32x16_bf16(kf[1],qr[0],C1,0,0,0), P0[6],P0[7],P0[8],P0[9],     pw0[2]=PKW(P0,4), pw0[3]=PKW(P0,6), pw0); \
    VRD(1); SBAR(); GAPA(C0=__builtin_amdgcn_mfma_f32_32x32x16_bf16(kf[2],qr[1],C0,0,0,0),   P0[10],P0[11],P0[12],P0[13], pw1[0]=PKW(P0,8), pw1[1]=PKW(P0,10), pw1); \
    VRD(5); SBAR(); GAPA(C1=__builtin_amdgcn_mfma_f32_32x32x16_bf16(kf[3],qr[1],C1,0,0,0),   P0[14],P0[15],P1[0],P1[1],   pw1[2]=PKW(P0,12),pw1[3]=PKW(P0,14), pw1); \
    VRD(2); SBAR(); GAPA(C0=__builtin_amdgcn_mfma_f32_32x32x16_bf16(kf[4],qr[2],C0,0,0,0),   P1[2],P1[3],P1[4],P1[5],     pw2[0]=PKW(P1,0), pw2[1]=PKW(P1,2), pw2); \
    VRD(6); SBAR(); GAPA(C1=__builtin_amdgcn_mfma_f32_32x32x16_bf16(kf[5],qr[2],C1,0,0,0),   P1[6],P1[7],P1[8],P1[9],     pw2[2]=PKW(P1,4), pw2[3]=PKW(P1,6), pw2); \
    VRD(3); SBAR(); GAPA(C0=__builtin_amdgcn_mfma_f32_32x32x16_bf16(kf[6],qr[3],C0,0,0,0),   P1[10],P1[11],P1[12],P1[13], pw3[0]=PKW(P1,8), pw3[1]=PKW(P1,10), pw3); \
    VRD(7); SBAR(); GAPA(C1=__builtin_amdgcn_mfma_f32_32x32x16_bf16(kf[7],qr[3],C1,0,0,0),   P1[14],P1[15],0.f,0.f,       pw3[2]=PKW(P1,12),pw3[3]=PKW(P1,14), pw3); \
    l_reg+=sacc; \
    if(GK){DMA_K((t)+3,sl_cur);} if(GV){DMA_V((t)+1,sl_next);} \
    CMASK(C0,C1,t); \
    { float a=MX3(C0[0],C0[1],C1[0]),b=MX3(C0[2],C0[3],C1[1]); a=MX3(a,C1[2],C1[3]); \
      _Pragma("unroll") for(int r=4;r<16;r+=4){a=MX3(a,C0[r],C0[r+1]);b=MX3(b,C0[r+2],C0[r+3]);a=MX3(a,C1[r],C1[r+1]);b=MX3(b,C1[r+2],C1[r+3]);} \
      float rm=__builtin_fmaxf(a,b); { auto rr=__builtin_amdgcn_permlane32_swap(__float_as_uint(rm),__float_as_uint(rm),false,false); rm=__builtin_fmaxf(__uint_as_float(rr[0]),__uint_as_float(rr[1])); } \
      resc=false; \
      if(__builtin_expect(__any(rm>(float)THRL),0)){ const float dl=__builtin_fmaxf(rm,0.f); mhat+=dl; \
        _Pragma("unroll") for(int r=0;r<16;++r){C0[r]-=dl;C1[r]-=dl;} \
        negms=-mhat; \
        const float f=__builtin_amdgcn_exp2f(-dl); l_reg*=f; if(hi==0)wsf[r32]=f; resc=true; } } \
    SBAR(); \
    GAPB(o[0]=__builtin_amdgcn_mfma_f32_32x32x16_bf16(PAF(0),VFR(0),o[0],0,0,0), C0,0); \
    GAPB(o[1]=__builtin_amdgcn_mfma_f32_32x32x16_bf16(PAF(0),VFR(4),o[1],0,0,0), C0,4); \
    KRD(GL,0); GAPB(o[0]=__builtin_amdgcn_mfma_f32_32x32x16_bf16(PAF(1),VFR(1),o[0],0,0,0), C0,8); \
    KRD(GL,1); GAPB(o[1]=__builtin_amdgcn_mfma_f32_32x32x16_bf16(PAF(1),VFR(5),o[1],0,0,0), C0,12); \
    KRD(GL,2); GAPB(o[0]=__builtin_amdgcn_mfma_f32_32x32x16_bf16(PAF(2),VFR(2),o[0],0,0,0), C1,0); \
    KRD(GL,3); GAPB(o[1]=__builtin_amdgcn_mfma_f32_32x32x16_bf16(PAF(2),VFR(6),o[1],0,0,0), C1,4); \
    GAPB(o[0]=__builtin_amdgcn_mfma_f32_32x32x16_bf16(PAF(3),VFR(3),o[0],0,0,0), C1,8); \
    GAPB(o[1]=__builtin_amdgcn_mfma_f32_32x32x16_bf16(PAF(3),VFR(7),o[1],0,0,0), C1,12); \
    }while(0)
  int t=1;
  #undef CMASK
  #define CMASK(P0,P1,t) do{}while(0)
  for(;t+5<NT;t+=2){
    STEP(pB0,pB1,pA0,pA1,t,true,true,true);     WAIT_BAR(2); RESC(); ROT();
    STEP(pA0,pA1,pB0,pB1,t+1,true,true,true);   WAIT_BAR(2); RESC(); ROT();
  }
  #undef CMASK
  #define CMASK(P0,P1,t) do{int jb_=(t)-(NT-4); if(jb_>=0)cmask(P0,P1,jb_,qrel,hi);}while(0)
  #define ENDW(tt) do{ if((tt)+3<NT){WAIT_BAR(2);} else if((tt)+2<NT){WAIT_BAR(1);} else {WAIT_BAR(0);} }while(0)
  for(;t+1<NT;t+=2){
    STEP(pB0,pB1,pA0,pA1,t,(t+3<NT),(t+1<NT),(t+1<NT));       ENDW(t);   RESC(); ROT();
    STEP(pA0,pA1,pB0,pB1,t+1,(t+4<NT),(t+2<NT),(t+2<NT));     ENDW(t+1); RESC(); ROT();
  }
  STEP(pB0,pB1,pA0,pA1,NT-1,false,false,false); RESC();
  { float sacc=pB0[0]+pB0[1]; _Pragma("unroll") for(int r=2;r<16;++r)sacc+=pB0[r]; _Pragma("unroll") for(int r=0;r<16;++r)sacc+=pB1[r]; l_reg+=sacc;
    pw0=(u32x4){PKW(pB0,0),PKW(pB0,2),PKW(pB0,4),PKW(pB0,6)};pw1=(u32x4){PKW(pB0,8),PKW(pB0,10),PKW(pB0,12),PKW(pB0,14)};pw2=(u32x4){PKW(pB1,0),PKW(pB1,2),PKW(pB1,4),PKW(pB1,6)};pw3=(u32x4){PKW(pB1,8),PKW(pB1,10),PKW(pB1,12),PKW(pB1,14)};
    SBAR(); pv(o,vb0+sl_cur,PAF(0),PAF(1),PAF(2),PAF(3)); }
  #undef PKW
  #undef PAF
  #undef VFR
  #undef PIN
  #undef MX3
  #undef GAPA
  #undef GAPB
  #undef EX
  #undef VRD
  #undef KRD
  #undef STEP
  #undef ENDW
  {auto rr=__builtin_amdgcn_permlane32_swap(__float_as_uint(l_reg),__float_as_uint(l_reg),false,false);l_reg=__uint_as_float(rr[0])+__uint_as_float(rr[1]);}
  if(hi==0)wsf[32+r32]=l_reg;asm volatile("s_waitcnt lgkmcnt(0)":::"memory");
  float rli[16];
  #pragma unroll
  for(int r=0;r<16;++r)rli[r]=__builtin_amdgcn_rcpf(wsf[32+crow(r,hi)]);
  bf16*Ow=O+(rowbase+q0+wid*QBLK)*DM+h*D;
  { bf16*stg=(bf16*)(shm+LDS_OST)+wid*2048;
    #pragma unroll
    for(int r=0;r<16;++r){const int orow=crow(r,hi);
      #pragma unroll
      for(int d0=0;d0<2;++d0)stg[orow*64+d0*32+r32]=__float2bfloat16(o[d0][r]*rli[r]);}
    asm volatile("s_waitcnt lgkmcnt(0)":::"memory");
    #pragma unroll
    for(int i=0;i<4;++i){const int row=i*8+(lane>>3),ch=lane&7; const u32x4 v=*(const u32x4*)(stg+row*64+ch*8); ATTN_STORE16(Ow+(long)row*DM+ch*8,v);} }
  asm volatile("s_waitcnt lgkmcnt(0)\n\ts_barrier":::"memory");
  #undef DECAY
  #undef CINIT
  #undef DMA_K
  #undef DMA_V
  #undef CMASK
  #undef START
  #undef RESC
  #undef ROT
}
constexpr int ATTN_LDS_BYTES=LDS_BYTES;
struct AttnTensors { const bf16* Q; const bf16* K; const bf16* V; bf16* O; const float* cum; float thr2; };
struct AttnUnit { int bh; int qb; };
struct StaticOrder {
  int vcu;
  __device__ __forceinline__ explicit StaticOrder(int grid,int block):vcu((block%8)*(grid/8)+block/8){}
  __device__ __forceinline__ bool next(int i,AttnUnit&u)const{ if(i>=2)return false; const int s=vcu&15; u.bh=vcu>>4; u.qb=(i==0)?s:31-s; return true; }
  __device__ __forceinline__ void a_ready(const AttnUnit&)const{}
  __device__ __forceinline__ void done(const AttnUnit&)const{}
};
template<class Sched,int THRL=24> __device__ __forceinline__ void attn_phase(char*lds,const AttnTensors&T,const Sched&S){
  AttnUnit u;
  for(int i=0;S.next(i,u);++i){ S.a_ready(u); attn_unit<THRL>(u.bh/NHEAD,u.bh%NHEAD,u.qb,T.Q,T.K,T.V,T.O,T.cum,T.thr2,lds); S.done(u); }
}
#undef SBAR
#undef WAIT_BAR
}

constexpr int NWAVES = 8;
constexpr int BATCH = 2, SEQ = 8192, DMODEL = 1024, T = BATCH * SEQ;
constexpr int CONVD = 512, CONVW = 31, NHEAD = 8, HD = 64, ATT = 512;
constexpr int NE = 64, TOPK = 8, EF = 256, SF = 256;
constexpr int INCOLS = 4616, OFF_Q = 1024, OFF_K = 1536, OFF_V = 2048, OFF_F = 2560, OFF_GC = 2568, OFF_GA = 3592;
constexpr int NIN = 4608;
constexpr float EPS = 1e-6f, LOG2E = 1.4426950408889634f, ROUTED_SCALE = 2.5f;
constexpr float C2Q = 0.125f * 1.4426950408889634f;
constexpr int LISTCAP = T;
constexpr int ACT_ROWS = T * TOPK + NE * 256;

constexpr size_t MiB = 1u << 20, KiB = 1u << 10;
constexpr size_t WS_CTL = 0, CTL_ZERO_BYTES = 1 * MiB;
constexpr size_t WS_MODP = 1 * MiB;
constexpr size_t WS_MOD = WS_MODP + 768 * KiB;
constexpr size_t WS_LOGF = 2 * MiB;
constexpr size_t WS_CUM = 2 * MiB + 512 * KiB;
constexpr size_t WS_SSQ = 3 * MiB;
constexpr size_t WS_XMX = 3 * MiB + 256 * KiB;
constexpr size_t WS_WFT = 3 * MiB + 640 * KiB;
constexpr size_t WS_SA1 = 3 * MiB + 512 * KiB, WS_SA2 = 3 * MiB + 576 * KiB;
constexpr size_t WS_SLIST = 21 * MiB;
constexpr size_t WS_WRH = 4 * MiB, WS_WRL = 4 * MiB + 128 * KiB;
constexpr size_t WS_WLIST = 5 * MiB;
constexpr size_t WS_LIST = 9 * MiB;
constexpr size_t WS_WIN = 16 * MiB, WS_WC = 25 * MiB, WS_WA = 26 * MiB, WS_WOUT = 27 * MiB, WS_WSGU = 29 * MiB, WS_WSD = 30 * MiB;
constexpr size_t WS_WGU = 32 * MiB, WS_WD = 96 * MiB;
constexpr size_t WS_H2 = 128 * MiB, WS_ACT = 160 * MiB, WS_SACT = 232 * MiB;
constexpr size_t WS_H1 = 240 * MiB, WS_U = 272 * MiB, WS_Q = 288 * MiB, WS_K = 304 * MiB, WS_V = 320 * MiB, WS_SG = 336 * MiB, WS_UC = 400 * MiB, WS_O = 416 * MiB, WS_MG = 432 * MiB;
constexpr size_t WS_SLAB = 240 * MiB;
constexpr size_t WS_END = 512 * MiB;
static_assert(WS_ACT + (size_t)ACT_ROWS * EF * 2 <= WS_SACT && WS_SLAB + (size_t)T * TOPK * DMODEL * 2 <= WS_END && WS_MG + (size_t)T * DMODEL * 2 <= WS_SLAB + 256 * MiB, "ws map");
constexpr int CW_TMO = 0, CW_CODE = 1;
constexpr int CW_CNT = 1024;
constexpr int CW_DYN = 7168;
constexpr int CW_BAR = 8192;

constexpr int RING_OFF = 0, RING_BYTES = 131072;
constexpr int LDSCTL_OFF = RING_BYTES, MISC_OFF = LDSCTL_OFF + 320;
constexpr int TAB_OFF = RING_BYTES + 1024;
constexpr int LDS_BYTES = 147456;

#define GAS __attribute__((address_space(1)))
#define LAS __attribute__((address_space(3)))
typedef unsigned short bf16;
typedef unsigned v4u __attribute__((ext_vector_type(4)));
typedef unsigned v2u __attribute__((ext_vector_type(2)));
typedef float f32x4 __attribute__((ext_vector_type(4)));
typedef float f32x2 __attribute__((ext_vector_type(2)));
typedef float f32x16 __attribute__((ext_vector_type(16)));
typedef short bf16x8 __attribute__((ext_vector_type(8)));
typedef GAS unsigned gu32;
#define RLX_AGENT __ATOMIC_RELAXED, __HIP_MEMORY_SCOPE_AGENT
#define LDS_WAIT() asm volatile("s_waitcnt lgkmcnt(0)" ::: "memory")
#define VM_WAIT() asm volatile("s_waitcnt vmcnt(0)" ::: "memory")
__device__ __forceinline__ unsigned f2bf(float f) { unsigned u = __builtin_bit_cast(unsigned, f); return (u + 0x7fffu + ((u >> 16) & 1u)) >> 16; }
__device__ __forceinline__ unsigned pk2(float lo, float hi) { return pg8::cvt_pk_bf16(lo, hi); }
__device__ __forceinline__ float bf2f(unsigned h) { return __builtin_bit_cast(float, h << 16); }
template <int CTRL> __device__ __forceinline__ float dppf(float v) { return __builtin_bit_cast(float, __builtin_amdgcn_update_dpp(__builtin_bit_cast(int, v), __builtin_bit_cast(int, v), CTRL, 0xf, 0xf, false)); }
__device__ __forceinline__ float shx1(float v) { return dppf<0xB1>(v); }
__device__ __forceinline__ float shx2(float v) { return dppf<0x4E>(v); }
__device__ __forceinline__ float shx4(float v) { return dppf<0x1B>(dppf<0x141>(v)); }
__device__ __forceinline__ float shx8(float v) { return dppf<0x128>(v); }
__device__ __forceinline__ float row16_sum(float v) { v += shx1(v); v += shx2(v); v += dppf<0x141>(v); v += dppf<0x140>(v); return v; }
__device__ __forceinline__ float row16_max(float v) { v = fmaxf(v, shx1(v)); v = fmaxf(v, shx2(v)); v = fmaxf(v, dppf<0x141>(v)); v = fmaxf(v, dppf<0x140>(v)); return v; }
__device__ __forceinline__ float rdl(float v, int l) { return __builtin_bit_cast(float, __builtin_amdgcn_readlane(__builtin_bit_cast(int, v), l)); }
__device__ __forceinline__ float wave_sum(float v) { v = row16_sum(v); return (rdl(v, 0) + rdl(v, 16)) + (rdl(v, 32) + rdl(v, 48)); }
__device__ __forceinline__ float wave_max(float v) { v = row16_max(v); return fmaxf(fmaxf(rdl(v, 0), rdl(v, 16)), fmaxf(rdl(v, 32), rdl(v, 48))); }
using pg8::cvt_pk_bf16; using pg8::bf_lo; using pg8::bf_hi; using pg8::sigmoidf_fast;

#ifndef DIAG_BLK
#define DIAG_BLK 0
#endif
#define XB_TMO      128
#define XB_XCNT(j)  (256  + 64 * (j))
#define XB_XSUB(j)  (1280 + 64 * (j))
#define XB_XGEN(j)  (2304 + 64 * (j))
#define XB_TOP      3328
#define XB_TOPGEN   3392
#define XCD_BAR_WORDS 3456
#define XB_SPIN_CAP (1u << 18)

__device__ __forceinline__ unsigned xb_ld(unsigned* p)              { return __hip_atomic_load(p, __ATOMIC_RELAXED, __HIP_MEMORY_SCOPE_AGENT); }
__device__ __forceinline__ unsigned xb_add(unsigned* p, unsigned v) { return __hip_atomic_fetch_add(p, v, __ATOMIC_RELAXED, __HIP_MEMORY_SCOPE_AGENT); }
__device__ __forceinline__ unsigned xb_xcc_id() { return (unsigned)__builtin_amdgcn_s_getreg((3 << 11) | 20) & 0xFu; }
#define XB_SPIN(cond, bar) do { unsigned _sp = 0; while (cond) { __builtin_amdgcn_s_sleep(1); \
    if ((++_sp & 255u) == 0u) { if (xb_ld(&(bar)[XB_TMO])) break; if (_sp > XB_SPIN_CAP) { atomicAdd(&(bar)[XB_TMO], 1u); break; } } } } while (0)

struct XcdBarrier {
    unsigned* bar; unsigned x;
    volatile LAS unsigned* st;
};

__device__ __forceinline__ XcdBarrier xcd_barrier_post(unsigned* bar, volatile LAS unsigned* st) {
    XcdBarrier b; b.bar = bar; b.x = xb_xcc_id(); b.st = st;
    if (threadIdx.x == 0) (void)xb_add(&bar[XB_XCNT(b.x)], 1u);
    return b;
}
__device__ __forceinline__ void xcd_barrier_complete(unsigned* bar, unsigned x, unsigned& nloc, unsigned& nx) {
    const unsigned G = gridDim.x * gridDim.y * gridDim.z;
    unsigned sum, cnt, mine, sp = 0u;
    for (;;) {
        sum = 0u; cnt = 0u; mine = 0u;
#pragma unroll
        for (unsigned j = 0; j < 16; ++j) { const unsigned c = xb_ld(&bar[XB_XCNT(j)]); sum += c; cnt += (c > 0u) ? 1u : 0u; mine = (j == x) ? c : mine; }
        if (sum == G) break;
        __builtin_amdgcn_s_sleep(1);
        if ((++sp & 255u) == 0u) { if (xb_ld(&bar[XB_TMO])) break; if (sp > XB_SPIN_CAP) { atomicAdd(&bar[XB_TMO], 1u); break; } }
    }
    nloc = mine > 0u ? mine : 1u; nx = cnt > 0u ? cnt : 1u;
}

template <bool SPLIT = false>
__device__ __forceinline__ void xcd_barrier(const XcdBarrier& b) {
    if constexpr (!SPLIT) {
    asm volatile("s_waitcnt vmcnt(0)" ::: "memory");
    __syncthreads();
    }
    if (threadIdx.x == 0) {
        unsigned* bar = b.bar;
        __builtin_amdgcn_s_waitcnt(0);
        unsigned nloc = b.st[0], nx = b.st[1];
        if (nloc == 0u) { xcd_barrier_complete(bar, b.x, nloc, nx); b.st[0] = nloc; b.st[1] = nx; }
        const unsigned old = xb_add(&bar[XB_XSUB(b.x)], 1u);
        const unsigned gen = old / nloc;
        if (old + 1u == (gen + 1u) * nloc) {
            asm volatile("buffer_wbl2 sc1\n\tbuffer_inv sc1\n\ts_waitcnt vmcnt(0)" ::: "memory");
            const unsigned og = xb_add(&bar[XB_TOP], 1u);
            const unsigned tg = og / nx;
            if (og + 1u == (tg + 1u) * nx) xb_add(&bar[XB_TOPGEN], 1u);
            else XB_SPIN(xb_ld(&bar[XB_TOPGEN]) == tg, bar);
            asm volatile("" ::: "memory");
            xb_add(&bar[XB_XGEN(b.x)], 1u);
            asm volatile("s_waitcnt vmcnt(0)" ::: "memory");
        } else {
            asm volatile("buffer_inv sc1" ::: "memory");
            XB_SPIN(xb_ld(&bar[XB_XGEN(b.x)]) == gen, bar);
            asm volatile("" ::: "memory");
            asm volatile("s_waitcnt vmcnt(0)" ::: "memory");
        }
    }
    __syncthreads();
}

__device__ __forceinline__ int win_dst_row(int n) {
    if (n < 512) return 256 * (n >> 7) + (n & 127);
    if (n < 1024) { const int f = n - 512; return 256 * (f >> 7) + 128 + (f & 127); }
    if (n < 2048) { const int isk = n >= OFF_K, j = n - (isk ? OFF_K : OFF_Q), head = j >> 6, d = j & 63;
        return 256 * (4 + 2 * isk + (head >> 2)) + 128 * (d >> 5) + 32 * (head & 3) + (d & 31); }
    if (n < OFF_F) return 256 * 8 + (n - OFF_V);
    if (n < OFF_GC) return -1;
    return 256 * 10 + (n - OFF_GC);
}
__device__ __forceinline__ int glu_dst_row(int n, int F) { const int isu = n >= F, f = n - (isu ? F : 0); return 256 * (f >> 7) + 128 * isu + (f & 127); }

__device__ __forceinline__ unsigned pk4_i8_nc(float a, float b, float c, float d) {
    const unsigned ua = __builtin_bit_cast(unsigned, a + 12582912.0f), ub = __builtin_bit_cast(unsigned, b + 12582912.0f), uc = __builtin_bit_cast(unsigned, c + 12582912.0f), ud = __builtin_bit_cast(unsigned, d + 12582912.0f);
    return __builtin_amdgcn_perm(__builtin_amdgcn_perm(ud, uc, 0x0c0c0400u), __builtin_amdgcn_perm(ub, ua, 0x0c0c0400u), 0x05040100u); }
__device__ __forceinline__ unsigned pk4_i8(float a, float b, float c, float d) {
    return pk4_i8_nc(__builtin_amdgcn_fmed3f(a, -127.f, 127.f), __builtin_amdgcn_fmed3f(b, -127.f, 127.f), __builtin_amdgcn_fmed3f(c, -127.f, 127.f), __builtin_amdgcn_fmed3f(d, -127.f, 127.f)); }
constexpr float WGU_MARGIN = 1.25f;
constexpr int CW_AMAX = 6144;
__device__ __forceinline__ unsigned pk4_fp8(float a, float b, float c, float d) { int p = __builtin_amdgcn_cvt_pk_fp8_f32(a, b, 0, false); p = __builtin_amdgcn_cvt_pk_fp8_f32(c, d, p, true); return (unsigned)p; }
#ifndef MOE_FP8
#define MOE_FP8 0
#endif
constexpr float W8SCALE = MOE_FP8 ? 32.0f : 1.0f;
constexpr float SLABSCALE = 16.0f;
__device__ __forceinline__ void tr_load(f32x4 (&ld)[8], const float* W, int ldw, int k0, int n0, int lane) {
#pragma unroll
    for (int i = 0; i < 8; ++i) ld[i] = __builtin_nontemporal_load((const f32x4*)(W + (size_t)(k0 + 8 * i + (lane >> 3)) * ldw + n0 + 4 * (lane & 7)));
}
template <int MODE>
__device__ __forceinline__ void tr_finish(const f32x4 (&ld)[8], int ldw, int K, bf16* WT, bf16* WT2, int k0, int n0, LAS float* scr, int lane, float qs = 1.0f) {
#pragma unroll
    for (int i = 0; i < 8; ++i) { LAS float* d = scr + (8 * i + (lane >> 3)) * 33 + 4 * (lane & 7); d[0] = ld[i][0]; d[1] = ld[i][1]; d[2] = ld[i][2]; d[3] = ld[i][3]; }
    LDS_WAIT(); asm volatile("" ::: "memory");
    if (MODE == 5 || MODE == 6) {
        const int c16 = lane & 3;
#pragma unroll
        for (int j = 0; j < 2; ++j) { const int n = (lane >> 2) + 16 * j; const LAS float* s = scr + (16 * c16) * 33 + n;
            int row = n0 + n;
            if (MODE == 5) row = win_dst_row(row); else row = glu_dst_row(row, ldw >> 1);
            float v[16];
#pragma unroll
            for (int q = 0; q < 16; ++q) v[q] = s[q * 33] * qs;
            if (MODE == 5 && row < 0) continue;
            *(GAS v4u*)((unsigned char*)WT + (size_t)row * K + k0 + 16 * c16) = (v4u){pk4_i8(v[0], v[1], v[2], v[3]), pk4_i8(v[4], v[5], v[6], v[7]), pk4_i8(v[8], v[9], v[10], v[11]), pk4_i8(v[12], v[13], v[14], v[15])}; }
        LDS_WAIT(); asm volatile("" ::: "memory");
        return;
    }
    const int c = lane & 7;
#pragma unroll
    for (int j = 0; j < 4; ++j) { const int n = (lane >> 3) + 8 * j; const LAS float* s = scr + (8 * c) * 33 + n;
        int row = n0 + n;
        if (MODE == 1 || MODE == 5) row = win_dst_row(row);
        if (MODE == 2 || MODE == 4 || MODE == 6) row = glu_dst_row(row, ldw >> 1);
        float v[8];
#pragma unroll
        for (int q = 0; q < 8; ++q) v[q] = s[q * 33];
        if ((MODE == 1 || MODE == 5) && row < 0) continue;
        if (MODE == 5 || MODE == 6) { v2u o8; o8.x = pk4_i8(v[0] * qs, v[1] * qs, v[2] * qs, v[3] * qs); o8.y = pk4_i8(v[4] * qs, v[5] * qs, v[6] * qs, v[7] * qs);
            *(GAS v2u*)((unsigned char*)WT + (size_t)row * K + k0 + 8 * c) = o8; continue; }
        if (MODE == 4) { v2u o8; o8.x = pk4_fp8(v[0] * W8SCALE, v[1] * W8SCALE, v[2] * W8SCALE, v[3] * W8SCALE); o8.y = pk4_fp8(v[4] * W8SCALE, v[5] * W8SCALE, v[6] * W8SCALE, v[7] * W8SCALE);
            *(GAS v2u*)((unsigned char*)WT + (size_t)row * K + k0 + 8 * c) = o8; continue; }
        v4u o; o.x = pk2(v[0], v[1]); o.y = pk2(v[2], v[3]); o.z = pk2(v[4], v[5]); o.w = pk2(v[6], v[7]);
        *(GAS v4u*)(WT + (size_t)row * K + k0 + 8 * c) = o;
        if (MODE == 3) { float r[8];
#pragma unroll
            for (int q = 0; q < 8; ++q) r[q] = v[q] - bf2f(f2bf(v[q]));
            v4u o2; o2.x = pk2(r[0], r[1]); o2.y = pk2(r[2], r[3]); o2.z = pk2(r[4], r[5]); o2.w = pk2(r[6], r[7]);
            *(GAS v4u*)(WT2 + (size_t)row * K + k0 + 8 * c) = o2; }
    }
    LDS_WAIT(); asm volatile("" ::: "memory");
}

template <int MODE>
__device__ __forceinline__ void tr_item(const float* W, int ldw, int K, bf16* WT, bf16* WT2, int k0, int n0, LAS float* scr, int lane, float qs = 1.0f) {
    f32x4 ld[8]; tr_load(ld, W, ldw, k0, n0, lane); tr_finish<MODE>(ld, ldw, K, WT, WT2, k0, n0, scr, lane, qs);
}
struct KArgs { const float* in[23]; float* out; unsigned char* ws; int ph_lo, ph_hi; };

__device__ __forceinline__ void p0_prologue(const KArgs& a, LAS unsigned char* lds, int vcu, int G, int wave, int lane) {
    LAS float* scr = (LAS float*)(lds + RING_OFF + wave * 16384);
    const int gw = vcu * NWAVES + wave, NGW = G * NWAVES;
    unsigned char* ws = a.ws;
    {
        const float* c = a.in[1]; const float* wada = a.in[2]; float* modp = (float*)(ws + WS_MODP);
        for (int it = gw; it < 96 * 16; it += NGW) {
            const int cg = it % 96, kc = it / 96, n = 64 * cg + lane; float s0 = 0.f, s1 = 0.f;
            const float* wp = wada + (size_t)(64 * kc) * 6144 + n;
            float wv[64];
#pragma unroll
            for (int k = 0; k < 64; ++k) wv[k] = __builtin_nontemporal_load(wp + (size_t)k * 6144);
            const float cl0 = c[64 * kc + lane], cl1 = c[1024 + 64 * kc + lane];
            const float sl0 = cl0 / (1.0f + __expf(-cl0)), sl1 = cl1 / (1.0f + __expf(-cl1));
#pragma unroll
            for (int k = 0; k < 64; ++k) { s0 += __builtin_bit_cast(float, __builtin_amdgcn_readlane(__builtin_bit_cast(int, sl0), k)) * wv[k]; s1 += __builtin_bit_cast(float, __builtin_amdgcn_readlane(__builtin_bit_cast(int, sl1), k)) * wv[k]; }
            modp[(size_t)(kc * 2 + 0) * 6144 + n] = s0; modp[(size_t)(kc * 2 + 1) * 6144 + n] = s1;
        }
    }
    for (int it = gw - 1536; it >= 0 && it < 16; it += NGW) { const int k = 64 * it + lane; const float* src = a.in[5] + (size_t)k * INCOLS + OFF_F;
        const f32x4 w0 = *(const f32x4*)src, w1 = *(const f32x4*)(src + 4); float* dst = (float*)(ws + WS_WFT) + k;
        dst[0] = w0[0]; dst[1024] = w0[1]; dst[2048] = w0[2]; dst[3072] = w0[3]; dst[4096] = w1[0]; dst[5120] = w1[1]; dst[6144] = w1[2]; dst[7168] = w1[3]; }
#if defined(DIAG_A)
    if (blockIdx.x == DIAG_BLK && threadIdx.x == 0) ((unsigned long long*)(ws + WS_CTL + 512 * 1024))[23] = __builtin_amdgcn_s_memrealtime();
#endif
    {
        unsigned* amax = (unsigned*)(ws + WS_CTL) + CW_AMAX;
        constexpr int C4 = 2048, N_WIN4 = DMODEL * INCOLS / 4, IT_WIN = (N_WIN4 + C4 - 1) / C4, IT_WSGU = (1024 * 512 / 4) / C4, WGU_SAMPLE = 8, IT_WGU = 64 * WGU_SAMPLE;
        constexpr int NABS = IT_WIN + IT_WSGU + IT_WGU, AB0 = 2048 - NABS;
        static_assert(AB0 >= 0, "absmax item placement");
        int it0 = gw, step = NGW;
        if (NGW == 2048) { step = 1 << 30; it0 = gw >= AB0 ? gw - AB0 : NABS; }
        for (int it = it0; it < NABS; it += step) {
            const f32x4* p; int n4; unsigned* dst;
            if (it < IT_WIN) { p = (const f32x4*)a.in[5] + (size_t)it * C4; n4 = (it == IT_WIN - 1) ? N_WIN4 - it * C4 : C4; dst = amax; }
            else if (it < IT_WIN + IT_WSGU) { p = (const f32x4*)a.in[21] + (size_t)(it - IT_WIN) * C4; n4 = C4; dst = amax + 1; }
            else { const int r = it - IT_WIN - IT_WSGU, e = r / WGU_SAMPLE; p = (const f32x4*)a.in[19] + ((size_t)e * IT_WSGU + r % WGU_SAMPLE) * C4; n4 = C4; dst = amax + 2 + e; }
            float m = 0.f;
#pragma unroll 16
            for (int i = lane; i < n4; i += 64) { const f32x4 v = __builtin_nontemporal_load(p + i); m = fmaxf(m, fmaxf(fmaxf(fabsf(v[0]), fabsf(v[1])), fmaxf(fabsf(v[2]), fabsf(v[3])))); }
            m = wave_max(m);
            if (lane == 0) atomicMax(dst, __builtin_bit_cast(unsigned, m));
        }
    }
}
__device__ __forceinline__ void p0_copies(const KArgs& a, LAS unsigned char* lds, int vcu, int G, int wave, int lane) {
    LAS float* scr = (LAS float*)(lds + RING_OFF + wave * 16384);
    const int gw = vcu * NWAVES + wave, NGW = G * NWAVES; unsigned char* ws = a.ws;
    constexpr int I_WC = 8 * 32, I_WA = 8 * 32, I_WOUT = 16 * 32, I_WSD = 4 * 32, I_WR = 16 * 2;
    constexpr int NITEMS = I_WC + I_WA + I_WOUT + I_WSD + I_WR;
    for (int it = gw; it < NITEMS; it += NGW) {
        int r = it;
        if (r < I_WC) { tr_item<0>(a.in[10], 1024, 512, (bf16*)(ws + WS_WC), nullptr, 64 * (r / 32), 32 * (r % 32), scr, lane); continue; } r -= I_WC;
        if (r < I_WA) { tr_item<0>(a.in[14], 1024, 512, (bf16*)(ws + WS_WA), nullptr, 64 * (r / 32), 32 * (r % 32), scr, lane); continue; } r -= I_WA;
        if (r < I_WOUT) { tr_item<0>(a.in[15], 1024, 1024, (bf16*)(ws + WS_WOUT), nullptr, 64 * (r / 32), 32 * (r % 32), scr, lane); continue; } r -= I_WOUT;
        if (r < I_WSD) { tr_item<0>(a.in[22], 1024, 256, (bf16*)(ws + WS_WSD), nullptr, 64 * (r / 32), 32 * (r % 32), scr, lane); continue; } r -= I_WSD;
        tr_item<3>(a.in[17], 64, 1024, (bf16*)(ws + WS_WRH), (bf16*)(ws + WS_WRL), 64 * (r / 2), 32 * (r % 2), scr, lane);
    }
}
__device__ __forceinline__ void q8_items(const KArgs& a, LAS unsigned char* lds, int first, int last, int vcu, int G, int wave, int lane) {
    LAS float* scr = (LAS float*)(lds + RING_OFF + wave * 16384);
    const int gw = vcu * NWAVES + wave, NGW = G * NWAVES; unsigned char* ws = a.ws;
    const unsigned* amax = (const unsigned*)(ws + WS_CTL) + CW_AMAX;
    const float am_w = __builtin_bit_cast(float, amax[0]), am_s = __builtin_bit_cast(float, amax[1]), am_l = __builtin_bit_cast(float, amax[2 + lane]);
    constexpr int I_WIN = 144 * 16, I_WSGU = 16 * 16, I_WGU = 64 * 256, NIT = I_WIN + I_WSGU + I_WGU;
    struct Job { const float* W; int ldw, k0, n0, mode; unsigned char* WT; float qs; };
    auto job = [&](int it) { Job j; int r = it;
        if (r < I_WIN) { const int cb = r % 144, kb = r / 144; j.W = a.in[5]; j.ldw = INCOLS; j.k0 = 64 * kb; j.n0 = cb < 80 ? 32 * cb : OFF_GC + 32 * (cb - 80); j.mode = 5; j.WT = ws + WS_WIN; j.qs = 127.0f / am_w; return j; } r -= I_WIN;
        if (r < I_WSGU) { j.W = a.in[21]; j.ldw = 512; j.k0 = 64 * (r / 16); j.n0 = 32 * (r % 16); j.mode = 6; j.WT = ws + WS_WSGU; j.qs = 127.0f / am_s; return j; } r -= I_WSGU;
        const int e = r / 256, q = r % 256; j.W = a.in[19] + (size_t)e * 1024 * 512; j.ldw = 512; j.k0 = 64 * (q / 16); j.n0 = 32 * (q % 16); j.mode = 6; j.WT = ws + WS_WGU + (size_t)e * 512 * 1024; j.qs = 127.0f / (WGU_MARGIN * rdl(am_l, e)); return j; };
    auto fin = [&](const f32x4 (&ld)[8], const Job& j) { if (j.mode == 5) tr_finish<5>(ld, j.ldw, 1024, (bf16*)j.WT, nullptr, j.k0, j.n0, scr, lane, j.qs); else tr_finish<6>(ld, j.ldw, 1024, (bf16*)j.WT, nullptr, j.k0, j.n0, scr, lane, j.qs); };
    f32x4 lA[8], lB[8]; int it = first + gw; if (last > NIT) last = NIT; if (it >= last) return;
    Job jA = job(it), jB = jA; tr_load(lA, jA.W, jA.ldw, jA.k0, jA.n0, lane);
    for (;;) {
        const bool hb = it + NGW < last; if (hb) { jB = job(it + NGW); tr_load(lB, jB.W, jB.ldw, jB.k0, jB.n0, lane); }
        fin(lA, jA); if (!hb) break; it += NGW;
        const bool ha = it + NGW < last; if (ha) { jA = job(it + NGW); tr_load(lA, jA.W, jA.ldw, jA.k0, jA.n0, lane); }
        fin(lB, jB); if (!ha) break; it += NGW;
    }
}
__device__ __forceinline__ void wd_items(const KArgs& a, LAS unsigned char* lds, int first, int last, int slot, int nslots, int wave, int lane) {
    LAS float* scr = (LAS float*)(lds + RING_OFF + wave * 16384);
    const int step = nslots * NWAVES; int r = first + slot * NWAVES + wave; if (r >= last) return;
    const float* Wd = a.in[20]; bf16* WT = (bf16*)(a.ws + WS_WD);
#define WD_LOAD(L, rr) tr_load(L, Wd + (size_t)((rr) / 128) * 256 * 1024, 1024, 64 * (((rr) % 128) / 32), 32 * (((rr) % 128) % 32), lane)
#define WD_FIN(L, rr) tr_finish<0>(L, 1024, 256, WT + (size_t)((rr) / 128) * 1024 * 256, nullptr, 64 * (((rr) % 128) / 32), 32 * (((rr) % 128) % 32), scr, lane)
    f32x4 lA[8], lB[8]; WD_LOAD(lA, r);
    for (;;) {
        const bool hb = r + step < last; if (hb) WD_LOAD(lB, r + step);
        WD_FIN(lA, r); if (!hb) break; r += step;
        const bool ha = r + step < last; if (ha) WD_LOAD(lA, r + step);
        WD_FIN(lB, r); if (!ha) break; r += step;
    }
#undef WD_LOAD
#undef WD_FIN
}

__device__ __forceinline__ void p1_prefetch(const KArgs& a, int vcu, int wave, int lane, f32x4 (&vvA)[4][4], f32x4 (&vvB)[4][4]) {
#pragma unroll
    for (int j = 0; j < 4; ++j) { const GAS f32x4* xa = (const GAS f32x4*)(a.in[0] + (size_t)(64 * vcu + 8 * wave + j) * DMODEL) + lane; const GAS f32x4* xb = (const GAS f32x4*)(a.in[0] + (size_t)(64 * vcu + 8 * wave + 4 + j) * DMODEL) + lane;
#pragma unroll
        for (int q = 0; q < 4; ++q) { vvA[j][q] = __builtin_nontemporal_load(xa + 64 * q); vvB[j][q] = __builtin_nontemporal_load(xb + 64 * q); } }
}
__device__ __forceinline__ void p1_rows(const KArgs& a, LAS unsigned char* lds, int vcu, int tid, int wave, int lane, f32x4 (&vvA)[4][4], f32x4 (&vvB)[4][4]) {
    unsigned char* ws = a.ws;
    const float* modp = (const float*)(ws + WS_MODP); const float* bada = a.in[3];
    LAS float* gs1 = (LAS float*)(lds + RING_OFF); LAS float* sh1 = gs1 + 1024; LAS float* wfl = gs1 + 2048;
    const int b = vcu >> 7;
    {
        const f32x4* wft = (const f32x4*)(ws + WS_WFT); f32x4 wq[4];
#pragma unroll
        for (int i = 0; i < 4; ++i) wq[i] = wft[tid + 512 * i];
        const int col = 4 * tid; f32x4 s = *(const f32x4*)(bada + col); const f32x4 g = *(const f32x4*)(a.in[4] + (col & 1023));
#pragma unroll
        for (int kc = 0; kc < 16; ++kc) s += *(const f32x4*)(modp + (size_t)(kc * 2 + b) * 6144 + col);
#pragma unroll
        for (int i = 0; i < 4; ++i) *(LAS f32x4*)(wfl + 4 * (tid + 512 * i)) = wq[i];
        if (col < 1024) { *(LAS f32x4*)(sh1 + col) = s; }
        else { *(LAS f32x4*)(gs1 + col - 1024) = g * (1.0f + s); }
    }
    __syncthreads();
    if (tid < 12) {
        float* mod = (float*)(ws + WS_MOD); const int gi = blockIdx.x * 12 + tid, bb = gi / 1536, col = 4 * (gi % 1536); f32x4 s = *(const f32x4*)(bada + col);
#pragma unroll
        for (int kc = 0; kc < 16; ++kc) s += *(const f32x4*)(modp + (size_t)(kc * 2 + bb) * 6144 + col);
        *(f32x4*)(mod + (size_t)bb * 6144 + col) = s;
    }
#if defined(DIAG_A)
    if (blockIdx.x == DIAG_BLK && threadIdx.x == 0) ((unsigned long long*)(ws + WS_CTL + 512 * 1024))[27] = __builtin_amdgcn_s_memrealtime();
#endif
    const float* x = a.in[0]; bf16* h1 = (bf16*)(ws + WS_H1); float* logf_ = (float*)(ws + WS_LOGF); const float* bfg = a.in[13];
#pragma nounroll
    for (int jb = 0; jb < 2; ++jb) {
    f32x4 vv[4][4];
#pragma unroll
    for (int j = 0; j < 4; ++j)
#pragma unroll
        for (int q = 0; q < 4; ++q) vv[j][q] = jb ? vvB[j][q] : vvA[j][q];
#pragma unroll
    for (int j = 0; j < 4; ++j) {
        const int row = 64 * vcu + 8 * wave + 4 * jb + j, t = row & (SEQ - 1);
        LAS float* gs1_ = gs1; asm volatile("" : "+v"(gs1_));
        LAS float* sh1_ = gs1_ + 1024; LAS float* wfl_ = gs1_ + 2048;
        f32x4 v[4]; float ss = 0.f;
#pragma unroll
        for (int q = 0; q < 4; ++q) { v[q] = vv[j][q]; ss += (v[q].x * v[q].x + v[q].y * v[q].y) + (v[q].z * v[q].z + v[q].w * v[q].w); }
        const float rstd = 1.0f / sqrtf(wave_sum(ss) * (1.0f / DMODEL) + EPS);
        float hm = 0.f;
#pragma unroll
        for (int q = 0; q < 4; ++q) { const f32x4 g = *(const LAS f32x4*)(gs1_ + 4 * lane + 256 * q), s = *(const LAS f32x4*)(sh1_ + 4 * lane + 256 * q);
            v[q] = v[q] * rstd * g + s; hm = fmaxf(hm, fmaxf(fmaxf(fabsf(v[q].x), fabsf(v[q].y)), fmaxf(fabsf(v[q].z), fabsf(v[q].w)))); }
        hm = wave_max(hm);
        hm = fmaxf(hm, 1e-20f); const float qinv = 127.0f / hm;
        GAS unsigned* o4 = (GAS unsigned*)((unsigned char*)h1 + (size_t)row * DMODEL) + lane;
#pragma unroll
        for (int q = 0; q < 4; ++q) o4[64 * q] = pk4_i8_nc(v[q].x * qinv, v[q].y * qinv, v[q].z * qinv, v[q].w * qinv);
        if (lane == 0) ((float*)(ws + WS_SA1))[row] = hm * (1.0f / 127.0f);
        float pf[8];
#pragma unroll
        for (int f = 0; f < 8; ++f) { float p = 0.f;
#pragma unroll
            for (int q = 0; q < 4; ++q) { const f32x4 w = *(const LAS f32x4*)(wfl_ + f * 1024 + 4 * lane + 256 * q); p += (v[q].x * w.x + v[q].y * w.y) + (v[q].z * w.z + v[q].w * w.w); }
            pf[f] = p; }
        float r4[4], r2[2], mine;
#pragma unroll
        for (int i = 0; i < 4; ++i) { const float keep = (lane & 1) ? pf[2 * i + 1] : pf[2 * i], send = (lane & 1) ? pf[2 * i] : pf[2 * i + 1]; r4[i] = keep + shx1(send); }
#pragma unroll
        for (int i = 0; i < 2; ++i) { const float keep = (lane & 2) ? r4[2 * i + 1] : r4[2 * i], send = (lane & 2) ? r4[2 * i] : r4[2 * i + 1]; r2[i] = keep + shx2(send); }
        { const float keep = (lane & 4) ? r2[1] : r2[0], send = (lane & 4) ? r2[0] : r2[1]; mine = keep + shx4(send); }
        mine += shx8(mine); mine += __shfl_xor(mine, 16); mine += __shfl_xor(mine, 32);
        if (lane < 8) { const float z = mine + bfg[lane]; const float ls = fminf(z, 0.f) - __logf(1.0f + __expf(-fabsf(z)));
            logf_[(size_t)(b * 8 + lane) * SEQ + t] = ls; }
    }
    }
}

__device__ __forceinline__ void p1_pair(f32x4 (&pv)[8], int rowa, int b, int lane, LAS float* gs1, unsigned char* ws, bf16* h1, float* logf_, const float* bfg) {
    const int ta = rowa & (SEQ - 1);
    LAS float* gs1_ = gs1; asm volatile("" : "+v"(gs1_));
    LAS float* sh1_ = gs1_ + 1024; LAS float* wfl_ = gs1_ + 2048;
    float ssa = 0.f, ssb = 0.f;
#pragma unroll
    for (int q = 0; q < 4; ++q) { const f32x4 xa = pv[q], xb = pv[4 + q];
        ssa += (xa.x * xa.x + xa.y * xa.y) + (xa.z * xa.z + xa.w * xa.w); ssb += (xb.x * xb.x + xb.y * xb.y) + (xb.z * xb.z + xb.w * xb.w); }
    const float rstda = __builtin_amdgcn_rsqf(wave_sum(ssa) * (1.0f / DMODEL) + EPS), rstdb = __builtin_amdgcn_rsqf(wave_sum(ssb) * (1.0f / DMODEL) + EPS);
    float hma = 0.f, hmb = 0.f;
#pragma unroll
    for (int q = 0; q < 4; ++q) { const f32x4 g = *(const LAS f32x4*)(gs1_ + 4 * lane + 256 * q), s = *(const LAS f32x4*)(sh1_ + 4 * lane + 256 * q);
        pv[q] = pv[q] * rstda * g + s; hma = fmaxf(hma, fmaxf(fmaxf(fabsf(pv[q].x), fabsf(pv[q].y)), fmaxf(fabsf(pv[q].z), fabsf(pv[q].w))));
        pv[4 + q] = pv[4 + q] * rstdb * g + s; hmb = fmaxf(hmb, fmaxf(fmaxf(fabsf(pv[4 + q].x), fabsf(pv[4 + q].y)), fmaxf(fabsf(pv[4 + q].z), fabsf(pv[4 + q].w)))); }
    hma = fmaxf(wave_max(hma), 1e-20f); hmb = fmaxf(wave_max(hmb), 1e-20f);
    const float qia = 127.0f * __builtin_amdgcn_rcpf(hma), qib = 127.0f * __builtin_amdgcn_rcpf(hmb);
    GAS unsigned* oa = (GAS unsigned*)((unsigned char*)h1 + (size_t)rowa * DMODEL) + lane; GAS unsigned* ob = oa + DMODEL / 4;
#pragma unroll
    for (int q = 0; q < 4; ++q) { oa[64 * q] = pk4_i8_nc(pv[q].x * qia, pv[q].y * qia, pv[q].z * qia, pv[q].w * qia); ob[64 * q] = pk4_i8_nc(pv[4 + q].x * qib, pv[4 + q].y * qib, pv[4 + q].z * qib, pv[4 + q].w * qib); }
    if (lane == 0) { ((float*)(ws + WS_SA1))[rowa] = hma * (1.0f / 127.0f); ((float*)(ws + WS_SA1))[rowa + 1] = hmb * (1.0f / 127.0f); }
    float pa[8], pb[8];
#pragma unroll
    for (int f = 0; f < 8; ++f) { float xa = 0.f, xb = 0.f;
#pragma unroll
        for (int q = 0; q < 4; ++q) { const f32x4 w = *(const LAS f32x4*)(wfl_ + f * 1024 + 4 * lane + 256 * q);
            xa += (pv[q].x * w.x + pv[q].y * w.y) + (pv[q].z * w.z + pv[q].w * w.w); xb += (pv[4 + q].x * w.x + pv[4 + q].y * w.y) + (pv[4 + q].z * w.z + pv[4 + q].w * w.w); }
        pa[f] = xa; pb[f] = xb; asm volatile("" ::: "memory"); }
#pragma unroll
    for (int h = 0; h < 2; ++h) { float r4[4], r2[2], mine;
#pragma unroll
        for (int i = 0; i < 4; ++i) { const float p0 = h ? pb[2 * i] : pa[2 * i], p1 = h ? pb[2 * i + 1] : pa[2 * i + 1]; const float keep = (lane & 1) ? p1 : p0, send = (lane & 1) ? p0 : p1; r4[i] = keep + shx1(send); }
#pragma unroll
        for (int i = 0; i < 2; ++i) { const float keep = (lane & 2) ? r4[2 * i + 1] : r4[2 * i], send = (lane & 2) ? r4[2 * i] : r4[2 * i + 1]; r2[i] = keep + shx2(send); }
        { const float keep = (lane & 4) ? r2[1] : r2[0], send = (lane & 4) ? r2[0] : r2[1]; mine = keep + shx4(send); }
        mine += shx8(mine); mine += __shfl_xor(mine, 16); mine += __shfl_xor(mine, 32);
        if (lane < 8) { const float z = mine + bfg[lane]; const float ls = fminf(z, 0.f) - __logf(1.0f + __expf(-fabsf(z)));
            logf_[(size_t)(b * 8 + lane) * SEQ + ta + h] = ls; } }
}
__device__ __forceinline__ void p1_load_pair(f32x4 (&pv)[8], const float* x, int rowa, int lane) {
#pragma unroll
    for (int q = 0; q < 4; ++q) { pv[q] = __builtin_nontemporal_load((const GAS f32x4*)(x + (size_t)rowa * DMODEL) + lane + 64 * q); pv[4 + q] = __builtin_nontemporal_load((const GAS f32x4*)(x + (size_t)(rowa + 1) * DMODEL) + lane + 64 * q); }
}
__device__ __forceinline__ void p1_rows2(const KArgs& a, LAS unsigned char* lds, int vcu, int tid, int wave, int lane) {
    const float* x = a.in[0]; const int row0 = 64 * vcu + 8 * wave;
    f32x4 X[8], Y[8];
    p1_load_pair(X, x, row0, lane); p1_load_pair(Y, x, row0 + 2, lane);
    unsigned char* ws = a.ws;
    const float* modp = (const float*)(ws + WS_MODP); const float* bada = a.in[3];
    LAS float* gs1 = (LAS float*)(lds + RING_OFF); LAS float* sh1 = gs1 + 1024; LAS float* wfl = gs1 + 2048;
    const int b = vcu >> 7;
    {
        const f32x4* wft = (const f32x4*)(ws + WS_WFT); f32x4 wq[4];
#pragma unroll
        for (int i = 0; i < 4; ++i) wq[i] = wft[tid + 512 * i];
        const int col = 4 * tid; f32x4 s = *(const f32x4*)(bada + col); const f32x4 g = *(const f32x4*)(a.in[4] + (col & 1023));
#pragma unroll
        for (int kc = 0; kc < 16; ++kc) s += *(const f32x4*)(modp + (size_t)(kc * 2 + b) * 6144 + col);
#pragma unroll
        for (int i = 0; i < 4; ++i) *(LAS f32x4*)(wfl + 4 * (tid + 512 * i)) = wq[i];
        if (col < 1024) { *(LAS f32x4*)(sh1 + col) = s; }
        else { *(LAS f32x4*)(gs1 + col - 1024) = g * (1.0f + s); }
    }
    __syncthreads();
    if (tid < 12) {
        float* mod = (float*)(ws + WS_MOD); const int gi = blockIdx.x * 12 + tid, bb = gi / 1536, col = 4 * (gi % 1536); f32x4 s = *(const f32x4*)(bada + col);
#pragma unroll
        for (int kc = 0; kc < 16; ++kc) s += *(const f32x4*)(modp + (size_t)(kc * 2 + bb) * 6144 + col);
        *(f32x4*)(mod + (size_t)bb * 6144 + col) = s;
    }
#if defined(DIAG_A)
    if (blockIdx.x == DIAG_BLK && threadIdx.x == 0) ((unsigned long long*)(ws + WS_CTL + 512 * 1024))[27] = __builtin_amdgcn_s_memrealtime();
#endif
    bf16* h1 = (bf16*)(ws + WS_H1); float* logf_ = (float*)(ws + WS_LOGF); const float* bfg = a.in[13];
    p1_pair(X, row0, b, lane, gs1, ws, h1, logf_, bfg); p1_load_pair(X, x, row0 + 4, lane);
    p1_pair(Y, row0 + 2, b, lane, gs1, ws, h1, logf_, bfg); p1_load_pair(Y, x, row0 + 6, lane);
    p1_pair(X, row0 + 4, b, lane, gs1, ws, h1, logf_, bfg);
    p1_pair(Y, row0 + 6, b, lane, gs1, ws, h1, logf_, bfg);
}
__device__ __forceinline__ void p2_cumsum(const KArgs& a, LAS unsigned char* lds, int seq, int tid, int wave, int lane) {
    const float* lf = (const float*)(a.ws + WS_LOGF) + (size_t)seq * SEQ + 16 * tid; float* cm = (float*)(a.ws + WS_CUM) + (size_t)seq * SEQ + 16 * tid;
    LAS double* wt = (LAS double*)(lds + RING_OFF);
    float v[16];
#pragma unroll
    for (int q = 0; q < 4; ++q) { const f32x4 x = *(const f32x4*)(lf + 4 * q); v[4 * q] = x.x; v[4 * q + 1] = x.y; v[4 * q + 2] = x.z; v[4 * q + 3] = x.w; }
    double pre[16]; double run = 0.0;
#pragma unroll
    for (int i = 0; i < 16; ++i) { run += (double)v[i]; pre[i] = run; }
    double sc = run;
#pragma unroll
    for (int o = 1; o < 64; o <<= 1) { const double up = __shfl_up(sc, o); if (lane >= o) sc += up; }
    if (lane == 63) wt[wave] = sc;
    __syncthreads();
    double off = sc - run;
    for (int w = 0; w < wave; ++w) off += wt[w];
#pragma unroll
    for (int q = 0; q < 4; ++q) { f32x4 o; o.x = (float)(off + pre[4 * q]); o.y = (float)(off + pre[4 * q + 1]); o.z = (float)(off + pre[4 * q + 2]); o.w = (float)(off + pre[4 * q + 3]); *(f32x4*)(cm + 4 * q) = o; }
    __syncthreads();
}

__device__ __forceinline__ void conv_items(const KArgs& a, LAS unsigned char* lds, int first, int stride, int tid) {
    const int g = first & 7, c0 = 64 * g;
    const int c2 = tid & 31, seg = tid >> 5;
    const int tok = tid >> 2, q = tid & 3;
    float w0[CONVW], w1[CONVW];
#pragma unroll
    for (int j = 0; j < CONVW; ++j) { const f32x2 wv = *(const f32x2*)(a.in[6] + (size_t)j * CONVD + c0 + 2 * c2); w0[j] = wv[0]; w1[j] = wv[1]; }
    const f32x2 bv = *(const f32x2*)(a.in[7] + c0 + 2 * c2);
    v2u pre[5];
#define CONV_PREFETCH(it_) do { const int r0_ = 128 * ((it_) >> 3), tz_ = r0_ & (SEQ - 1); _Pragma("unroll") for (int p_ = 0; p_ < 5; ++p_) { const int idx = tid + p_ * NWAVES * 64, r = idx >> 4, ch = idx & 15; \
        pre[p_] = (v2u){0u, 0u}; if (idx < 158 * 16 && tz_ - 30 + r >= 0) pre[p_] = __builtin_nontemporal_load((const GAS v2u*)(U + (size_t)(r0_ - 30 + r) * CONVD + c0 + 4 * ch)); } } while (0)
    const bf16* U = (const bf16*)(a.ws + WS_U); bf16* UC = (bf16*)(a.ws + WS_UC);
    if (first < 1024) CONV_PREFETCH(first);
    for (int item = first; item < 1024; item += stride) {
    const int tt = item >> 3, row0 = 128 * tt;
    constexpr int RS = 132;
    LAS unsigned char* ut = lds + RING_OFF;
    LAS float* yt = (LAS float*)(lds + RING_OFF + 24576);
    constexpr int YS = 68;
#pragma unroll
    for (int p_ = 0; p_ < 5; ++p_) { const int idx = tid + p_ * NWAVES * 64, r = idx >> 4, ch = idx & 15;
        if (idx < 158 * 16) { *(LAS unsigned*)(ut + r * RS + 8 * ch) = pre[p_].x; *(LAS unsigned*)(ut + r * RS + 8 * ch + 4) = pre[p_].y; } }
    __syncthreads();
    if (item + stride < 1024) CONV_PREFETCH(item + stride);
    float y0[8], y1[8];
#pragma unroll
    for (int t = 0; t < 8; ++t) { y0[t] = bv[0]; y1[t] = bv[1]; }
#pragma unroll
    for (int r = 0; r < 38; ++r) { const unsigned uu = *(const LAS unsigned*)(ut + (8 * seg + r) * RS + 4 * c2); const float x0 = bf_lo(uu), x1v = bf_hi(uu);
#pragma unroll
        for (int t = 0; t < 8; ++t) { const int j = r - t; if (j >= 0 && j < CONVW) { y0[t] += x0 * w0[j]; y1[t] += x1v * w1[j]; } } }
#pragma unroll
    for (int t = 0; t < 8; ++t) *(LAS f32x2*)(yt + (8 * seg + t) * YS + 2 * c2) = (f32x2){y0[t], y1[t]};
    __syncthreads();
    float acc[16];
#pragma unroll
    for (int i = 0; i < 4; ++i) { const f32x4 v = *(const LAS f32x4*)(yt + tok * YS + 16 * q + 4 * i); acc[4 * i] = v[0]; acc[4 * i + 1] = v[1]; acc[4 * i + 2] = v[2]; acc[4 * i + 3] = v[3]; }
    float s = 0.f;
#pragma unroll
    for (int i = 0; i < 16; ++i) s += acc[i];
    s += shx1(s); s += shx2(s);
    const float mu = s * (1.0f / 64.0f); float qv = 0.f;
#pragma unroll
    for (int i = 0; i < 16; ++i) { acc[i] -= mu; qv += acc[i] * acc[i]; }
    qv += shx1(qv); qv += shx2(qv);
    const float rstd = 1.0f / sqrtf(qv * (1.0f / 64.0f) + EPS);
    unsigned o[8];
#pragma unroll
    for (int i = 0; i < 16; i += 2) { float v0 = acc[i] * rstd * a.in[8][c0 + 16 * q + i] + a.in[9][c0 + 16 * q + i], v1 = acc[i + 1] * rstd * a.in[8][c0 + 16 * q + i + 1] + a.in[9][c0 + 16 * q + i + 1];
        v0 = v0 * sigmoidf_fast(v0); v1 = v1 * sigmoidf_fast(v1); o[i >> 1] = pk2(v0, v1); }
    GAS v4u* dst = (GAS v4u*)(UC + (size_t)(row0 + tok) * CONVD + c0 + 16 * q);
    dst[0] = (v4u){o[0], o[1], o[2], o[3]}; dst[1] = (v4u){o[4], o[5], o[6], o[7]};
    __syncthreads();
    }
#undef CONV_PREFETCH
}
__device__ __forceinline__ void conv_items_dyn(const KArgs& a, LAS unsigned char* lds, int g, int first_tt, unsigned* head, volatile LAS unsigned* slot, int tid) {
    const int c0 = 64 * g;
    const int c2 = tid & 31, seg = tid >> 5;
    const int tok = tid >> 2, q = tid & 3;
    float w0[CONVW], w1[CONVW];
#pragma unroll
    for (int j = 0; j < CONVW; ++j) { const f32x2 wv = *(const f32x2*)(a.in[6] + (size_t)j * CONVD + c0 + 2 * c2); w0[j] = wv[0]; w1[j] = wv[1]; }
    const f32x2 bv = *(const f32x2*)(a.in[7] + c0 + 2 * c2);
    v2u pre[5];
#define CONV_PREFETCH(tt_) do { const int r0_ = 128 * (tt_), tz_ = r0_ & (SEQ - 1); _Pragma("unroll") for (int p_ = 0; p_ < 5; ++p_) { const int idx = tid + p_ * NWAVES * 64, r = idx >> 4, ch = idx & 15; \
        pre[p_] = (v2u){0u, 0u}; if (idx < 158 * 16 && tz_ - 30 + r >= 0) pre[p_] = __builtin_nontemporal_load((const GAS v2u*)(U + (size_t)(r0_ - 30 + r) * CONVD + c0 + 4 * ch)); } } while (0)
    const bf16* U = (const bf16*)(a.ws + WS_U); bf16* UC = (bf16*)(a.ws + WS_UC);
    int tt = first_tt; unsigned nx = 0u;
    CONV_PREFETCH(tt);
    if (tid == 0) nx = 32u + __hip_atomic_fetch_add(head, 1u, RLX_AGENT);
    for (;;) {
    const int row0 = 128 * tt;
    constexpr int RS = 132;
    LAS unsigned char* ut = lds + RING_OFF;
    LAS float* yt = (LAS float*)(lds + RING_OFF + 24576);
    constexpr int YS = 68;
#pragma unroll
    for (int p_ = 0; p_ < 5; ++p_) { const int idx = tid + p_ * NWAVES * 64, r = idx >> 4, ch = idx & 15;
        if (idx < 158 * 16) { *(LAS unsigned*)(ut + r * RS + 8 * ch) = pre[p_].x; *(LAS unsigned*)(ut + r * RS + 8 * ch + 4) = pre[p_].y; } }
    if (tid == 0) *slot = nx;
    __syncthreads();
    const int ntt = (int)*slot;
    if (ntt < 128) { CONV_PREFETCH(ntt); if (tid == 0) nx = 32u + __hip_atomic_fetch_add(head, 1u, RLX_AGENT); }
    float y0[8], y1[8];
#pragma unroll
    for (int t = 0; t < 8; ++t) { y0[t] = bv[0]; y1[t] = bv[1]; }
#pragma unroll
    for (int r = 0; r < 38; ++r) { const unsigned uu = *(const LAS unsigned*)(ut + (8 * seg + r) * RS + 4 * c2); const float x0 = bf_lo(uu), x1v = bf_hi(uu);
#pragma unroll
        for (int t = 0; t < 8; ++t) { const int j = r - t; if (j >= 0 && j < CONVW) { y0[t] += x0 * w0[j]; y1[t] += x1v * w1[j]; } } }
#pragma unroll
    for (int t = 0; t < 8; ++t) *(LAS f32x2*)(yt + (8 * seg + t) * YS + 2 * c2) = (f32x2){y0[t], y1[t]};
    __syncthreads();
    float acc[16];
#pragma unroll
    for (int i = 0; i < 4; ++i) { const f32x4 v = *(const LAS f32x4*)(yt + tok * YS + 16 * q + 4 * i); acc[4 * i] = v[0]; acc[4 * i + 1] = v[1]; acc[4 * i + 2] = v[2]; acc[4 * i + 3] = v[3]; }
    float s = 0.f;
#pragma unroll
    for (int i = 0; i < 16; ++i) s += acc[i];
    s += shx1(s); s += shx2(s);
    const float mu = s * (1.0f / 64.0f); float qv = 0.f;
#pragma unroll
    for (int i = 0; i < 16; ++i) { acc[i] -= mu; qv += acc[i] * acc[i]; }
    qv += shx1(qv); qv += shx2(qv);
    const float rstd = 1.0f / sqrtf(qv * (1.0f / 64.0f) + EPS);
    unsigned o[8];
#pragma unroll
    for (int i = 0; i < 16; i += 2) { float v0 = acc[i] * rstd * a.in[8][c0 + 16 * q + i] + a.in[9][c0 + 16 * q + i], v1 = acc[i + 1] * rstd * a.in[8][c0 + 16 * q + i + 1] + a.in[9][c0 + 16 * q + i + 1];
        v0 = v0 * sigmoidf_fast(v0); v1 = v1 * sigmoidf_fast(v1); o[i >> 1] = pk2(v0, v1); }
    GAS v4u* dst = (GAS v4u*)(UC + (size_t)(row0 + tok) * CONVD + c0 + 16 * q);
    dst[0] = (v4u){o[0], o[1], o[2], o[3]}; dst[1] = (v4u){o[4], o[5], o[6], o[7]};
    __syncthreads();
    if (ntt >= 128) break;
    tt = ntt;
    }
#undef CONV_PREFETCH
}

struct SchedDense {
    static constexpr bool GATHER = false;
    int nM, nN, G, c, K; const char* A; const char* B;
    __device__ __forceinline__ bool next(int i, pg8::Unit& u) const {
        const long L = (long)i * G + c; if (L >= (long)nM * nN) return false;
        pg8::tile_of((int)L, nM, nN, u.pm, u.pn); u.e = 0; u.mt = 0;
        u.A = A + (size_t)u.pm * 256 * K * 2; u.B = B + (size_t)u.pn * 256 * K * 2; return true; }
    __device__ __forceinline__ int row(const pg8::Unit&, int) const { return 0; }
};
struct SchedMerge {
    static constexpr bool GATHER = false;
    int c; const char* A0; const char* B0; const char* A1; const char* B1;
    __device__ __forceinline__ bool next(int i, pg8::Unit& u) const {
        if (i >= 2 || c >= 256) return false;
        pg8::tile_of(c, 64, 4, u.pm, u.pn); u.e = i; u.mt = 0;
        u.A = (i ? A1 : A0) + (size_t)u.pm * 256 * 512 * 2; u.B = (i ? B1 : B0) + (size_t)u.pn * 256 * 512 * 2; return true; }
    __device__ __forceinline__ int row(const pg8::Unit&, int) const { return 0; }
};
struct MoeTab { const LAS int* tstart; const LAS int* cnt; const LAS float* amx; };
struct SchedMoe1 {
    static constexpr bool GATHER = true;
    MoeTab tb; int nmoe, ntot, per, c, lane; const char* h2; const char* wgu; const char* wsgu; const int* list;
    __device__ __forceinline__ bool next(int i, pg8::Unit& u) const {
        const int L = i * per + c; if (L >= ntot) return false;
        if (L < nmoe) { const int tt = L >> 1; const int e = __popcll(__ballot(tb.tstart[lane + 1] <= tt));
            u.e = e; u.mt = tt - tb.tstart[e]; u.pm = tt; u.pn = L & 1; u.A = h2; u.B = wgu + ((size_t)e * 512 + (size_t)u.pn * 256) * 1024; }
        else { const int s = L - nmoe; u.e = -1; u.mt = 0; u.pm = s & 63; u.pn = s >> 6; u.A = h2; u.B = wsgu + (size_t)u.pn * 256 * 1024; }
        return true; }
    __device__ __forceinline__ int row(const pg8::Unit& u, int r) const {
        if (u.e < 0) return u.pm * 256 + r;
        const int idx = u.mt * 256 + r; return idx < tb.cnt[u.e] ? (list[(size_t)u.e * LISTCAP + idx] >> 3) : 0; }
};
#ifndef P8_CONTIG
#define P8_CONTIG 0
#endif
struct SchedMoe2 {
    static constexpr bool GATHER = false;
    MoeTab tb; int ntot, per, c, lane; const char* act; const char* wd;
    __device__ __forceinline__ bool next(int i, pg8::Unit& u) const {
#if P8_CONTIG
        const int q_ = ntot / per, r_ = ntot % per; if (i >= q_ + (c < r_ ? 1 : 0)) return false;
        const int L = c * q_ + (c < r_ ? c : r_) + i;
#else
        const int L = i * per + c; if (L >= ntot) return false;
#endif
        const int j = L >> 2, half = 0, nti = 1 << 30; (void)nti;
        const int tt = j; const int e = __popcll(__ballot(tb.tstart[lane + 1] <= tt));
        u.e = e; u.mt = tt - tb.tstart[e]; u.pm = tt; u.pn = (L & 3) + half; u.A = act + (size_t)tt * 256 * 256 * 2; u.B = wd + ((size_t)e * 1024 + (size_t)u.pn * 256) * 256 * 2; return true; }
    __device__ __forceinline__ int row(const pg8::Unit&, int) const { return 0; }
};

typedef pg8::f32x4 (AccT)[2][2][4][2];
#define NO_PRE_MEMBERS static constexpr bool AFTER_DRAIN = false; struct Pre {}; __device__ __forceinline__ void prefetch(Pre&, const pg8::Unit&, int, int, int, int) const {} static constexpr bool ROWTAB = false; static constexpr int NTAB = 1; __device__ __forceinline__ const char* tab_src(const pg8::Unit&, int) const { return nullptr; }
__device__ __forceinline__ v4u pack8(const f32x4& a, const f32x4& b) { v4u w; w.x = cvt_pk_bf16(a[0], a[1]); w.y = cvt_pk_bf16(a[2], a[3]); w.z = cvt_pk_bf16(b[0], b[1]); w.w = cvt_pk_bf16(b[2], b[3]); return w; }
__device__ __forceinline__ void unpack8(const v4u& w, f32x4& a, f32x4& b) { a = (f32x4){bf_lo(w.x), bf_hi(w.x), bf_lo(w.y), bf_hi(w.y)}; b = (f32x4){bf_lo(w.z), bf_hi(w.z), bf_lo(w.w), bf_hi(w.w)}; }
__device__ __forceinline__ f32x4 sig4(const f32x4& v) { return (f32x4){sigmoidf_fast(v[0]), sigmoidf_fast(v[1]), sigmoidf_fast(v[2]), sigmoidf_fast(v[3])}; }

struct EpiIn {
    static constexpr bool PERM = true; static constexpr bool AFTER_DRAIN = false; struct Pre {}; __device__ __forceinline__ void prefetch(Pre&, const pg8::Unit&, int, int, int, int) const {}
    static constexpr bool ROWTAB = true; static constexpr int NTAB = 1;
    __device__ __forceinline__ const char* tab_src(const pg8::Unit& u, int) const { return (const char*)(sA + u.pm * 256); }
    bf16 *U, *Q, *Kb, *V, *SG; const float *gq, *gk; const float* sA; float sW;
    __device__ __forceinline__ void operator()(const AccT& acc, const pg8::Unit& u, int wr, int wc, int fr_, int fq_, const Pre& pre, const LAS unsigned* rtab) const {
        int fr = fr_, fq = fq_; asm volatile("" : "+v"(fr), "+v"(fq));
        const int rl0 = wr * 64 + fr, row0 = u.pm * 256 + rl0, pn = u.pn;
        if (pn < 4) {
            const int col0 = 128 * pn + 32 * wc + 8 * fq;
#pragma unroll
            for (int ai = 0; ai < 2; ++ai)
#pragma unroll
                for (int m = 0; m < 4; ++m) { const float sc = __builtin_bit_cast(float, rtab[rl0 + ai * 128 + m * 16]) * sW;
                    const f32x4 v0 = acc[ai][0][m][0] * sc * sig4(acc[ai][1][m][0] * sc), v1 = acc[ai][0][m][1] * sc * sig4(acc[ai][1][m][1] * sc);
                    *(v4u*)(U + (size_t)(row0 + ai * 128 + m * 16) * CONVD + col0) = pack8(v0, v1); }
        } else if (pn < 8) {
            const bool isk = pn >= 6; const int head = 4 * ((pn - 4) & 1) + wc; const float* g = isk ? gk : gq; bf16* dst = isk ? Kb : Q; const float qsc = isk ? 1.0f : C2Q;
            f32x4 gv[2][2];
#pragma unroll
            for (int bj = 0; bj < 2; ++bj)
#pragma unroll
                for (int n = 0; n < 2; ++n) gv[bj][n] = *(const f32x4*)(g + 32 * bj + 8 * fq + 4 * n) * qsc;
#pragma unroll
            for (int ai = 0; ai < 2; ++ai)
#pragma unroll
                for (int m = 0; m < 4; ++m) { const float sc = __builtin_bit_cast(float, rtab[rl0 + ai * 128 + m * 16]) * sW; float ss = 0.f;
#pragma unroll
                    for (int bj = 0; bj < 2; ++bj)
#pragma unroll
                        for (int n = 0; n < 2; ++n) { const f32x4 x = acc[ai][bj][m][n]; ss += (x[0] * x[0] + x[1] * x[1]) + (x[2] * x[2] + x[3] * x[3]); }
                    ss += __shfl_xor(ss, 16); ss += __shfl_xor(ss, 32);
                    const float r = sc / sqrtf(ss * (sc * sc) * (1.0f / 64.0f) + EPS);
                    bf16* rowp = dst + (size_t)(row0 + ai * 128 + m * 16) * ATT + head * 64 + 8 * fq;
#pragma unroll
                    for (int bj = 0; bj < 2; ++bj) *(v4u*)(rowp + 32 * bj) = pack8(acc[ai][bj][m][0] * r * gv[bj][0], acc[ai][bj][m][1] * r * gv[bj][1]); }
        } else if (pn < 10) {
            const int col0 = 256 * (pn - 8) + 32 * wc + 8 * fq;
#pragma unroll
            for (int ai = 0; ai < 2; ++ai)
#pragma unroll
                for (int m = 0; m < 4; ++m) { const float sc = __builtin_bit_cast(float, rtab[rl0 + ai * 128 + m * 16]) * sW;
#pragma unroll
                    for (int bj = 0; bj < 2; ++bj) *(v4u*)(V + (size_t)(row0 + ai * 128 + m * 16) * ATT + col0 + 128 * bj) = pack8(acc[ai][bj][m][0] * sc, acc[ai][bj][m][1] * sc); }
        } else {
            unsigned char* dst = (unsigned char*)SG + (size_t)((pn - 10) >> 2) * T * DMODEL; const int col0 = 256 * ((pn - 10) & 3) + 64 * wc + 16 * fq;
#pragma unroll
            for (int ai = 0; ai < 2; ++ai)
#pragma unroll
                for (int m = 0; m < 4; ++m) { const float sc = __builtin_bit_cast(float, rtab[rl0 + ai * 128 + m * 16]) * sW;
                    const f32x4 a0 = sig4(acc[ai][0][m][0] * sc), a1 = sig4(acc[ai][0][m][1] * sc), b0 = sig4(acc[ai][1][m][0] * sc), b1 = sig4(acc[ai][1][m][1] * sc);
                    *(v4u*)(dst + (size_t)(row0 + ai * 128 + m * 16) * DMODEL + col0) = (v4u){pk4_fp8(a0[0], a0[1], a0[2], a0[3]), pk4_fp8(a1[0], a1[1], a1[2], a1[3]), pk4_fp8(b0[0], b0[1], b0[2], b0[3]), pk4_fp8(b1[0], b1[1], b1[2], b1[3])}; }
        }
    }
};
struct EpiMerge {
    static constexpr bool PERM = true; static constexpr bool AFTER_DRAIN = true; struct Pre {}; __device__ __forceinline__ void prefetch(Pre&, const pg8::Unit&, int, int, int, int) const {}
    static constexpr bool ROWTAB = false; static constexpr int NTAB = 1; __device__ __forceinline__ const char* tab_src(const pg8::Unit&, int) const { return nullptr; }
    const bf16* SG; bf16* MG;
    __device__ __forceinline__ void operator()(const AccT& acc, const pg8::Unit& u, int wr, int wc, int fr_, int fq_, const Pre& pre, const LAS unsigned* rtab) const {
        int fr = fr_, fq = fq_; asm volatile("" : "+v"(fr), "+v"(fq));
        const int row0 = u.pm * 256 + wr * 64 + fr, col0 = u.pn * 256 + 32 * wc + 8 * fq;
#pragma unroll
        for (int ai = 0; ai < 2; ++ai)
#pragma unroll
            for (int m = 0; m < 4; ++m)
#pragma unroll
                for (int bj = 0; bj < 2; ++bj) *(v4u*)(MG + (size_t)(row0 + ai * 128 + m * 16) * DMODEL + col0 + 128 * bj) = pack8(acc[ai][bj][m][0], acc[ai][bj][m][1]);
    }
    __device__ __forceinline__ void fused(const AccT& acc, const pg8::Unit& u, int wr, int wc, int fr, int fq, LAS unsigned char* lds) const;
};
struct EpiX1 {
    static constexpr bool PERM = true; static constexpr bool AFTER_DRAIN = true; struct Pre {}; __device__ __forceinline__ void prefetch(Pre&, const pg8::Unit&, int, int, int, int) const {}
    static constexpr bool ROWTAB = false; static constexpr int NTAB = 1; __device__ __forceinline__ const char* tab_src(const pg8::Unit&, int) const { return nullptr; }
    const float* x; float* out; const float* mod; float* ssq; float* xmx;
    __device__ __forceinline__ void operator()(const AccT&, const pg8::Unit&, int, int, int, int, const Pre&, const LAS unsigned*) const {}
    __device__ __forceinline__ void fused(const AccT& acc, const pg8::Unit& u, int wr, int wc, int fr, int fq, LAS unsigned char* lds) const;
};
struct EpiGlu {
    static constexpr bool PERM = true;
    bf16 *ACT, *SACT; const float* wlist; const float* slist; const float* sA2; const unsigned* amax; MoeTab tb;
    struct Pre {}; __device__ __forceinline__ void prefetch(Pre&, const pg8::Unit&, int, int, int, int) const {}
    static constexpr bool AFTER_DRAIN = false;
    static constexpr bool ROWTAB = true; static constexpr int NTAB = 2;
    __device__ __forceinline__ const char* tab_src(const pg8::Unit& u, int t) const {
        if (u.e >= 0) return (const char*)((t ? slist : wlist) + (size_t)u.e * LISTCAP + u.mt * 256);
        return t ? (const char*)(sA2 + u.pm * 256) : nullptr; }
    __device__ __forceinline__ void operator()(const AccT& acc, const pg8::Unit& u, int wr, int wc, int fr_, int fq_, const Pre& pre, const LAS unsigned* rtab) const {
        int fr = fr_, fq = fq_; asm volatile("" : "+v"(fr), "+v"(fq));
        const int rl0 = wr * 64 + fr, col0 = 128 * u.pn + 32 * wc + 8 * fq; bf16* dst = (u.e >= 0 ? ACT : SACT) + (size_t)u.pm * 256 * EF;
        const int cnt = u.e >= 0 ? tb.cnt[u.e] : 0; const float sW = tb.amx[u.e >= 0 ? 2 + u.e : 1] * ((u.e >= 0 ? WGU_MARGIN : 1.0f) / 127.0f);
#pragma unroll
        for (int ai = 0; ai < 2; ++ai)
#pragma unroll
            for (int m = 0; m < 4; ++m) { const int rl = rl0 + ai * 128 + m * 16; const bool valid = (u.e < 0) || (u.mt * 256 + rl < cnt);
                const float w = (u.e >= 0) ? (valid ? __builtin_bit_cast(float, rtab[rl]) : 0.0f) : 1.0f, gsc = valid ? __builtin_bit_cast(float, rtab[256 + rl]) * sW : 0.0f;
                const f32x4 g0 = acc[ai][0][m][0] * gsc, g1 = acc[ai][0][m][1] * gsc;
                const f32x4 v0 = g0 * sig4(g0) * acc[ai][1][m][0] * (w * gsc), v1 = g1 * sig4(g1) * acc[ai][1][m][1] * (w * gsc);
                *(v4u*)(dst + (size_t)rl * EF + col0) = pack8(v0, v1); asm volatile("" ::: "memory"); }
    }
};
struct EpiSlab {
    static constexpr bool PERM = true;
    unsigned char* SLAB; const int* list; MoeTab tb;
    struct Pre {}; __device__ __forceinline__ void prefetch(Pre&, const pg8::Unit&, int, int, int, int) const {}
    static constexpr bool AFTER_DRAIN = false;
    static constexpr bool ROWTAB = true; static constexpr int NTAB = 1;
    __device__ __forceinline__ const char* tab_src(const pg8::Unit& u, int) const { return (const char*)(list + (size_t)u.e * LISTCAP + u.mt * 256); }
    __device__ __forceinline__ void operator()(const AccT& acc, const pg8::Unit& u, int wr, int wc, int fr_, int fq_, const Pre& pre, const LAS unsigned* rtab) const {
        int fr = fr_, fq = fq_; asm volatile("" : "+v"(fr), "+v"(fq));
        const int col0 = 256 * u.pn + 64 * wc + 16 * fq;
#pragma unroll
        for (int ai = 0; ai < 2; ++ai)
#pragma unroll
            for (int m = 0; m < 4; ++m) { const int rl = wr * 64 + fr + ai * 128 + m * 16; const int slot = (int)rtab[rl];
                if (u.mt * 256 + rl < tb.cnt[u.e]) { unsigned char* rowp = SLAB + (size_t)slot * DMODEL + col0;
                    const f32x4 a0 = acc[ai][0][m][0] * SLABSCALE, a1 = acc[ai][0][m][1] * SLABSCALE, b0 = acc[ai][1][m][0] * SLABSCALE, b1 = acc[ai][1][m][1] * SLABSCALE;
                    *(v4u*)rowp = (v4u){pk4_fp8(a0[0], a0[1], a0[2], a0[3]), pk4_fp8(a1[0], a1[1], a1[2], a1[3]), pk4_fp8(b0[0], b0[1], b0[2], b0[3]), pk4_fp8(b1[0], b1[1], b1[2], b1[3])}; }
                asm volatile("" ::: "memory"); }
    }
};
__device__ __forceinline__ void park_tile(const AccT& acc, LAS unsigned char* lds, int wr, int wc, int fr, int fq) {
#pragma unroll
    for (int ai = 0; ai < 2; ++ai)
#pragma unroll
        for (int m = 0; m < 4; ++m) { const int row = 128 * ai + 64 * wr + 16 * m + fr;
#pragma unroll
            for (int bj = 0; bj < 2; ++bj) { const int c16 = 16 * bj + 4 * wc + fq; *(LAS v4u*)(lds + row * 512 + ((c16 ^ (row & 31)) << 4)) = pack8(acc[ai][bj][m][0], acc[ai][bj][m][1]); } }
    asm volatile("s_waitcnt lgkmcnt(0)" ::: "memory"); __builtin_amdgcn_s_barrier(); asm volatile("" ::: "memory");
}
struct EpiFinal {
    static constexpr bool PERM = true; static constexpr bool AFTER_DRAIN = true; struct Pre {}; __device__ __forceinline__ void prefetch(Pre&, const pg8::Unit&, int, int, int, int) const {}
    static constexpr bool ROWTAB = false; static constexpr int NTAB = 1; __device__ __forceinline__ const char* tab_src(const pg8::Unit&, int) const { return nullptr; }
    float* out; const unsigned char* SLAB; const float* mod;
    __device__ __forceinline__ void operator()(const AccT&, const pg8::Unit&, int, int, int, int, const Pre&, const LAS unsigned*) const {}
    __device__ __forceinline__ void fused(const AccT& acc, const pg8::Unit& u, int wr, int wc, int fr, int fq, LAS unsigned char* lds) const {
        typedef float f32x2v __attribute__((ext_vector_type(2)));
        park_tile(acc, lds, wr, wc, fr, fq);
        const int tid = threadIdx.x, wave = tid >> 6, lane = tid & 63, rsub = lane >> 4, i = lane & 15;
        const int cA = 32 * (i >> 2) + 8 * (i & 3), cB = cA + 128;
        const float* g2 = mod + (size_t)(u.pm >> 5) * 6144 + 5120 + u.pn * 256;
        const f32x4 gA0 = *(const f32x4*)(g2 + cA), gA1 = *(const f32x4*)(g2 + cA + 4), gB0 = *(const f32x4*)(g2 + cB), gB1 = *(const f32x4*)(g2 + cB + 4);
#pragma unroll 2
        for (int s = 0; s < 8; ++s) { const int rl = 32 * wave + 4 * s + rsub; const size_t row = (size_t)u.pm * 256 + rl;
            const unsigned char* sp = SLAB + row * TOPK * DMODEL + u.pn * 256 + 16 * i;
            v4u sv[TOPK];
#if FWD_LEVEL >= 2
#pragma unroll
            for (int k = 0; k < TOPK; ++k) sv[k] = __builtin_nontemporal_load((const v4u*)(sp + (size_t)k * DMODEL));
#endif
            float* op = out + row * DMODEL + u.pn * 256;
            const f32x4 xA0 = __builtin_nontemporal_load((const f32x4*)(op + cA)), xA1 = __builtin_nontemporal_load((const f32x4*)(op + cA + 4)), xB0 = __builtin_nontemporal_load((const f32x4*)(op + cB)), xB1 = __builtin_nontemporal_load((const f32x4*)(op + cB + 4));
            f32x4 aA0, aA1, aB0, aB1;
            { const v4u pa_ = *(const LAS v4u*)(lds + rl * 512 + (((cA >> 3) ^ (rl & 31)) << 4)), pb_ = *(const LAS v4u*)(lds + rl * 512 + (((cB >> 3) ^ (rl & 31)) << 4)); unpack8(pa_, aA0, aA1); unpack8(pb_, aB0, aB1); }
            f32x4 sA0 = (f32x4){0.f, 0.f, 0.f, 0.f}, sA1 = sA0, sB0 = sA0, sB1 = sA0;
#if FWD_LEVEL >= 2
#pragma unroll
            for (int k = 0; k < TOPK; ++k) { const f32x2v a = __builtin_amdgcn_cvt_pk_f32_fp8((int)sv[k].x, false), b = __builtin_amdgcn_cvt_pk_f32_fp8((int)sv[k].x, true), c = __builtin_amdgcn_cvt_pk_f32_fp8((int)sv[k].y, false), d = __builtin_amdgcn_cvt_pk_f32_fp8((int)sv[k].y, true);
                const f32x2v e = __builtin_amdgcn_cvt_pk_f32_fp8((int)sv[k].z, false), f = __builtin_amdgcn_cvt_pk_f32_fp8((int)sv[k].z, true), g = __builtin_amdgcn_cvt_pk_f32_fp8((int)sv[k].w, false), h = __builtin_amdgcn_cvt_pk_f32_fp8((int)sv[k].w, true);
                sA0 += (f32x4){a[0], a[1], b[0], b[1]}; sA1 += (f32x4){c[0], c[1], d[0], d[1]}; sB0 += (f32x4){e[0], e[1], f[0], f[1]}; sB1 += (f32x4){g[0], g[1], h[0], h[1]}; }
#endif
            sA0 = sA0 * (1.0f / SLABSCALE) + aA0; sA1 = sA1 * (1.0f / SLABSCALE) + aA1; sB0 = sB0 * (1.0f / SLABSCALE) + aB0; sB1 = sB1 * (1.0f / SLABSCALE) + aB1;
            __builtin_nontemporal_store(xA0 + gA0 * sA0, (f32x4*)(op + cA)); __builtin_nontemporal_store(xA1 + gA1 * sA1, (f32x4*)(op + cA + 4));
            __builtin_nontemporal_store(xB0 + gB0 * sB0, (f32x4*)(op + cB)); __builtin_nontemporal_store(xB1 + gB1 * sB1, (f32x4*)(op + cB + 4)); }
    }
};
__device__ __forceinline__ void EpiMerge::fused(const AccT& acc, const pg8::Unit& u, int wr, int wc, int fr, int fq, LAS unsigned char* lds) const {
    typedef float f32x2v __attribute__((ext_vector_type(2)));
    park_tile(acc, lds, wr, wc, fr, fq);
    const int tid = threadIdx.x, wave = tid >> 6, lane = tid & 63, hl = lane >> 5, i = lane & 31;
    const int col0 = 128 * (i & 1) + 32 * (i >> 3) + 8 * ((i >> 1) & 3);
    const unsigned char* G8 = (const unsigned char*)SG;
#pragma unroll 4
    for (int s = 0; s < 16; ++s) { const int rl = 32 * wave + 2 * s + hl; const size_t rowo = ((size_t)u.pm * 256 + rl) * DMODEL + u.pn * 256, off = rowo + col0;
        const v2u gcv = __builtin_nontemporal_load((const v2u*)(G8 + rowo + 8 * i)), gav = __builtin_nontemporal_load((const v2u*)(G8 + (size_t)T * DMODEL + rowo + 8 * i)); const v4u ycv = *(const v4u*)(MG + off);
        f32x4 a0, a1, c0, c1; { const v4u pk_ = *(const LAS v4u*)(lds + rl * 512 + (((col0 >> 3) ^ (rl & 31)) << 4)); unpack8(pk_, a0, a1); }
        unpack8(ycv, c0, c1);
        const f32x2v p0 = __builtin_amdgcn_cvt_pk_f32_fp8((int)gcv.x, false), p1 = __builtin_amdgcn_cvt_pk_f32_fp8((int)gcv.x, true), p2 = __builtin_amdgcn_cvt_pk_f32_fp8((int)gcv.y, false), p3 = __builtin_amdgcn_cvt_pk_f32_fp8((int)gcv.y, true);
        const f32x2v q0 = __builtin_amdgcn_cvt_pk_f32_fp8((int)gav.x, false), q1 = __builtin_amdgcn_cvt_pk_f32_fp8((int)gav.x, true), q2 = __builtin_amdgcn_cvt_pk_f32_fp8((int)gav.y, false), q3 = __builtin_amdgcn_cvt_pk_f32_fp8((int)gav.y, true);
        const f32x4 g0 = (f32x4){p0[0], p0[1], p1[0], p1[1]}, g1 = (f32x4){p2[0], p2[1], p3[0], p3[1]}, h0 = (f32x4){q0[0], q0[1], q1[0], q1[1]}, h1 = (f32x4){q2[0], q2[1], q3[0], q3[1]};
        *(v4u*)(MG + off) = pack8(g0 * c0 + h0 * a0, g1 * c1 + h1 * a1); }
}
__device__ __forceinline__ void EpiX1::fused(const AccT& acc, const pg8::Unit& u, int wr, int wc, int fr, int fq, LAS unsigned char* lds) const {
    park_tile(acc, lds, wr, wc, fr, fq);
    const int tid = threadIdx.x, wave = tid >> 6, lane = tid & 63, hl = lane >> 5, i = lane & 31;
    const float* g1 = mod + (size_t)(u.pm >> 5) * 6144 + 2048 + u.pn * 256 + 8 * i;
    const f32x4 gv0 = *(const f32x4*)g1, gv1 = *(const f32x4*)(g1 + 4);
#pragma unroll 4
    for (int s = 0; s < 16; ++s) { const int rl = 32 * wave + 2 * s + hl; const size_t off = ((size_t)u.pm * 256 + rl) * DMODEL + u.pn * 256 + 8 * i;
        const f32x4 x0 = __builtin_nontemporal_load((const f32x4*)(x + off)), x1v = __builtin_nontemporal_load((const f32x4*)(x + off + 4));
        f32x4 a0, a1; { const v4u pk_ = *(const LAS v4u*)(lds + rl * 512 + ((i ^ (rl & 31)) << 4)); unpack8(pk_, a0, a1); }
        const f32x4 v0 = x0 + gv0 * a0, v1 = x1v + gv1 * a1;
        *(f32x4*)(out + off) = v0; *(f32x4*)(out + off + 4) = v1;
        float ss = ((v0[0] * v0[0] + v0[1] * v0[1]) + (v0[2] * v0[2] + v0[3] * v0[3])) + ((v1[0] * v1[0] + v1[1] * v1[1]) + (v1[2] * v1[2] + v1[3] * v1[3]));
        float mx = fmaxf(fmaxf(fmaxf(fabsf(v0[0]), fabsf(v0[1])), fmaxf(fabsf(v0[2]), fabsf(v0[3]))), fmaxf(fmaxf(fabsf(v1[0]), fabsf(v1[1])), fmaxf(fabsf(v1[2]), fabsf(v1[3]))));
        ss = row16_sum(ss); ss += __shfl_xor(ss, 16);
        mx = row16_max(mx); mx = fmaxf(mx, __shfl_xor(mx, 16));
        if (i == 0) { ssq[(size_t)u.pn * T + (size_t)u.pm * 256 + rl] = ss; xmx[(size_t)u.pn * T + (size_t)u.pm * 256 + rl] = mx; } }
}


__device__ __forceinline__ void p6_item(const KArgs& a, LAS unsigned char* lds, int item, int tid, int wave, int lane) {
    unsigned char* ws = a.ws;
    const int row0 = 32 * item, r = lane & 31, h = lane >> 5, row = row0 + r, b = row >> 13;
    const float* x1 = a.out; const float* ssq = (const float*)(ws + WS_SSQ); const float* mod = (const float*)(ws + WS_MOD) + (size_t)b * 6144;
    unsigned char* H2 = ws + WS_H2;
    const bf16* WRH = (const bf16*)(ws + WS_WRH); const bf16* WRL = (const bf16*)(ws + WS_WRL);
    constexpr int WREG = 9216, TROW = 144;
    LAS unsigned char* wreg = lds + RING_OFF + wave * WREG;
    LAS float* scl = (LAS float*)(lds + RING_OFF + 8 * WREG);
    LAS float* bil = scl + 32 * 65;
    LAS int* hist = (LAS int*)(bil + 32 * 65);
    LAS int* gbase = hist + 512;
    LAS float* rstl = (LAS float*)(gbase + 64);
    if (tid < 32) { float ss = 0.f;
#pragma unroll
        for (int p = 0; p < 4; ++p) ss += ssq[(size_t)p * T + row0 + tid];
        rstl[tid] = 1.0f / sqrtf(ss * (1.0f / DMODEL) + EPS); }
    const int lr = lane >> 4, lc4 = (lane & 15) * 4;
    __syncthreads();
    f32x16 acc0, acc1;
#pragma unroll
    for (int i = 0; i < 16; ++i) { acc0[i] = 0.f; acc1[i] = 0.f; }
#pragma nounroll
    for (int ms = 0; ms < 2; ++ms) {
        const int kb = 128 * wave + 64 * ms;
        f32x4 xv[8];
#pragma unroll
        for (int i = 0; i < 8; ++i) xv[i] = *(const f32x4*)(x1 + (size_t)(row0 + 4 * i + lr) * DMODEL + kb + lc4);
        const f32x4 gs = *(const f32x4*)(a.in[16] + kb + lc4) * (1.0f + *(const f32x4*)(mod + 4096 + kb + lc4)), sh = *(const f32x4*)(mod + 3072 + kb + lc4);
#pragma unroll
        for (int i = 0; i < 8; ++i) { const int rr = 4 * i + lr; const f32x4 hv = xv[i] * rstl[rr] * gs + sh;
            const unsigned h0 = f2bf(hv[0]), h1_ = f2bf(hv[1]), h2_ = f2bf(hv[2]), h3 = f2bf(hv[3]);
            const v2u whi = (v2u){h0 | (h1_ << 16), h2_ | (h3 << 16)};
            const v2u wlo = (v2u){pk2(hv[0] - bf2f(h0), hv[1] - bf2f(h1_)), pk2(hv[2] - bf2f(h2_), hv[3] - bf2f(h3))};
#if MOE_FP8
            *(GAS unsigned*)(H2 + (size_t)(row0 + rr) * DMODEL + kb + lc4) = pk4_fp8(hv[0], hv[1], hv[2], hv[3]);
#else
            *(GAS v2u*)(H2 + ((size_t)(row0 + rr) * DMODEL + kb + lc4) * 2) = whi;
#endif
            *(LAS v2u*)(wreg + rr * TROW + lc4 * 2) = whi; *(LAS v2u*)(wreg + 32 * TROW + rr * TROW + lc4 * 2) = wlo; }
#pragma unroll
        for (int sp = 0; sp < 2; ++sp) {
            bf16x8 bh0[2], bh1[2], bl0[2], bl1[2];
#pragma unroll
            for (int s2 = 0; s2 < 2; ++s2) { const size_t o = (size_t)r * DMODEL + kb + 16 * (2 * sp + s2) + 8 * h;
                bh0[s2] = *(const bf16x8*)(WRH + o); bh1[s2] = *(const bf16x8*)(WRH + o + 32 * DMODEL); bl0[s2] = *(const bf16x8*)(WRL + o); bl1[s2] = *(const bf16x8*)(WRL + o + 32 * DMODEL); }
#pragma unroll
            for (int s2 = 0; s2 < 2; ++s2) { const int s_ = 2 * sp + s2;
                const bf16x8 ahi = *(const LAS bf16x8*)(wreg + r * TROW + (16 * s_ + 8 * h) * 2), alo = *(const LAS bf16x8*)(wreg + 32 * TROW + r * TROW + (16 * s_ + 8 * h) * 2);
                acc0 = __builtin_amdgcn_mfma_f32_32x32x16_bf16(alo, bh0[s2], acc0, 0, 0, 0); acc1 = __builtin_amdgcn_mfma_f32_32x32x16_bf16(alo, bh1[s2], acc1, 0, 0, 0);
                acc0 = __builtin_amdgcn_mfma_f32_32x32x16_bf16(ahi, bl0[s2], acc0, 0, 0, 0); acc1 = __builtin_amdgcn_mfma_f32_32x32x16_bf16(ahi, bl1[s2], acc1, 0, 0, 0);
                acc0 = __builtin_amdgcn_mfma_f32_32x32x16_bf16(ahi, bh0[s2], acc0, 0, 0, 0); acc1 = __builtin_amdgcn_mfma_f32_32x32x16_bf16(ahi, bh1[s2], acc1, 0, 0, 0); }
            asm volatile("" ::: "memory");
        }
        asm volatile("" ::: "memory");
    }
    { LAS float* part = (LAS float*)wreg;
#pragma unroll
      for (int i = 0; i < 16; ++i) { const int tr = (i & 3) + 8 * (i >> 2) + 4 * h; part[tr * 64 + r] = acc0[i]; part[tr * 64 + 32 + r] = acc1[i]; } }
    __syncthreads();
    {
        const int tr = tid >> 4, e4 = (tid & 15) * 4; f32x4 s = *(const LAS f32x4*)(lds + RING_OFF + tr * 256 + e4 * 4);
#pragma unroll
        for (int w = 1; w < 8; ++w) s += *(const LAS f32x4*)(lds + RING_OFF + w * WREG + tr * 256 + e4 * 4);
        const f32x4 rb = *(const f32x4*)(a.in[18] + e4);
#pragma unroll
        for (int j = 0; j < 4; ++j) { const float sc = 1.0f / (1.0f + expf(-s[j])); scl[tr * 65 + e4 + j] = sc; bil[tr * 65 + e4 + j] = sc + rb[j]; }
    }
    __syncthreads();
    LAS int* selk = (LAS int*)(rstl + 32); LAS float* selw = (LAS float*)(selk + 32 * 64);
    int lc = 0;
#pragma nounroll
    for (int j = 0; j < 4; ++j) {
        const int tr = wave * 4 + j; const float v = bil[tr * 65 + lane], sc = scl[tr * 65 + lane];
        int rk = 0;
#pragma unroll
        for (int d = 1; d < 8; ++d) { const int src = (lane & ~7) | ((lane + d) & 7); const float o = __shfl(v, src); rk += (o > v) || (o == v && src < lane); }
        float t2 = rk < 2 ? v : 0.f; t2 += __shfl_xor(t2, 1); t2 += __shfl_xor(t2, 2); t2 += __shfl_xor(t2, 4);
        int grk = 0; const int g = lane >> 3;
#pragma unroll
        for (int g2 = 0; g2 < 8; ++g2) { const float og = __builtin_bit_cast(float, __builtin_amdgcn_readlane(__builtin_bit_cast(int, t2), g2 * 8)); grk += (og > t2) || (og == t2 && g2 < g); }
        const bool gsel = grk < 4;
        const float c = gsel ? v : -INFINITY; int erk = 0;
#pragma nounroll
        for (int e2 = 0; e2 < 64; ++e2) { const float oc = __builtin_bit_cast(float, __builtin_amdgcn_readlane(__builtin_bit_cast(int, c), e2)); erk += (oc > c) || (oc == c && e2 < lane); }
        const bool sel = gsel && erk < TOPK;
        const float wsum = wave_sum(sel ? sc : 0.f);
        selk[tr * 64 + lane] = sel ? erk : -1; selw[tr * 64 + lane] = sc * (ROUTED_SCALE / wsum); lc += sel ? 1 : 0;
    }
    hist[wave * 64 + lane] = lc;
    __syncthreads();
    if (wave == 0) { int tot = 0;
#pragma unroll
        for (int w = 0; w < 8; ++w) tot += hist[w * 64 + lane];
        gbase[lane] = tot ? (int)__hip_atomic_fetch_add((unsigned*)(ws + WS_CTL) + CW_CNT + 64 * lane, (unsigned)tot, RLX_AGENT) : 0; }
    __syncthreads();
    {   int base = gbase[lane];
        for (int w = 0; w < wave; ++w) base += hist[w * 64 + lane];
        int* list = (int*)(ws + WS_LIST); float* wl = (float*)(ws + WS_WLIST);
#pragma unroll
        for (int j = 0; j < 4; ++j) { const int tr = wave * 4 + j, k = selk[tr * 64 + lane]; if (k >= 0) { const size_t p = (size_t)lane * LISTCAP + base; list[p] = (row0 + tr) * TOPK + k; wl[p] = selw[tr * 64 + lane]; ++base; } } }
    __syncthreads();
}

__device__ __forceinline__ float p6_rank_slow(float c, int lane) {
    int erk = 0;
#pragma nounroll
    for (int e2 = 0; e2 < 64; ++e2) { const float oc = __builtin_bit_cast(float, __builtin_amdgcn_readlane(__builtin_bit_cast(int, c), e2)); erk += (oc > c) || (oc == c && e2 < lane); }
    return (float)erk;
}
__device__ __forceinline__ void p6_block(const KArgs& a, LAS unsigned char* lds, int vcu, int tid, int wave, int lane) {
    unsigned char* ws = a.ws;
    const int rowb = 64 * vcu + 8 * wave, b = (64 * vcu) >> 13;
    const float* x1 = a.out; const float* ssq = (const float*)(ws + WS_SSQ); const float* mod = (const float*)(ws + WS_MOD) + (size_t)b * 6144;
    unsigned char* H2 = ws + WS_H2;
    const bf16* WRH = (const bf16*)(ws + WS_WRH); const bf16* WRL = (const bf16*)(ws + WS_WRL);
    constexpr int RS = 272, BSH = 64 * RS, BSB = 2 * BSH;
    LAS unsigned char* BS = lds + RING_OFF;
    LAS unsigned char* AW = lds + RING_OFF + 2 * BSB + wave * (2 * 8 * RS);
    LAS int* hist = (LAS int*)(lds + RING_OFF + 2 * BSB + 8 * (2 * 8 * RS)); LAS int* gbase = hist + 512;
    float ss = 0.f, mx = 0.f;
    { const float* xm = (const float*)(ws + WS_XMX); const int rl = rowb + (lane & 7);
#pragma unroll
      for (int p = 0; p < 4; ++p) { ss += ssq[(size_t)p * T + rl]; mx = fmaxf(mx, xm[(size_t)p * T + rl]); } }
    float gmx = 0.f, smx = 0.f;
#pragma unroll
    for (int q = 0; q < 4; ++q) { const f32x4 gq_ = *(const f32x4*)(a.in[16] + 4 * lane + 256 * q) * (1.0f + *(const f32x4*)(mod + 4096 + 4 * lane + 256 * q)), sq_ = *(const f32x4*)(mod + 3072 + 4 * lane + 256 * q);
        gmx = fmaxf(gmx, fmaxf(fmaxf(fabsf(gq_[0]), fabsf(gq_[1])), fmaxf(fabsf(gq_[2]), fabsf(gq_[3])))); smx = fmaxf(smx, fmaxf(fmaxf(fabsf(sq_[0]), fabsf(sq_[1])), fmaxf(fabsf(sq_[2]), fabsf(sq_[3])))); }
    float rstd4[4], qinv4[4];
    const int lrow = lane >> 5, lcol = (lane & 31) * 4;
    const int fr = lane & 15, fg = lane >> 4;
    f32x4 acc[4];
#pragma unroll
    for (int nb = 0; nb < 4; ++nb) acc[nb] = (f32x4){0.f, 0.f, 0.f, 0.f};
    v4u bsA[4], bsB[4], bsC[4]; f32x4 xvA[4], xvB[4], xvC[4], gsA, gsB, gsC, shA, shB, shC;
#define P6_LOAD(S, c) do { _Pragma("unroll") for (int q = 0; q < 4; ++q) { const int idx = tid + 512 * q, e = (idx >> 4) & 63, part = idx & 15; \
            bs##S[q] = *(const v4u*)(((idx >> 10) ? WRL : WRH) + (size_t)e * DMODEL + 128 * (c) + part * 8); } \
        _Pragma("unroll") for (int i = 0; i < 4; ++i) xv##S[i] = __builtin_nontemporal_load((const f32x4*)(x1 + (size_t)(rowb + 2 * i + lrow) * DMODEL + 128 * (c) + lcol)); \
        gs##S = *(const f32x4*)(a.in[16] + 128 * (c) + lcol) * (1.0f + *(const f32x4*)(mod + 4096 + 128 * (c) + lcol)); sh##S = *(const f32x4*)(mod + 3072 + 128 * (c) + lcol); } while (0)
#define P6_BSTORE(S, buf) do { _Pragma("unroll") for (int q = 0; q < 4; ++q) { const int idx = tid + 512 * q, e = (idx >> 4) & 63, part = idx & 15; \
            *(LAS v4u*)(BS + (buf) * BSB + (idx >> 10) * BSH + e * RS + part * 16) = bs##S[q]; } } while (0)
#define P6_CONVERT(S, c) do { _Pragma("unroll") for (int i = 0; i < 4; ++i) { const int rr = 2 * i + lrow; const f32x4 hv = xv##S[i] * rstd4[i] * gs##S + sh##S; \
            const unsigned w01 = cvt_pk_bf16(hv[0], hv[1]), w23 = cvt_pk_bf16(hv[2], hv[3]); \
            const v2u whi = (v2u){w01, w23}; \
            const v2u wlo = (v2u){cvt_pk_bf16(hv[0] - bf_lo(w01), hv[1] - bf_hi(w01)), cvt_pk_bf16(hv[2] - bf_lo(w23), hv[3] - bf_hi(w23))}; \
            *(GAS unsigned*)(H2 + (size_t)(rowb + rr) * DMODEL + 128 * (c) + lcol) = pk4_i8_nc(hv[0] * qinv4[i], hv[1] * qinv4[i], hv[2] * qinv4[i], hv[3] * qinv4[i]); \
            *(LAS v2u*)(AW + rr * RS + lcol * 2) = whi; *(LAS v2u*)(AW + 8 * RS + rr * RS + lcol * 2) = wlo; } } while (0)
#if defined(P6_ABL) && P6_ABL == 4
#define P6_MMA(c) do { } while (0)
#else
#define P6_MMA(c) do { const LAS unsigned char* bsl = BS + ((c) & 1) * BSB; _Pragma("unroll") for (int ks = 0; ks < 4; ++ks) { \
            const bf16x8 ahi = *(const LAS bf16x8*)(AW + (fr & 7) * RS + (32 * ks + 8 * fg) * 2), alo = *(const LAS bf16x8*)(AW + 8 * RS + (fr & 7) * RS + (32 * ks + 8 * fg) * 2); \
            _Pragma("unroll") for (int nb = 0; nb < 4; ++nb) { const bf16x8 bh = *(const LAS bf16x8*)(bsl + (16 * nb + fr) * RS + (32 * ks + 8 * fg) * 2), bl = *(const LAS bf16x8*)(bsl + BSH + (16 * nb + fr) * RS + (32 * ks + 8 * fg) * 2); \
                acc[nb] = __builtin_amdgcn_mfma_f32_16x16x32_bf16(alo, bh, acc[nb], 0, 0, 0); acc[nb] = __builtin_amdgcn_mfma_f32_16x16x32_bf16(ahi, bl, acc[nb], 0, 0, 0); acc[nb] = __builtin_amdgcn_mfma_f32_16x16x32_bf16(ahi, bh, acc[nb], 0, 0, 0); } } } while (0)
#endif
#if defined(P6_ABL) && P6_ABL == 2
    return;
#endif
    P6_LOAD(A, 0); P6_LOAD(B, 1); P6_LOAD(C, 2);
    gmx = wave_max(gmx); smx = wave_max(smx);
    const float rs_l = 1.0f / sqrtf(ss * (1.0f / DMODEL) + EPS), s2_l = fmaxf(rs_l * mx * gmx + smx, 1e-20f) * (1.0f / 127.0f);
    if (lane < 8) ((float*)(ws + WS_SA2))[rowb + lane] = s2_l;
#pragma unroll
    for (int i = 0; i < 4; ++i) { rstd4[i] = __shfl(rs_l, 2 * i + (lane >> 5)); qinv4[i] = 1.0f / __shfl(s2_l, 2 * i + (lane >> 5)); }
    P6_BSTORE(A, 0);
    __syncthreads();

#if defined(DIAG_A)
    if (blockIdx.x == DIAG_BLK && tid == 0) ((unsigned long long*)(ws + WS_CTL + 512 * 1024))[40] = __builtin_amdgcn_s_memrealtime();
#endif
    P6_CONVERT(A, 0); P6_LOAD(A, 3); P6_MMA(0); P6_BSTORE(B, 1); __syncthreads();
    P6_CONVERT(B, 1); P6_LOAD(B, 4); P6_MMA(1); P6_BSTORE(C, 0); __syncthreads();
    P6_CONVERT(C, 2); P6_LOAD(C, 5); P6_MMA(2); P6_BSTORE(A, 1); __syncthreads();
    P6_CONVERT(A, 3); P6_LOAD(A, 6); P6_MMA(3); P6_BSTORE(B, 0); __syncthreads();
    P6_CONVERT(B, 4); P6_LOAD(B, 7); P6_MMA(4); P6_BSTORE(C, 1); __syncthreads();
    P6_CONVERT(C, 5); P6_MMA(5); P6_BSTORE(A, 0); __syncthreads();
    P6_CONVERT(A, 6); P6_MMA(6); P6_BSTORE(B, 1); __syncthreads();
    P6_CONVERT(B, 7); P6_MMA(7); __syncthreads();

#if defined(DIAG_A)
    if (blockIdx.x == DIAG_BLK && tid == 0) ((unsigned long long*)(ws + WS_CTL + 512 * 1024))[41] = __builtin_amdgcn_s_memrealtime();
#endif
#undef P6_LOAD
#undef P6_BSTORE
#undef P6_CONVERT
#undef P6_MMA
#if defined(P6_ABL) && P6_ABL == 1
    { if (fg < 2 && acc[0][0] == 12345.f) a.out[1] = acc[1][1] + acc[2][2] + acc[3][3]; return; }
#endif
    LAS float* LG = (LAS float*)AW;
    if (fg < 2) {
#pragma unroll
        for (int nb = 0; nb < 4; ++nb)
#pragma unroll
            for (int r = 0; r < 4; ++r) LG[(4 * fg + r) * 64 + 16 * nb + fr] = acc[nb][r];
    }
    LAS float* RSW = (LAS float*)(BS + wave * 8192);
    const float rbias = a.in[18][lane];
    int selk[8]; float selw[8]; int lc = 0;
#if defined(P6_ABL) && P6_ABL >= 3
#pragma unroll
    for (int j = 0; j < 8; ++j) { const bool sel = (lane >> 3) == j; selk[j] = sel ? (lane & 7) : -1; selw[j] = 0.3125f + 1e-9f * LG[j * 64 + lane] + 0.f * rbias; lc += sel ? 1 : 0; }
#else
#pragma unroll
    for (int jq = 0; jq < 2; ++jq) {
        float sc4[4], v4[4], gs4[4]; int grk4[4], gt4[4]; bool gsel4[4];
#define P6_TB(u) (RSW + (4 * jq + (u)) * 160)
#pragma unroll
        for (int u = 0; u < 4; ++u) { sc4[u] = sigmoidf_fast(LG[(4 * jq + u) * 64 + lane]); v4[u] = sc4[u] + rbias; P6_TB(u)[lane] = v4[u]; }
#pragma unroll
        for (int u = 0; u < 4; ++u) { LAS float* Vb = P6_TB(u); LAS float* Gb = Vb + 128;
            const f32x4 ga = *(const LAS f32x4*)(Vb + (lane & ~7)), gb = *(const LAS f32x4*)(Vb + (lane & ~7) + 4);
            float m1 = -INFINITY, m2 = -INFINITY;
#pragma unroll
            for (int q = 0; q < 8; ++q) { const float o = q < 4 ? ga[q] : gb[q - 4]; if (o > m1) { m2 = m1; m1 = o; } else if (o > m2) m2 = o; }
            gs4[u] = m1 + m2;
            if ((lane & 7) == 0) Gb[lane >> 3] = gs4[u]; }
#pragma unroll
        for (int u = 0; u < 4; ++u) { LAS float* Vb = P6_TB(u); LAS float* Cb = Vb + 64; LAS float* Gb = Vb + 128; LAS float* Tb = Vb + 136;
            const f32x4 sa = *(const LAS f32x4*)Gb, sb = *(const LAS f32x4*)(Gb + 4);
            int grk = 0; const int g = lane >> 3; const float gs = gs4[u];
#pragma unroll
            for (int g2 = 0; g2 < 8; ++g2) { const float og = g2 < 4 ? sa[g2] : sb[g2 - 4]; grk += (og > gs) || (og == gs && g2 < g); }
            grk4[u] = grk; gsel4[u] = grk < 4;
            if (gsel4[u]) Cb[grk * 8 + (lane & 7)] = v4[u];
            if (lane < 8) ((LAS int*)Tb)[lane] = -1; }
#pragma unroll
        for (int u = 0; u < 4; ++u) { LAS float* Vb = P6_TB(u); LAS float* Cb = Vb + 64; LAS float* Tb = Vb + 136; const float v = v4[u];
            int gt = 0;
#pragma unroll
            for (int q = 0; q < 8; ++q) { const f32x4 o = *(const LAS f32x4*)(Cb + 4 * q); gt += (o[0] > v) + (o[1] > v) + (o[2] > v) + (o[3] > v); }
            gt4[u] = gt;
            if (gsel4[u] && gt < TOPK) Tb[gt] = sc4[u]; }
#pragma unroll
        for (int u = 0; u < 4; ++u) { LAS float* Tb = P6_TB(u) + 136; const int j = 4 * jq + u; const float v = v4[u], sc = sc4[u]; const bool gsel = gsel4[u];
            int erk = gt4[u]; bool sel = gsel && erk < TOPK;
            f32x4 ta = *(const LAS f32x4*)Tb, tb_ = *(const LAS f32x4*)(Tb + 4);
            const int anyneg = (__builtin_bit_cast(int, ta[0]) | __builtin_bit_cast(int, ta[1]) | __builtin_bit_cast(int, ta[2]) | __builtin_bit_cast(int, ta[3])) | (__builtin_bit_cast(int, tb_[0]) | __builtin_bit_cast(int, tb_[1]) | __builtin_bit_cast(int, tb_[2]) | __builtin_bit_cast(int, tb_[3]));
            if (__builtin_expect(__any(anyneg < 0) || __popcll(__ballot(sel)) != TOPK, 0)) {
                erk = (int)p6_rank_slow(gsel ? v : -INFINITY, lane); sel = gsel && erk < TOPK;
                if (sel) Tb[erk] = sc;
                ta = *(const LAS f32x4*)Tb; tb_ = *(const LAS f32x4*)(Tb + 4); }
            const float wsum = ((ta[0] + ta[1]) + (ta[2] + ta[3])) + ((tb_[0] + tb_[1]) + (tb_[2] + tb_[3]));
            selk[j] = sel ? erk : -1; selw[j] = sc * (ROUTED_SCALE / wsum); lc += sel ? 1 : 0; }
#undef P6_TB
    }
#endif
    hist[wave * 64 + lane] = lc;
    __syncthreads();

#if defined(DIAG_A)
    if (blockIdx.x == DIAG_BLK && tid == 0) ((unsigned long long*)(ws + WS_CTL + 512 * 1024))[42] = __builtin_amdgcn_s_memrealtime();
#endif
    if (wave == 0) { int tot = 0;
#pragma unroll
        for (int w = 0; w < 8; ++w) tot += hist[w * 64 + lane];
        gbase[lane] = tot ? (int)__hip_atomic_fetch_add((unsigned*)(ws + WS_CTL) + CW_CNT + 64 * lane, (unsigned)tot, RLX_AGENT) : 0; }
    __syncthreads();

#if defined(DIAG_A)
    if (blockIdx.x == DIAG_BLK && tid == 0) ((unsigned long long*)(ws + WS_CTL + 512 * 1024))[43] = __builtin_amdgcn_s_memrealtime();
#endif
    {   int base = gbase[lane];
        for (int w = 0; w < wave; ++w) base += hist[w * 64 + lane];
        int* list = (int*)(ws + WS_LIST); float* wl = (float*)(ws + WS_WLIST); float* sl = (float*)(ws + WS_SLIST);
#pragma unroll
        for (int j = 0; j < 8; ++j) { const float s2j = __shfl(s2_l, j); if (selk[j] >= 0) { const size_t p = (size_t)lane * LISTCAP + base; list[p] = (rowb + j) * TOPK + selk[j]; wl[p] = selw[j]; sl[p] = s2j; ++base; } } }
    __syncthreads();

#if defined(DIAG_A)
    if (blockIdx.x == DIAG_BLK && tid == 0) ((unsigned long long*)(ws + WS_CTL + 512 * 1024))[44] = __builtin_amdgcn_s_memrealtime();
#endif
}


constexpr int Q8_SPLIT = 4608;
constexpr int WD_SPLIT = 4096, WD_SPLIT2 = 6144;
__device__ __forceinline__ void moe_tables(const KArgs& a, LAS unsigned char* lds, int tid, int lane) {
    LAS int* tstart = (LAS int*)(lds + TAB_OFF); LAS int* cntl = tstart + 80;
    if (tid < 64) { const int c = (int)__hip_atomic_load((unsigned*)(a.ws + WS_CTL) + CW_CNT + 64 * tid, RLX_AGENT); const int tl = (c + 255) >> 8; int sc = tl;
#pragma unroll
        for (int o = 1; o < 64; o <<= 1) { const int up = __shfl_up(sc, o); if (lane >= o) sc += up; }
        cntl[tid] = c; tstart[tid + 1] = sc; if (tid == 0) tstart[0] = 0; }
    else if (tid >= 64 && tid < 64 + 66) ((LAS float*)(tstart + 160))[tid - 64] = __builtin_bit_cast(float, __hip_atomic_load((unsigned*)(a.ws + WS_CTL) + CW_AMAX + (tid - 64), RLX_AGENT));
    __syncthreads();
}

__global__ void __launch_bounds__(NWAVES * 64, 2) fox_fwd(KArgs args) {
    extern __shared__ __attribute__((aligned(16))) unsigned char lds_raw[];
    LAS unsigned char* lds = (LAS unsigned char*)lds_raw;
    volatile LAS unsigned* MISC = (volatile LAS unsigned*)(lds + MISC_OFF);
    const int tid = threadIdx.x, lane = tid & 63, wave = __builtin_amdgcn_readfirstlane(tid >> 6);
    const int G = gridDim.x; int vcu; { const int bx = blockIdx.x; vcu = (G % 8 == 0) ? (bx % 8) * (G / 8) + bx / 8 : bx; }
    unsigned char* ws = args.ws; gu32* ctl = (gu32*)(ws + WS_CTL);
    for (int u = tid; u < (LDS_BYTES - LDSCTL_OFF) / 4; u += NWAVES * 64) ((LAS unsigned*)(lds + LDSCTL_OFF))[u] = 0u;
    __syncthreads();
    const int lo = args.ph_lo, hi = args.ph_hi; const bool single = (hi - lo) > 1;
    XcdBarrier bar; bar.bar = (unsigned*)(ctl + CW_BAR); bar.x = 0; bar.st = nullptr;
    if (single) bar = xcd_barrier_post((unsigned*)(ctl + CW_BAR), MISC + 8);
#ifndef PHASE_MASK
#define PHASE_MASK 0x3ff
#endif
#define IN(k) (((PHASE_MASK >> (k)) & 1) && lo <= (k) && (k) < hi)
#ifndef DIAG_BLK
#define DIAG_BLK 0
#endif
#if defined(DIAG_A)
#define DSTAMP_PTR dstamp
    unsigned long long* dstamp = (unsigned long long*)(ws + WS_CTL + 512 * 1024);
#define GRID_BAR(k) do { if (tid == 0) dstamp[256 + (k) * 256 + blockIdx.x] = __builtin_amdgcn_s_memrealtime(); if (IN(k) && IN((k) + 1)) xcd_barrier(bar); if (blockIdx.x == 0 && tid == 0) dstamp[(k) + 1] = __builtin_amdgcn_s_memrealtime(); } while (0)
    if (blockIdx.x == 0 && tid == 0) dstamp[0] = __builtin_amdgcn_s_memrealtime();
#else
#define DSTAMP_PTR nullptr
#define GRID_BAR(k) do { if (IN(k) && IN((k) + 1)) xcd_barrier(bar); } while (0)
#endif
    bf16* H1 = (bf16*)(ws + WS_H1); bf16* Ub = (bf16*)(ws + WS_U); bf16* Qb = (bf16*)(ws + WS_Q); bf16* Kb = (bf16*)(ws + WS_K); bf16* Vb = (bf16*)(ws + WS_V);
    bf16* SG = (bf16*)(ws + WS_SG); bf16* UC = (bf16*)(ws + WS_UC); bf16* Ob = (bf16*)(ws + WS_O); bf16* MG = (bf16*)(ws + WS_MG);
    const float* mod = (const float*)(ws + WS_MOD);

#if FWD_LEVEL == 0
    if (IN(0)) { const f32x4* xs = (const f32x4*)args.in[0]; f32x4* od = (f32x4*)args.out;
        for (size_t i = (size_t)blockIdx.x * 512 + tid; i < (size_t)T * DMODEL / 4; i += (size_t)G * 512) od[i] = xs[i]; }
    for (int k = 0; k < 9; ++k) GRID_BAR(k);
#else
    if (IN(0)) p0_prologue(args, lds, vcu, G, wave, lane);
#if defined(DIAG_A)
    if (blockIdx.x == DIAG_BLK && tid == 0) dstamp[24] = __builtin_amdgcn_s_memrealtime();
    if (tid == 0) dstamp[256 + blockIdx.x] = __builtin_amdgcn_s_memrealtime();
#endif
    GRID_BAR(0);
    if (IN(1)) {
        q8_items(args, lds, 0, Q8_SPLIT, vcu, G, wave, lane);
        wd_items(args, lds, WD_SPLIT2, 64 * 128, vcu, G, wave, lane);
        __syncthreads();
#if defined(DIAG_A)
        if (blockIdx.x == DIAG_BLK && tid == 0) dstamp[25] = __builtin_amdgcn_s_memrealtime();
#endif
        if (G == 256) p1_rows2(args, lds, vcu, tid, wave, lane);
#if defined(DIAG_A)
        if (blockIdx.x == DIAG_BLK && tid == 0) dstamp[26] = __builtin_amdgcn_s_memrealtime();
#endif
    }
    GRID_BAR(1);
    if (IN(2)) {
        if (blockIdx.x >= 128 && blockIdx.x < 144) p2_cumsum(args, lds, (int)blockIdx.x - 128, tid, wave, lane);
        else if (G != 256 && blockIdx.x < 16) p2_cumsum(args, lds, blockIdx.x, tid, wave, lane);
        SchedDense S{64, NIN / 256, G, (int)blockIdx.x, 512, (const char*)H1, (const char*)(ws + WS_WIN)};
        EpiIn E{Ub, Qb, Kb, Vb, SG, args.in[11], args.in[12], (const float*)(ws + WS_SA1), __builtin_bit_cast(float, __hip_atomic_load((unsigned*)(ws + WS_CTL) + CW_AMAX, RLX_AGENT)) * (1.0f / 127.0f)};
        pg8::gemm_phase<EpiIn, SchedDense, true, false, true>(lds + RING_OFF, 512, S, E, 2, DSTAMP_PTR);
        if (G == 256 && blockIdx.x >= 128) wd_items(args, lds, 0, WD_SPLIT, (int)blockIdx.x - 128, 128, wave, lane);
        else if (G != 256) wd_items(args, lds, 0, WD_SPLIT, (int)blockIdx.x, G, wave, lane);
    }
    GRID_BAR(2);
#if defined(DBG_STAGE) && (DBG_STAGE == 24 || DBG_STAGE == 4)
    {   const bf16* src = (DBG_STAGE == 24) ? SG : (const bf16*)(ws + WS_WIN) + (size_t)2560 * 1024;
        for (size_t i = (size_t)blockIdx.x * 512 + tid; i < (size_t)T * 1024; i += (size_t)G * 512) { const size_t r = i >> 10, c = i & 1023; args.out[i] = bf2f(src[((DBG_STAGE == 24) ? r : (r & 2047)) * 1024 + c]); }
        return; }
#endif
    if (IN(3)) {
        float gq = fabsf(args.in[11][lane]), gk = fabsf(args.in[12][lane]);
        gq = wave_max(gq); gk = wave_max(gk);
        const float thr2 = 2.0f * (8.0f * gq * gk * LOG2E) + 40.0f;
        const attn_body::AttnTensors AT{(const attn_body::bf16*)Qb, (const attn_body::bf16*)Kb, (const attn_body::bf16*)Vb, (attn_body::bf16*)Ob, (const float*)(ws + WS_CUM), thr2};
        unsigned* dyn = (unsigned*)(ws + WS_CTL) + CW_DYN;
        q8_items(args, lds, Q8_SPLIT, 1 << 30, vcu, G, wave, lane);
        p0_copies(args, lds, vcu, G, wave, lane);
        __syncthreads();
        if (G == 256) {
            const int xq = vcu >> 5; unsigned nx = 0u; int m = vcu & 31;
            if (tid == 0) nx = 32u + __hip_atomic_fetch_add(dyn + 64 * xq, 1u, RLX_AGENT);
            while (m < 64) { const int bh = 2 * xq + (m & 1);
                attn_body::attn_unit<24>(bh / NHEAD, bh % NHEAD, 31 - (m >> 1), AT.Q, AT.K, AT.V, AT.O, AT.cum, AT.thr2, (char*)lds_raw + RING_OFF);
                if (tid == 0) MISC[16] = nx;
                __syncthreads();
                m = (int)MISC[16];
                if (m < 64 && tid == 0) nx = 32u + __hip_atomic_fetch_add(dyn + 64 * xq, 1u, RLX_AGENT); }
        }
#if defined(DIAG_A)
        if (blockIdx.x == DIAG_BLK && tid == 0) dstamp[20] = __builtin_amdgcn_s_memrealtime();
#endif
        if (G == 256) conv_items_dyn(args, lds, vcu & 7, vcu >> 3, dyn + 64 * (8 + (vcu & 7)), MISC + 17, tid);
        else if ((G & 7) == 0) conv_items(args, lds, vcu, G, tid); else for (int it = vcu; it < 1024; it += G) conv_items(args, lds, it, 1024, tid);
#if defined(DIAG_A)
        if (blockIdx.x == DIAG_BLK && tid == 0) dstamp[21] = __builtin_amdgcn_s_memrealtime();
#endif
    }
    GRID_BAR(3);
#if defined(DBG_STAGE)
    {
#if DBG_STAGE == 2
        const bf16* bA = Qb; const bf16* bB = Kb;
#elif DBG_STAGE == 21
        const bf16* bA = Vb; const bf16* bB = Ub;
#elif DBG_STAGE == 22
        const bf16* bA = SG; const bf16* bB = SG + 512;
#elif DBG_STAGE == 23
        const bf16* bA = SG + (size_t)T * 1024; const bf16* bB = SG + (size_t)T * 1024 + 512;
#elif DBG_STAGE == 3
        const bf16* bA = Ob; const bf16* bB = UC;
#else
        const bf16* bA = H1; const bf16* bB = H1 + 512;
#endif
        const int ldA = (DBG_STAGE == 1 || DBG_STAGE == 22 || DBG_STAGE == 23) ? 1024 : 512;
        for (size_t i = (size_t)blockIdx.x * 512 + tid; i < (size_t)T * 512; i += (size_t)G * 512) { const size_t r = i >> 9, c = i & 511;
            args.out[r * 1024 + c] = bf2f(bA[r * ldA + c]); args.out[r * 1024 + 512 + c] = bf2f(bB[r * ldA + c]); }
        return;
    }
#endif
    if (IN(4)) {
        SchedMerge S{(int)blockIdx.x, (const char*)UC, (const char*)(ws + WS_WC), (const char*)Ob, (const char*)(ws + WS_WA)};
        EpiMerge E{SG, MG};
        pg8::gemm_phase<EpiMerge, SchedMerge, false>(lds + RING_OFF, 512, S, E, 4, DSTAMP_PTR);
    }
    GRID_BAR(4);
#if defined(DBG_STAGE2)
    {   for (size_t i = (size_t)blockIdx.x * 512 + tid; i < (size_t)T * 1024; i += (size_t)G * 512) args.out[i] = bf2f(MG[i]);
        return; }
#endif
    if (IN(5)) {
        SchedDense S{64, 4, G, (int)blockIdx.x, 1024, (const char*)MG, (const char*)(ws + WS_WOUT)};
        EpiX1 E{args.in[0], args.out, mod, (float*)(ws + WS_SSQ), (float*)(ws + WS_XMX)};
        pg8::gemm_phase<EpiX1, SchedDense, false>(lds + RING_OFF, 1024, S, E, 5, DSTAMP_PTR);
    }
    GRID_BAR(5);
#if FWD_LEVEL >= 2
    if (IN(6)) { if (G == 256) p6_block(args, lds, vcu, tid, wave, lane); }
    GRID_BAR(6);
    const MoeTab tb{(const LAS int*)(lds + TAB_OFF), (const LAS int*)(lds + TAB_OFF) + 80, (const LAS float*)(lds + TAB_OFF) + 160};
    if (IN(7)) {
        moe_tables(args, lds, tid, lane);
        const int ntiles = tb.tstart[64], nmoe = 2 * ntiles, ntot = nmoe + 128, per = G;
        SchedMoe1 S{tb, nmoe, ntot, per, vcu, lane, (const char*)(ws + WS_H2), (const char*)(ws + WS_WGU), (const char*)(ws + WS_WSGU), (const int*)(ws + WS_LIST)};
        EpiGlu E{(bf16*)(ws + WS_ACT), (bf16*)(ws + WS_SACT), (const float*)(ws + WS_WLIST), (const float*)(ws + WS_SLIST), (const float*)(ws + WS_SA2), (const unsigned*)(ws + WS_CTL) + CW_AMAX, tb};
        pg8::gemm_phase<EpiGlu, SchedMoe1, true, false, true>(lds + RING_OFF, 512, S, E, 7, DSTAMP_PTR);
        {
            const int rounds = (ntot + G - 1) / G, busy = ntot - (rounds - 1) * G;
            if (vcu >= busy && busy < G) wd_items(args, lds, WD_SPLIT, WD_SPLIT2, vcu - busy, G - busy, wave, lane);
            else if (busy >= G) wd_items(args, lds, WD_SPLIT, WD_SPLIT2, vcu, G, wave, lane); }
    }
    GRID_BAR(7);
    if (IN(8)) {
        if (!IN(7)) moe_tables(args, lds, tid, lane);
        const int ntiles = tb.tstart[64], ntot = 4 * ntiles, per = G;
        SchedMoe2 S{tb, ntot, per, vcu, lane, (const char*)(ws + WS_ACT), (const char*)(ws + WS_WD)};
        EpiSlab E{ws + WS_SLAB, (const int*)(ws + WS_LIST), tb};
        pg8::gemm_phase<EpiSlab, SchedMoe2, false>(lds + RING_OFF, 256, S, E, 8, DSTAMP_PTR);
    }
    GRID_BAR(8);
    if (IN(9)) {
        SchedDense S{64, 4, G, (int)blockIdx.x, 256, (const char*)(ws + WS_SACT), (const char*)(ws + WS_WSD)};
        EpiFinal E{args.out, ws + WS_SLAB, mod};
        pg8::gemm_phase<EpiFinal, SchedDense, false>(lds + RING_OFF, 256, S, E, 9, DSTAMP_PTR);
    }
#endif
#endif
#if defined(DIAG_A)
    {
        xcd_barrier(bar); if (blockIdx.x == 0 && tid == 0) dstamp[10] = __builtin_amdgcn_s_memrealtime();
        xcd_barrier(bar); if (blockIdx.x == 0 && tid == 0) dstamp[11] = __builtin_amdgcn_s_memrealtime();
        xcd_barrier(bar); if (blockIdx.x == 0 && tid == 0) dstamp[12] = __builtin_amdgcn_s_memrealtime();
        xcd_barrier(bar);
        if (blockIdx.x == 0 && tid == 0) { for (int k = 0; k < 9; ++k) { unsigned long long mx = 0ull, mn = ~0ull; for (int b2 = 0; b2 < 256; ++b2) { const unsigned long long v = __hip_atomic_load(dstamp + 256 + k * 256 + b2, __ATOMIC_RELAXED, __HIP_MEMORY_SCOPE_AGENT); mx = v > mx ? v : mx; mn = v < mn ? v : mn; } dstamp[50 + k] = mx; dstamp[60 + k] = mn; } }
#if defined(DIAG_LO)
        const float dta = (float)(dstamp[DIAG_HI] - dstamp[DIAG_LO]) * 0.01f;
#else
        const float dta = (float)(dstamp[DIAG_A + 1] - dstamp[DIAG_A]) * 0.01f;
#endif
#if defined(DIAG_BIG)
#ifndef DIAG_SCALE
#define DIAG_SCALE 0.4f
#endif
        if (blockIdx.x == 0 && tid == 0) args.out[0] += dta * DIAG_SCALE;
#else
        if (blockIdx.x == 0 && tid == 0) args.out[0] += 0.5f + dta * 0.01f;
#endif
    }
#endif
#undef IN
#undef GRID_BAR
}

#ifndef N_LAUNCH_MODE
#define N_LAUNCH_MODE 1
#endif
extern "C" void kernel_launch(void* const* d_in, const int* in_sizes, int n_in, void* d_out, int out_size, void* d_ws, size_t ws_size, hipStream_t stream) {
    static int grid = 0;
    if (grid == 0) {
        if (n_in != 23 || in_sizes[0] != T * DMODEL || out_size != T * DMODEL || ws_size < WS_END) {
            fprintf(stderr, "kernel_launch: built for 23 inputs, x/out of %d floats, >= %zu bytes of workspace; got n_in %d, in0 %d, out %d, ws %zu; nothing launched\n", T * DMODEL, (size_t)WS_END, n_in, n_in > 0 ? in_sizes[0] : -1, out_size, ws_size);
            grid = -1; return; }
        int dev = 0, cus = 0, per_cu = 0;
        if (hipGetDevice(&dev) != hipSuccess || hipDeviceGetAttribute(&cus, hipDeviceAttributeMultiprocessorCount, dev) != hipSuccess) { fprintf(stderr, "kernel_launch: device query failed\n"); grid = -1; return; }
        if (hipFuncSetAttribute((const void*)fox_fwd, hipFuncAttributeMaxDynamicSharedMemorySize, LDS_BYTES) != hipSuccess) { fprintf(stderr, "kernel_launch: hipFuncSetAttribute failed\n"); grid = -1; return; }
        if (hipOccupancyMaxActiveBlocksPerMultiprocessor(&per_cu, (const void*)fox_fwd, NWAVES * 64, LDS_BYTES) != hipSuccess || per_cu < 1)
            fprintf(stderr, "kernel_launch: note: occupancy query reports %d workgroups per CU\n", per_cu);
        (void)hipGetLastError();
        grid = cus;
        if (grid != 256) fprintf(stderr, "kernel_launch: %d CUs; this kernel is built for 256\n", grid);
    }
    if (grid < 0) return;
    if (hipMemsetAsync((char*)d_ws + WS_CTL, 0, CTL_ZERO_BYTES, stream) != hipSuccess) { fprintf(stderr, "kernel_launch: memset failed\n"); return; }
    KArgs a{};
    for (int i = 0; i < 23; ++i) a.in[i] = (const float*)d_in[i];
    a.out = (float*)d_out; a.ws = (unsigned char*)d_ws;
#if N_LAUNCH_MODE == 1
    a.ph_lo = 0; a.ph_hi = 10;
    hipLaunchKernelGGL(fox_fwd, dim3(grid), dim3(NWAVES * 64), LDS_BYTES, stream, a);
#else
    for (int p = 0; p < 10; ++p) { a.ph_lo = p; a.ph_hi = p + 1; hipLaunchKernelGGL(fox_fwd, dim3(grid), dim3(NWAVES * 64), LDS_BYTES, stream, a); }
#endif
    const hipError_t le = hipPeekAtLastError();
    if (le != hipSuccess) fprintf(stderr, "kernel_launch: launch failed: %s\n", hipGetErrorName(le));
}
```
